# Optimizing an MI355X kernel written in HIP

```python
import math
import jax
import jax.numpy as jnp
from jax import lax
import numpy as np

D_MODEL = 1024
BATCH = 8
SEQ = 2048
DEPTH = 2

GRID_W = 64
CTX_LEN = 256
D_MIX = D_MODEL

ML_HEADS = 4
ML_DH = 64
ML_W = ML_HEADS * ML_DH
ML_CHUNK = 64
ML_CONV = 3
ML_M_INIT = -1e30
ML_COLS = 4 * ML_W + 4 * ML_HEADS

RW_HEADS = 6
RW_DH = 64
RW_W = RW_HEADS * RW_DH
RW_W_LORA = 64
RW_A_LORA = 64
RW_G_LORA = 128
RW_DECAY_SCALE = math.exp(-0.5)
RW_GN_EPS = 64e-5
RW_COLS = 3 * RW_W + 2 * RW_W_LORA + 2 * RW_A_LORA + RW_G_LORA

MLA_HEADS = 6
MLA_NOPE = 64
MLA_ROPE = 32
MLA_V = 64
MLA_Q_RANK = 384
MLA_KV_RANK = 256
MLA_W = MLA_HEADS * MLA_V
MLA_Q_BLOCK = 128
MLA_COLS = MLA_Q_RANK + MLA_KV_RANK + MLA_ROPE
MLA_SCALE = (MLA_NOPE + MLA_ROPE) ** -0.5
ROPE_AXIS_FREQS = MLA_ROPE // 4
ROPE_THETA = 10000.0

N_IN = ML_COLS + RW_COLS + MLA_COLS

PEER_HEADS = 8
PEER_NKEYS = 128
PEER_EXPERTS = PEER_NKEYS * PEER_NKEYS
PEER_DK = 128
PEER_TOPK = 16
PEER_CHUNK = 128

DEEPNORM_ALPHA = (2 * DEPTH) ** 0.25
DEEPNORM_BETA = (8 * DEPTH) ** -0.25
LN_EPS = 1e-6

kernel_name = 'hybrid_dit_mlstm_rwkv7_mla_peer'


def _ln(x, eps=LN_EPS):
    xf = x.astype(jnp.float32)
    mu = jnp.mean(xf, axis=-1, keepdims=True)
    var = jnp.mean(jnp.square(xf - mu), axis=-1, keepdims=True)
    return (xf - mu) * lax.rsqrt(var + eps)


def _ln_affine(x, g, b):
    return (_ln(x) * g + b).astype(x.dtype)


def _rms(x, g):
    xf = x.astype(jnp.float32)
    return (xf * lax.rsqrt(jnp.mean(jnp.square(xf), axis=-1, keepdims=True) + LN_EPS) * g).astype(x.dtype)


def _modulate(x, shift, scale):
    return (_ln(x) * (1.0 + scale) + shift).astype(x.dtype)


def _split(a, sizes):
    return jnp.split(a, [int(s) for s in np.cumsum(sizes)[:-1]], axis=-1)


def _heads(a, n_heads):
    b, t, _ = a.shape
    return a.reshape(b, t, n_heads, -1).transpose(0, 2, 1, 3)


def _merge_heads(a):
    b, h, t, d = a.shape
    return a.transpose(0, 2, 1, 3).reshape(b, t, h * d)


def _shift3(x):
    xp = jnp.pad(x, ((0, 0), (1, 1), (0, 0)))
    return xp[:, :-2], xp[:, 2:]


def _flip_if(a, rev, axis):
    return jnp.flip(a, axis=axis) if rev else a


def _mlstm_scan(q, k, v, li, lf, state):
    b, h, t, d = q.shape
    nc = t // ML_CHUNK

    def chunks(a):
        return jnp.moveaxis(a.reshape((b, h, nc, ML_CHUNK) + a.shape[3:]), 2, 0)

    causal = jnp.tril(jnp.ones((ML_CHUNK, ML_CHUNK), dtype=bool))

    def step(carry, inp):
        C, n, m = carry
        qc, kc, vc, ic, fc = inp
        bcum = jnp.cumsum(fc, axis=-1)
        a_inter = bcum + m[..., None]
        dmat = jnp.where(causal, bcum[..., :, None] - bcum[..., None, :] + ic[..., None, :], -jnp.inf)
        m_t = jnp.maximum(a_inter, jnp.max(dmat, axis=-1))
        w_inter = jnp.exp(a_inter - m_t)
        s = jnp.einsum('bhtd,bhsd->bhts', qc, kc) * jnp.exp(dmat - m_t[..., None])
        num = w_inter[..., None] * jnp.einsum('bhed,bhtd->bhte', C, qc) + jnp.einsum('bhts,bhse->bhte', s, vc)
        den = w_inter * jnp.einsum('bhd,bhtd->bht', n, qc) + jnp.sum(s, axis=-1)
        h_out = num / jnp.maximum(jnp.abs(den), jnp.exp(-m_t))[..., None]
        b_end = bcum[..., -1]
        g = b_end[..., None] - bcum + ic
        m_new = jnp.maximum(b_end + m, jnp.max(g, axis=-1))
        decay = jnp.exp(b_end + m - m_new)
        wk = jnp.exp(g - m_new[..., None])
        C = decay[..., None, None] * C + jnp.einsum('bhs,bhse,bhsd->bhed', wk, vc, kc)
        n = decay[..., None] * n + jnp.einsum('bhs,bhsd->bhd', wk, kc)
        return (C, n, m_new), h_out

    state, hs = lax.scan(step, state, tuple(chunks(a) for a in (q, k, v, li, lf)))
    return jnp.moveaxis(hs, 0, 2).reshape(b, h, t, d), state


def _mlstm_prep(p, conv_w, conv_b, i_bias, f_bias):
    b, t, _ = p.shape
    qk, v, o, gates = _split(p, [2 * ML_W, ML_W, ML_W, 4 * ML_HEADS])
    prev, nxt = _shift3(qk)
    qk = jax.nn.silu(prev * conv_w[0] + qk * conv_w[1] + nxt * conv_w[2] + conv_b)
    q, k = jnp.split(qk, 2, axis=-1)
    q = _heads(q, ML_HEADS).astype(jnp.float32) * ML_DH ** -0.5
    k = _heads(k, ML_HEADS).astype(jnp.float32)
    v = _heads(v, ML_HEADS).astype(jnp.float32)
    gates = gates.astype(jnp.float32).reshape(b, t, 2, 2, ML_HEADS).transpose(2, 3, 0, 4, 1)
    li = gates[:, 0] + i_bias[:, None, :, None]
    lf = jax.nn.log_sigmoid(gates[:, 1] + f_bias[:, None, :, None])
    return q, k, v, o, li, lf


def _mlstm_out(h, o, norm_g):
    return (jax.nn.sigmoid(o.astype(jnp.float32)) * _merge_heads(_ln(h)) * norm_g).astype(o.dtype)


def _mlstm_mixer(p_ctx, p_lat, ml, need_ctx):
    conv_w, conv_b, i_bias, f_bias, norm_g = ml
    qc, kc, vc, oc, lic, lfc = _mlstm_prep(p_ctx, conv_w, conv_b, i_bias, f_bias)
    ql, kl, vl, ol, lil, lfl = _mlstm_prep(p_lat, conv_w, conv_b, i_bias, f_bias)
    b = p_lat.shape[0]
    init = (jnp.zeros((b, ML_HEADS, ML_DH, ML_DH), jnp.float32),
            jnp.zeros((b, ML_HEADS, ML_DH), jnp.float32),
            jnp.full((b, ML_HEADS), ML_M_INIT, jnp.float32))
    h_ctx = 0.0
    h_lat = 0.0
    for dr in range(2):
        rev = dr == 1
        f = lambda a: _flip_if(a, rev, 2)
        hc, st = _mlstm_scan(f(qc), f(kc), f(vc), f(lic[dr]), f(lfc[dr]), init)
        hl, _ = _mlstm_scan(f(ql), f(kl), f(vl), f(lil[dr]), f(lfl[dr]), st)
        h_lat = h_lat + f(hl)
        if need_ctx:
            h_ctx = h_ctx + f(hc)
    y_ctx = _mlstm_out(h_ctx, oc, norm_g) if need_ctx else None
    return y_ctx, _mlstm_out(h_lat, ol, norm_g)


def _rwkv_prep(p, mu, w0, w_up, a0, a_up, g_up, k_k, k_a):
    b, t, _ = p.shape
    prev, nxt = _shift3(p)
    p = p + mu[0] * (prev - p) + mu[1] * (nxt - p)
    r, k, v, wd, ad, gd = _split(p, [RW_W, RW_W, RW_W, 2 * RW_W_LORA, 2 * RW_A_LORA, RW_G_LORA])
    lora = lambda z, up: jnp.einsum('btdr,drc->btdc', z.reshape(b, t, 2, -1), up)
    w = jnp.exp(-RW_DECAY_SCALE * jax.nn.sigmoid((w0 + lora(jnp.tanh(wd), w_up)).astype(jnp.float32)))
    a = jax.nn.sigmoid((a0 + lora(ad, a_up)).astype(jnp.float32))
    g = jax.nn.sigmoid(gd) @ g_up
    k = k.astype(jnp.float32)
    kk = (k * k_k).reshape(b, t, RW_HEADS, RW_DH)
    kh = (kk * lax.rsqrt(jnp.sum(kk * kk, axis=-1, keepdims=True) + 1e-12)).reshape(b, t, RW_W)
    kt = k[:, :, None] * (1.0 + (a - 1.0) * k_a)
    ab = kh[:, :, None] * a
    tm1 = lambda z: z.reshape(b, t, RW_HEADS, RW_DH).transpose(1, 0, 2, 3).astype(jnp.float32)
    tm2 = lambda z: z.reshape(b, t, 2, RW_HEADS, RW_DH).transpose(2, 1, 0, 3, 4)
    return tm1(r), tm1(kh), tm1(v), tm2(w), tm2(ab), tm2(kt), g


def _rwkv_scan(r, w, kh, ab, v, kt, s0):
    def step(S, inp):
        r_t, w_t, kh_t, ab_t, v_t, kt_t = inp
        sa = jnp.einsum('bhvk,bhk->bhv', S, kh_t)
        S = S * w_t[..., None, :] - sa[..., None] * ab_t[..., None, :] + v_t[..., None] * kt_t[..., None, :]
        return S, jnp.einsum('bhvk,bhk->bhv', S, r_t)
    return lax.scan(step, s0, (r, w, kh, ab, v, kt))


def _rwkv_out(y, bonus, g, gn_g, gn_b):
    t, b = y.shape[:2]
    merge = lambda z: z.transpose(1, 0, 2, 3).reshape(b, t, RW_W)
    z = merge(_ln(y, RW_GN_EPS)) * gn_g + gn_b + merge(bonus)
    return (z * g).astype(g.dtype)


def _rwkv_mixer(p_ctx, p_lat, rw, need_ctx):
    mu, w0, w_up, a0, a_up, g_up, k_k, k_a, r_k, gn_g, gn_b = rw
    sc = _rwkv_prep(p_ctx, mu, w0, w_up, a0, a_up, g_up, k_k, k_a)
    sl = _rwkv_prep(p_lat, mu, w0, w_up, a0, a_up, g_up, k_k, k_a)
    rho = r_k.reshape(RW_HEADS, RW_DH).astype(jnp.float32)
    s0 = jnp.zeros((p_lat.shape[0], RW_HEADS, RW_DH, RW_DH), jnp.float32)

    def run(s, dr, s_init):
        r, kh, v, w, ab, kt, _ = s
        rev = dr == 1
        f = lambda a: _flip_if(a, rev, 0)
        s_fin, y = _rwkv_scan(f(r), f(w[dr]), f(kh), f(ab[dr]), f(v), f(kt[dr]), s_init)
        bonus = jnp.sum(r * rho * kt[dr], axis=-1, keepdims=True) * v
        return s_fin, f(y), bonus

    y_c = b_c = y_l = b_l = 0.0
    for dr in range(2):
        s_c, yc, bc = run(sc, dr, s0)
        _, yl, bl = run(sl, dr, s_c)
        y_l = y_l + yl
        b_l = b_l + bl
        if need_ctx:
            y_c = y_c + yc
            b_c = b_c + bc
    y_ctx = _rwkv_out(y_c, b_c, sc[6], gn_g, gn_b) if need_ctx else None
    return y_ctx, _rwkv_out(y_l, b_l, sl[6], gn_g, gn_b)


def _rope2d(x, ang):
    xf = x.astype(jnp.float32).reshape(x.shape[:-1] + (2, MLA_ROPE // 2))
    x1, x2 = jnp.split(xf, 2, axis=-1)
    cos = jnp.cos(ang)[None, :, None]
    sin = jnp.sin(ang)[None, :, None]
    out = jnp.concatenate([x1 * cos - x2 * sin, x2 * cos + x1 * sin], axis=-1)
    return out.reshape(x.shape).astype(x.dtype)


def _mla_prep(p, q_norm_g, q_up, kv_norm_g, kv_up, ang):
    b, t, _ = p.shape
    cq, ckv, k_rope = _split(p, [MLA_Q_RANK, MLA_KV_RANK, MLA_ROPE])
    q = (_rms(cq, q_norm_g) @ q_up).reshape(b, t, MLA_HEADS, MLA_NOPE + MLA_ROPE)
    kv = (_rms(ckv, kv_norm_g) @ kv_up).reshape(b, t, MLA_HEADS, MLA_NOPE + MLA_V)
    q_nope, q_rope = jnp.split(q, [MLA_NOPE], axis=-1)
    k_nope, v = jnp.split(kv, [MLA_NOPE], axis=-1)
    k_rope = k_rope[:, :, None, :]
    if ang is not None:
        q_rope = _rope2d(q_rope, ang)
        k_rope = _rope2d(k_rope, ang)
    k_rope = jnp.broadcast_to(k_rope, (b, t, MLA_HEADS, MLA_ROPE))
    return (jnp.concatenate([q_nope, q_rope], axis=-1),
            jnp.concatenate([k_nope, k_rope], axis=-1), v)


def _attend(q, k, v):
    s = jnp.einsum('bqhd,bkhd->bhqk', q, k).astype(jnp.float32) * MLA_SCALE
    pr = jax.nn.softmax(s, axis=-1).astype(v.dtype)
    return jnp.einsum('bhqk,bkhd->bqhd', pr, v)


def _mla_mixer(p_ctx, p_lat, mla, ang, need_ctx):
    q_norm_g, q_up, kv_norm_g, kv_up = mla
    qc, kc, vc = _mla_prep(p_ctx, q_norm_g, q_up, kv_norm_g, kv_up, None)
    ql, kl, vl = _mla_prep(p_lat, q_norm_g, q_up, kv_norm_g, kv_up, ang)
    b, t = ql.shape[:2]
    k_all = jnp.concatenate([kl, kc], axis=1)
    v_all = jnp.concatenate([vl, vc], axis=1)
    nb = t // MLA_Q_BLOCK
    qb = jnp.moveaxis(ql.reshape(b, nb, MLA_Q_BLOCK, MLA_HEADS, -1), 1, 0)
    ol = lax.map(lambda qi: _attend(qi, k_all, v_all), qb)
    y_lat = jnp.moveaxis(ol, 0, 1).reshape(b, t, MLA_W)
    y_ctx = _attend(qc, kc, vc).reshape(b, p_ctx.shape[1], MLA_W) if need_ctx else None
    return y_ctx, y_lat


def _hybrid_mixer(h_ctx, h_lat, ang, need_ctx, w_in, w_out, ml, rw, mla):
    pc_ml, pc_rw, pc_at = _split(h_ctx @ w_in, [ML_COLS, RW_COLS, MLA_COLS])
    pl_ml, pl_rw, pl_at = _split(h_lat @ w_in, [ML_COLS, RW_COLS, MLA_COLS])
    ml_c, ml_l = _mlstm_mixer(pc_ml, pl_ml, ml, need_ctx)
    rw_c, rw_l = _rwkv_mixer(pc_rw, pl_rw, rw, need_ctx)
    at_c, at_l = _mla_mixer(pc_at, pl_at, mla, ang, need_ctx)
    y_lat = jnp.concatenate([ml_l, rw_l, at_l], axis=-1) @ w_out
    y_ctx = jnp.concatenate([ml_c, rw_c, at_c], axis=-1) @ w_out if need_ctx else None
    return y_ctx, y_lat


def _peer(h, w_q, keys, u_tab, v_tab):
    n, d = h.shape

    def chunk(hc):
        tc = hc.shape[0]
        q = (hc @ w_q).reshape(tc, PEER_HEADS, 2, PEER_DK)
        s = jnp.einsum('thpd,hpkd->thpk', q, keys).astype(jnp.float32)
        s1, i1 = lax.top_k(s[:, :, 0], PEER_TOPK)
        s2, i2 = lax.top_k(s[:, :, 1], PEER_TOPK)
        cand = (s1[..., :, None] + s2[..., None, :]).reshape(tc, PEER_HEADS, PEER_TOPK * PEER_TOPK)
        cid = (i1[..., :, None] * PEER_NKEYS + i2[..., None, :]).reshape(tc, PEER_HEADS, PEER_TOPK * PEER_TOPK)
        best, pos = lax.top_k(cand, PEER_TOPK)
        eid = jnp.take_along_axis(cid, pos, axis=-1).reshape(tc, PEER_HEADS * PEER_TOPK)
        gate = jax.nn.softmax(best, axis=-1).reshape(tc, PEER_HEADS * PEER_TOPK)
        act = jax.nn.gelu(jnp.einsum('ted,td->te', u_tab[eid], hc).astype(jnp.float32))
        return jnp.einsum('te,ted->td', (gate * act).astype(hc.dtype), v_tab[eid])

    out = lax.map(chunk, h.reshape(n // PEER_CHUNK, PEER_CHUNK, d))
    return out.reshape(n, d)


def setup_inputs(seed: int = 0) -> dict:
    key = jax.random.key(seed)
    ks = iter(jax.random.split(key, 40))
    nrm = lambda shape, s: jax.random.normal(next(ks), shape, jnp.float32) * s
    uni = lambda shape, lo, hi: jax.random.uniform(next(ks), shape, jnp.float32, lo, hi)
    L, D = DEPTH, D_MODEL
    return {
        'x': nrm((BATCH, SEQ, D), 1.0),
        'c': nrm((BATCH, D), 1.0),
        'ctx': nrm((BATCH, CTX_LEN, D), 1.0),
        'c_ctx': nrm((D,), 1.0),
        'w_mod': nrm((L, D, 6 * D), 0.5 * D ** -0.5),
        'b_mod': nrm((L, 6 * D), 0.02),
        'w_in': nrm((L, D, N_IN), D ** -0.5),
        'ml_conv_w': nrm((L, ML_CONV, 2 * ML_W), ML_CONV ** -0.5),
        'ml_conv_b': nrm((L, 2 * ML_W), 0.02),
        'ml_i_bias': nrm((L, 2, ML_HEADS), 0.1),
        'ml_f_bias': uni((L, 2, ML_HEADS), 3.0, 6.0),
        'ml_norm_g': 1.0 + nrm((L, ML_W), 0.02),
        'rw_mu': uni((L, 2, RW_COLS), 0.0, 0.5),
        'rw_w0': uni((L, 2, RW_W), -6.0, -1.0),
        'rw_w_up': nrm((L, 2, RW_W_LORA, RW_W), 0.1),
        'rw_a0': nrm((L, 2, RW_W), 0.1),
        'rw_a_up': nrm((L, 2, RW_A_LORA, RW_W), 0.1),
        'rw_g_up': nrm((L, RW_G_LORA, RW_W), RW_G_LORA ** -0.5),
        'rw_k_k': 0.85 + nrm((L, RW_W), 0.02),
        'rw_k_a': 1.0 + nrm((L, RW_W), 0.02),
        'rw_r_k': nrm((L, RW_W), 0.1),
        'rw_gn_g': 1.0 + nrm((L, RW_W), 0.02),
        'rw_gn_b': nrm((L, RW_W), 0.02),
        'mla_q_norm_g': 1.0 + nrm((L, MLA_Q_RANK), 0.02),
        'mla_q_up': nrm((L, MLA_Q_RANK, MLA_HEADS * (MLA_NOPE + MLA_ROPE)), MLA_Q_RANK ** -0.5),
        'mla_kv_norm_g': 1.0 + nrm((L, MLA_KV_RANK), 0.02),
        'mla_kv_up': nrm((L, MLA_KV_RANK, MLA_HEADS * (MLA_NOPE + MLA_V)), MLA_KV_RANK ** -0.5),
        'w_out': nrm((L, D_MIX, D), DEEPNORM_BETA * D_MIX ** -0.5),
        'ln_mix_g': 1.0 + nrm((L, D), 0.02),
        'ln_mix_b': nrm((L, D), 0.02),
        'peer_w_q': nrm((L, D, PEER_HEADS * 2 * PEER_DK), D ** -0.5),
        'peer_keys': nrm((L, PEER_HEADS, 2, PEER_NKEYS, PEER_DK), PEER_DK ** -0.5),
        'peer_u': nrm((L, PEER_EXPERTS, D), D ** -0.5),
        'peer_v': nrm((L, PEER_EXPERTS, D), DEEPNORM_BETA),
        'ln_ffn_g': 1.0 + nrm((L, D), 0.02),
        'ln_ffn_b': nrm((L, D), 0.02),
    }


def reference(x, c, ctx, c_ctx, w_mod, b_mod, w_in, ml_conv_w, ml_conv_b, ml_i_bias, ml_f_bias, ml_norm_g,
              rw_mu, rw_w0, rw_w_up, rw_a0, rw_a_up, rw_g_up, rw_k_k, rw_k_a, rw_r_k, rw_gn_g, rw_gn_b,
              mla_q_norm_g, mla_q_up, mla_kv_norm_g, mla_kv_up, w_out, ln_mix_g, ln_mix_b,
              peer_w_q, peer_keys, peer_u, peer_v, ln_ffn_g, ln_ffn_b):
    b, t, d = x.shape
    n_ctx = ctx.shape[1]
    ROWS = t // GRID_W
    row = jnp.repeat(jnp.arange(ROWS), GRID_W)
    col = jnp.tile(jnp.arange(GRID_W), ROWS)
    inv_freq = ROPE_THETA ** (-jnp.arange(ROPE_AXIS_FREQS, dtype=jnp.float32) / ROPE_AXIS_FREQS)
    ang = jnp.stack([row[:, None] * inv_freq, col[:, None] * inv_freq], axis=1)

    s_ctx = ctx
    for l in range(DEPTH):
        need_ctx = l < DEPTH - 1
        sh_a, sc_a, g_a, sh_f, sc_f, g_f = jnp.split((jax.nn.silu(c) @ w_mod[l] + b_mod[l])[:, None, :], 6, axis=-1)
        csh_a, csc_a, cg_a, csh_f, csc_f, cg_f = jnp.split(jax.nn.silu(c_ctx) @ w_mod[l] + b_mod[l], 6, axis=-1)
        ml = (ml_conv_w[l], ml_conv_b[l], ml_i_bias[l], ml_f_bias[l], ml_norm_g[l])
        rw = (rw_mu[l], rw_w0[l], rw_w_up[l], rw_a0[l], rw_a_up[l], rw_g_up[l], rw_k_k[l], rw_k_a[l],
              rw_r_k[l], rw_gn_g[l], rw_gn_b[l])
        mla = (mla_q_norm_g[l], mla_q_up[l], mla_kv_norm_g[l], mla_kv_up[l])

        y_c, y_l = _hybrid_mixer(_modulate(s_ctx, csh_a, csc_a), _modulate(x, sh_a, sc_a), ang, need_ctx,
                                 w_in[l], w_out[l], ml, rw, mla)
        x = _ln_affine(DEEPNORM_ALPHA * x + g_a * y_l, ln_mix_g[l], ln_mix_b[l])
        h_l = _modulate(x, sh_f, sc_f).reshape(b * t, d)

        if need_ctx:
            s_ctx = _ln_affine(DEEPNORM_ALPHA * s_ctx + cg_a * y_c, ln_mix_g[l], ln_mix_b[l])
            h_c = _modulate(s_ctx, csh_f, csc_f).reshape(b * n_ctx, d)
            y = _peer(jnp.concatenate([h_c, h_l], axis=0), peer_w_q[l], peer_keys[l], peer_u[l], peer_v[l])
            y_c = y[: b * n_ctx].reshape(b, n_ctx, d)
            y_l = y[b * n_ctx:].reshape(b, t, d)
            s_ctx = _ln_affine(DEEPNORM_ALPHA * s_ctx + cg_f * y_c, ln_ffn_g[l], ln_ffn_b[l])
        else:
            y_l = _peer(h_l, peer_w_q[l], peer_keys[l], peer_u[l], peer_v[l]).reshape(b, t, d)
        x = _ln_affine(DEEPNORM_ALPHA * x + g_f * y_l, ln_ffn_g[l], ln_ffn_b[l])
    return x
```

```cpp
#include <hip/hip_runtime.h>
#include <hip/hip_cooperative_groups.h>
namespace cg = cooperative_groups;

#ifndef MULTI_LAUNCH
#define MULTI_LAUNCH 0
#endif

#ifndef REPSET
#define REPSET 0
#endif
#define DEV __device__ __forceinline__
#define LAS __attribute__((address_space(3)))
typedef unsigned short bf16_t;
typedef short bf16x8 __attribute__((ext_vector_type(8)));
typedef float f32x4 __attribute__((ext_vector_type(4)));
typedef float f32x2 __attribute__((ext_vector_type(2)));
typedef float f32x16 __attribute__((ext_vector_type(16)));
typedef unsigned u32x4 __attribute__((ext_vector_type(4)));
typedef unsigned u32x2 __attribute__((ext_vector_type(2)));

constexpr int NTOK = 18432, NCTXR = 2048, NLAT = 16384, DM = 1024;
constexpr int NIN = 3248, NINP = 3328;
constexpr float ALPHA = 1.41421356237f;
constexpr float LN_EPS = 1e-6f;
constexpr int NTHREADS = 512;
constexpr size_t LDS_BYTES = 160 * 1024;
#if REPSET == 5
__device__ constexpr int REPS[11] = {1, 1, 2, 1, 1, 1, 1, 1, 1, 1, 1};
#elif REPSET == 6
__device__ constexpr int REPS[11] = {1, 1, 1, 1, 1, 1, 1, 1, 1, 2, 1};
#elif REPSET == 7
__device__ constexpr int REPS[11] = {2, 1, 1, 1, 1, 2, 1, 1, 1, 1, 1};
#elif REPSET == 13
__device__ constexpr int REPS[11] = {1, 2, 1, 1, 1, 1, 1, 1, 1, 1, 1};
#elif REPSET == 14
__device__ constexpr int REPS[11] = {1, 1, 1, 1, 1, 1, 2, 1, 2, 1, 1};
#else
__device__ constexpr int REPS[11] = {1, 1, 1, 1, 1, 1, 1, 1, 1, 1, 1};
#endif
constexpr bool FP4_EMU = REPSET == 30;
constexpr int PM_REP = REPSET == 20 ? 2 : 1, PF_REP = REPSET == 21 ? 2 : 1, T1_REP = REPSET == 22 ? 2 : 1, T2_REP = REPSET == 23 ? 2 : 1, T3_REP = REPSET == 24 ? 2 : 1;
constexpr int GREP = REPSET == 8 ? 2 : 1, XBAR = REPSET == 9 ? 20 : 0, RWREP = REPSET == 10 ? 2 : 1, ATREP = REPSET == 11 ? 2 : 1, MLREP = REPSET == 12 ? 2 : 1;

enum { I_X = 0, I_C, I_CTX, I_CCTX, I_WMOD, I_BMOD, I_WIN, I_MLCW, I_MLCB, I_MLIB, I_MLFB, I_MLNG, I_RWMU, I_RWW0, I_RWWUP, I_RWA0, I_RWAUP,
       I_RWGUP, I_RWKK, I_RWKA, I_RWRK, I_RWGNG, I_RWGNB, I_QNG, I_QUP, I_KVNG, I_KVUP, I_WOUT, I_LNMG, I_LNMB, I_PWQ, I_PKEYS, I_PU, I_PV, I_LNFG, I_LNFB, N_INPUTS };

constexpr size_t A256(size_t x) { return (x + 255) & ~size_t(255); }
constexpr size_t SZ_WIN = 2ull * NINP * 1024 * 2, SZ_WOUT = 2ull * 1024 * 1024 * 2, SZ_WPQ = 2ull * 2048 * 1024 * 2, SZ_WLORA = 2ull * 2048 * 384 * 2,
                 SZ_WQUP = 2ull * 768 * 384 * 2, SZ_WKVUP = 2ull * 768 * 256 * 2, SZ_KEYS = 2ull * 16 * 128 * 128 * 2, SZ_MOD = 2ull * 9 * 6144 * 4, SZ_CNT = 4096 + 16384  ;
constexpr size_t OFF_WIN = 0, OFF_WOUT = OFF_WIN + SZ_WIN, OFF_WPQ = OFF_WOUT + SZ_WOUT, OFF_WLORA = OFF_WPQ + SZ_WPQ, OFF_WQUP = OFF_WLORA + SZ_WLORA,
                 OFF_WKVUP = OFF_WQUP + SZ_WQUP, OFF_KEYS = OFF_WKVUP + SZ_WKVUP, OFF_MOD = OFF_KEYS + SZ_KEYS, OFF_CNT = OFF_MOD + SZ_MOD;
constexpr size_t OFF_CTXX = A256(OFF_CNT + SZ_CNT);
constexpr size_t OFF_H = OFF_CTXX + 2048ull * 1024 * 4;
constexpr size_t OFF_P = OFF_H + (size_t)NTOK * 1024 * 2;
constexpr size_t SZ_P = (size_t)NTOK * NIN * 2;
constexpr size_t OFF_TABU = OFF_P, OFF_TABV = OFF_TABU + 16384ull * 1024, OFF_RWY = OFF_TABV + 16384ull * 1024;
constexpr size_t OFF_BAR = OFF_CNT + 4096;
static_assert(OFF_RWY + 2ull * NTOK * 384 * 2 <= OFF_P + SZ_P, "P region overflow");
constexpr size_t OFF_BS = OFF_P + 96ull * 1024 * 1024;
static_assert(OFF_BS >= OFF_RWY + 2ull * NTOK * 384 * 2 && OFF_BS + 2ull * NTOK * 6 * 4 <= OFF_P + SZ_P, "BS placement");
constexpr size_t SZ_R1 = (size_t)NTOK * 384 * 2;
constexpr size_t OFF_R = OFF_P + SZ_P;
constexpr size_t OFF_RB = OFF_R, OFF_KB = OFF_RB + SZ_R1, OFF_KH = OFF_KB + SZ_R1, OFF_VB = OFF_KH + SZ_R1, OFF_LORA = OFF_VB + SZ_R1  ,
                 OFF_ZB = OFF_LORA + 5 * SZ_R1;
constexpr size_t SZ_R = 10 * SZ_R1;
constexpr size_t OFF_Y = OFF_R, OFF_QP = OFF_R;
static_assert((size_t)NTOK * 1024 * 4 <= SZ_R && (size_t)NTOK * 2048 * 2 <= SZ_R, "R region overflow");
constexpr size_t OFF_A = OFF_R + SZ_R;
constexpr size_t OFF_CQN = OFF_A, OFF_CKVN = OFF_CQN + (size_t)NTOK * 384 * 2, OFF_QB = OFF_CKVN + (size_t)NTOK * 256 * 2,
                 OFF_KV = OFF_QB + (size_t)NTOK * 576 * 2  , OFF_KR = OFF_KV + (size_t)NTOK * 768 * 2  ,
                 OFF_AEND = OFF_KR + (size_t)NTOK * 32 * 2;
constexpr size_t OFF_EID = OFF_A, OFF_GATE = OFF_EID + (size_t)NTOK * 128 * 4;
static_assert(OFF_GATE + (size_t)NTOK * 128 * 4 <= OFF_QB, "EID/GATE overflow");
constexpr size_t OFF_M = OFF_AEND;
constexpr size_t SZ_M1 = (size_t)NTOK * 256 * 2;
constexpr size_t OFF_MQ = OFF_M, OFF_MK = OFF_MQ + SZ_M1, OFF_MVT = OFF_MK + SZ_M1, OFF_MO = OFF_MVT + SZ_M1, OFF_GLI = OFF_MO + SZ_M1,
                 OFF_GLF = OFF_GLI + 8ull * NTOK * 4, OFF_ST = OFF_GLF + 8ull * NTOK * 4, OFF_SCM = OFF_ST + 2304ull * 5120 * 2,
                 OFF_SCB = OFF_SCM + 2304 * 4, OFF_SCMB = OFF_SCB + 2304 * 4, OFF_END = A256(OFF_SCMB + 2304 * 4);
constexpr size_t OFF_XC = OFF_END;
constexpr size_t WS_NEEDED = OFF_XC + (size_t)NTOK * 1024 * 2;
static_assert(WS_NEEDED <= 512ull * 1024 * 1024, "workspace budget");

struct Params {
  const float* in[N_INPUTS];
  float* out;
  unsigned char* ws;
};
typedef const __attribute__((address_space(4))) Params CParams;

DEV int TIDX() { int t = (int)__builtin_amdgcn_workitem_id_x(); asm volatile("" : "+v"(t)); return t; }
DEV float bf2f(bf16_t b) { return __uint_as_float(((unsigned)b) << 16); }
DEV bf16_t f2bf(float f) { unsigned u = __float_as_uint(f); u += 0x7FFFu + ((u >> 16) & 1u); return (bf16_t)(u >> 16); }
typedef __bf16 bf16v2_t __attribute__((ext_vector_type(2)));
DEV unsigned pack2(float lo, float hi) { return __builtin_bit_cast(unsigned, __builtin_convertvector((f32x2){lo, hi}, bf16v2_t)); }
DEV float lo16(unsigned w) { return __uint_as_float(w << 16); }
DEV float hi16(unsigned w) { return __uint_as_float(w & 0xffff0000u); }
DEV void unpack8(u32x4 w, float* f) { f[0] = lo16(w[0]); f[1] = hi16(w[0]); f[2] = lo16(w[1]); f[3] = hi16(w[1]); f[4] = lo16(w[2]); f[5] = hi16(w[2]); f[6] = lo16(w[3]); f[7] = hi16(w[3]); }
DEV u32x4 pack8(const float* f) { u32x4 w; w[0] = pack2(f[0], f[1]); w[1] = pack2(f[2], f[3]); w[2] = pack2(f[4], f[5]); w[3] = pack2(f[6], f[7]); return w; }
DEV float sigmoidf_(float x) { return __builtin_amdgcn_rcpf(1.0f + __expf(-x)); }
DEV float siluf_(float x) { return x * __builtin_amdgcn_rcpf(1.0f + __expf(-x)); }
template <int CTRL> DEV float dppf(float x) { return __builtin_bit_cast(float, __builtin_amdgcn_mov_dpp(__builtin_bit_cast(int, x), CTRL, 0xf, 0xf, true)); }
template <int CTRL> DEV float dpp_upd(float old, float x) { return __builtin_bit_cast(float, __builtin_amdgcn_update_dpp(__builtin_bit_cast(int, old), __builtin_bit_cast(int, x), CTRL, 0xf, 0xf, false)); }
DEV float rdlane(float v, int l) { return __builtin_bit_cast(float, __builtin_amdgcn_readlane(__builtin_bit_cast(int, v), l)); }
DEV float bperm(int srclane, float v) { return __builtin_bit_cast(float, __builtin_amdgcn_ds_bpermute(srclane << 2, __builtin_bit_cast(int, v))); }
DEV float row16_max(float x) { x = fmaxf(x, dppf<0x128>(x)); x = fmaxf(x, dppf<0x124>(x)); x = fmaxf(x, dppf<0x122>(x)); x = fmaxf(x, dppf<0x121>(x)); return x; }
DEV float grp8_sum(float x) { x += dppf<0xB1>(x); x += dppf<0x4E>(x); x += dppf<0x141>(x); return x; }
DEV float scan_sum64(float x, int lane) {
  x += dpp_upd<0x111>(0.f, x); x += dpp_upd<0x112>(0.f, x); x += dpp_upd<0x114>(0.f, x); x += dpp_upd<0x118>(0.f, x);
  const float t0 = rdlane(x, 15), t1 = rdlane(x, 31), t2 = rdlane(x, 47); const int r = lane >> 4;
  return x + (r == 0 ? 0.f : r == 1 ? t0 : r == 2 ? t0 + t1 : t0 + t1 + t2); }
DEV float scan_max64(float x, int lane) {
  const float NI = -3.0e38f;
  x = fmaxf(x, dpp_upd<0x111>(NI, x)); x = fmaxf(x, dpp_upd<0x112>(NI, x)); x = fmaxf(x, dpp_upd<0x114>(NI, x)); x = fmaxf(x, dpp_upd<0x118>(NI, x));
  const float t0 = rdlane(x, 15), t1 = rdlane(x, 31), t2 = rdlane(x, 47); const int r = lane >> 4;
  return fmaxf(x, r == 0 ? NI : r == 1 ? t0 : r == 2 ? fmaxf(t0, t1) : fmaxf(fmaxf(t0, t1), t2)); }
DEV float row16_sum(float x) { x += dppf<0x128>(x); x += dppf<0x124>(x); x += dppf<0x122>(x); x += dppf<0x121>(x); return x; }
DEV float wave_sum(float v) { v = row16_sum(v); return (rdlane(v, 0) + rdlane(v, 16)) + (rdlane(v, 32) + rdlane(v, 48)); }
DEV float wave_max(float v) { v = row16_max(v); return fmaxf(fmaxf(rdlane(v, 0), rdlane(v, 16)), fmaxf(rdlane(v, 32), rdlane(v, 48))); }
DEV float xhalf_sum(float x) { auto rr = __builtin_amdgcn_permlane32_swap(__float_as_uint(x), __float_as_uint(x), false, false); return __uint_as_float(rr[0]) + __uint_as_float(rr[1]); }
DEV float xhalf_max(float x) { auto rr = __builtin_amdgcn_permlane32_swap(__float_as_uint(x), __float_as_uint(x), false, false); return fmaxf(__uint_as_float(rr[0]), __uint_as_float(rr[1])); }

DEV int modrow_of(int row) { return row < NCTXR ? 8 : ((row - NCTXR) >> 11); }

#define XB_TMO      128
#define XB_XCNT(j)  (256  + 64 * (j))
#define XB_XSUB(j)  (1280 + 64 * (j))
#define XB_XGEN(j)  (2304 + 64 * (j))
#define XB_TOP      3328
#define XB_TOPGEN   3392
#define XCD_BAR_WORDS 3456
#define XB_SPIN_CAP (1u << 20)
DEV unsigned xb_ld(unsigned* p) { return __hip_atomic_load(p, __ATOMIC_RELAXED, __HIP_MEMORY_SCOPE_AGENT); }
DEV unsigned xb_add(unsigned* p, unsigned v) { return __hip_atomic_fetch_add(p, v, __ATOMIC_RELAXED, __HIP_MEMORY_SCOPE_AGENT); }
DEV unsigned xb_xcc_id() { return (unsigned)__builtin_amdgcn_s_getreg((3 << 11) | 20) & 0xFu; }
#define XB_SPIN(cond, bar) do { unsigned _sp = 0; while (cond) { __builtin_amdgcn_s_sleep(1); \
    if ((++_sp & 255u) == 0u) { if (xb_ld(&(bar)[XB_TMO])) break; if (_sp > XB_SPIN_CAP) { atomicAdd(&(bar)[XB_TMO], 1u); break; } } } } while (0)
DEV void xcd_barrier_post(unsigned* bar) { if (TIDX() == 0) (void)xb_add(&bar[XB_XCNT(xb_xcc_id())], 1u); }
DEV void xcd_barrier_complete(unsigned* bar, unsigned x, unsigned& nloc, unsigned& nx) {
  const unsigned G = gridDim.x; unsigned sum, cnt, mine, sp = 0u;
  for (;;) { sum = 0u; cnt = 0u; mine = 0u;
#pragma unroll
    for (unsigned j = 0; j < 16; ++j) { const unsigned c = xb_ld(&bar[XB_XCNT(j)]); sum += c; cnt += (c > 0u) ? 1u : 0u; mine = (j == x) ? c : mine; }
    if (sum == G) break;
    __builtin_amdgcn_s_sleep(1);
    if ((++sp & 255u) == 0u) { if (xb_ld(&bar[XB_TMO])) break; if (sp > XB_SPIN_CAP) { atomicAdd(&bar[XB_TMO], 1u); break; } } }
  nloc = mine > 0u ? mine : 1u; nx = cnt > 0u ? cnt : 1u;
}
DEV void xcd_barrier(unsigned* bar, volatile LAS unsigned* st) {
  asm volatile("s_waitcnt vmcnt(0)" ::: "memory");
  __syncthreads();
  if (TIDX() == 0) {
    const unsigned x = xb_xcc_id();
    __builtin_amdgcn_s_waitcnt(0);
    unsigned nloc = st[0], nx = st[1];
    if (nloc == 0u) { xcd_barrier_complete(bar, x, nloc, nx); st[0] = nloc; st[1] = nx; }
    const unsigned old = xb_add(&bar[XB_XSUB(x)], 1u);
    const unsigned gen = old / nloc;
    if (old + 1u == (gen + 1u) * nloc) {
      __builtin_amdgcn_fence(__ATOMIC_RELEASE, "agent");
      asm volatile("s_waitcnt vmcnt(0)" ::: "memory");
      const unsigned og = xb_add(&bar[XB_TOP], 1u);
      const unsigned tg = og / nx;
      if (og + 1u == (tg + 1u) * nx) xb_add(&bar[XB_TOPGEN], 1u);
      else XB_SPIN(xb_ld(&bar[XB_TOPGEN]) == tg, bar);
      __builtin_amdgcn_fence(__ATOMIC_ACQUIRE, "agent");
      xb_add(&bar[XB_XGEN(x)], 1u);
      asm volatile("s_waitcnt vmcnt(0)" ::: "memory");
    } else {
      XB_SPIN(xb_ld(&bar[XB_XGEN(x)]) == gen, bar);
      __builtin_amdgcn_fence(__ATOMIC_ACQUIRE, "agent");
      asm volatile("s_waitcnt vmcnt(0)" ::: "memory");
    }
  }
  __syncthreads();
}

namespace pg8 {
constexpr int BM = 256, BK = 64, HALF = 128, HTB = HALF * BK * 2, STAGE_BYTES = 8 * HTB, NXCD = 8, WGM = 8;
DEV int lds_byte(int r, int c) { const int st = (r >> 4) * 2 + (c >> 5), rr = r & 15, cc = c & 31, ob = rr * 64 + cc * 2; return st * 1024 + (ob ^ (((ob >> 9) & 1) << 5)); }
DEV void stage_rc(int b, int& R, int& C) { const int st = b / 1024, sb = b % 1024, swz = sb ^ (((sb >> 9) & 1) << 5); R = (st >> 1) * 16 + swz / 64; C = (st & 1) * 32 + (swz % 64) / 2; }
DEV int perm32(int rho) { const int n = rho >> 4, i = rho & 15; return 8 * (i >> 2) + 4 * n + (i & 3); }
struct Unit { int pm, pn; };
struct Gemm { const bf16_t* A; const bf16_t* Bt; int M, N, K; };
struct StaticOrder {
  int nM, nN, nwg, G, c;
  DEV void init(int M, int N, int G_, int c_) { nM = M / BM; nN = N / BM; nwg = nM * nN; G = G_; c = c_; }
  DEV bool next(int i, Unit& u) const {
    const long L = (long)i * G + c; if (L >= nwg) return false;
    int wgid = (int)L; { const int q = nwg / NXCD, r = nwg % NXCD, xcd = wgid % NXCD, off = wgid / NXCD; wgid = (xcd < r ? xcd * (q + 1) : r * (q + 1) + (xcd - r) * q) + off; }
    const int nig = WGM * nN, gid = wgid / nig, fm = gid * WGM, gsz = (nM - fm) < WGM ? (nM - fm) : WGM;
    u.pm = fm + ((wgid % nig) % gsz); u.pn = (wgid % nig) / gsz; return true;
  }
};
struct OneUnit { bool has; Unit u0; DEV bool next(int i, Unit& u) const { if (i == 0 && has) { u = u0; return true; } return false; } };
template <class Epi, class Ord>
DEV void gemm_phase(LAS unsigned char* lds, const Gemm g, const Ord& S, const Epi& E) {
  const int tid = TIDX(), wid = __builtin_amdgcn_readfirstlane(tid >> 6), lane = tid & 63, wr = wid >> 2, wc = wid & 3, fr = lane & 15, fq = lane >> 4;
  const int K = g.K, nt = K / BK;
  unsigned voffA[2], voffB[2];
#pragma unroll
  for (int i = 0; i < 2; ++i) { int R, C; stage_rc(tid * 16 + i * 8192, R, C); const int Rb = Epi::PERM ? ((R & ~31) + perm32(R & 31)) : R;
    voffA[i] = (unsigned)(R * K + C) * 2u; voffB[i] = (unsigned)(Rb * K + C) * 2u; }
  const size_t kstep = (size_t)(BK * 2);
  const size_t hstep = (size_t)HALF * K * 2;
  const size_t tstep = 2 * hstep;
  const unsigned ldsw = (unsigned)wid * 1024u;
  const int aoff = lds_byte(wr * 64 + fr, fq * 8), boff = lds_byte(wc * 32 + fr, fq * 8);
#define PG8_SA(b, h) (((b) * 2 + (h)) * HTB)
#define PG8_SB(b, h) ((4 + (b) * 2 + (h)) * HTB)
#define PG8_STAGE(bufoff, gbase, voff) do { _Pragma("unroll") for (int _i = 0; _i < 2; ++_i) \
        __builtin_amdgcn_global_load_lds((const unsigned*)((const char*)(gbase) + (voff)[_i]), (LAS unsigned*)(lds + (bufoff) + ldsw + _i * 8192), 16, 0, 0); } while (0)
#define PG8_LDA(dst, b, h) do { _Pragma("unroll") for (int m = 0; m < 4; ++m) _Pragma("unroll") for (int k = 0; k < 2; ++k) dst[m][k] = *(const LAS bf16x8*)(lds + PG8_SA(b, h) + aoff + m * 2048 + k * 1024); } while (0)
#define PG8_LDB(dst, b, h) do { _Pragma("unroll") for (int n = 0; n < 2; ++n) _Pragma("unroll") for (int k = 0; k < 2; ++k) dst[n][k] = *(const LAS bf16x8*)(lds + PG8_SB(b, h) + boff + n * 2048 + k * 1024); } while (0)
#define PG8_MMA(ai, bj, At, Bt) do { __builtin_amdgcn_s_setprio(1); _Pragma("unroll") for (int m = 0; m < 4; ++m) _Pragma("unroll") for (int n = 0; n < 2; ++n) _Pragma("unroll") for (int k = 0; k < 2; ++k) \
        acc[ai][bj][m][n] = __builtin_amdgcn_mfma_f32_16x16x32_bf16(Bt[n][k], At[m][k], acc[ai][bj][m][n], 0, 0, 0); __builtin_amdgcn_s_setprio(0); } while (0)
#define PG8_WAIT_V(n) asm volatile("s_waitcnt vmcnt(" #n ")" ::: "memory")
#define PG8_WAIT_L(n) asm volatile("s_waitcnt lgkmcnt(" #n ")" ::: "memory")
#define PG8_BAR __builtin_amdgcn_s_barrier()
#define PG8_SCHED __builtin_amdgcn_sched_barrier(0)
  Unit cur, nxt; int ui = 0;
  if (!S.next(0, cur)) return;
  f32x4 acc[2][2][4][2];
#pragma unroll
  for (int a = 0; a < 2; ++a)
#pragma unroll
    for (int b = 0; b < 2; ++b)
#pragma unroll
      for (int m = 0; m < 4; ++m)
#pragma unroll
        for (int n = 0; n < 2; ++n) acc[a][b][m][n] = (f32x4){0.f, 0.f, 0.f, 0.f};
  bf16x8 At[4][2], B0[2][2], B1[2][2];
  const char* cA = (const char*)g.A + (size_t)cur.pm * tstep; const char* cB = (const char*)g.Bt + (size_t)cur.pn * tstep;
  PG8_STAGE(PG8_SB(0, 0), cB, voffB); PG8_STAGE(PG8_SA(0, 0), cA, voffA); PG8_STAGE(PG8_SB(0, 1), cB + hstep, voffB); PG8_STAGE(PG8_SA(0, 1), cA + hstep, voffA);
  if (wr == 1) PG8_BAR;
  PG8_WAIT_V(4); PG8_BAR;
  PG8_STAGE(PG8_SB(1, 0), cB + kstep, voffB); PG8_STAGE(PG8_SA(1, 0), cA + kstep, voffA); PG8_STAGE(PG8_SB(1, 1), cB + hstep + kstep, voffB);
  PG8_WAIT_V(6); PG8_BAR;
  for (;;) {
    const bool has_next = S.next(ui + 1, nxt);
    const char* nA = has_next ? (const char*)g.A + (size_t)nxt.pm * tstep : cA; const char* nB = has_next ? (const char*)g.Bt + (size_t)nxt.pn * tstep : cB;
    for (int t = 0; t < nt; t += 2) {
      const bool last = (t == nt - 2);
      const char* a1 = cA + (size_t)(t + 1) * kstep;
      const char* a2 = last ? nA : cA + (size_t)(t + 2) * kstep; const char* b2 = last ? nB : cB + (size_t)(t + 2) * kstep;
      const char* a3 = a2 + kstep; const char* b3 = b2 + kstep;
      PG8_LDB(B0, 0, 0); PG8_SCHED; PG8_LDA(At, 0, 0); PG8_STAGE(PG8_SA(1, 1), a1 + hstep, voffA);
      PG8_WAIT_L(8); PG8_BAR; PG8_WAIT_L(0); PG8_MMA(0, 0, At, B0); PG8_BAR; PG8_SCHED;
      PG8_LDB(B1, 0, 1); PG8_STAGE(PG8_SB(0, 0), b2, voffB);
      PG8_BAR; PG8_WAIT_L(0); PG8_MMA(0, 1, At, B1); PG8_BAR;
      PG8_LDA(At, 0, 1); PG8_STAGE(PG8_SA(0, 0), a2, voffA);
      PG8_BAR; PG8_WAIT_L(0); PG8_MMA(1, 0, At, B0); PG8_BAR; PG8_SCHED;
      PG8_STAGE(PG8_SB(0, 1), b2 + hstep, voffB);
      PG8_WAIT_V(6); PG8_BAR; PG8_MMA(1, 1, At, B1); PG8_BAR;
      PG8_LDB(B0, 1, 0); PG8_SCHED; PG8_LDA(At, 1, 0); PG8_STAGE(PG8_SA(0, 1), a2 + hstep, voffA);
      PG8_WAIT_L(8); PG8_BAR; PG8_WAIT_L(0); PG8_MMA(0, 0, At, B0); PG8_BAR; PG8_SCHED;
      PG8_LDB(B1, 1, 1); PG8_STAGE(PG8_SB(1, 0), b3, voffB);
      PG8_BAR; PG8_WAIT_L(0); PG8_MMA(0, 1, At, B1); PG8_BAR;
      PG8_LDA(At, 1, 1); PG8_STAGE(PG8_SA(1, 0), a3, voffA);
      PG8_BAR; PG8_WAIT_L(0); PG8_MMA(1, 0, At, B0); PG8_BAR; PG8_SCHED;
      PG8_STAGE(PG8_SB(1, 1), b3 + hstep, voffB);
      PG8_WAIT_V(6); PG8_BAR; PG8_MMA(1, 1, At, B1); PG8_BAR;
    }
    E(acc, cur, wr, wc, fr, fq);
    if (!has_next) break;
#pragma unroll
    for (int a = 0; a < 2; ++a)
#pragma unroll
      for (int b = 0; b < 2; ++b)
#pragma unroll
        for (int m = 0; m < 4; ++m)
#pragma unroll
          for (int n = 0; n < 2; ++n) acc[a][b][m][n] = (f32x4){0.f, 0.f, 0.f, 0.f};
    cur = nxt; cA = nA; cB = nB; ++ui;
  }
  PG8_WAIT_V(0);
  if (wr == 0) PG8_BAR;
  PG8_BAR;
#undef PG8_SA
#undef PG8_SB
#undef PG8_STAGE
#undef PG8_LDA
#undef PG8_LDB
#undef PG8_MMA
#undef PG8_WAIT_V
#undef PG8_WAIT_L
#undef PG8_BAR
#undef PG8_SCHED
}
}
using pg8::Unit;
typedef f32x4 AccT[2][2][4][2];

struct EpiBf16 {
  static constexpr bool PERM = true;
  bf16_t* O; int ldc; int ncols;
  DEV void operator()(const AccT& acc, const Unit& u, int wr, int wc, int fr, int fq) const {
    { const int t_ = TIDX(); fr = t_ & 15; fq = (t_ >> 4) & 3; }
    const int row0 = u.pm * 256 + wr * 64 + fr, col0 = u.pn * 256 + wc * 32 + 8 * fq;
#pragma unroll
    for (int ai = 0; ai < 2; ++ai)
#pragma unroll
      for (int m = 0; m < 4; ++m) { bf16_t* rowp = O + (size_t)(row0 + ai * 128 + m * 16) * ldc;
#pragma unroll
        for (int bj = 0; bj < 2; ++bj) { const int col = col0 + bj * 128; if (col < ncols) {
          const f32x4 v0 = acc[ai][bj][m][0], v1 = acc[ai][bj][m][1];
          u32x4 w; w[0] = pack2(v0[0], v0[1]); w[1] = pack2(v0[2], v0[3]); w[2] = pack2(v1[0], v1[1]); w[3] = pack2(v1[2], v1[3]);
          *(u32x4*)(rowp + col) = w; } } }
  }
};
struct EpiF32 {
  static constexpr bool PERM = false;
  float* C; int ldc;
  DEV void operator()(const AccT& acc, const Unit& u, int wr, int wc, int fr, int fq) const {
    { const int t_ = TIDX(); fr = t_ & 15; fq = (t_ >> 4) & 3; }
    const int row0 = u.pm * 256 + wr * 64 + fr, col0 = u.pn * 256 + wc * 32 + 4 * fq;
#pragma unroll
    for (int ai = 0; ai < 2; ++ai)
#pragma unroll
      for (int m = 0; m < 4; ++m) { float* rowp = C + (size_t)(row0 + ai * 128 + m * 16) * ldc + col0;
#pragma unroll
        for (int bj = 0; bj < 2; ++bj)
#pragma unroll
          for (int n = 0; n < 2; ++n) *(f32x4*)(rowp + bj * 128 + n * 16) = acc[ai][bj][m][n]; }
  }
};

#define WS(T, off) ((T*)(p.ws + (off)))
DEV const float* x_in_row(CParams& p, int row) { return row < NCTXR ? p.in[I_CTX] + (size_t)row * DM : p.in[I_X] + (size_t)(row - NCTXR) * DM; }
DEV float* x_cur_row(CParams& p, int row) { return row < NCTXR ? WS(float, OFF_CTXX) + (size_t)row * DM : p.out + (size_t)(row - NCTXR) * DM; }

DEV void tr_tile(const float* __restrict__ src, bf16_t* __restrict__ dst, int K, int N, int nt, int kt, float* tile) {
  const int tid = TIDX();
  { const int r = tid >> 4, c4 = (tid & 15) * 4;
#pragma unroll
    for (int i = 0; i < 2; ++i) { const int k = kt * 64 + r + 32 * i, n = nt * 64 + c4;
      f32x4 v = {0.f, 0.f, 0.f, 0.f}; if (n < N) v = *(const f32x4*)(src + (size_t)k * N + n);
      float* tp = tile + (r + 32 * i) * 65 + c4; tp[0] = v[0]; tp[1] = v[1]; tp[2] = v[2]; tp[3] = v[3]; } }
  __syncthreads();
  { const int n = tid >> 3, k8 = (tid & 7) * 8; float f[8];
#pragma unroll
    for (int j = 0; j < 8; ++j) f[j] = tile[(k8 + j) * 65 + n];
    *(u32x4*)(dst + (size_t)(nt * 64 + n) * K + kt * 64 + k8) = pack8(f); }
  __syncthreads();
}
DEV void mod_unit(CParams& p, int l, int cgp, float* lds) {
  float* sc = lds; float* red = lds + 9 * 1024;
  const int tid = TIDX();
  for (int i = tid; i < 9 * 1024; i += NTHREADS) { const int r = i >> 10, k = i & 1023; const float cv = r < 8 ? p.in[I_C][r * 1024 + k] : p.in[I_CCTX][k]; sc[i] = siluf_(cv); }
  __syncthreads();
  const int kg = tid >> 6, cl = tid & 63, col = cgp * 64 + cl;
  float acc[9];
#pragma unroll
  for (int r = 0; r < 9; ++r) acc[r] = 0.f;
  const float* w = p.in[I_WMOD] + (size_t)l * 1024 * 6144 + col;
  for (int k = kg * 128; k < kg * 128 + 128; ++k) { const float wv = w[(size_t)k * 6144];
#pragma unroll
    for (int r = 0; r < 9; ++r) acc[r] += sc[r * 1024 + k] * wv; }
#pragma unroll
  for (int r = 0; r < 9; ++r) red[(kg * 9 + r) * 64 + cl] = acc[r];
  __syncthreads();
  for (int o = tid; o < 9 * 64; o += NTHREADS) { const int r = o >> 6, c2 = o & 63; float s = 0.f;
    for (int g = 0; g < 8; ++g) s += red[(g * 9 + r) * 64 + c2];
    WS(float, OFF_MOD)[(size_t)(l * 9 + r) * 6144 + cgp * 64 + c2] = s + p.in[I_BMOD][l * 6144 + cgp * 64 + c2]; }
  __syncthreads();
}
DEV void ph_init(CParams& p, unsigned char* lds) {
  const int tid = TIDX(), nb = gridDim.x;
  if (blockIdx.x == 0 && tid < 64) WS(unsigned, OFF_CNT)[tid] = 0u;
  const int tcount[5] = {(NINP / 64) * 16, 16 * 16, 32 * 16, 12 * 6, 12 * 4};
  const int tl = tcount[0] + tcount[1] + tcount[2] + tcount[3] + tcount[4];
  const int total = 192 + 2 * tl;
  for (int u = blockIdx.x; u < total; u += nb) {
    if (u < 192) { mod_unit(p, u / 96, u % 96, (float*)lds); continue; }
    int v = u - 192; const int l = v / tl; v -= l * tl;
    if (v < tcount[0]) { tr_tile(p.in[I_WIN] + (size_t)l * 1024 * NIN, WS(bf16_t, OFF_WIN) + (size_t)l * NINP * 1024, 1024, NIN, v / 16, v % 16, (float*)lds); continue; }
    v -= tcount[0];
    if (v < tcount[1]) { tr_tile(p.in[I_WOUT] + (size_t)l * 1024 * 1024, WS(bf16_t, OFF_WOUT) + (size_t)l * 1024 * 1024, 1024, 1024, v / 16, v % 16, (float*)lds); continue; }
    v -= tcount[1];
    if (v < tcount[2]) { tr_tile(p.in[I_PWQ] + (size_t)l * 1024 * 2048, WS(bf16_t, OFF_WPQ) + (size_t)l * 2048 * 1024, 1024, 2048, v / 16, v % 16, (float*)lds); continue; }
    v -= tcount[2];
    if (v < tcount[3]) { tr_tile(p.in[I_QUP] + (size_t)l * 384 * 576, WS(bf16_t, OFF_WQUP) + (size_t)l * 768 * 384, 384, 576, v / 6, v % 6, (float*)lds); continue; }
    v -= tcount[3];
    tr_tile(p.in[I_KVUP] + (size_t)l * 256 * 768, WS(bf16_t, OFF_WKVUP) + (size_t)l * 768 * 256, 256, 768, v / 4, v % 4, (float*)lds);
  }
  const size_t gtid = (size_t)blockIdx.x * NTHREADS + tid, gsz = (size_t)nb * NTHREADS;
  for (size_t i = gtid; i < 2ull * 2048 * 384; i += gsz) {
    const int l = (int)(i / (2048 * 384)); const int rem = (int)(i % (2048 * 384)); const int n = rem / 384, k = rem % 384;
    float v = 0.f;
    if (n < 1920) { const int grp = n / 384, cc = n % 384;
      if (grp < 2) { if ((k >> 6) == grp) v = p.in[I_RWWUP][((size_t)(l * 2 + grp) * 64 + (k & 63)) * 384 + cc]; }
      else if (grp < 4) { if ((k >> 6) == grp) v = p.in[I_RWAUP][((size_t)(l * 2 + grp - 2) * 64 + (k & 63)) * 384 + cc]; }
      else { if (k >= 256) v = p.in[I_RWGUP][((size_t)l * 128 + (k - 256)) * 384 + cc]; } }
    WS(bf16_t, OFF_WLORA)[i] = f2bf(v);
  }
  for (size_t i = gtid; i < 2ull * 16 * 128 * 128; i += gsz) WS(bf16_t, OFF_KEYS)[i] = f2bf(p.in[I_PKEYS][i]);
}

DEV void ph_lnmod(CParams& p, int l) {
  const int lane = TIDX() & 63, per = (NTOK + (int)gridDim.x - 1) / (int)gridDim.x, r0 = (int)blockIdx.x * per, r1 = r0 + per < NTOK ? r0 + per : NTOK;
  for (int row = r0 + (TIDX() >> 6); row < r1; row += 8) {
    const float* xr = x_in_row(p, row); f32x4 v[4]; float s = 0.f;
#pragma unroll
    for (int i = 0; i < 4; ++i) { v[i] = *(const f32x4*)(xr + lane * 4 + 256 * i); s += (v[i][0] + v[i][1]) + (v[i][2] + v[i][3]); }
    const float mean = wave_sum(s) * (1.f / 1024.f); float q = 0.f;
#pragma unroll
    for (int i = 0; i < 4; ++i) { v[i] -= mean; q += (v[i][0] * v[i][0] + v[i][1] * v[i][1]) + (v[i][2] * v[i][2] + v[i][3] * v[i][3]); }
    const float rstd = rsqrtf(wave_sum(q) * (1.f / 1024.f) + LN_EPS);
    const float* md = WS(float, OFF_MOD) + (size_t)(l * 9 + modrow_of(row)) * 6144;
#pragma unroll
    for (int i = 0; i < 4; ++i) { const int col = lane * 4 + 256 * i; const f32x4 sh = *(const f32x4*)(md + col), sc = *(const f32x4*)(md + 1024 + col);
      const f32x4 o = v[i] * rstd * (sc + 1.f) + sh; u32x2 w; w[0] = pack2(o[0], o[1]); w[1] = pack2(o[2], o[3]);
      *(u32x2*)(WS(bf16_t, OFF_H) + (size_t)row * 1024 + col) = w; }
  }
}

struct ChunkInfo { int row0, b, cseq, T, t0; bool isctx; };
DEV ChunkInfo chunk_info(int chunk) { ChunkInfo c; c.row0 = chunk * 64; c.isctx = chunk < 32;
  if (c.isctx) { c.b = chunk >> 2; c.cseq = chunk & 3; c.T = 256; } else { const int lc = chunk - 32; c.b = lc >> 5; c.cseq = lc & 31; c.T = 2048; }
  c.t0 = c.cseq * 64; return c; }
DEV int ml_pc(const ChunkInfo& c, int dir) { return dir == 0 ? (c.isctx ? c.cseq : 4 + c.cseq) : (c.isctx ? 3 - c.cseq : 4 + (31 - c.cseq)); }
DEV u32x4 ld8g(const bf16_t* ptr) { return *(const u32x4*)ptr; }

DEV void prep_mlstm(CParams& p, int l, const ChunkInfo& c, int chunk, int hd, unsigned char* lds) {
  bf16_t* VTl = (bf16_t*)lds;
  bf16_t* KWl = (bf16_t*)(lds + 10880);
  float* wkl = (float*)(lds + 10880 + 17408);
  const bf16_t* pb = WS(bf16_t, OFF_P);
  const int tid = TIDX(), lane = tid & 63, wid = tid >> 6;
  if (tid < 128) {
    const int dir = tid >> 6, s = lane, row = c.row0 + s;
    const float gi = bf2f(pb[(size_t)row * NIN + 1024 + dir * 8 + hd]) + p.in[I_MLIB][l * 8 + dir * 4 + hd];
    const float gf = bf2f(pb[(size_t)row * NIN + 1024 + dir * 8 + 4 + hd]) + p.in[I_MLFB][l * 8 + dir * 4 + hd];
    const float lf = fminf(gf, 0.f) - log1pf(__expf(-fabsf(gf)));
    WS(float, OFF_GLI)[(size_t)(dir * 4 + hd) * NTOK + row] = gi; WS(float, OFF_GLF)[(size_t)(dir * 4 + hd) * NTOK + row] = lf;
    const float incl = scan_sum64(lf, lane);
    const float total = rdlane(incl, 63);
    const float g = (dir == 0 ? total - incl : incl - lf) + gi;
    const float mloc = wave_max(g);
    wkl[dir * 64 + s] = __expf(g - mloc);
    if (s == 0) { const int chain = dir * 32 + c.b * 4 + hd, pc = ml_pc(c, dir); WS(float, OFF_SCM)[chain * 36 + pc] = mloc; WS(float, OFF_SCB)[chain * 36 + pc] = total; }
  }
  __syncthreads();
  { const int s = tid >> 3, d0 = (tid & 7) * 8, row = c.row0 + s, t = c.t0 + s;
    const bool hp = t > 0, hn = t < c.T - 1;
    const float* cw = p.in[I_MLCW] + l * 3 * 512; const float* cb = p.in[I_MLCB] + l * 512;
    const u32x4 z4 = {0u, 0u, 0u, 0u};
    float qk[2][8];
#pragma unroll
    for (int which = 0; which < 2; ++which) { const int col = which * 256 + hd * 64 + d0; const bf16_t* pr = pb + (size_t)row * NIN + col;
      float cur[8], prv[8], nxt[8]; unpack8(ld8g(pr), cur); unpack8(hp ? ld8g(pr - NIN) : z4, prv); unpack8(hn ? ld8g(pr + NIN) : z4, nxt);
#pragma unroll
      for (int i = 0; i < 8; ++i) { const int j = col + i; const float x = prv[i] * cw[j] + cur[i] * cw[512 + j] + nxt[i] * cw[1024 + j] + cb[j]; qk[which][i] = siluf_(x); } }
#pragma unroll
    for (int i = 0; i < 8; ++i) qk[0][i] *= 0.125f;
    *(u32x4*)(WS(bf16_t, OFF_MQ) + (size_t)row * 256 + hd * 64 + d0) = pack8(qk[0]);
    *(u32x4*)(WS(bf16_t, OFF_MK) + (size_t)row * 256 + hd * 64 + d0) = pack8(qk[1]);
    const float w0 = wkl[s], w1 = wkl[64 + s];
#pragma unroll
    for (int i = 0; i < 8; ++i) { KWl[(0 * 64 + d0 + i) * 68 + s] = f2bf(qk[1][i] * w0); KWl[(1 * 64 + d0 + i) * 68 + s] = f2bf(qk[1][i] * w1); }
    const u32x4 vv = ld8g(pb + (size_t)row * NIN + 512 + hd * 64 + d0);
#pragma unroll
    for (int i = 0; i < 4; ++i) { VTl[(d0 + 2 * i) * 68 + s] = (bf16_t)(vv[i] & 0xffffu); VTl[(d0 + 2 * i + 1) * 68 + s] = (bf16_t)(vv[i] >> 16); }
    *(u32x4*)(WS(bf16_t, OFF_MO) + (size_t)row * 256 + hd * 64 + d0) = ld8g(pb + (size_t)row * NIN + 768 + hd * 64 + d0);
    if (tid < 64) VTl[64 * 68 + tid] = (bf16_t)0x3F80u;
    for (int i = tid; i < 15 * 68; i += NTHREADS) VTl[65 * 68 + i] = 0;
  }
  __syncthreads();
  { const int e = tid >> 3, sseg = (tid & 7) * 8; const u32x2 a = *(const u32x2*)(VTl + e * 68 + sseg), b2 = *(const u32x2*)(VTl + e * 68 + sseg + 4);
    u32x4 w; w[0] = a[0]; w[1] = a[1]; w[2] = b2[0]; w[3] = b2[1];
    *(u32x4*)(WS(bf16_t, OFF_MVT) + ((size_t)(chunk * 4 + hd) * 64 + e) * 64 + sseg) = w; }
  { const int fr = lane & 15, fq = lane >> 4;
#pragma unroll 1
    for (int ti = 0; ti < 5; ++ti) { const int id = wid * 5 + ti, dir = id / 20, et = (id % 20) >> 2, dt = id & 3;
      f32x4 acc = {0.f, 0.f, 0.f, 0.f};
#pragma unroll
      for (int ks = 0; ks < 2; ++ks) {
        const bf16_t* ap = VTl + (et * 16 + fr) * 68 + ks * 32 + fq * 8; const bf16_t* bp = KWl + (dir * 64 + dt * 16 + fr) * 68 + ks * 32 + fq * 8;
        u32x4 aw, bw; { const u32x2 x0 = *(const u32x2*)ap, x1 = *(const u32x2*)(ap + 4); aw[0] = x0[0]; aw[1] = x0[1]; aw[2] = x1[0]; aw[3] = x1[1]; }
        { const u32x2 x0 = *(const u32x2*)bp, x1 = *(const u32x2*)(bp + 4); bw[0] = x0[0]; bw[1] = x0[1]; bw[2] = x1[0]; bw[3] = x1[1]; }
        acc = __builtin_amdgcn_mfma_f32_16x16x32_bf16(__builtin_bit_cast(bf16x8, aw), __builtin_bit_cast(bf16x8, bw), acc, 0, 0, 0); }
      const int chain = dir * 32 + c.b * 4 + hd, pc = ml_pc(c, dir);
      bf16_t* st = WS(bf16_t, OFF_ST) + (size_t)(chain * 36 + pc) * 5120;
#pragma unroll
      for (int j = 0; j < 4; ++j) st[(et * 16 + fq * 4 + j) * 64 + dt * 16 + fr] = f2bf(acc[j]); }
  }
  __syncthreads();
}

DEV float tanh_fast(float x) { return 1.f - 2.f * __builtin_amdgcn_rcpf(1.f + __expf(2.f * x)); }
DEV void prep_rwkv_flat(CParams& p, int l) {
  const bf16_t* pb = WS(bf16_t, OFF_P); const float* mu = p.in[I_RWMU] + l * 3072;
  const int lane = TIDX() & 63, wid = TIDX() >> 6;
  const int per = (NTOK + (int)gridDim.x - 1) / (int)gridDim.x, pw = (per + 7) / 8;
  const int rA = (int)blockIdx.x * per + wid * pw; int rB = rA + pw; { const int re = (int)blockIdx.x * per + per; if (rB > re) rB = re; if (rB > NTOK) rB = NTOK; }
  if (rA >= rB) return;
  const u32x4 z4 = {0u, 0u, 0u, 0u};
  u32x4 prv[3], cur[3], nxt[3];
#pragma unroll
  for (int st = 0; st < 3; ++st) { const bf16_t* pr = pb + (size_t)rA * NIN + 1040 + (st * 64 + lane) * 8; cur[st] = ld8g(pr); prv[st] = rA > 0 ? ld8g(pr - NIN) : z4; }
#pragma unroll 1
  for (int row = rA; row < rB; ++row) {
    int t, T; if (row < NCTXR) { t = row & 255; T = 256; } else { t = (row - NCTXR) & 2047; T = 2048; }
#pragma unroll
    for (int st = 0; st < 3; ++st) nxt[st] = row + 1 < NTOK ? ld8g(pb + (size_t)(row + 1) * NIN + 1040 + (st * 64 + lane) * 8) : z4;
    const bool hp = t > 0, hn = t < T - 1;
#pragma unroll
    for (int st = 0; st < 3; ++st) { const int seg = st * 64 + lane, col = seg * 8;
      float c[8], pv[8], nx[8], x[8]; unpack8(cur[st], c); unpack8(hp ? prv[st] : z4, pv); unpack8(hn ? nxt[st] : z4, nx);
#pragma unroll
      for (int i = 0; i < 8; ++i) x[i] = c[i] + mu[col + i] * (pv[i] - c[i]) + mu[1536 + col + i] * (nx[i] - c[i]);
      if (st == 0 && lane < 48) *(u32x4*)(WS(bf16_t, OFF_RB) + (size_t)row * 384 + col) = pack8(x);
      if ((st == 0 && lane >= 48) || (st == 1 && lane < 32)) { const int kc = (seg - 48) * 8; float kk[8], ss = 0.f;
#pragma unroll
        for (int i = 0; i < 8; ++i) { kk[i] = x[i] * p.in[I_RWKK][l * 384 + kc + i]; ss += kk[i] * kk[i]; }
        ss = grp8_sum(ss);
        *(u32x4*)(WS(bf16_t, OFF_KB) + (size_t)row * 384 + kc) = pack8(x); const float inv = rsqrtf(ss + 1e-12f);
#pragma unroll
        for (int i = 0; i < 8; ++i) kk[i] *= inv;
        *(u32x4*)(WS(bf16_t, OFF_KH) + (size_t)row * 384 + kc) = pack8(kk); }
      if ((st == 1 && lane >= 32) || (st == 2 && lane < 16)) *(u32x4*)(WS(bf16_t, OFF_VB) + (size_t)row * 384 + (seg - 96) * 8) = pack8(x);
      if (st == 2 && lane >= 16) { const int zc = (seg - 144) * 8;
        if (zc < 128) { for (int i = 0; i < 8; ++i) x[i] = tanh_fast(x[i]); } else if (zc >= 256) { for (int i = 0; i < 8; ++i) x[i] = sigmoidf_(x[i]); }
        *(u32x4*)(WS(bf16_t, OFF_ZB) + (size_t)row * 384 + zc) = pack8(x); }
      prv[st] = cur[st]; cur[st] = nxt[st]; }
  }
}
DEV void prep_mla_flat(CParams& p, int l) {
  const bf16_t* pb = WS(bf16_t, OFF_P); const int tid = TIDX(), lane = tid & 63, gw = (int)blockIdx.x * 8 + (tid >> 6), nw = (int)gridDim.x * 8;
#pragma unroll 3
  for (int row = gw; row < NTOK; row += nw) { const bool isctx = row < NCTXR; const int t = isctx ? (row & 255) : ((row - NCTXR) & 2047); const bf16_t* pr = pb + (size_t)row * NIN;
    { float v[8]; float ss = 0.f; if (lane < 48) { unpack8(ld8g(pr + 2576 + lane * 8), v); for (int i = 0; i < 8; ++i) ss += v[i] * v[i]; }
      const float inv = rsqrtf(wave_sum(ss) * (1.f / 384.f) + LN_EPS);
      if (lane < 48) { for (int i = 0; i < 8; ++i) v[i] = v[i] * inv * p.in[I_QNG][l * 384 + lane * 8 + i]; *(u32x4*)(WS(bf16_t, OFF_CQN) + (size_t)row * 384 + lane * 8) = pack8(v); } }
    { float v[8]; float ss = 0.f; if (lane < 32) { unpack8(ld8g(pr + 2960 + lane * 8), v); for (int i = 0; i < 8; ++i) ss += v[i] * v[i]; }
      const float inv = rsqrtf(wave_sum(ss) * (1.f / 256.f) + LN_EPS);
      if (lane < 32) { for (int i = 0; i < 8; ++i) v[i] = v[i] * inv * p.in[I_KVNG][l * 256 + lane * 8 + i]; *(u32x4*)(WS(bf16_t, OFF_CKVN) + (size_t)row * 256 + lane * 8) = pack8(v); } }
    { const float x = bf2f(pr[3216 + (lane & 31)]); const float pt = dppf<0x128>(x); float o = x;
      if (!isctx) { const int f = lane & 7; const int pos = (lane & 16) ? (t & 63) : (t >> 6);
        const float invf = __expf(-(float)f * (9.210340372f / 8.f)); float rev = (float)pos * invf * 0.15915494309f; rev -= floorf(rev);
        const float sn = __builtin_amdgcn_sinf(rev), cs = __builtin_amdgcn_cosf(rev);
        o = (lane & 8) ? x * cs + pt * sn : x * cs - pt * sn; }
      if (lane < 32) WS(bf16_t, OFF_KR)[(size_t)row * 32 + lane] = f2bf(o); }
  }
}

DEV void ph_prep(CParams& p, int l, unsigned char* lds) {
  for (int r_ = 0; r_ < PM_REP; ++r_)
  for (int u = blockIdx.x; u < 288 * 4; u += gridDim.x) { const int chunk = u >> 2; const ChunkInfo c = chunk_info(chunk); prep_mlstm(p, l, c, chunk, u & 3, lds); }
  for (int r_ = 0; r_ < PF_REP; ++r_) { prep_rwkv_flat(p, l); prep_mla_flat(p, l); }
}

DEV void mlstm_state_scan(CParams& p, int chain) {
  const int tid = TIDX(); const bool two = tid < 128;
  float C0[8], C1[8];
#pragma unroll
  for (int i = 0; i < 8; ++i) { C0[i] = 0.f; C1[i] = 0.f; }
  float m = -1e30f;
  bf16_t* blk = WS(bf16_t, OFF_ST) + (size_t)chain * 36 * 5120;
  u32x4 q0a, q0b = {0u, 0u, 0u, 0u}, q1a, q1b = {0u, 0u, 0u, 0u}, q2a, q2b = {0u, 0u, 0u, 0u};
#define SS_LOAD(A, B, pc_) do { const bf16_t* sp_ = blk + (size_t)(pc_) * 5120; A = *(const u32x4*)(sp_ + tid * 8); if (two) B = *(const u32x4*)(sp_ + (512 + tid) * 8); } while (0)
#define SS_STEP(A, B, pc_) do { bf16_t* cb = blk + (size_t)(pc_) * 5120; const u32x4 l0 = A, l1 = B; \
    if ((pc_) + 3 < 36) SS_LOAD(A, B, (pc_) + 3); \
    const float mloc = WS(float, OFF_SCM)[chain * 36 + (pc_)], bend = WS(float, OFF_SCB)[chain * 36 + (pc_)]; \
    *(u32x4*)(cb + tid * 8) = pack8(C0); if (two) *(u32x4*)(cb + (512 + tid) * 8) = pack8(C1); \
    if (tid == 0) WS(float, OFF_SCMB)[chain * 36 + (pc_)] = m; \
    const float mnew = fmaxf(bend + m, mloc), decay = __expf(bend + m - mnew), sl = __expf(mloc - mnew); \
    float f0[8], f1[8]; unpack8(l0, f0); unpack8(l1, f1); \
    _Pragma("unroll") for (int i = 0; i < 8; ++i) { C0[i] = decay * C0[i] + sl * f0[i]; C1[i] = decay * C1[i] + sl * f1[i]; } \
    m = mnew; } while (0)
  SS_LOAD(q0a, q0b, 0); SS_LOAD(q1a, q1b, 1); SS_LOAD(q2a, q2b, 2);
#pragma unroll 1
  for (int pc = 0; pc < 36; pc += 3) { SS_STEP(q0a, q0b, pc); SS_STEP(q1a, q1b, pc + 1); SS_STEP(q2a, q2b, pc + 2); }
#undef SS_LOAD
#undef SS_STEP
}
template <int MASK> DEV void ph_mid_t(CParams& p, int lx, unsigned char* lds) {
  const int l = lx & 1;
  LAS unsigned char* ll = (LAS unsigned char*)lds;
  pg8::StaticOrder S;
  if constexpr (MASK & 1) { S.init(NTOK, 2048, gridDim.x, blockIdx.x); pg8::Gemm g{WS(bf16_t, OFF_ZB), WS(bf16_t, OFF_WLORA) + (size_t)l * 2048 * 384, NTOK, 2048, 384};
    EpiBf16 E{WS(bf16_t, OFF_LORA), 1920, 1920}; pg8::gemm_phase(ll, g, S, E); }
  if constexpr (MASK & 2) { S.init(NTOK, 768, gridDim.x, blockIdx.x); pg8::Gemm g{WS(bf16_t, OFF_CQN), WS(bf16_t, OFF_WQUP) + (size_t)l * 768 * 384, NTOK, 768, 384};
    EpiBf16 E{WS(bf16_t, OFF_QB), 576, 576}; pg8::gemm_phase(ll, g, S, E); }
  if constexpr (MASK & 4) { S.init(NTOK, 768, gridDim.x, blockIdx.x); pg8::Gemm g{WS(bf16_t, OFF_CKVN), WS(bf16_t, OFF_WKVUP) + (size_t)l * 768 * 256, NTOK, 768, 256};
    EpiBf16 E{WS(bf16_t, OFF_KV), 768, 768}; pg8::gemm_phase(ll, g, S, E); }
  if constexpr (MASK & 8) { const int c = (int)gridDim.x - 1 - (int)blockIdx.x; if (c < 64) mlstm_state_scan(p, c); }
  if constexpr (MASK & 8) {
  unsigned* cnt = WS(unsigned, OFF_CNT) + 8 + lx; unsigned* slot = (unsigned*)lds;
  for (;;) {
    __syncthreads();
    if (TIDX() == 0) *slot = atomicAdd(cnt, 1u);
    __syncthreads();
    const unsigned ch = *slot; if (ch >= 2048u) break;
    const int tb = ch >> 10, e = (int)(ch & 1023) * 16 + (TIDX() >> 5), seg = TIDX() & 31;
    const float* src = p.in[tb ? I_PV : I_PU] + ((size_t)l * 16384 + e) * 1024 + seg * 32; const float scl = tb ? 4.f : 64.f;
    unsigned char* dst = WS(unsigned char, tb ? OFF_TABV : OFF_TABU) + ((size_t)(seg >> 3) * 16384 + e) * 128 + (seg & 7) * 16;
    u32x4 w0;
#pragma unroll
    for (int i = 0; i < 4; ++i) { const f32x4 a = *(const f32x4*)(src + i * 8) * scl, b2 = *(const f32x4*)(src + i * 8 + 4) * scl; unsigned w = 0u;
      w = __builtin_amdgcn_cvt_scalef32_pk_fp4_f32(w, a[0], a[1], 1.0f, 0); w = __builtin_amdgcn_cvt_scalef32_pk_fp4_f32(w, a[2], a[3], 1.0f, 1);
      w = __builtin_amdgcn_cvt_scalef32_pk_fp4_f32(w, b2[0], b2[1], 1.0f, 2); w = __builtin_amdgcn_cvt_scalef32_pk_fp4_f32(w, b2[2], b2[3], 1.0f, 3);
      w0[i] = w; }
    *(u32x4*)dst = w0;
  }
  }
  __syncthreads();
}
DEV void ph_mid(CParams& p, int l, unsigned char* lds) { ph_mid_t<15>(p, l, lds); }

DEV int rw_rowof(int dir, int b, int pos) { if (pos < 256) { const int t = dir ? 255 - pos : pos; return b * 256 + t; } const int q = pos - 256; const int t = dir ? 2047 - q : q; return NCTXR + b * 2048 + t; }
DEV void rwkv_scan_unit(CParams& p, int l, int u, unsigned char* lds) {
  constexpr int TS = 32;
  const int chain = u >> 1, half = u & 1, dir = chain / 48, bh = chain % 48, b = bh / 6, h6 = bh % 6;
  float* sb = (float*)lds;
  float* yb = sb + 2 * 6 * TS * 64;
  const int tid = TIDX(), rl = tid >> 4, kq = tid & 15, col = h6 * 64 + kq * 4;
  float ka[4];
#pragma unroll
  for (int i = 0; i < 4; ++i) ka[i] = p.in[I_RWKA][l * 384 + col + i];
  const bf16_t* RBp = WS(bf16_t, OFF_RB); const bf16_t* KBp = WS(bf16_t, OFF_KB); const bf16_t* KHp = WS(bf16_t, OFF_KH); const bf16_t* VBp = WS(bf16_t, OFF_VB);
  const bf16_t* LOp = WS(bf16_t, OFF_LORA) + dir * 384 + col;
  float w0v[4], a0v[4];
#pragma unroll
  for (int i = 0; i < 4; ++i) { w0v[i] = p.in[I_RWW0][l * 768 + dir * 384 + col + i]; a0v[i] = p.in[I_RWA0][l * 768 + dir * 384 + col + i]; }
  u32x2 g_r, g_k, g_kh, g_v, g_lw, g_a;
#define RW_LOAD(c) do { const size_t off = (size_t)rw_rowof(dir, b, (c) * TS + rl) * 384 + col; g_r = *(const u32x2*)(RBp + off); g_k = *(const u32x2*)(KBp + off); \
    g_kh = *(const u32x2*)(KHp + off); g_v = *(const u32x2*)(VBp + off); const size_t off2 = (size_t)rw_rowof(dir, b, (c) * TS + rl) * 1920; g_lw = *(const u32x2*)(LOp + off2); g_a = *(const u32x2*)(LOp + off2 + 768); } while (0)
#define RW_WRITE(bi) do { float* base = sb + (bi) * 6 * TS * 64 + rl * 64 + kq * 4; \
    const float r_[4] = {lo16(g_r[0]), hi16(g_r[0]), lo16(g_r[1]), hi16(g_r[1])}, k_[4] = {lo16(g_k[0]), hi16(g_k[0]), lo16(g_k[1]), hi16(g_k[1])}; \
    const float kh_[4] = {lo16(g_kh[0]), hi16(g_kh[0]), lo16(g_kh[1]), hi16(g_kh[1])}, v_[4] = {lo16(g_v[0]), hi16(g_v[0]), lo16(g_v[1]), hi16(g_v[1])}; \
    const float lw_[4] = {lo16(g_lw[0]), hi16(g_lw[0]), lo16(g_lw[1]), hi16(g_lw[1])}, a_[4] = {lo16(g_a[0]), hi16(g_a[0]), lo16(g_a[1]), hi16(g_a[1])}; \
    f32x4 o0, o1, o2, o3, o4, o5; \
    _Pragma("unroll") for (int i = 0; i < 4; ++i) { const float aa = sigmoidf_(a0v[i] + a_[i]); o0[i] = __expf(-0.60653065971f * sigmoidf_(w0v[i] + lw_[i])); o1[i] = kh_[i]; o2[i] = kh_[i] * aa; o3[i] = k_[i] * (1.f + (aa - 1.f) * ka[i]); o4[i] = r_[i]; o5[i] = v_[i]; } \
    *(f32x4*)(base + 0 * TS * 64) = o0; *(f32x4*)(base + 1 * TS * 64) = o1; *(f32x4*)(base + 2 * TS * 64) = o2; *(f32x4*)(base + 3 * TS * 64) = o3; \
    *(f32x4*)(base + 4 * TS * 64) = o4; *(f32x4*)(base + 5 * TS * 64) = o5; } while (0)
  f32x2 SA = {0.f, 0.f}, SB = {0.f, 0.f};
  __syncthreads();
  RW_LOAD(0); RW_WRITE(0);
  __syncthreads();
  constexpr int NCH = 2304 / TS;
#pragma unroll 1
  for (int c = 0; c < NCH; ++c) {
    if (c + 1 < NCH) RW_LOAD(c + 1);
    const float* base = sb + (c & 1) * 6 * TS * 64 + kq * 4; const float* vbase = sb + (c & 1) * 6 * TS * 64 + 5 * TS * 64 + half * 32 + rl;
    f32x4 w4 = *(const f32x4*)(base), kh4 = *(const f32x4*)(base + TS * 64), ab4 = *(const f32x4*)(base + 2 * TS * 64), kt4 = *(const f32x4*)(base + 3 * TS * 64), r4 = *(const f32x4*)(base + 4 * TS * 64);
    float vv = vbase[0];
#pragma unroll
    for (int ts = 0; ts < TS; ++ts) {
      f32x4 nw4 = w4, nkh4 = kh4, nab4 = ab4, nkt4 = kt4, nr4 = r4; float nvv = vv;
      if (ts + 1 < TS) { const float* bp = base + (ts + 1) * 64;
        nw4 = *(const f32x4*)(bp); nkh4 = *(const f32x4*)(bp + TS * 64); nab4 = *(const f32x4*)(bp + 2 * TS * 64); nkt4 = *(const f32x4*)(bp + 3 * TS * 64); nr4 = *(const f32x4*)(bp + 4 * TS * 64);
        nvv = vbase[(ts + 1) * 64]; }
      const f32x2 khA = {kh4[0], kh4[1]}, khB = {kh4[2], kh4[3]}, wA = {w4[0], w4[1]}, wB = {w4[2], w4[3]}, abA = {ab4[0], ab4[1]}, abB = {ab4[2], ab4[3]},
                  ktA = {kt4[0], kt4[1]}, ktB = {kt4[2], kt4[3]}, rA = {r4[0], r4[1]}, rB = {r4[2], r4[3]};
      f32x2 pa = SA * khA + SB * khB;
      float sa = row16_sum(pa[0] + pa[1]);
      const f32x2 vv2 = {vv, vv}, sa2 = {sa, sa};
      SA = SA * wA + (vv2 * ktA - sa2 * abA); SB = SB * wB + (vv2 * ktB - sa2 * abB);
      f32x2 py = SA * rA + SB * rB;
      float y = row16_sum(py[0] + py[1]);
      yb[ts * 32 + rl] = y;
      w4 = nw4; kh4 = nkh4; ab4 = nab4; kt4 = nkt4; r4 = nr4; vv = nvv;
    }
    __syncthreads();
    { const int ts = tid >> 4, pr = tid & 15; const int row = rw_rowof(dir, b, c * TS + ts);
      *(unsigned*)(WS(bf16_t, OFF_RWY) + ((size_t)dir * NTOK + row) * 384 + h6 * 64 + half * 32 + pr * 2) = pack2(yb[ts * 32 + pr * 2], yb[ts * 32 + pr * 2 + 1]); }
    if (c + 1 < NCH) RW_WRITE((c + 1) & 1);
    __syncthreads();
  }
#undef RW_LOAD
#undef RW_WRITE
}

DEV bf16x8 ld_frag16(const bf16_t* ptr) { return *(const bf16x8*)ptr; }
DEV bf16x8 ld_frag8x2(const bf16_t* p0, const bf16_t* p1) { const u32x2 x0 = *(const u32x2*)p0, x1 = *(const u32x2*)p1; u32x4 w; w[0] = x0[0]; w[1] = x0[1]; w[2] = x1[0]; w[3] = x1[1]; return __builtin_bit_cast(bf16x8, w); }
DEV bf16x8 frag_lo(u32x2 lo) { u32x4 w; w[0] = lo[0]; w[1] = lo[1]; w[2] = 0u; w[3] = 0u; return __builtin_bit_cast(bf16x8, w); }
DEV bf16x8 frag2(u32x2 lo, u32x2 hi) { u32x4 w; w[0] = lo[0]; w[1] = lo[1]; w[2] = hi[0]; w[3] = hi[1]; return __builtin_bit_cast(bf16x8, w); }
DEV u32x2 acc2bf(f32x4 a) { u32x2 w; w[0] = (unsigned)f2bf(a[0]) | ((unsigned)f2bf(a[1]) << 16); w[1] = (unsigned)f2bf(a[2]) | ((unsigned)f2bf(a[3]) << 16); return w; }
DEV void rwkv_chunk_unit(CParams& p, int l, int u, unsigned char* lds) {
  constexpr int O_A = 0, O_Q = 2176, O_NBT = 4352, O_CT = 6400, O_M1T = 8448, O_U1T = 8960, O_NU2T = 9472, O_TT = 9984, O_VT = 10496, O_GAM = 12544, SCB = 12800, CHB = 4 * SCB;
  constexpr int O_PRIV = 2 * CHB, P_LW = 0, P_BR = 4096, P_CR = 6272, P_M2 = 8448, PRIV = 9472, O_CONST = O_PRIV + 4 * PRIV;
  const int chain = u, dir = chain / 48, bh = chain % 48, b = bh / 6, h6 = bh % 6;
  const int tid = TIDX(), lane = tid & 63, wid = tid >> 6, fr = lane & 15, fq = lane >> 4;
  float* cst = (float*)(lds + O_CONST);
  __syncthreads();
  if (tid < 64) { cst[tid] = p.in[I_RWW0][l * 768 + dir * 384 + h6 * 64 + tid]; cst[64 + tid] = p.in[I_RWA0][l * 768 + dir * 384 + h6 * 64 + tid]; cst[128 + tid] = p.in[I_RWKA][l * 384 + h6 * 64 + tid]; cst[192 + tid] = p.in[I_RWRK][l * 384 + h6 * 64 + tid]; }
  __syncthreads();
  const bool producer = wid >= 4;
  const int pj = wid - 4, pt = lane >> 2, pks = lane & 3;
  u32x4 in_r[2], in_k[2], in_kh[2], in_v[2], in_lw[2], in_a[2];
#define RC_LOAD(c) do { int lo32_ = h6 * 64 + pks * 16; asm volatile("" : "+v"(lo32_));   \
    const int row_ = rw_rowof(dir, b, (c) * 64 + pj * 16 + pt); const size_t o_ = (size_t)row_ * 384 + lo32_; \
    in_r[0] = ld8g(WS(bf16_t, OFF_RB) + o_); in_r[1] = ld8g(WS(bf16_t, OFF_RB) + o_ + 8); in_k[0] = ld8g(WS(bf16_t, OFF_KB) + o_); in_k[1] = ld8g(WS(bf16_t, OFF_KB) + o_ + 8); \
    in_kh[0] = ld8g(WS(bf16_t, OFF_KH) + o_); in_kh[1] = ld8g(WS(bf16_t, OFF_KH) + o_ + 8); in_v[0] = ld8g(WS(bf16_t, OFF_VB) + o_); in_v[1] = ld8g(WS(bf16_t, OFF_VB) + o_ + 8); \
    const bf16_t* lo_ = WS(bf16_t, OFF_LORA) + (size_t)row_ * 1920 + dir * 384 + lo32_; in_lw[0] = ld8g(lo_); in_lw[1] = ld8g(lo_ + 8); in_a[0] = ld8g(lo_ + 768); in_a[1] = ld8g(lo_ + 776); } while (0)
  f32x4 sacc[4];
#pragma unroll
  for (int i = 0; i < 4; ++i) sacc[i] = (f32x4){0.f, 0.f, 0.f, 0.f};
  if (producer) RC_LOAD(0);
#pragma unroll 1
  for (int c = -1; c < 36; ++c) {
    if (producer) {
      if (c + 1 < 36) {
        unsigned char* scb = lds + ((c + 1) & 1) * CHB + pj * SCB; unsigned char* prv = lds + O_PRIV + pj * PRIV;
        float r_[16], k_[16], kh_[16], lw_[16], aa_[16];
        unpack8(in_r[0], r_); unpack8(in_r[1], r_ + 8); unpack8(in_k[0], k_); unpack8(in_k[1], k_ + 8); unpack8(in_kh[0], kh_); unpack8(in_kh[1], kh_ + 8);
        unpack8(in_lw[0], lw_); unpack8(in_lw[1], lw_ + 8); unpack8(in_a[0], aa_); unpack8(in_a[1], aa_ + 8);
        const u32x4 vraw0 = in_v[0], vraw1 = in_v[1];
        float* LW = (float*)(prv + P_LW);
#pragma unroll
        for (int i = 0; i < 16; ++i) { const int col = pks * 16 + i; aa_[i] = sigmoidf_(cst[64 + col] + aa_[i]); lw_[i] = -0.60653065971f * sigmoidf_(cst[col] + lw_[i]); }
#pragma unroll
        for (int i = 0; i < 4; ++i) *(f32x4*)(LW + pt * 64 + pks * 16 + i * 4) = (f32x4){lw_[4 * i], lw_[4 * i + 1], lw_[4 * i + 2], lw_[4 * i + 3]};
        { bf16_t* VT = (bf16_t*)(scb + O_VT);
#pragma unroll
          for (int i = 0; i < 4; ++i) { VT[(pks * 16 + 2 * i) * 16 + pt] = (bf16_t)(vraw0[i] & 0xffffu); VT[(pks * 16 + 2 * i + 1) * 16 + pt] = (bf16_t)(vraw0[i] >> 16);
            VT[(pks * 16 + 8 + 2 * i) * 16 + pt] = (bf16_t)(vraw1[i] & 0xffffu); VT[(pks * 16 + 8 + 2 * i + 1) * 16 + pt] = (bf16_t)(vraw1[i] >> 16); } }
        asm volatile("s_waitcnt lgkmcnt(0)" ::: "memory"); __builtin_amdgcn_wave_barrier();
        { float g = 0.f;
#pragma unroll
          for (int t = 0; t < 16; ++t) { g += LW[t * 64 + lane]; LW[t * 64 + lane] = g; }
          ((float*)(scb + O_GAM))[lane] = __expf(g); }
        asm volatile("s_waitcnt lgkmcnt(0)" ::: "memory"); __builtin_amdgcn_wave_barrier();
        { float av[16], bv[16], cv[16], qv[16];
#pragma unroll
          for (int i = 0; i < 4; ++i) { const f32x4 g4 = *(const f32x4*)(LW + pt * 64 + pks * 16 + i * 4);
#pragma unroll
            for (int jj = 0; jj < 4; ++jj) { const int e = 4 * i + jj; const float G = g4[jj], e1 = __expf(G), e2 = __expf(-G), e3 = __expf(G - lw_[e]);
              const float ab = kh_[e] * aa_[e], kt = k_[e] * (1.f + (aa_[e] - 1.f) * cst[128 + pks * 16 + e]);
              av[e] = kh_[e] * e3; bv[e] = ab * e2; cv[e] = kt * e2; qv[e] = r_[e] * e1; } }
          bf16_t* Ap = (bf16_t*)(scb + O_A) + pt * 68 + pks * 16; bf16_t* Qp = (bf16_t*)(scb + O_Q) + pt * 68 + pks * 16;
          bf16_t* Bp = (bf16_t*)(prv + P_BR) + pt * 68 + pks * 16; bf16_t* Cp = (bf16_t*)(prv + P_CR) + pt * 68 + pks * 16;
#pragma unroll
          for (int i = 0; i < 4; ++i) { u32x2 w; w[0] = pack2(av[4 * i], av[4 * i + 1]); w[1] = pack2(av[4 * i + 2], av[4 * i + 3]); *(u32x2*)(Ap + 4 * i) = w;
            w[0] = pack2(qv[4 * i], qv[4 * i + 1]); w[1] = pack2(qv[4 * i + 2], qv[4 * i + 3]); *(u32x2*)(Qp + 4 * i) = w;
            w[0] = pack2(bv[4 * i], bv[4 * i + 1]); w[1] = pack2(bv[4 * i + 2], bv[4 * i + 3]); *(u32x2*)(Bp + 4 * i) = w;
            w[0] = pack2(cv[4 * i], cv[4 * i + 1]); w[1] = pack2(cv[4 * i + 2], cv[4 * i + 3]); *(u32x2*)(Cp + 4 * i) = w; }
          bf16_t* NBT = (bf16_t*)(scb + O_NBT); bf16_t* CT = (bf16_t*)(scb + O_CT);
#pragma unroll
          for (int e = 0; e < 16; ++e) { NBT[(pks * 16 + e) * 16 + pt] = f2bf(-bv[e]); CT[(pks * 16 + e) * 16 + pt] = f2bf(cv[e]); } }
        asm volatile("s_waitcnt lgkmcnt(0)" ::: "memory"); __builtin_amdgcn_wave_barrier();
        if (c + 2 < 36) RC_LOAD(c + 2);
        {
          f32x4 mBA = {0.f, 0.f, 0.f, 0.f}, mCA = mBA, mBQ = mBA, mCQ = mBA;
#pragma unroll
          for (int ks = 0; ks < 2; ++ks) { const int ko = fr * 68 + ks * 32 + fq * 8;
            const bf16_t* bp = (const bf16_t*)(prv + P_BR) + ko; const bf16_t* cp = (const bf16_t*)(prv + P_CR) + ko; const bf16_t* ap = (const bf16_t*)(scb + O_A) + ko; const bf16_t* qp = (const bf16_t*)(scb + O_Q) + ko;
            const bf16x8 fb = ld_frag8x2(bp, bp + 4), fc = ld_frag8x2(cp, cp + 4), fa = ld_frag8x2(ap, ap + 4), fqv = ld_frag8x2(qp, qp + 4);
            mBA = __builtin_amdgcn_mfma_f32_16x16x32_bf16(fb, fa, mBA, 0, 0, 0); mCA = __builtin_amdgcn_mfma_f32_16x16x32_bf16(fc, fa, mCA, 0, 0, 0);
            mBQ = __builtin_amdgcn_mfma_f32_16x16x32_bf16(fb, fqv, mBQ, 0, 0, 0); mCQ = __builtin_amdgcn_mfma_f32_16x16x32_bf16(fc, fqv, mCQ, 0, 0, 0); }
          float* M2 = (float*)(prv + P_M2); float m1[4], u1[4], u2[4];
#pragma unroll
          for (int j = 0; j < 4; ++j) { const int s_ = 4 * fq + j; M2[s_ * 16 + fr] = s_ < fr ? mBA[j] : 0.f; m1[j] = s_ < fr ? mCA[j] : 0.f; u1[j] = s_ <= fr ? mCQ[j] : 0.f; u2[j] = s_ <= fr ? -mBQ[j] : 0.f; }
          u32x2 w; w[0] = pack2(m1[0], m1[1]); w[1] = pack2(m1[2], m1[3]); *(u32x2*)((bf16_t*)(scb + O_M1T) + fr * 16 + 4 * fq) = w;
          w[0] = pack2(u1[0], u1[1]); w[1] = pack2(u1[2], u1[3]); *(u32x2*)((bf16_t*)(scb + O_U1T) + fr * 16 + 4 * fq) = w;
          w[0] = pack2(u2[0], u2[1]); w[1] = pack2(u2[2], u2[3]); *(u32x2*)((bf16_t*)(scb + O_NU2T) + fr * 16 + 4 * fq) = w; }
        asm volatile("s_waitcnt lgkmcnt(0)" ::: "memory"); __builtin_amdgcn_wave_barrier();
        {
          const float* M2 = (const float*)(prv + P_M2); float Tc[16];
#pragma unroll
          for (int s_ = 15; s_ >= 0; --s_) { float x0 = (fr == s_) ? 1.f : 0.f, x1 = 0.f;
#pragma unroll
            for (int j = s_ + 1; j < 16; ++j) { if (j & 1) x1 -= M2[s_ * 16 + j] * Tc[j]; else x0 -= M2[s_ * 16 + j] * Tc[j]; }
            Tc[s_] = x0 + x1; }
          if (fq == 0) { bf16_t* TT = (bf16_t*)(scb + O_TT) + fr * 16; *(u32x4*)TT = pack8(Tc); *(u32x4*)(TT + 8) = pack8(Tc + 8); } }
      }
    } else if (c >= 0) {
      const int v0 = wid * 16;
      const int bt = lane >> 2, bks = lane & 3, brow = rw_rowof(dir, b, c * 64 + wid * 16 + bt);
      u32x4 b_r0, b_r1, b_k0, b_k1, b_a0, b_a1;
      { int bc = h6 * 64 + bks * 16; asm volatile("" : "+v"(bc)); const size_t bo = (size_t)brow * 384 + bc; const bf16_t* blo = WS(bf16_t, OFF_LORA) + (size_t)brow * 1920 + dir * 384 + bc + 768;
        b_r0 = ld8g(WS(bf16_t, OFF_RB) + bo); b_r1 = ld8g(WS(bf16_t, OFF_RB) + bo + 8); b_k0 = ld8g(WS(bf16_t, OFF_KB) + bo); b_k1 = ld8g(WS(bf16_t, OFF_KB) + bo + 8); b_a0 = ld8g(blo); b_a1 = ld8g(blo + 8); }
#pragma unroll 1
      for (int j = 0; j < 4; ++j) { const unsigned char* scb = lds + (c & 1) * CHB + j * SCB;
        bf16x8 sb[2];
#pragma unroll
        for (int ks = 0; ks < 2; ++ks) sb[ks] = frag2(acc2bf(sacc[2 * ks]), acc2bf(sacc[2 * ks + 1]));
        const bf16x8 vt = frag_lo(*(const u32x2*)((const bf16_t*)(scb + O_VT) + (v0 + fr) * 16 + 4 * fq));
        const bf16_t* Ar = (const bf16_t*)(scb + O_A) + fr * 68 + 4 * fq; const bf16_t* Qr = (const bf16_t*)(scb + O_Q) + fr * 68 + 4 * fq;
        f32x4 racc = {0.f, 0.f, 0.f, 0.f}, yacc = racc;
#pragma unroll
        for (int ks = 0; ks < 2; ++ks) { racc = __builtin_amdgcn_mfma_f32_16x16x32_bf16(ld_frag8x2(Ar + 32 * ks, Ar + 32 * ks + 16), sb[ks], racc, 0, 0, 0);
          yacc = __builtin_amdgcn_mfma_f32_16x16x32_bf16(ld_frag8x2(Qr + 32 * ks, Qr + 32 * ks + 16), sb[ks], yacc, 0, 0, 0); }
        racc = __builtin_amdgcn_mfma_f32_16x16x32_bf16(frag_lo(*(const u32x2*)((const bf16_t*)(scb + O_M1T) + fr * 16 + 4 * fq)), vt, racc, 0, 0, 0);
        yacc = __builtin_amdgcn_mfma_f32_16x16x32_bf16(frag_lo(*(const u32x2*)((const bf16_t*)(scb + O_U1T) + fr * 16 + 4 * fq)), vt, yacc, 0, 0, 0);
        f32x4 zacc = {0.f, 0.f, 0.f, 0.f};
        zacc = __builtin_amdgcn_mfma_f32_16x16x32_bf16(frag_lo(*(const u32x2*)((const bf16_t*)(scb + O_TT) + fr * 16 + 4 * fq)), frag_lo(acc2bf(racc)), zacc, 0, 0, 0);
        const bf16x8 zf = frag_lo(acc2bf(zacc));
        yacc = __builtin_amdgcn_mfma_f32_16x16x32_bf16(frag_lo(*(const u32x2*)((const bf16_t*)(scb + O_NU2T) + fr * 16 + 4 * fq)), zf, yacc, 0, 0, 0);
        const float* gam = (const float*)(scb + O_GAM);
#pragma unroll
        for (int kt = 0; kt < 4; ++kt) {
          sacc[kt] = __builtin_amdgcn_mfma_f32_16x16x32_bf16(frag_lo(*(const u32x2*)((const bf16_t*)(scb + O_CT) + (kt * 16 + fr) * 16 + 4 * fq)), vt, sacc[kt], 0, 0, 0);
          sacc[kt] = __builtin_amdgcn_mfma_f32_16x16x32_bf16(frag_lo(*(const u32x2*)((const bf16_t*)(scb + O_NBT) + (kt * 16 + fr) * 16 + 4 * fq)), zf, sacc[kt], 0, 0, 0);
          sacc[kt] *= *(const f32x4*)(gam + kt * 16 + 4 * fq); }
#pragma unroll
        for (int jj = 0; jj < 4; ++jj) { const int row = rw_rowof(dir, b, c * 64 + j * 16 + 4 * fq + jj);
          WS(bf16_t, OFF_RWY)[((size_t)dir * NTOK + row) * 384 + h6 * 64 + v0 + fr] = f2bf(yacc[jj]); } }
      { float r_[16], k_[16], a_[16]; unpack8(b_r0, r_); unpack8(b_r1, r_ + 8); unpack8(b_k0, k_); unpack8(b_k1, k_ + 8); unpack8(b_a0, a_); unpack8(b_a1, a_ + 8);
        float s = 0.f;
#pragma unroll
        for (int i = 0; i < 16; ++i) { const int col = bks * 16 + i; const float a = sigmoidf_(cst[64 + col] + a_[i]); s += r_[i] * cst[192 + col] * (k_[i] * (1.f + (a - 1.f) * cst[128 + col])); }
        s += dppf<0xB1>(s); s += dppf<0x4E>(s);
        if (bks == 0) WS(float, OFF_BS)[((size_t)dir * NTOK + brow) * 6 + h6] = s; }
    }
    __syncthreads();
  }
#undef RC_LOAD
}

typedef short v4s16 __attribute__((ext_vector_type(4)));
template <int OFF> DEV u32x2 tr_read(unsigned addr) { return __builtin_bit_cast(u32x2, __builtin_amdgcn_ds_read_tr16_b64_v4i16((LAS v4s16*)(addr + (unsigned)OFF))); }
DEV void attn_unit(CParams& p, int u, unsigned char* lds) {
  int b, head, qrow0, ntile; const bool lat = u < 384;
  if (lat) { b = u / 48; const int r = u % 48; head = r / 8; const int qb = r % 8; qrow0 = NCTXR + b * 2048 + qb * 256; ntile = 36; }
  else { const int v = u - 384; b = v / 6; head = v % 6; qrow0 = b * 256; ntile = 4; }
  const int tid = TIDX(), lane = tid & 63, wid = tid >> 6, r32 = lane & 31, hi = lane >> 5;
  constexpr int KROW = 208, VROW = 192, KT_B = 64 * KROW, VT_B = 64 * VROW, BUF_B = KT_B + VT_B;
  const bf16_t* KVp = WS(bf16_t, OFF_KV) + head * 128; const bf16_t* KRp = WS(bf16_t, OFF_KR);
  const int qrow = qrow0 + wid * 32 + r32;
  bf16x8 qf[6];
  { const bf16_t* qp = WS(bf16_t, OFF_QB) + (size_t)qrow * 576 + head * 96 + hi * 8;
    const float SC = 0.10206207262f * 1.44269504089f;
    const int t = lat ? ((qrow - NCTXR) & 2047) : 0;
#pragma unroll
    for (int ks = 0; ks < 6; ++ks) { float f[8]; unpack8(ld8g(qp + ks * 16), f);
      if (ks >= 4) { float pt[8];
#pragma unroll
        for (int j = 0; j < 8; ++j) { auto rr = __builtin_amdgcn_permlane32_swap(__float_as_uint(f[j]), __float_as_uint(f[j]), false, false); pt[j] = __uint_as_float(hi ? rr[0] : rr[1]); }
        if (lat) { const int pos = ks == 4 ? (t >> 6) : (t & 63);
#pragma unroll
          for (int j = 0; j < 8; ++j) { const float invf = __expf(-(float)j * (9.210340372f / 8.f)); float rev = (float)pos * invf * 0.15915494309f; rev -= floorf(rev);
            const float sn = __builtin_amdgcn_sinf(rev), cs = __builtin_amdgcn_cosf(rev);
            f[j] = hi ? f[j] * cs + pt[j] * sn : f[j] * cs - pt[j] * sn; } } }
#pragma unroll
      for (int j = 0; j < 8; ++j) f[j] *= SC;
      qf[ks] = __builtin_bit_cast(bf16x8, pack8(f)); } }
  const int k0key = tid / 12, k0part = tid % 12, k1key = (tid + 512) / 12, k1part = (tid + 512) % 12, vkey = tid >> 3, vpart = tid & 7;
  u32x4 skA0, skA1 = {0u, 0u, 0u, 0u}, svA, skB0, skB1 = {0u, 0u, 0u, 0u}, svB;
#define AT_ROW0(kt) (lat ? ((kt) < 32 ? NCTXR + b * 2048 + (kt) * 64 : b * 256 + ((kt) - 32) * 64) : b * 256 + (kt) * 64)
#define AT_LOAD(kt, sk0, sk1, sv) do { const int r0_ = AT_ROW0(kt); \
    sk0 = k0part < 8 ? ld8g(KVp + (size_t)(r0_ + k0key) * 768 + k0part * 8) : ld8g(KRp + (size_t)(r0_ + k0key) * 32 + (k0part - 8) * 8); \
    if (tid < 256) sk1 = k1part < 8 ? ld8g(KVp + (size_t)(r0_ + k1key) * 768 + k1part * 8) : ld8g(KRp + (size_t)(r0_ + k1key) * 32 + (k1part - 8) * 8); \
    sv = ld8g(KVp + (size_t)(r0_ + vkey) * 768 + 64 + vpart * 8); } while (0)
#define AT_WRITE(bi, sk0, sk1, sv) do { unsigned char* bb = lds + (bi) * BUF_B; *(u32x4*)(bb + k0key * KROW + k0part * 16) = sk0; \
    if (tid < 256) *(u32x4*)(bb + k1key * KROW + k1part * 16) = sk1; *(u32x4*)(bb + KT_B + vkey * VROW + vpart * 16) = sv; } while (0)
  const unsigned trb = (unsigned)(uintptr_t)lds + KT_B + ((4 * (lane >> 5) + ((lane & 15) >> 2)) * VROW + (16 * ((lane >> 4) & 1) + 4 * (lane & 3)) * 2);
  f32x16 o0, o1;
#pragma unroll
  for (int i = 0; i < 16; ++i) { o0[i] = 0.f; o1[i] = 0.f; }
  float m_run = -1e30f, l_run = 0.f;
  __syncthreads();
  AT_LOAD(0, skA0, skA1, svA); AT_LOAD(1, skB0, skB1, svB);
  AT_WRITE(0, skA0, skA1, svA); AT_WRITE(1, skB0, skB1, svB);
  if (2 < ntile) AT_LOAD(2, skA0, skA1, svA);
  if (3 < ntile) AT_LOAD(3, skB0, skB1, svB);
  __syncthreads();
  f32x16 sa0, sa1, sb0, sb1;
#define AT_KF(kb_, ks) *(const bf16x8*)((kb_) + r32 * KROW + ((ks) * 16 + hi * 8) * 2), *(const bf16x8*)((kb_) + (32 + r32) * KROW + ((ks) * 16 + hi * 8) * 2)
  { const unsigned char* kb = lds;
#pragma unroll
    for (int i = 0; i < 16; ++i) { sa0[i] = 0.f; sa1[i] = 0.f; }
#pragma unroll
    for (int ks = 0; ks < 6; ++ks) { const bf16x8 a0 = *(const bf16x8*)(kb + r32 * KROW + (ks * 16 + hi * 8) * 2), a1 = *(const bf16x8*)(kb + (32 + r32) * KROW + (ks * 16 + hi * 8) * 2);
      sa0 = __builtin_amdgcn_mfma_f32_32x32x16_bf16(a0, qf[ks], sa0, 0, 0, 0); sa1 = __builtin_amdgcn_mfma_f32_32x32x16_bf16(a1, qf[ks], sa1, 0, 0, 0); } }
  auto step = [&](f32x16& c0, f32x16& c1, f32x16& n0, f32x16& n1, const int bufv, const int bufk) {
    const unsigned char* kb = lds + bufk * BUF_B;
    const unsigned ta = trb + (unsigned)(bufv * BUF_B);
#define TR(st, rd, eb) tr_read<(st) * 16 * VROW + (rd) * 8 * VROW + (eb) * 64>(ta)
    const u32x2 t00 = TR(0, 0, 0), t01 = TR(0, 1, 0), t10 = TR(1, 0, 0), t11 = TR(1, 1, 0), t20 = TR(2, 0, 0), t21 = TR(2, 1, 0), t30 = TR(3, 0, 0), t31 = TR(3, 1, 0);
    const u32x2 u00 = TR(0, 0, 1), u01 = TR(0, 1, 1), u10 = TR(1, 0, 1), u11 = TR(1, 1, 1), u20 = TR(2, 0, 1), u21 = TR(2, 1, 1), u30 = TR(3, 0, 1), u31 = TR(3, 1, 1);
#undef TR
#define QK(ks) do { const bf16x8 a0_ = *(const bf16x8*)(kb + r32 * KROW + ((ks) * 16 + hi * 8) * 2), a1_ = *(const bf16x8*)(kb + (32 + r32) * KROW + ((ks) * 16 + hi * 8) * 2); \
      n0 = __builtin_amdgcn_mfma_f32_32x32x16_bf16(a0_, qf[ks], n0, 0, 0, 0); n1 = __builtin_amdgcn_mfma_f32_32x32x16_bf16(a1_, qf[ks], n1, 0, 0, 0); } while (0)
#pragma unroll
    for (int i = 0; i < 16; ++i) { n0[i] = 0.f; n1[i] = 0.f; }
    QK(0);
    __builtin_amdgcn_sched_barrier(0);
    float mx = fmaxf(fmaxf(c0[0], c0[1]), c0[2]);
#pragma unroll
    for (int i = 3; i < 15; i += 2) mx = fmaxf(fmaxf(mx, c0[i]), c0[i + 1]);
    mx = fmaxf(fmaxf(mx, c0[15]), c1[0]);
    __builtin_amdgcn_sched_barrier(0);
    QK(1);
    __builtin_amdgcn_sched_barrier(0);
#pragma unroll
    for (int i = 1; i < 15; i += 2) mx = fmaxf(fmaxf(mx, c1[i]), c1[i + 1]);
    mx = fmaxf(mx, c1[15]);
    mx = xhalf_max(mx);
    if (__builtin_amdgcn_ballot_w64(mx > m_run + 8.f) != 0ull) {
      const float mnew = fmaxf(m_run, mx), alpha = __builtin_amdgcn_exp2f(m_run - mnew); const f32x2 al2 = {alpha, alpha};
      m_run = mnew; l_run *= alpha;
#pragma unroll
      for (int i = 0; i < 8; ++i) { f32x2 a = {o0[2 * i], o0[2 * i + 1]}, b2 = {o1[2 * i], o1[2 * i + 1]}; a *= al2; b2 *= al2; o0[2 * i] = a[0]; o0[2 * i + 1] = a[1]; o1[2 * i] = b2[0]; o1[2 * i + 1] = b2[1]; } }
    const f32x2 mm = {m_run, m_run}; f32x2 ps2 = {0.f, 0.f};
    bf16x8 pf[4];
#define SMX(cc, base, pi) do { u32x4 w_; _Pragma("unroll") for (int i_ = 0; i_ < 4; ++i_) { f32x2 a_ = {cc[base + 2 * i_], cc[base + 2 * i_ + 1]}; a_ -= mm; \
        a_[0] = __builtin_amdgcn_exp2f(a_[0]); a_[1] = __builtin_amdgcn_exp2f(a_[1]); ps2 += a_; w_[i_] = pack2(a_[0], a_[1]); } pf[pi] = __builtin_bit_cast(bf16x8, w_); } while (0)
    __builtin_amdgcn_sched_barrier(0);
    QK(2);
    __builtin_amdgcn_sched_barrier(0);
    SMX(c0, 0, 0);
    __builtin_amdgcn_sched_barrier(0);
    QK(3);
    __builtin_amdgcn_sched_barrier(0);
    SMX(c0, 8, 1);
    __builtin_amdgcn_sched_barrier(0);
    QK(4);
    __builtin_amdgcn_sched_barrier(0);
    SMX(c1, 0, 2);
    __builtin_amdgcn_sched_barrier(0);
    QK(5);
    __builtin_amdgcn_sched_barrier(0);
    SMX(c1, 8, 3);
    l_run += ps2[0] + ps2[1];
#undef SMX
#undef QK
    __builtin_amdgcn_sched_barrier(0);
#define VF(lo, hi_) __builtin_bit_cast(bf16x8, (u32x4){lo[0], lo[1], hi_[0], hi_[1]})
    o0 = __builtin_amdgcn_mfma_f32_32x32x16_bf16(VF(t00, t01), pf[0], o0, 0, 0, 0); o1 = __builtin_amdgcn_mfma_f32_32x32x16_bf16(VF(u00, u01), pf[0], o1, 0, 0, 0);
    o0 = __builtin_amdgcn_mfma_f32_32x32x16_bf16(VF(t10, t11), pf[1], o0, 0, 0, 0); o1 = __builtin_amdgcn_mfma_f32_32x32x16_bf16(VF(u10, u11), pf[1], o1, 0, 0, 0);
    o0 = __builtin_amdgcn_mfma_f32_32x32x16_bf16(VF(t20, t21), pf[2], o0, 0, 0, 0); o1 = __builtin_amdgcn_mfma_f32_32x32x16_bf16(VF(u20, u21), pf[2], o1, 0, 0, 0);
    o0 = __builtin_amdgcn_mfma_f32_32x32x16_bf16(VF(t30, t31), pf[3], o0, 0, 0, 0); o1 = __builtin_amdgcn_mfma_f32_32x32x16_bf16(VF(u30, u31), pf[3], o1, 0, 0, 0);
#undef VF
  };
  int bv = 0;
#pragma unroll 1
  for (int kt = 0; kt < ntile; kt += 2) {
    { const int b1 = bv == 2 ? 0 : bv + 1, b2 = b1 == 2 ? 0 : b1 + 1;
      __syncthreads();
      if (kt + 2 < ntile) { AT_WRITE(b2, skA0, skA1, svA); if (kt + 4 < ntile) AT_LOAD(kt + 4, skA0, skA1, svA); }
      step(sa0, sa1, sb0, sb1, bv, b1);
      bv = b1; }
    { const int b1 = bv == 2 ? 0 : bv + 1, b2 = b1 == 2 ? 0 : b1 + 1;
      __syncthreads();
      if (kt + 3 < ntile) { AT_WRITE(b2, skB0, skB1, svB); if (kt + 5 < ntile) AT_LOAD(kt + 5, skB0, skB1, svB); }
      step(sb0, sb1, sa0, sa1, bv, b1);
      bv = b1; }
  }
#undef AT_KF
#undef AT_LOAD
#undef AT_WRITE
#undef AT_ROW0
  const float inv = 1.f / xhalf_sum(l_run);
  bf16_t* op = WS(bf16_t, OFF_H) + (size_t)qrow * 1024 + 640 + head * 64;
#pragma unroll
  for (int g = 0; g < 4; ++g) {
    u32x2 w; w[0] = pack2(o0[4 * g] * inv, o0[4 * g + 1] * inv); w[1] = pack2(o0[4 * g + 2] * inv, o0[4 * g + 3] * inv); *(u32x2*)(op + 8 * g + 4 * hi) = w;
    w[0] = pack2(o1[4 * g] * inv, o1[4 * g + 1] * inv); w[1] = pack2(o1[4 * g + 2] * inv, o1[4 * g + 3] * inv); *(u32x2*)(op + 32 + 8 * g + 4 * hi) = w; }
}

DEV void mlstm_out_unit(CParams& p, int l, int chunk, int hd, unsigned char* lds) {
  const ChunkInfo c = chunk_info(chunk);
  bf16_t* Ql = (bf16_t*)lds;
  bf16_t* Kl = (bf16_t*)(lds + 9216);
  bf16_t* VTl = (bf16_t*)(lds + 18432);
  bf16_t* Cl = (bf16_t*)(lds + 18432 + 10880);
  float* sc = (float*)(lds + 18432 + 10880 + 23040);
  float* rowterm = sc; float* uarr = sc + 128; float* winter = sc + 256; float* emt = sc + 384; float* lnred = sc + 512;
  const int tid = TIDX(), lane = tid & 63, wid = tid >> 6, fr = lane & 15, fq = lane >> 4;
  __syncthreads();
  { const int t = tid >> 3, seg = tid & 7;
    *(u32x4*)(Ql + t * 72 + seg * 8) = ld8g(WS(bf16_t, OFF_MQ) + (size_t)(c.row0 + t) * 256 + hd * 64 + seg * 8);
    *(u32x4*)(Kl + t * 72 + seg * 8) = ld8g(WS(bf16_t, OFF_MK) + (size_t)(c.row0 + t) * 256 + hd * 64 + seg * 8);
    const u32x4 vv = ld8g(WS(bf16_t, OFF_MVT) + ((size_t)(chunk * 4 + hd) * 64 + t) * 64 + seg * 8);
    u32x2 a, b2; a[0] = vv[0]; a[1] = vv[1]; b2[0] = vv[2]; b2[1] = vv[3]; *(u32x2*)(VTl + t * 68 + seg * 8) = a; *(u32x2*)(VTl + t * 68 + seg * 8 + 4) = b2;
    if (tid < 64) VTl[64 * 68 + tid] = (bf16_t)0x3F80u;
    for (int i = tid; i < 15 * 68; i += NTHREADS) VTl[65 * 68 + i] = 0;
#pragma unroll
    for (int dir = 0; dir < 2; ++dir) { const int chain = dir * 32 + c.b * 4 + hd, pc = ml_pc(c, dir); const bf16_t* st = WS(bf16_t, OFF_ST) + (size_t)(chain * 36 + pc) * 5120;
      *(u32x4*)(Cl + dir * 80 * 72 + (tid >> 3) * 72 + (tid & 7) * 8) = ld8g(st + tid * 8);
      if (tid < 128) *(u32x4*)(Cl + dir * 80 * 72 + ((512 + tid) >> 3) * 72 + (tid & 7) * 8) = ld8g(st + (512 + tid) * 8); } }
  if (tid < 128) { const int dir = tid >> 6, t = dir ? 63 - lane : lane, row = c.row0 + t;
    const int chain = dir * 32 + c.b * 4 + hd, pc = ml_pc(c, dir);
    const float li = WS(float, OFF_GLI)[(size_t)(dir * 4 + hd) * NTOK + row], lf = WS(float, OFF_GLF)[(size_t)(dir * 4 + hd) * NTOK + row];
    const float ms = WS(float, OFF_SCMB)[chain * 36 + pc];
    const float bc = scan_sum64(lf, lane);
    const float uu = li - bc; const float pm = scan_max64(uu, lane);
    const float mt = fmaxf(bc + ms, bc + pm);
    rowterm[dir * 64 + t] = bc - mt; uarr[dir * 64 + t] = uu; winter[dir * 64 + t] = __expf(bc + ms - mt); emt[dir * 64 + t] = __expf(-mt); }
  __syncthreads();
  const int tt = wid & 3, eh = wid >> 2, t = tt * 16 + fr;
  bf16x8 qfr[2];
#pragma unroll
  for (int ks = 0; ks < 2; ++ks) qfr[ks] = ld_frag16(Ql + t * 72 + ks * 32 + fq * 8);
  f32x4 g[4];
#pragma unroll
  for (int st = 0; st < 4; ++st) { g[st] = (f32x4){0.f, 0.f, 0.f, 0.f};
#pragma unroll
    for (int ks = 0; ks < 2; ++ks) g[st] = __builtin_amdgcn_mfma_f32_16x16x32_bf16(ld_frag16(Kl + (st * 16 + fr) * 72 + ks * 32 + fq * 8), qfr[ks], g[st], 0, 0, 0); }
  const int et0 = eh * 2;
  float hsum[2][4];
#pragma unroll
  for (int a = 0; a < 2; ++a)
#pragma unroll
    for (int j = 0; j < 4; ++j) hsum[a][j] = 0.f;
#pragma unroll
  for (int dir = 0; dir < 2; ++dir) {
    const float rt = rowterm[dir * 64 + t], wi = winter[dir * 64 + t], em = emt[dir * 64 + t];
    bf16x8 pf[2];
#pragma unroll
    for (int kk = 0; kk < 2; ++kk) { float v[8];
#pragma unroll
      for (int hh = 0; hh < 2; ++hh)
#pragma unroll
        for (int j = 0; j < 4; ++j) { const int s = (2 * kk + hh) * 16 + fq * 4 + j; const bool valid = dir ? (s >= t) : (s <= t);
          const float e = __expf(rt + uarr[dir * 64 + s]); v[hh * 4 + j] = valid ? g[2 * kk + hh][j] * e : 0.f; }
      pf[kk] = __builtin_bit_cast(bf16x8, pack8(v)); }
    f32x4 acc[3];
#pragma unroll
    for (int a = 0; a < 3; ++a) { const int et = a < 2 ? et0 + a : 4; const bf16_t* crow = Cl + dir * 80 * 72 + (et * 16 + fr) * 72;
      f32x4 x = {0.f, 0.f, 0.f, 0.f};
#pragma unroll
      for (int ks = 0; ks < 2; ++ks) x = __builtin_amdgcn_mfma_f32_16x16x32_bf16(ld_frag16(crow + ks * 32 + fq * 8), qfr[ks], x, 0, 0, 0);
      x *= wi;
      const bf16_t* vrow = VTl + (et * 16 + fr) * 68;
#pragma unroll
      for (int kk = 0; kk < 2; ++kk) x = __builtin_amdgcn_mfma_f32_16x16x32_bf16(ld_frag8x2(vrow + 32 * kk + fq * 4, vrow + 32 * kk + 16 + fq * 4), pf[kk], x, 0, 0, 0);
      acc[a] = x; }
    const float den = bperm(fr, acc[2][0]);
    const float dinv = 1.f / fmaxf(fabsf(den), em);
#pragma unroll
    for (int a = 0; a < 2; ++a)
#pragma unroll
      for (int j = 0; j < 4; ++j) hsum[a][j] += acc[a][j] * dinv;
  }
  float s1 = 0.f, s2 = 0.f;
#pragma unroll
  for (int a = 0; a < 2; ++a)
#pragma unroll
    for (int j = 0; j < 4; ++j) { s1 += hsum[a][j]; s2 += hsum[a][j] * hsum[a][j]; }
  s1 += bperm(lane ^ 16, s1); s1 += bperm(lane ^ 32, s1); s2 += bperm(lane ^ 16, s2); s2 += bperm(lane ^ 32, s2);
  if (fq == 0) { lnred[(eh * 64 + t) * 2] = s1; lnred[(eh * 64 + t) * 2 + 1] = s2; }
  __syncthreads();
  { const float a1 = lnred[t * 2] + lnred[(64 + t) * 2], a2 = lnred[t * 2 + 1] + lnred[(64 + t) * 2 + 1];
    const float mean = a1 * (1.f / 64.f), var = fmaxf(a2 * (1.f / 64.f) - mean * mean, 0.f), rstd = rsqrtf(var + LN_EPS);
    const int row = c.row0 + t;
#pragma unroll
    for (int a = 0; a < 2; ++a) { const int e0 = (et0 + a) * 16 + fq * 4;
      const u32x2 ow = *(const u32x2*)(WS(bf16_t, OFF_MO) + (size_t)row * 256 + hd * 64 + e0);
      const float og[4] = {lo16(ow[0]), hi16(ow[0]), lo16(ow[1]), hi16(ow[1])};
      const f32x4 ng = *(const f32x4*)(p.in[I_MLNG] + l * 256 + hd * 64 + e0);
      float y[4];
#pragma unroll
      for (int j = 0; j < 4; ++j) y[j] = sigmoidf_(og[j]) * (hsum[a][j] - mean) * rstd * ng[j];
      u32x2 w; w[0] = pack2(y[0], y[1]); w[1] = pack2(y[2], y[3]);
      *(u32x2*)(WS(bf16_t, OFF_H) + (size_t)row * 1024 + hd * 64 + e0) = w; } }
}

DEV void ph_mix(CParams& p, int lx, unsigned char* lds) {
  const int l = lx & 1;
  constexpr int NRW = 96;
  const int n_att = l == 0 ? 432 : 384, n_ml = l == 0 ? 288 * 4 : 256 * 4, total = NRW + n_att + n_ml;
  unsigned* cnt = WS(unsigned, OFF_CNT) + 16 + lx; unsigned* slot = (unsigned*)(lds + LDS_BYTES - 16);
  for (;;) {
    __syncthreads();
    if (TIDX() == 0) *slot = atomicAdd(cnt, 1u);
    __syncthreads();
    const int u = (int)*slot; if (u >= total) break;
    if (u < NRW) { for (int r_ = 0; r_ < RWREP; ++r_) rwkv_chunk_unit(p, l, u, lds); }
    else if (u < NRW + n_att) { for (int r_ = 0; r_ < ATREP; ++r_) attn_unit(p, u - NRW, lds); }
    else { const int v = u - NRW - n_att; const int chunk = (l == 0 ? 0 : 32) + (v >> 2); for (int r_ = 0; r_ < MLREP; ++r_) mlstm_out_unit(p, l, chunk, v & 3, lds); }
  }
  __syncthreads();
}

DEV void ph_rwpost(CParams& p, int l) {
  const int tid = TIDX(), lane = tid & 63, gw = blockIdx.x * 8 + (tid >> 6), nw = gridDim.x * 8, sl = lane & 7;
  const int rowbase = l == 0 ? 0 : NCTXR, nitems = (NTOK - rowbase) * 6;
  for (int it0 = gw * 8; it0 < nitems; it0 += nw * 8) { const int it = it0 + (lane >> 3); const int row = rowbase + it / 6, h6 = it % 6, col = h6 * 64 + sl * 8; const size_t o = (size_t)row * 384 + col;
    const bf16_t* lo = WS(bf16_t, OFF_LORA) + (size_t)row * 1920 + col;
    const u32x4 wy0 = ld8g(WS(bf16_t, OFF_RWY) + o), wy1 = ld8g(WS(bf16_t, OFF_RWY) + (size_t)NTOK * 384 + o), wv = ld8g(WS(bf16_t, OFF_VB) + o), wg = ld8g(lo + 1536);
    const float bs = WS(float, OFF_BS)[(size_t)row * 6 + h6] + WS(float, OFF_BS)[((size_t)NTOK + row) * 6 + h6];
    float y[8], t1[8], t2[8];
    unpack8(wy0, y); unpack8(wy1, t1);
    float s = 0.f;
#pragma unroll
    for (int i = 0; i < 8; ++i) { y[i] += t1[i]; s += y[i]; }
    const float mean = grp8_sum(s) * (1.f / 64.f); float q = 0.f;
#pragma unroll
    for (int i = 0; i < 8; ++i) { y[i] -= mean; q += y[i] * y[i]; }
    const float rstd = rsqrtf(grp8_sum(q) * (1.f / 64.f) + 64e-5f);
    float v[8], g[8], o8[8]; unpack8(wv, v); unpack8(wg, g);
#pragma unroll
    for (int i = 0; i < 8; ++i) o8[i] = (y[i] * rstd * p.in[I_RWGNG][l * 384 + col + i] + p.in[I_RWGNB][l * 384 + col + i] + bs * v[i]) * g[i];
    *(u32x4*)(WS(bf16_t, OFF_H) + (size_t)row * 1024 + 256 + col) = pack8(o8); }
}

DEV void ph_gemm_in(CParams& p, int l, unsigned char* lds) {
  pg8::StaticOrder S; S.init(NTOK, NINP, gridDim.x, blockIdx.x);
  pg8::Gemm g{WS(bf16_t, OFF_H), WS(bf16_t, OFF_WIN) + (size_t)l * NINP * 1024, NTOK, NINP, 1024};
  EpiBf16 E{WS(bf16_t, OFF_P), NIN, NIN}; pg8::gemm_phase((LAS unsigned char*)lds, g, S, E);
}
DEV void gemm_out_rows(CParams& p, int l, int row0, int M, unsigned char* lds) {
  pg8::StaticOrder S; S.init(M, 1024, gridDim.x, blockIdx.x);
  pg8::Gemm g{WS(bf16_t, OFF_H) + (size_t)row0 * 1024, WS(bf16_t, OFF_WOUT) + (size_t)l * 1024 * 1024, M, 1024, 1024};
  EpiBf16 E{WS(bf16_t, OFF_Y) + (size_t)row0 * 1024, 1024, 1024}; pg8::gemm_phase((LAS unsigned char*)lds, g, S, E);
}
DEV void ph_gemm_out(CParams& p, int l, unsigned char* lds) { if (l == 0 && gridDim.x != 256) gemm_out_rows(p, 0, 0, NTOK, lds); else gemm_out_rows(p, l, NCTXR, NLAT, lds); }
DEV void ln1_rows(CParams& p, int l, int r0, int r1, unsigned char* lds);
DEV void ph_gemm_pq(CParams& p, int l, unsigned char* lds) {
  const bool split = l == 0 && gridDim.x == 256; const int rb = (l == 0 && !split) ? 0 : NCTXR, M = NTOK - rb;
  if (split) { ln1_rows(p, 0, (int)blockIdx.x * 8, (int)blockIdx.x * 8 + 8, lds); __syncthreads(); }
  pg8::StaticOrder S; S.init(M, 2048, gridDim.x, blockIdx.x);
  pg8::Gemm g{WS(bf16_t, OFF_H) + (size_t)rb * 1024, WS(bf16_t, OFF_WPQ) + (size_t)l * 2048 * 1024, M, 2048, 1024};
  EpiBf16 E{WS(bf16_t, OFF_QP) + (size_t)rb * 2048, 2048, 2048}; pg8::gemm_phase((LAS unsigned char*)lds, g, S, E);
}

DEV void stage_vec(float* dst, const float* src_) { const int tid = TIDX(); if (tid < 256) *(f32x4*)(dst + tid * 4) = *(const f32x4*)(src_ + tid * 4); }
DEV void ln1_rows(CParams& p, int l, int r0, int r1, unsigned char* lds) {
  const int tid = TIDX(), lane = tid & 63, wid = tid >> 6;
  float* pl = (float*)lds;
  for (int seg0 = r0; seg0 < r1;) { const int mr = modrow_of(seg0); int seg1 = mr == 8 ? NCTXR : NCTXR + (mr + 1) * 2048; if (seg1 > r1) seg1 = r1;
    const float* md = WS(float, OFF_MOD) + (size_t)(l * 9 + mr) * 6144;
    __syncthreads();
    if (tid < 256) { *(f32x4*)(pl + tid * 4) = *(const f32x4*)(md + 2048 + tid * 4); *(f32x4*)(pl + 1024 + tid * 4) = *(const f32x4*)(p.in[I_LNMG] + l * 1024 + tid * 4); *(f32x4*)(pl + 2048 + tid * 4) = *(const f32x4*)(p.in[I_LNMB] + l * 1024 + tid * 4); }
    else { const int t2 = tid - 256; *(f32x4*)(pl + 3072 + t2 * 4) = *(const f32x4*)(md + 4096 + t2 * 4); *(f32x4*)(pl + 4096 + t2 * 4) = *(const f32x4*)(md + 3072 + t2 * 4); }
    __syncthreads();
#pragma unroll 1
    for (int row = seg0 + wid; row < seg1; row += 8) {
      const float* xo = x_in_row(p, row); const bf16_t* xc = WS(bf16_t, OFF_XC) + (size_t)row * 1024; const bf16_t* yr = WS(bf16_t, OFF_Y) + (size_t)row * 1024;
      f32x4 v[4]; float s = 0.f;
#pragma unroll
      for (int i = 0; i < 4; ++i) { const int col = lane * 4 + 256 * i; const u32x2 yw = *(const u32x2*)(yr + col); const f32x4 yv = {lo16(yw[0]), hi16(yw[0]), lo16(yw[1]), hi16(yw[1])};
        f32x4 xv; if (l == 0) xv = *(const f32x4*)(xo + col); else { const u32x2 xw_ = *(const u32x2*)(xc + col); xv = (f32x4){lo16(xw_[0]), hi16(xw_[0]), lo16(xw_[1]), hi16(xw_[1])}; }
        v[i] = xv * ALPHA + *(const f32x4*)(pl + col) * yv; s += (v[i][0] + v[i][1]) + (v[i][2] + v[i][3]); }
      float mean = wave_sum(s) * (1.f / 1024.f), q = 0.f;
#pragma unroll
      for (int i = 0; i < 4; ++i) { v[i] -= mean; q += (v[i][0] * v[i][0] + v[i][1] * v[i][1]) + (v[i][2] * v[i][2] + v[i][3] * v[i][3]); }
      float rstd = rsqrtf(wave_sum(q) * (1.f / 1024.f) + LN_EPS);
      bf16_t* xw = WS(bf16_t, OFF_XC) + (size_t)row * 1024; s = 0.f;
#pragma unroll
      for (int i = 0; i < 4; ++i) { const int col = lane * 4 + 256 * i; v[i] = v[i] * rstd * *(const f32x4*)(pl + 1024 + col) + *(const f32x4*)(pl + 2048 + col);
        u32x2 wx; wx[0] = pack2(v[i][0], v[i][1]); wx[1] = pack2(v[i][2], v[i][3]); *(u32x2*)(xw + col) = wx;
        v[i] = (f32x4){lo16(wx[0]), hi16(wx[0]), lo16(wx[1]), hi16(wx[1])};
        s += (v[i][0] + v[i][1]) + (v[i][2] + v[i][3]); }
      mean = wave_sum(s) * (1.f / 1024.f); q = 0.f;
#pragma unroll
      for (int i = 0; i < 4; ++i) { v[i] -= mean; q += (v[i][0] * v[i][0] + v[i][1] * v[i][1]) + (v[i][2] * v[i][2] + v[i][3] * v[i][3]); }
      rstd = rsqrtf(wave_sum(q) * (1.f / 1024.f) + LN_EPS);
#pragma unroll
      for (int i = 0; i < 4; ++i) { const int col = lane * 4 + 256 * i; const f32x4 o = v[i] * rstd * (*(const f32x4*)(pl + 3072 + col) + 1.f) + *(const f32x4*)(pl + 4096 + col);
        u32x2 w; w[0] = pack2(o[0], o[1]); w[1] = pack2(o[2], o[3]); *(u32x2*)(WS(bf16_t, OFF_H) + (size_t)row * 1024 + col) = w; }
    }
    seg0 = seg1; }
  __syncthreads();
}

DEV void ph_ln1(CParams& p, int l, unsigned char* lds) {
  const int b = (int)blockIdx.x;
  if (l == 0 && gridDim.x != 256) { const int per = (NTOK + (int)gridDim.x - 1) / (int)gridDim.x, r0 = b * per; int r1 = r0 + per; if (r1 > NTOK) r1 = NTOK; if (r0 < NTOK) ln1_rows(p, 0, r0, r1, lds); }
  else if (l == 0) {
    if (b < 32) { gemm_out_rows(p, 0, 0, NCTXR, lds); __syncthreads(); }
    const int r0 = NCTXR + (b < 32 ? b * 4 : 128 + (b - 32) * 73); int r1 = r0 + (b < 32 ? 4 : 73); if (r1 > NTOK) r1 = NTOK;
    if (r0 < NTOK) ln1_rows(p, 0, r0, r1, lds);
  } else { const int per = (NLAT + (int)gridDim.x - 1) / (int)gridDim.x, r0 = NCTXR + b * per; int r1 = r0 + per; if (r1 > NTOK) r1 = NTOK; if (r0 < NTOK) ln1_rows(p, l, r0, r1, lds); }
}

DEV unsigned f2ord(float f) { const unsigned u = __float_as_uint(f); return (u >> 31) ? ~u : (u | 0x80000000u); }
DEV float ord2f(unsigned o) { return __uint_as_float((o >> 31) ? (o & 0x7fffffffu) : ~o); }
DEV unsigned dppu_max(unsigned x, unsigned y) { return x > y ? x : y; }
template <int CTRL> DEV unsigned dppu(unsigned x) { return (unsigned)__builtin_amdgcn_mov_dpp((int)x, CTRL, 0xf, 0xf, true); }
DEV void topk_unit(CParams& p, int l, int tile, int head, unsigned char* lds, const bf16x8 (&kf)[8][4]) {
  constexpr int RS = 136;
  unsigned* KEYSl = (unsigned*)lds;
  unsigned* LISTl = (unsigned*)(lds + 256 * RS * 4);
  const int tid = TIDX(), lane = tid & 63, wid = tid >> 6, fr = lane & 15, fq = lane >> 4;
  const int row0 = (l == 0 ? 0 : NCTXR) + tile * 128;
  __syncthreads();
  for (int r1_ = 0; r1_ < T1_REP; ++r1_)
  { const int g = head * 2 + (wid >> 2);
    const bf16_t* qp = WS(bf16_t, OFF_QP) + (size_t)(row0 + (wid & 3) * 32) * 2048 + g * 128 + fq * 8;
    bf16x8 af[2][4];
#pragma unroll
    for (int tm = 0; tm < 2; ++tm)
#pragma unroll
      for (int ks = 0; ks < 4; ++ks) af[tm][ks] = __builtin_bit_cast(bf16x8, ld8g(qp + (size_t)(tm * 16 + fr) * 2048 + ks * 32));
#pragma unroll
    for (int nt = 0; nt < 8; ++nt) { f32x4 a0 = {0.f, 0.f, 0.f, 0.f}, a1 = {0.f, 0.f, 0.f, 0.f};
#pragma unroll
      for (int ks = 0; ks < 4; ++ks) { a0 = __builtin_amdgcn_mfma_f32_16x16x32_bf16(kf[nt][ks], af[0][ks], a0, 0, 0, 0); a1 = __builtin_amdgcn_mfma_f32_16x16x32_bf16(kf[nt][ks], af[1][ks], a1, 0, 0, 0); }
      const int key0 = nt * 16 + fq * 4; const unsigned kb = 127u - (unsigned)key0; const int ko = key0 + (nt >= 4 ? 4 : 0);
      u32x4 w0, w1;
#pragma unroll
      for (int j = 0; j < 4; ++j) { w0[j] = (f2ord(a0[j]) & ~127u) | (kb - (unsigned)j); w1[j] = (f2ord(a1[j]) & ~127u) | (kb - (unsigned)j); }
      *(u32x4*)(KEYSl + (wid * 32 + fr) * RS + ko) = w0; *(u32x4*)(KEYSl + (wid * 32 + 16 + fr) * RS + ko) = w1; } }
  __syncthreads();
  for (int r2_ = 0; r2_ < T2_REP; ++r2_)
  { const int row = tid >> 1, hf = tid & 1; const unsigned* kr = KEYSl + row * RS + hf * 68; unsigned m[4];
#pragma unroll
    for (int sg = 0; sg < 4; ++sg) { unsigned mm = 0u;
#pragma unroll
      for (int i = 0; i < 4; ++i) { const u32x4 x = *(const u32x4*)(kr + sg * 16 + i * 4); mm = max(max(mm, x[0]), max(x[1], max(x[2], x[3]))); }
      m[sg] = mm; }
#pragma unroll 1
    for (int r = 0; r < 16; ++r) { const unsigned lb = max(max(m[0], m[1]), max(m[2], m[3])); const unsigned best = max(lb, dppu<0xB1>(lb));
      if (hf == 0) LISTl[row * 16 + r] = best;
      if (lb == best) { const int sg = ((int)(127u - (best & 127u)) >> 4) & 3; unsigned nm = 0u;
#pragma unroll
        for (int i = 0; i < 4; ++i) { const u32x4 x = *(const u32x4*)(kr + sg * 16 + i * 4);
#pragma unroll
          for (int j = 0; j < 4; ++j) nm = max(nm, x[j] < best ? x[j] : 0u); }
#pragma unroll
        for (int s2 = 0; s2 < 4; ++s2) m[s2] = (s2 == sg) ? nm : m[s2]; } } }
  __syncthreads();
  for (int r3_ = 0; r3_ < T3_REP; ++r3_)
  { const int token = tid >> 2, role = tid & 3;
    const unsigned* L1 = LISTl + token * 16; const unsigned* L2 = LISTl + (128 + token) * 16;
    unsigned ck[16];
#pragma unroll
    for (int i = 0; i < 16; ++i) { int a, b; bool valid;
      if (role == 0) { a = 0; b = i; valid = true; }
      else if (role == 1) { a = i < 8 ? 1 : 2; b = i < 8 ? i : i - 8; valid = i < 13; }
      else if (role == 2) { a = i < 4 ? 3 : i < 7 ? 4 : i < 9 ? 5 : 6; b = i - (i < 4 ? 0 : i < 7 ? 4 : i < 9 ? 7 : 9); valid = i < 11; }
      else { a = i < 2 ? 7 : 6 + i; b = i < 2 ? i : 0; valid = i < 10; }
      if (!valid) { a = 0; b = 0; }
      const float v = ord2f(L1[a] & ~127u) + ord2f(L2[b] & ~127u);
      ck[i] = valid ? ((f2ord(v) & ~255u) | (unsigned)(255 - (a * 16 + b))) : 0u; }
    unsigned rec[4]; unsigned prev = 0xffffffffu;
#pragma unroll
    for (int r = 0; r < 16; ++r) { unsigned best = 0u;
#pragma unroll
      for (int i = 0; i < 16; ++i) best = max(best, ck[i] < prev ? ck[i] : 0u);
      best = max(best, dppu<0xB1>(best)); best = max(best, dppu<0x4E>(best));
      prev = best;
      if (role == (r & 3)) rec[r >> 2] = best; }
    float bv[4]; int be[4];
#pragma unroll
    for (int j = 0; j < 4; ++j) { const int t = 255 - (int)(rec[j] & 255u); const unsigned x1 = L1[t >> 4], x2 = L2[t & 15];
      bv[j] = ord2f(x1 & ~127u) + ord2f(x2 & ~127u); be[j] = (int)(127u - (x1 & 127u)) * 128 + (int)(127u - (x2 & 127u)); }
    const float v0 = dppf<0x00>(bv[0]);
    float sum = 0.f;
#pragma unroll
    for (int j = 0; j < 4; ++j) { bv[j] = __expf(bv[j] - v0); sum += bv[j]; }
    sum += dppf<0xB1>(sum); sum += dppf<0x4E>(sum);
    const float isum = 1.f / sum;
    const int row = row0 + token;
    int* eo = WS(int, OFF_EID) + (size_t)row * 128 + head * 16; float* go = WS(float, OFF_GATE) + (size_t)row * 128 + head * 16;
#pragma unroll
    for (int j = 0; j < 4; ++j) { eo[j * 4 + role] = be[j]; go[j * 4 + role] = bv[j] * isum; }
  }
  __syncthreads();
}
DEV void topk_keys(CParams& p, int l, int head, bf16x8 (&kf)[8][4]) { const int lane = TIDX() & 63, wid = TIDX() >> 6;
  const bf16_t* kp = WS(bf16_t, OFF_KEYS) + ((size_t)(l * 16 + head * 2 + (wid >> 2)) * 128) * 128 + (lane >> 4) * 8;
#pragma unroll
  for (int nt = 0; nt < 8; ++nt)
#pragma unroll
    for (int ks = 0; ks < 4; ++ks) kf[nt][ks] = __builtin_bit_cast(bf16x8, ld8g(kp + (size_t)(nt * 16 + (lane & 15)) * 128 + ks * 32)); }
DEV void ph_topk_l0(CParams& p, unsigned char* lds) {
  const int b = (int)blockIdx.x, head = b & 7, j = b >> 3;
  bf16x8 kf[8][4];
  if (b < 64) {
    pg8::OneUnit S{true, {j, head}};
    pg8::Gemm g{WS(bf16_t, OFF_H), WS(bf16_t, OFF_WPQ), NCTXR, 2048, 1024};
    EpiBf16 E{WS(bf16_t, OFF_QP), 2048, 2048}; pg8::gemm_phase((LAS unsigned char*)lds, g, S, E);
    asm volatile("s_waitcnt vmcnt(0)" ::: "memory"); __syncthreads();
    __builtin_amdgcn_fence(__ATOMIC_ACQUIRE, "agent"); asm volatile("s_waitcnt vmcnt(0)" ::: "memory");
    topk_keys(p, 0, head, kf);
    topk_unit(p, 0, 2 * j, head, lds, kf); topk_unit(p, 0, 2 * j + 1, head, lds, kf);
    topk_unit(p, 0, 16 + j, head, lds, kf);
  } else {
    topk_keys(p, 0, head, kf);
#pragma unroll 1
    for (int i = 0; i < 5; ++i) topk_unit(p, 0, 16 + 8 + (j - 8) * 5 + i, head, lds, kf);
  }
}
DEV void ph_topk(CParams& p, int l, unsigned char* lds) {
  if (l == 0 && gridDim.x == 256) { ph_topk_l0(p, lds); return; }
  const int ntile = (l == 0 ? NTOK : NLAT) / 128;
  bf16x8 kf[8][4]; int curh = -1; const int lane = TIDX() & 63, wid = TIDX() >> 6;
  for (int u = blockIdx.x; u < ntile * 8; u += gridDim.x) { const int head = u & 7;
    if (head != curh) { curh = head;
      const bf16_t* kp = WS(bf16_t, OFF_KEYS) + ((size_t)(l * 16 + head * 2 + (wid >> 2)) * 128) * 128 + (lane >> 4) * 8;
#pragma unroll
      for (int nt = 0; nt < 8; ++nt)
#pragma unroll
        for (int ks = 0; ks < 4; ++ks) kf[nt][ks] = __builtin_bit_cast(bf16x8, ld8g(kp + (size_t)(nt * 16 + (lane & 15)) * 128 + ks * 32)); }
    topk_unit(p, l, u >> 3, head, lds, kf); }
}

DEV float gelu_tanh(float x) { const float z = 0.7978845608f * (x + 0.044715f * x * x * x); const float t = 1.f - 2.f * __builtin_amdgcn_rcpf(1.f + __expf(2.f * z)); return 0.5f * x * (1.f + t); }
DEV void fp8x16_to_f32(u32x4 w, float* f) {
#pragma unroll
  for (int i = 0; i < 4; ++i) { const f32x2 a = __builtin_amdgcn_cvt_pk_f32_fp8((int)w[i], false), b = __builtin_amdgcn_cvt_pk_f32_fp8((int)w[i], true); f[4 * i] = a[0]; f[4 * i + 1] = a[1]; f[4 * i + 2] = b[0]; f[4 * i + 3] = b[1]; } }
DEV void fp4x32_to_f32(u32x4 w, float* f) {
#pragma unroll
  for (int i = 0; i < 4; ++i) {
    const f32x2 a = __builtin_amdgcn_cvt_scalef32_pk_f32_fp4(w[i], 1.0f, 0), b = __builtin_amdgcn_cvt_scalef32_pk_f32_fp4(w[i], 1.0f, 1), c = __builtin_amdgcn_cvt_scalef32_pk_f32_fp4(w[i], 1.0f, 2), d = __builtin_amdgcn_cvt_scalef32_pk_f32_fp4(w[i], 1.0f, 3);
    f[8 * i] = a[0]; f[8 * i + 1] = a[1]; f[8 * i + 2] = b[0]; f[8 * i + 3] = b[1]; f[8 * i + 4] = c[0]; f[8 * i + 5] = c[1]; f[8 * i + 6] = d[0]; f[8 * i + 7] = d[1]; } }
DEV void ph_gather(CParams& p, int l, unsigned char* lds) {
  const int tid = TIDX(), lane = tid & 63, wid = tid >> 6, dl = lane & 7, g = lane >> 3;
  const int rb = l == 0 ? 0 : NCTXR, ntok = NTOK - rb;
  const int per = (ntok + (int)gridDim.x - 1) / (int)gridDim.x, tb0 = (int)blockIdx.x * per;
  int* eidl = (int*)lds; float* gatel = (float*)(lds + 36864); float* dotl = (float*)(lds + 73728);
  const unsigned char* TU = WS(unsigned char, OFF_TABU); const unsigned char* TV = WS(unsigned char, OFF_TABV);
  bf16_t* Yb = WS(bf16_t, OFF_Y);
  float* pvec = (float*)(lds + 110592); int mr0;
  { const int ra = rb + tb0, rz = rb + (tb0 + per < ntok ? tb0 + per : ntok) - 1; mr0 = modrow_of(ra < NTOK ? ra : NTOK - 1); const int mr1 = modrow_of(rz < ra ? (ra < NTOK ? ra : NTOK - 1) : rz);
    __syncthreads();
    for (int i = tid; i < 2 * 5 * 256; i += NTHREADS) { const int set = i / 1280, r5 = (i - set * 1280) >> 8, c4 = (i & 255) * 4; const int mr = set ? mr1 : mr0;
      const float* s_ = r5 == 0 ? WS(float, OFF_MOD) + (size_t)(l * 9 + mr) * 6144 + 5120 : r5 == 1 ? p.in[I_LNFG] + l * 1024 : r5 == 2 ? p.in[I_LNFB] + l * 1024 : WS(float, OFF_MOD) + (size_t)(9 + mr) * 6144 + (r5 - 3) * 1024;
      *(f32x4*)(pvec + set * 5120 + r5 * 1024 + c4) = *(const f32x4*)(s_ + c4); }
    __syncthreads(); }
  for (int base = tb0; base < tb0 + per && base < ntok; base += 72) {
    int n = tb0 + per - base; if (n > 72) n = 72; if (n > ntok - base) n = ntok - base;
    const int row0 = rb + base;
    for (int grep_ = 0; grep_ < GREP; ++grep_) {
    __builtin_amdgcn_wave_barrier();
    for (int tk = wid; tk < n; tk += 8) { const size_t o = (size_t)(row0 + tk) * 128;
      eidl[tk * 128 + lane] = WS(int, OFF_EID)[o + lane]; eidl[tk * 128 + 64 + lane] = WS(int, OFF_EID)[o + 64 + lane];
      gatel[tk * 128 + lane] = WS(float, OFF_GATE)[o + lane]; gatel[tk * 128 + 64 + lane] = WS(float, OFF_GATE)[o + 64 + lane];
      dotl[tk * 128 + lane] = 0.f; dotl[tk * 128 + 64 + lane] = 0.f; }
    asm volatile("s_waitcnt lgkmcnt(0)" ::: "memory"); __builtin_amdgcn_wave_barrier();
#pragma unroll 1
    for (int s = 0; s < 4; ++s) {
#pragma unroll 1
      for (int tk = wid; tk < n; tk += 8) {
        float hx[32]; { const bf16_t* hp = WS(bf16_t, OFF_H) + (size_t)(row0 + tk) * 1024 + s * 256 + dl * 32; unpack8(ld8g(hp), hx); unpack8(ld8g(hp + 8), hx + 8); unpack8(ld8g(hp + 16), hx + 16); unpack8(ld8g(hp + 24), hx + 24); }
        const unsigned char* tus = TU + (size_t)s * 16384 * 128 + dl * 16; const int* el = eidl + tk * 128 + g; float* dp = dotl + tk * 128 + g;
        u32x4 wq[16];
#pragma unroll
        for (int ps = 0; ps < 16; ++ps) wq[ps] = *(const u32x4*)(tus + (size_t)el[ps * 8] * 128);
#pragma unroll
        for (int ps = 0; ps < 16; ++ps) { const u32x4 w = wq[ps]; f32x2 dd = {0.f, 0.f};
#pragma unroll
          for (int i = 0; i < 4; ++i) {
            dd += __builtin_amdgcn_cvt_scalef32_pk_f32_fp4(w[i], 1.0f, 0) * (f32x2){hx[8 * i], hx[8 * i + 1]}; dd += __builtin_amdgcn_cvt_scalef32_pk_f32_fp4(w[i], 1.0f, 1) * (f32x2){hx[8 * i + 2], hx[8 * i + 3]};
            dd += __builtin_amdgcn_cvt_scalef32_pk_f32_fp4(w[i], 1.0f, 2) * (f32x2){hx[8 * i + 4], hx[8 * i + 5]}; dd += __builtin_amdgcn_cvt_scalef32_pk_f32_fp4(w[i], 1.0f, 3) * (f32x2){hx[8 * i + 6], hx[8 * i + 7]}; }
          const float d = grp8_sum(dd[0] + dd[1]);
          if (dl == 0) dp[ps * 8] += d; } } }
    asm volatile("s_waitcnt lgkmcnt(0)" ::: "memory"); __builtin_amdgcn_wave_barrier();
    for (int tk = wid; tk < n; tk += 8) {
#pragma unroll
      for (int hh = 0; hh < 2; ++hh) { const int i = tk * 128 + hh * 64 + lane; dotl[i] = gatel[i] * gelu_tanh(dotl[i] * (1.f / 64.f)); } }
    asm volatile("s_waitcnt lgkmcnt(0)" ::: "memory"); __builtin_amdgcn_wave_barrier();
#pragma unroll 1
    for (int s = 0; s < 4; ++s) {
#pragma unroll 1
      for (int tk = wid; tk < n; tk += 8) {
        const unsigned char* tvs = TV + (size_t)s * 16384 * 128 + dl * 16; const int* el = eidl + tk * 128 + g; const float* cp = dotl + tk * 128 + g;
        f32x2 ac2[16];
#pragma unroll
        for (int j = 0; j < 16; ++j) ac2[j] = (f32x2){0.f, 0.f};
        u32x4 wq[16];
#pragma unroll
        for (int ps = 0; ps < 16; ++ps) wq[ps] = *(const u32x4*)(tvs + (size_t)el[ps * 8] * 128);
#pragma unroll
        for (int ps = 0; ps < 16; ++ps) { const u32x4 w = wq[ps]; const float cc = cp[ps * 8]; const f32x2 c2 = {cc, cc};
#pragma unroll
          for (int i = 0; i < 4; ++i) { ac2[4 * i] += c2 * __builtin_amdgcn_cvt_scalef32_pk_f32_fp4(w[i], 1.0f, 0); ac2[4 * i + 1] += c2 * __builtin_amdgcn_cvt_scalef32_pk_f32_fp4(w[i], 1.0f, 1);
            ac2[4 * i + 2] += c2 * __builtin_amdgcn_cvt_scalef32_pk_f32_fp4(w[i], 1.0f, 2); ac2[4 * i + 3] += c2 * __builtin_amdgcn_cvt_scalef32_pk_f32_fp4(w[i], 1.0f, 3); } }
        float acc[32];
#pragma unroll
        for (int j = 0; j < 16; ++j) { acc[2 * j] = ac2[j][0]; acc[2 * j + 1] = ac2[j][1]; }
        float r16[16], r8[8];
#pragma unroll
        for (int j = 0; j < 16; ++j) { auto rr = __builtin_amdgcn_permlane32_swap(__float_as_uint(acc[j]), __float_as_uint(acc[j + 16]), false, false); r16[j] = __uint_as_float(rr[0]) + __uint_as_float(rr[1]); }
#pragma unroll
        for (int j = 0; j < 8; ++j) { auto rr = __builtin_amdgcn_permlane16_swap(__float_as_uint(r16[j]), __float_as_uint(r16[j + 8]), false, false); r8[j] = __uint_as_float(rr[0]) + __uint_as_float(rr[1]); }
        const bool b3 = (lane & 8) != 0; f32x4 o;
#pragma unroll
        for (int j = 0; j < 4; ++j) { const float x = r8[j] + dppf<0x128>(r8[j]), y = r8[j + 4] + dppf<0x128>(r8[j + 4]); o[j] = (b3 ? y : x) * 0.25f; }
        u32x2 ow; ow[0] = pack2(o[0], o[1]); ow[1] = pack2(o[2], o[3]);
        *(u32x2*)(Yb + (size_t)(row0 + tk) * 1024 + s * 256 + dl * 32 + ((lane >> 5) & 1) * 16 + ((lane >> 4) & 1) * 8 + (b3 ? 4 : 0)) = ow; } }
    }
    asm volatile("s_waitcnt vmcnt(0)" ::: "memory"); __builtin_amdgcn_fence(__ATOMIC_ACQUIRE, "agent"); asm volatile("s_waitcnt vmcnt(0)" ::: "memory");
#pragma unroll 1
    for (int tk = wid; tk < n; tk += 8) { const int row = row0 + tk;
      bf16_t* xw = WS(bf16_t, OFF_XC) + (size_t)row * 1024; const bf16_t* yr = Yb + (size_t)row * 1024;
      const float* pl = pvec + (modrow_of(row) == mr0 ? 0 : 5120);
      f32x4 v[4]; float sm = 0.f;
#pragma unroll
      for (int i = 0; i < 4; ++i) { const int col = lane * 4 + 256 * i; const u32x2 yw = *(const u32x2*)(yr + col), xq = *(const u32x2*)(xw + col);
        const f32x4 xo = {lo16(xq[0]), hi16(xq[0]), lo16(xq[1]), hi16(xq[1])}, ya = {lo16(yw[0]), hi16(yw[0]), lo16(yw[1]), hi16(yw[1])};
        v[i] = xo * ALPHA + *(const f32x4*)(pl + col) * ya; sm += (v[i][0] + v[i][1]) + (v[i][2] + v[i][3]); }
      float mean = wave_sum(sm) * (1.f / 1024.f), q = 0.f;
#pragma unroll
      for (int i = 0; i < 4; ++i) { v[i] -= mean; q += (v[i][0] * v[i][0] + v[i][1] * v[i][1]) + (v[i][2] * v[i][2] + v[i][3] * v[i][3]); }
      float rstd = rsqrtf(wave_sum(q) * (1.f / 1024.f) + LN_EPS);
      sm = 0.f;
#pragma unroll
      for (int i = 0; i < 4; ++i) { const int col = lane * 4 + 256 * i; const f32x4 o = v[i] * rstd * *(const f32x4*)(pl + 1024 + col) + *(const f32x4*)(pl + 2048 + col);
        v[i] = o; sm += (o[0] + o[1]) + (o[2] + o[3]);
        if (l == 0) { u32x2 wx; wx[0] = pack2(o[0], o[1]); wx[1] = pack2(o[2], o[3]); *(u32x2*)(xw + col) = wx; }
        else if (row >= NCTXR) *(f32x4*)(p.out + (size_t)(row - NCTXR) * DM + col) = o; }
      if (l == 0) {
        mean = wave_sum(sm) * (1.f / 1024.f); q = 0.f;
#pragma unroll
        for (int i = 0; i < 4; ++i) { v[i] -= mean; q += (v[i][0] * v[i][0] + v[i][1] * v[i][1]) + (v[i][2] * v[i][2] + v[i][3] * v[i][3]); }
        rstd = rsqrtf(wave_sum(q) * (1.f / 1024.f) + LN_EPS);
#pragma unroll
        for (int i = 0; i < 4; ++i) { const int col = lane * 4 + 256 * i; const f32x4 o = v[i] * rstd * (*(const f32x4*)(pl + 4096 + col) + 1.f) + *(const f32x4*)(pl + 3072 + col);
          u32x2 w; w[0] = pack2(o[0], o[1]); w[1] = pack2(o[2], o[3]); *(u32x2*)(WS(bf16_t, OFF_H) + (size_t)row * 1024 + col) = w; }
      } }
  }
}

#if !MULTI_LAUNCH
__global__ __launch_bounds__(NTHREADS, 2) void mega(Params p_, int lo, int hi, int coop) {
  extern __shared__ __attribute__((aligned(16))) unsigned char shm[];
  volatile LAS unsigned* bst = (volatile LAS unsigned*)(LAS unsigned char*)(shm + LDS_BYTES - 32);
  if (TIDX() == 0) { bst[0] = 0u; bst[1] = 0u; }
  __syncthreads();
  { CParams* kp0 = (CParams*)__builtin_amdgcn_kernarg_segment_ptr(); xcd_barrier_post((unsigned*)(kp0->ws + OFF_BAR)); }
  for (int step = lo; step < hi; ++step) {
    CParams* kp = (CParams*)__builtin_amdgcn_kernarg_segment_ptr(); asm volatile("" : "+s"(kp)); CParams& p = *kp;
    if (step == 0) { ph_init(p, shm); if (REPSET == 25) { __syncthreads(); ph_init(p, shm); } }
    else { const int l = (step - 1) / 11, k = (step - 1) % 11;
      for (int rep = 0; rep < REPS[k]; ++rep) { if (rep > 0 && coop) xcd_barrier(WS(unsigned, OFF_BAR), bst);
      switch (k) {
        case 0: if (l == 0) ph_lnmod(p, 0); break;
        case 1: ph_gemm_in(p, l, shm); break;
        case 2: ph_prep(p, l, shm); break;
        case 3: ph_mid(p, l + 2 * rep, shm); break;
        case 4: ph_mix(p, l + 2 * rep, shm); break;
        case 5: ph_rwpost(p, l); break;
        case 6: ph_gemm_out(p, l, shm); break;
        case 7: ph_ln1(p, l, shm); break;
        case 8: ph_gemm_pq(p, l, shm); break;
        case 9: ph_topk(p, l, shm); break;
        case 10: ph_gather(p, l, shm); break;
      } } }
    if (coop && step + 1 < hi) { if (lo < 0) cg::this_grid().sync(); else xcd_barrier(WS(unsigned, OFF_BAR), bst); }
    if (coop && step == 5) for (int xb_ = 0; xb_ < XBAR; ++xb_) xcd_barrier(WS(unsigned, OFF_BAR), bst);
  }
}
#endif

#if MULTI_LAUNCH
template <int K> __global__ __launch_bounds__(NTHREADS, 2) void phase_k(Params p_, int l) {
  extern __shared__ __attribute__((aligned(16))) unsigned char shm[];
  CParams& p = *(CParams*)__builtin_amdgcn_kernarg_segment_ptr();
  if constexpr (K == -1) ph_init(p, shm);
  if constexpr (K == 0) ph_lnmod(p, 0);
  if constexpr (K == 1) ph_gemm_in(p, l, shm);
  if constexpr (K == 2) ph_prep(p, l, shm);
  if constexpr (K == 3) ph_mid(p, l, shm);
  if constexpr (K == 4) ph_mix(p, l, shm);
  if constexpr (K == 5) ph_rwpost(p, l);
  if constexpr (K == 6) ph_gemm_out(p, l, shm);
  if constexpr (K == 7) ph_ln1(p, l, shm);
  if constexpr (K == 8) ph_gemm_pq(p, l, shm);
  if constexpr (K == 9) ph_topk(p, l, shm);
  if constexpr (K == 10) ph_gather(p, l, shm);
  if constexpr (K >= 30) ph_mid_t<K - 30>(p, l, shm);
}
template __global__ void phase_k<-1>(Params, int); template __global__ void phase_k<0>(Params, int); template __global__ void phase_k<1>(Params, int);
template __global__ void phase_k<2>(Params, int); template __global__ void phase_k<4>(Params, int);
template __global__ void phase_k<5>(Params, int); template __global__ void phase_k<6>(Params, int); template __global__ void phase_k<7>(Params, int);
template __global__ void phase_k<8>(Params, int); template __global__ void phase_k<31>(Params, int); template __global__ void phase_k<32>(Params, int); template __global__ void phase_k<34>(Params, int); template __global__ void phase_k<38>(Params, int); template __global__ void phase_k<9>(Params, int); template __global__ void phase_k<10>(Params, int);

#endif

extern "C" void kernel_launch(void* const* d_in, const int* in_sizes, int n_in, void* d_out, int out_size, void* d_ws, size_t ws_size, hipStream_t stream) {
  if (n_in < N_INPUTS || ws_size < WS_NEEDED) return;
  Params p{};
  for (int i = 0; i < N_INPUTS; ++i) p.in[i] = (const float*)d_in[i];
  p.out = (float*)d_out; p.ws = (unsigned char*)d_ws;
  static int grid = 0;
  if (!grid) {
    int dev = 0, cus = 0; (void)hipGetDevice(&dev); (void)hipDeviceGetAttribute(&cus, hipDeviceAttributeMultiprocessorCount, dev);
    grid = cus > 0 ? (cus > 256 ? 256 : cus) : 256;
#if !MULTI_LAUNCH
    (void)hipFuncSetAttribute((const void*)mega, hipFuncAttributeMaxDynamicSharedMemorySize, (int)LDS_BYTES);
    int per = 0; (void)hipOccupancyMaxActiveBlocksPerMultiprocessor(&per, mega, NTHREADS, LDS_BYTES);
    if (per < 1) grid = 0;
#endif
  }
  const int nsteps = 23;
#if MULTI_LAUNCH
#define LAUNCH_K(K, L) do { (void)hipFuncSetAttribute((const void*)phase_k<K>, hipFuncAttributeMaxDynamicSharedMemorySize, (int)LDS_BYTES); \
    hipLaunchKernelGGL(phase_k<K>, dim3(grid), dim3(NTHREADS), LDS_BYTES, stream, p, L); } while (0)
  (void)nsteps;
  LAUNCH_K(-1, 0);
  for (int l = 0; l < 2; ++l) {
    if (l == 0) LAUNCH_K(0, 0);
    LAUNCH_K(1, l); LAUNCH_K(2, l); LAUNCH_K(31, l); LAUNCH_K(32, l); LAUNCH_K(34, l); LAUNCH_K(38, l);
    LAUNCH_K(4, l); LAUNCH_K(5, l); LAUNCH_K(6, l); LAUNCH_K(7, l); LAUNCH_K(8, l); LAUNCH_K(9, l); LAUNCH_K(10, l);
  }
#else
  if (grid <= 0) return;
  (void)hipMemsetAsync((unsigned char*)d_ws + OFF_CNT, 0, SZ_CNT, stream);
  int lo = 0, hi = nsteps, coop = 1; void* args[] = {&p, &lo, &hi, &coop};
  (void)hipLaunchCooperativeKernel((const void*)mega, dim3(grid), dim3(NTHREADS), args, LDS_BYTES, stream);
#endif
}
```

```cpp
#include <hip/hip_runtime.h>
#include <hip/hip_cooperative_groups.h>
namespace cg = cooperative_groups;

#ifndef MULTI_LAUNCH
#define MULTI_LAUNCH 0
#endif

#ifndef REPSET
#define REPSET 0
#endif
#define DEV __device__ __forceinline__
#define LAS __attribute__((address_space(3)))
typedef unsigned short bf16_t;
typedef short bf16x8 __attribute__((ext_vector_type(8)));
typedef float f32x4 __attribute__((ext_vector_type(4)));
typedef float f32x2 __attribute__((ext_vector_type(2)));
typedef float f32x16 __attribute__((ext_vector_type(16)));
typedef unsigned u32x4 __attribute__((ext_vector_type(4)));
typedef unsigned u32x2 __attribute__((ext_vector_type(2)));

constexpr int NTOK = 18432, NCTXR = 2048, NLAT = 16384, DM = 1024;
constexpr int NIN = 3248, NINP = 3328;
constexpr float ALPHA = 1.41421356237f;
constexpr float LN_EPS = 1e-6f;
constexpr int NTHREADS = 512;
constexpr size_t LDS_BYTES = 160 * 1024;
#if REPSET == 5
__device__ constexpr int REPS[11] = {1, 1, 2, 1, 1, 1, 1, 1, 1, 1, 1};
#elif REPSET == 6
__device__ constexpr int REPS[11] = {1, 1, 1, 1, 1, 1, 1, 1, 1, 2, 1};
#elif REPSET == 7
__device__ constexpr int REPS[11] = {2, 1, 1, 1, 1, 2, 1, 1, 1, 1, 1};
#elif REPSET == 13
__device__ constexpr int REPS[11] = {1, 2, 1, 1, 1, 1, 1, 1, 1, 1, 1};
#elif REPSET == 14
__device__ constexpr int REPS[11] = {1, 1, 1, 1, 1, 1, 2, 1, 2, 1, 1};
#else
__device__ constexpr int REPS[11] = {1, 1, 1, 1, 1, 1, 1, 1, 1, 1, 1};
#endif
constexpr bool FP4_EMU = REPSET == 30;
constexpr int PM_REP = REPSET == 20 ? 2 : 1, PF_REP = REPSET == 21 ? 2 : 1, T1_REP = REPSET == 22 ? 2 : 1, T2_REP = REPSET == 23 ? 2 : 1, T3_REP = REPSET == 24 ? 2 : 1;
constexpr unsigned CONV_MID0 = (96u * 4u * 36u) / 8u;
constexpr int GREP = REPSET == 8 ? 2 : 1, XBAR = REPSET == 9 ? 20 : 0, RWREP = REPSET == 10 ? 2 : 1, ATREP = REPSET == 11 ? 2 : 1, MLREP = REPSET == 12 ? 2 : 1;

enum { I_X = 0, I_C, I_CTX, I_CCTX, I_WMOD, I_BMOD, I_WIN, I_MLCW, I_MLCB, I_MLIB, I_MLFB, I_MLNG, I_RWMU, I_RWW0, I_RWWUP, I_RWA0, I_RWAUP,
       I_RWGUP, I_RWKK, I_RWKA, I_RWRK, I_RWGNG, I_RWGNB, I_QNG, I_QUP, I_KVNG, I_KVUP, I_WOUT, I_LNMG, I_LNMB, I_PWQ, I_PKEYS, I_PU, I_PV, I_LNFG, I_LNFB, N_INPUTS };

constexpr size_t A256(size_t x) { return (x + 255) & ~size_t(255); }
constexpr size_t SZ_WIN = 2ull * NINP * 1024 * 2, SZ_WOUT = 2ull * 1024 * 1024 * 2, SZ_WPQ = 2ull * 2048 * 1024 * 2, SZ_WLORA = 2ull * 2048 * 384 * 2,
                 SZ_WQUP = 2ull * 768 * 384 * 2, SZ_WKVUP = 2ull * 768 * 256 * 2, SZ_KEYS = 2ull * 16 * 128 * 128 * 2, SZ_MOD = 2ull * 9 * 6144 * 4, SZ_CNT = 4096 + 16384  ;
constexpr size_t OFF_WIN = 0, OFF_WOUT = OFF_WIN + SZ_WIN, OFF_WPQ = OFF_WOUT + SZ_WOUT, OFF_WLORA = OFF_WPQ + SZ_WPQ, OFF_WQUP = OFF_WLORA + SZ_WLORA,
                 OFF_WKVUP = OFF_WQUP + SZ_WQUP, OFF_KEYS = OFF_WKVUP + SZ_WKVUP, OFF_MOD = OFF_KEYS + SZ_KEYS, OFF_CNT = OFF_MOD + SZ_MOD;
constexpr size_t OFF_CTXX = A256(OFF_CNT + SZ_CNT);
constexpr size_t OFF_H = OFF_CTXX + 2048ull * 1024 * 4;
constexpr size_t OFF_P = OFF_H + (size_t)NTOK * 1024 * 2;
constexpr size_t SZ_P = (size_t)NTOK * NIN * 2;
constexpr size_t OFF_TABU = OFF_P, OFF_TABV = OFF_TABU + 16384ull * 1024, OFF_RWY = OFF_TABV + 16384ull * 1024;
constexpr size_t OFF_BAR = OFF_CNT + 4096;
static_assert(OFF_RWY + 2ull * NTOK * 384 * 2 <= OFF_P + SZ_P, "P region overflow");
constexpr size_t OFF_BS = OFF_P + 96ull * 1024 * 1024;
static_assert(OFF_BS >= OFF_RWY + 2ull * NTOK * 384 * 2 && OFF_BS + 2ull * NTOK * 6 * 4 <= OFF_P + SZ_P, "BS placement");
constexpr size_t SZ_R1 = (size_t)NTOK * 384 * 2;
constexpr size_t OFF_R = OFF_P + SZ_P;
constexpr size_t OFF_RB = OFF_R, OFF_KB = OFF_RB + SZ_R1, OFF_KH = OFF_KB + SZ_R1, OFF_VB = OFF_KH + SZ_R1, OFF_LORA = OFF_VB + SZ_R1  ,
                 OFF_ZB = OFF_LORA + 5 * SZ_R1;
constexpr size_t SZ_R = 10 * SZ_R1;
constexpr size_t OFF_Y = OFF_R, OFF_QP = OFF_R;
static_assert((size_t)NTOK * 1024 * 4 <= SZ_R && (size_t)NTOK * 2048 * 2 <= SZ_R, "R region overflow");
constexpr size_t OFF_A = OFF_R + SZ_R;
constexpr size_t OFF_CQN = OFF_A, OFF_CKVN = OFF_CQN + (size_t)NTOK * 384 * 2, OFF_QB = OFF_CKVN + (size_t)NTOK * 256 * 2,
                 OFF_KV = OFF_QB + (size_t)NTOK * 576 * 2  , OFF_KR = OFF_KV + (size_t)NTOK * 768 * 2  ,
                 OFF_AEND = OFF_KR + (size_t)NTOK * 32 * 2;
constexpr size_t OFF_EID = OFF_A, OFF_GATE = OFF_EID + (size_t)NTOK * 128 * 4;
static_assert(OFF_GATE + (size_t)NTOK * 128 * 4 <= OFF_QB, "EID/GATE overflow");
constexpr size_t OFF_M = OFF_AEND;
constexpr size_t SZ_M1 = (size_t)NTOK * 256 * 2;
constexpr size_t OFF_MQ = OFF_M, OFF_MK = OFF_MQ + SZ_M1, OFF_MVT = OFF_MK + SZ_M1, OFF_MO = OFF_MVT + SZ_M1, OFF_GLI = OFF_MO + SZ_M1,
                 OFF_GLF = OFF_GLI + 8ull * NTOK * 4, OFF_ST = OFF_GLF + 8ull * NTOK * 4, OFF_SCM = OFF_ST + 2304ull * 5120 * 2,
                 OFF_SCB = OFF_SCM + 2304 * 4, OFF_SCMB = OFF_SCB + 2304 * 4, OFF_END = A256(OFF_SCMB + 2304 * 4);
constexpr size_t OFF_XC = OFF_END;
constexpr size_t WS_NEEDED = OFF_XC + (size_t)NTOK * 1024 * 2;
static_assert(WS_NEEDED <= 512ull * 1024 * 1024, "workspace budget");

struct Params {
  const float* in[N_INPUTS];
  float* out;
  unsigned char* ws;
};
typedef const __attribute__((address_space(4))) Params CParams;

DEV int TIDX() { int t = (int)__builtin_amdgcn_workitem_id_x(); asm volatile("" : "+v"(t)); return t; }
DEV float bf2f(bf16_t b) { return __uint_as_float(((unsigned)b) << 16); }
DEV bf16_t f2bf(float f) { unsigned u = __float_as_uint(f); u += 0x7FFFu + ((u >> 16) & 1u); return (bf16_t)(u >> 16); }
typedef __bf16 bf16v2_t __attribute__((ext_vector_type(2)));
DEV unsigned pack2(float lo, float hi) { return __builtin_bit_cast(unsigned, __builtin_convertvector((f32x2){lo, hi}, bf16v2_t)); }
DEV float lo16(unsigned w) { return __uint_as_float(w << 16); }
DEV float hi16(unsigned w) { return __uint_as_float(w & 0xffff0000u); }
DEV void unpack8(u32x4 w, float* f) { f[0] = lo16(w[0]); f[1] = hi16(w[0]); f[2] = lo16(w[1]); f[3] = hi16(w[1]); f[4] = lo16(w[2]); f[5] = hi16(w[2]); f[6] = lo16(w[3]); f[7] = hi16(w[3]); }
DEV u32x4 pack8(const float* f) { u32x4 w; w[0] = pack2(f[0], f[1]); w[1] = pack2(f[2], f[3]); w[2] = pack2(f[4], f[5]); w[3] = pack2(f[6], f[7]); return w; }
DEV float sigmoidf_(float x) { return __builtin_amdgcn_rcpf(1.0f + __expf(-x)); }
DEV float siluf_(float x) { return x * __builtin_amdgcn_rcpf(1.0f + __expf(-x)); }
template <int CTRL> DEV float dppf(float x) { return __builtin_bit_cast(float, __builtin_amdgcn_mov_dpp(__builtin_bit_cast(int, x), CTRL, 0xf, 0xf, true)); }
template <int CTRL> DEV float dpp_upd(float old, float x) { return __builtin_bit_cast(float, __builtin_amdgcn_update_dpp(__builtin_bit_cast(int, old), __builtin_bit_cast(int, x), CTRL, 0xf, 0xf, false)); }
DEV float rdlane(float v, int l) { return __builtin_bit_cast(float, __builtin_amdgcn_readlane(__builtin_bit_cast(int, v), l)); }
DEV float bperm(int srclane, float v) { return __builtin_bit_cast(float, __builtin_amdgcn_ds_bpermute(srclane << 2, __builtin_bit_cast(int, v))); }
DEV float row16_max(float x) { x = fmaxf(x, dppf<0x128>(x)); x = fmaxf(x, dppf<0x124>(x)); x = fmaxf(x, dppf<0x122>(x)); x = fmaxf(x, dppf<0x121>(x)); return x; }
DEV float grp8_sum(float x) { x += dppf<0xB1>(x); x += dppf<0x4E>(x); x += dppf<0x141>(x); return x; }
DEV float scan_sum64(float x, int lane) {
  x += dpp_upd<0x111>(0.f, x); x += dpp_upd<0x112>(0.f, x); x += dpp_upd<0x114>(0.f, x); x += dpp_upd<0x118>(0.f, x);
  const float t0 = rdlane(x, 15), t1 = rdlane(x, 31), t2 = rdlane(x, 47); const int r = lane >> 4;
  return x + (r == 0 ? 0.f : r == 1 ? t0 : r == 2 ? t0 + t1 : t0 + t1 + t2); }
DEV float scan_max64(float x, int lane) {
  const float NI = -3.0e38f;
  x = fmaxf(x, dpp_upd<0x111>(NI, x)); x = fmaxf(x, dpp_upd<0x112>(NI, x)); x = fmaxf(x, dpp_upd<0x114>(NI, x)); x = fmaxf(x, dpp_upd<0x118>(NI, x));
  const float t0 = rdlane(x, 15), t1 = rdlane(x, 31), t2 = rdlane(x, 47); const int r = lane >> 4;
  return fmaxf(x, r == 0 ? NI : r == 1 ? t0 : r == 2 ? fmaxf(t0, t1) : fmaxf(fmaxf(t0, t1), t2)); }
DEV float row16_sum(float x) { x += dppf<0x128>(x); x += dppf<0x124>(x); x += dppf<0x122>(x); x += dppf<0x121>(x); return x; }
DEV float wave_sum(float v) { v = row16_sum(v); return (rdlane(v, 0) + rdlane(v, 16)) + (rdlane(v, 32) + rdlane(v, 48)); }
DEV float wave_max(float v) { v = row16_max(v); return fmaxf(fmaxf(rdlane(v, 0), rdlane(v, 16)), fmaxf(rdlane(v, 32), rdlane(v, 48))); }
DEV float xhalf_sum(float x) { auto rr = __builtin_amdgcn_permlane32_swap(__float_as_uint(x), __float_as_uint(x), false, false); return __uint_as_float(rr[0]) + __uint_as_float(rr[1]); }
DEV float xhalf_max(float x) { auto rr = __builtin_amdgcn_permlane32_swap(__float_as_uint(x), __float_as_uint(x), false, false); return fmaxf(__uint_as_float(rr[0]), __uint_as_float(rr[1])); }

DEV int modrow_of(int row) { return row < NCTXR ? 8 : ((row - NCTXR) >> 11); }

#define XB_TMO      128
#define XB_XCNT(j)  (256  + 64 * (j))
#define XB_XSUB(j)  (1280 + 64 * (j))
#define XB_XGEN(j)  (2304 + 64 * (j))
#define XB_TOP      3328
#define XB_TOPGEN   3392
#define XCD_BAR_WORDS 3456
#define XB_SPIN_CAP (1u << 20)
DEV unsigned xb_ld(unsigned* p) { return __hip_atomic_load(p, __ATOMIC_RELAXED, __HIP_MEMORY_SCOPE_AGENT); }
DEV unsigned xb_add(unsigned* p, unsigned v) { return __hip_atomic_fetch_add(p, v, __ATOMIC_RELAXED, __HIP_MEMORY_SCOPE_AGENT); }
DEV unsigned xb_xcc_id() { return (unsigned)__builtin_amdgcn_s_getreg((3 << 11) | 20) & 0xFu; }
#define XB_SPIN(cond, bar) do { unsigned _sp = 0; while (cond) { __builtin_amdgcn_s_sleep(1); \
    if ((++_sp & 255u) == 0u) { if (xb_ld(&(bar)[XB_TMO])) break; if (_sp > XB_SPIN_CAP) { atomicAdd(&(bar)[XB_TMO], 1u); break; } } } } while (0)
DEV void xcd_barrier_post(unsigned* bar) { if (TIDX() == 0) (void)xb_add(&bar[XB_XCNT(xb_xcc_id())], 1u); }
DEV void xcd_barrier_complete(unsigned* bar, unsigned x, unsigned& nloc, unsigned& nx) {
  const unsigned G = gridDim.x; unsigned sum, cnt, mine, sp = 0u;
  for (;;) { sum = 0u; cnt = 0u; mine = 0u;
#pragma unroll
    for (unsigned j = 0; j < 16; ++j) { const unsigned c = xb_ld(&bar[XB_XCNT(j)]); sum += c; cnt += (c > 0u) ? 1u : 0u; mine = (j == x) ? c : mine; }
    if (sum == G) break;
    __builtin_amdgcn_s_sleep(1);
    if ((++sp & 255u) == 0u) { if (xb_ld(&bar[XB_TMO])) break; if (sp > XB_SPIN_CAP) { atomicAdd(&bar[XB_TMO], 1u); break; } } }
  nloc = mine > 0u ? mine : 1u; nx = cnt > 0u ? cnt : 1u;
}
DEV void xcd_barrier(unsigned* bar, volatile LAS unsigned* st) {
  asm volatile("s_waitcnt vmcnt(0)" ::: "memory");
  __syncthreads();
  if (TIDX() == 0) {
    const unsigned x = xb_xcc_id();
    __builtin_amdgcn_s_waitcnt(0);
    unsigned nloc = st[0], nx = st[1];
    if (nloc == 0u) { xcd_barrier_complete(bar, x, nloc, nx); st[0] = nloc; st[1] = nx; }
    const unsigned old = xb_add(&bar[XB_XSUB(x)], 1u);
    const unsigned gen = old / nloc;
    if (old + 1u == (gen + 1u) * nloc) {
      __builtin_amdgcn_fence(__ATOMIC_RELEASE, "agent");
      asm volatile("s_waitcnt vmcnt(0)" ::: "memory");
      const unsigned og = xb_add(&bar[XB_TOP], 1u);
      const unsigned tg = og / nx;
      if (og + 1u == (tg + 1u) * nx) xb_add(&bar[XB_TOPGEN], 1u);
      else XB_SPIN(xb_ld(&bar[XB_TOPGEN]) == tg, bar);
      __builtin_amdgcn_fence(__ATOMIC_ACQUIRE, "agent");
      xb_add(&bar[XB_XGEN(x)], 1u);
      asm volatile("s_waitcnt vmcnt(0)" ::: "memory");
    } else {
      XB_SPIN(xb_ld(&bar[XB_XGEN(x)]) == gen, bar);
      __builtin_amdgcn_fence(__ATOMIC_ACQUIRE, "agent");
      asm volatile("s_waitcnt vmcnt(0)" ::: "memory");
    }
  }
  __syncthreads();
}

namespace pg8 {
constexpr int BM = 256, BK = 64, HALF = 128, HTB = HALF * BK * 2, STAGE_BYTES = 8 * HTB, NXCD = 8, WGM = 8;
DEV int lds_byte(int r, int c) { const int st = (r >> 4) * 2 + (c >> 5), rr = r & 15, cc = c & 31, ob = rr * 64 + cc * 2; return st * 1024 + (ob ^ (((ob >> 9) & 1) << 5)); }
DEV void stage_rc(int b, int& R, int& C) { const int st = b / 1024, sb = b % 1024, swz = sb ^ (((sb >> 9) & 1) << 5); R = (st >> 1) * 16 + swz / 64; C = (st & 1) * 32 + (swz % 64) / 2; }
DEV int perm32(int rho) { const int n = rho >> 4, i = rho & 15; return 8 * (i >> 2) + 4 * n + (i & 3); }
struct Unit { int pm, pn; };
struct Gemm { const bf16_t* A; const bf16_t* Bt; int M, N, K; };
struct StaticOrder {
  int nM, nN, nwg, G, c;
  DEV void init(int M, int N, int G_, int c_) { nM = M / BM; nN = N / BM; nwg = nM * nN; G = G_; c = c_; }
  DEV bool next(int i, Unit& u) const {
    const long L = (long)i * G + c; if (L >= nwg) return false;
    int wgid = (int)L; { const int q = nwg / NXCD, r = nwg % NXCD, xcd = wgid % NXCD, off = wgid / NXCD; wgid = (xcd < r ? xcd * (q + 1) : r * (q + 1) + (xcd - r) * q) + off; }
    const int nig = WGM * nN, gid = wgid / nig, fm = gid * WGM, gsz = (nM - fm) < WGM ? (nM - fm) : WGM;
    u.pm = fm + ((wgid % nig) % gsz); u.pn = (wgid % nig) / gsz; return true;
  }
};
struct OneUnit { bool has; Unit u0; DEV bool next(int i, Unit& u) const { if (i == 0 && has) { u = u0; return true; } return false; } };
template <class Epi, class Ord>
DEV void gemm_phase(LAS unsigned char* lds, const Gemm g, const Ord& S, const Epi& E) {
  const int tid = TIDX(), wid = __builtin_amdgcn_readfirstlane(tid >> 6), lane = tid & 63, wr = wid >> 2, wc = wid & 3, fr = lane & 15, fq = lane >> 4;
  const int K = g.K, nt = K / BK;
  unsigned voffA[2], voffB[2];
#pragma unroll
  for (int i = 0; i < 2; ++i) { int R, C; stage_rc(tid * 16 + i * 8192, R, C); const int Rb = Epi::PERM ? ((R & ~31) + perm32(R & 31)) : R;
    voffA[i] = (unsigned)(R * K + C) * 2u; voffB[i] = (unsigned)(Rb * K + C) * 2u; }
  const size_t kstep = (size_t)(BK * 2);
  const size_t hstep = (size_t)HALF * K * 2;
  const size_t tstep = 2 * hstep;
  const unsigned ldsw = (unsigned)wid * 1024u;
  const int aoff = lds_byte(wr * 64 + fr, fq * 8), boff = lds_byte(wc * 32 + fr, fq * 8);
#define PG8_SA(b, h) (((b) * 2 + (h)) * HTB)
#define PG8_SB(b, h) ((4 + (b) * 2 + (h)) * HTB)
#define PG8_STAGE(bufoff, gbase, voff) do { _Pragma("unroll") for (int _i = 0; _i < 2; ++_i) \
        __builtin_amdgcn_global_load_lds((const unsigned*)((const char*)(gbase) + (voff)[_i]), (LAS unsigned*)(lds + (bufoff) + ldsw + _i * 8192), 16, 0, 0); } while (0)
#define PG8_LDA(dst, b, h) do { _Pragma("unroll") for (int m = 0; m < 4; ++m) _Pragma("unroll") for (int k = 0; k < 2; ++k) dst[m][k] = *(const LAS bf16x8*)(lds + PG8_SA(b, h) + aoff + m * 2048 + k * 1024); } while (0)
#define PG8_LDB(dst, b, h) do { _Pragma("unroll") for (int n = 0; n < 2; ++n) _Pragma("unroll") for (int k = 0; k < 2; ++k) dst[n][k] = *(const LAS bf16x8*)(lds + PG8_SB(b, h) + boff + n * 2048 + k * 1024); } while (0)
#define PG8_MMA(ai, bj, At, Bt) do { __builtin_amdgcn_s_setprio(1); _Pragma("unroll") for (int m = 0; m < 4; ++m) _Pragma("unroll") for (int n = 0; n < 2; ++n) _Pragma("unroll") for (int k = 0; k < 2; ++k) \
        acc[ai][bj][m][n] = __builtin_amdgcn_mfma_f32_16x16x32_bf16(Bt[n][k], At[m][k], acc[ai][bj][m][n], 0, 0, 0); __builtin_amdgcn_s_setprio(0); } while (0)
#define PG8_WAIT_V(n) asm volatile("s_waitcnt vmcnt(" #n ")" ::: "memory")
#define PG8_WAIT_L(n) asm volatile("s_waitcnt lgkmcnt(" #n ")" ::: "memory")
#define PG8_BAR __builtin_amdgcn_s_barrier()
#define PG8_SCHED __builtin_amdgcn_sched_barrier(0)
  Unit cur, nxt; int ui = 0;
  if (!S.next(0, cur)) return;
  f32x4 acc[2][2][4][2];
#pragma unroll
  for (int a = 0; a < 2; ++a)
#pragma unroll
    for (int b = 0; b < 2; ++b)
#pragma unroll
      for (int m = 0; m < 4; ++m)
#pragma unroll
        for (int n = 0; n < 2; ++n) acc[a][b][m][n] = (f32x4){0.f, 0.f, 0.f, 0.f};
  bf16x8 At[4][2], B0[2][2], B1[2][2];
  const char* cA = (const char*)g.A + (size_t)cur.pm * tstep; const char* cB = (const char*)g.Bt + (size_t)cur.pn * tstep;
  PG8_STAGE(PG8_SB(0, 0), cB, voffB); PG8_STAGE(PG8_SA(0, 0), cA, voffA); PG8_STAGE(PG8_SB(0, 1), cB + hstep, voffB); PG8_STAGE(PG8_SA(0, 1), cA + hstep, voffA);
  if (wr == 1) PG8_BAR;
  PG8_WAIT_V(4); PG8_BAR;
  PG8_STAGE(PG8_SB(1, 0), cB + kstep, voffB); PG8_STAGE(PG8_SA(1, 0), cA + kstep, voffA); PG8_STAGE(PG8_SB(1, 1), cB + hstep + kstep, voffB);
  PG8_WAIT_V(6); PG8_BAR;
  for (;;) {
    const bool has_next = S.next(ui + 1, nxt);
    const char* nA = has_next ? (const char*)g.A + (size_t)nxt.pm * tstep : cA; const char* nB = has_next ? (const char*)g.Bt + (size_t)nxt.pn * tstep : cB;
    for (int t = 0; t < nt; t += 2) {
      const bool last = (t == nt - 2);
      const char* a1 = cA + (size_t)(t + 1) * kstep;
      const char* a2 = last ? nA : cA + (size_t)(t + 2) * kstep; const char* b2 = last ? nB : cB + (size_t)(t + 2) * kstep;
      const char* a3 = a2 + kstep; const char* b3 = b2 + kstep;
      PG8_LDB(B0, 0, 0); PG8_SCHED; PG8_LDA(At, 0, 0); PG8_STAGE(PG8_SA(1, 1), a1 + hstep, voffA);
      PG8_WAIT_L(8); PG8_BAR; PG8_WAIT_L(0); PG8_MMA(0, 0, At, B0); PG8_BAR; PG8_SCHED;
      PG8_LDB(B1, 0, 1); PG8_STAGE(PG8_SB(0, 0), b2, voffB);
      PG8_BAR; PG8_WAIT_L(0); PG8_MMA(0, 1, At, B1); PG8_BAR;
      PG8_LDA(At, 0, 1); PG8_STAGE(PG8_SA(0, 0), a2, voffA);
      PG8_BAR; PG8_WAIT_L(0); PG8_MMA(1, 0, At, B0); PG8_BAR; PG8_SCHED;
      PG8_STAGE(PG8_SB(0, 1), b2 + hstep, voffB);
      PG8_WAIT_V(6); PG8_BAR; PG8_MMA(1, 1, At, B1); PG8_BAR;
      PG8_LDB(B0, 1, 0); PG8_SCHED; PG8_LDA(At, 1, 0); PG8_STAGE(PG8_SA(0, 1), a2 + hstep, voffA);
      PG8_WAIT_L(8); PG8_BAR; PG8_WAIT_L(0); PG8_MMA(0, 0, At, B0); PG8_BAR; PG8_SCHED;
      PG8_LDB(B1, 1, 1); PG8_STAGE(PG8_SB(1, 0), b3, voffB);
      PG8_BAR; PG8_WAIT_L(0); PG8_MMA(0, 1, At, B1); PG8_BAR;
      PG8_LDA(At, 1, 1); PG8_STAGE(PG8_SA(1, 0), a3, voffA);
      PG8_BAR; PG8_WAIT_L(0); PG8_MMA(1, 0, At, B0); PG8_BAR; PG8_SCHED;
      PG8_STAGE(PG8_SB(1, 1), b3 + hstep, voffB);
      PG8_WAIT_V(6); PG8_BAR; PG8_MMA(1, 1, At, B1); PG8_BAR;
    }
    E(acc, cur, wr, wc, fr, fq);
    if (!has_next) break;
#pragma unroll
    for (int a = 0; a < 2; ++a)
#pragma unroll
      for (int b = 0; b < 2; ++b)
#pragma unroll
        for (int m = 0; m < 4; ++m)
#pragma unroll
          for (int n = 0; n < 2; ++n) acc[a][b][m][n] = (f32x4){0.f, 0.f, 0.f, 0.f};
    cur = nxt; cA = nA; cB = nB; ++ui;
  }
  PG8_WAIT_V(0);
  if (wr == 0) PG8_BAR;
  PG8_BAR;
#undef PG8_SA
#undef PG8_SB
#undef PG8_STAGE
#undef PG8_LDA
#undef PG8_LDB
#undef PG8_MMA
#undef PG8_WAIT_V
#undef PG8_WAIT_L
#undef PG8_BAR
#undef PG8_SCHED
}
}
using pg8::Unit;
typedef f32x4 AccT[2][2][4][2];

struct EpiBf16 {
  static constexpr bool PERM = true;
  bf16_t* O; int ldc; int ncols;
  DEV void operator()(const AccT& acc, const Unit& u, int wr, int wc, int fr, int fq) const {
    { const int t_ = TIDX(); fr = t_ & 15; fq = (t_ >> 4) & 3; }
    const int row0 = u.pm * 256 + wr * 64 + fr, col0 = u.pn * 256 + wc * 32 + 8 * fq;
#pragma unroll
    for (int ai = 0; ai < 2; ++ai)
#pragma unroll
      for (int m = 0; m < 4; ++m) { bf16_t* rowp = O + (size_t)(row0 + ai * 128 + m * 16) * ldc;
#pragma unroll
        for (int bj = 0; bj < 2; ++bj) { const int col = col0 + bj * 128; if (col < ncols) {
          const f32x4 v0 = acc[ai][bj][m][0], v1 = acc[ai][bj][m][1];
          u32x4 w; w[0] = pack2(v0[0], v0[1]); w[1] = pack2(v0[2], v0[3]); w[2] = pack2(v1[0], v1[1]); w[3] = pack2(v1[2], v1[3]);
          *(u32x4*)(rowp + col) = w; } } }
  }
};
struct EpiF32 {
  static constexpr bool PERM = false;
  float* C; int ldc;
  DEV void operator()(const AccT& acc, const Unit& u, int wr, int wc, int fr, int fq) const {
    { const int t_ = TIDX(); fr = t_ & 15; fq = (t_ >> 4) & 3; }
    const int row0 = u.pm * 256 + wr * 64 + fr, col0 = u.pn * 256 + wc * 32 + 4 * fq;
#pragma unroll
    for (int ai = 0; ai < 2; ++ai)
#pragma unroll
      for (int m = 0; m < 4; ++m) { float* rowp = C + (size_t)(row0 + ai * 128 + m * 16) * ldc + col0;
#pragma unroll
        for (int bj = 0; bj < 2; ++bj)
#pragma unroll
          for (int n = 0; n < 2; ++n) *(f32x4*)(rowp + bj * 128 + n * 16) = acc[ai][bj][m][n]; }
  }
};

#define WS(T, off) ((T*)(p.ws + (off)))
DEV const float* x_in_row(CParams& p, int row) { return row < NCTXR ? p.in[I_CTX] + (size_t)row * DM : p.in[I_X] + (size_t)(row - NCTXR) * DM; }
DEV float* x_cur_row(CParams& p, int row) { return row < NCTXR ? WS(float, OFF_CTXX) + (size_t)row * DM : p.out + (size_t)(row - NCTXR) * DM; }

DEV void tr_tile(const float* __restrict__ src, bf16_t* __restrict__ dst, int K, int N, int nt, int kt, float* tile) {
  const int tid = TIDX();
  { const int r = tid >> 4, c4 = (tid & 15) * 4;
#pragma unroll
    for (int i = 0; i < 2; ++i) { const int k = kt * 64 + r + 32 * i, n = nt * 64 + c4;
      f32x4 v = {0.f, 0.f, 0.f, 0.f}; if (n < N) v = *(const f32x4*)(src + (size_t)k * N + n);
      float* tp = tile + (r + 32 * i) * 65 + c4; tp[0] = v[0]; tp[1] = v[1]; tp[2] = v[2]; tp[3] = v[3]; } }
  __syncthreads();
  { const int n = tid >> 3, k8 = (tid & 7) * 8; float f[8];
#pragma unroll
    for (int j = 0; j < 8; ++j) f[j] = tile[(k8 + j) * 65 + n];
    *(u32x4*)(dst + (size_t)(nt * 64 + n) * K + kt * 64 + k8) = pack8(f); }
  __syncthreads();
}
DEV void mod_unit(CParams& p, int l, int cgp, float* lds) {
  float* sc = lds; float* red = lds + 9 * 1024;
  const int tid = TIDX();
  for (int i = tid; i < 9 * 1024; i += NTHREADS) { const int r = i >> 10, k = i & 1023; const float cv = r < 8 ? p.in[I_C][r * 1024 + k] : p.in[I_CCTX][k]; sc[i] = siluf_(cv); }
  __syncthreads();
  const int kg = tid >> 6, cl = tid & 63, col = cgp * 64 + cl;
  float acc[9];
#pragma unroll
  for (int r = 0; r < 9; ++r) acc[r] = 0.f;
  const float* w = p.in[I_WMOD] + (size_t)l * 1024 * 6144 + col;
  for (int k = kg * 128; k < kg * 128 + 128; ++k) { const float wv = w[(size_t)k * 6144];
#pragma unroll
    for (int r = 0; r < 9; ++r) acc[r] += sc[r * 1024 + k] * wv; }
#pragma unroll
  for (int r = 0; r < 9; ++r) red[(kg * 9 + r) * 64 + cl] = acc[r];
  __syncthreads();
  for (int o = tid; o < 9 * 64; o += NTHREADS) { const int r = o >> 6, c2 = o & 63; float s = 0.f;
    for (int g = 0; g < 8; ++g) s += red[(g * 9 + r) * 64 + c2];
    WS(float, OFF_MOD)[(size_t)(l * 9 + r) * 6144 + cgp * 64 + c2] = s + p.in[I_BMOD][l * 6144 + cgp * 64 + c2]; }
  __syncthreads();
}
DEV void ph_init(CParams& p, unsigned char* lds) {
  const int tid = TIDX(), nb = gridDim.x;
  if (blockIdx.x == 0 && tid < 64) WS(unsigned, OFF_CNT)[tid] = 0u;
  const int tcount[5] = {(NINP / 64) * 16, 16 * 16, 32 * 16, 12 * 6, 12 * 4};
  const int tl = tcount[0] + tcount[1] + tcount[2] + tcount[3] + tcount[4];
  const int total = 192 + 2 * tl;
  for (int u = blockIdx.x; u < total; u += nb) {
    if (u < 192) { mod_unit(p, u / 96, u % 96, (float*)lds); continue; }
    int v = u - 192; const int l = v / tl; v -= l * tl;
    if (v < tcount[0]) { tr_tile(p.in[I_WIN] + (size_t)l * 1024 * NIN, WS(bf16_t, OFF_WIN) + (size_t)l * NINP * 1024, 1024, NIN, v / 16, v % 16, (float*)lds); continue; }
    v -= tcount[0];
    if (v < tcount[1]) { tr_tile(p.in[I_WOUT] + (size_t)l * 1024 * 1024, WS(bf16_t, OFF_WOUT) + (size_t)l * 1024 * 1024, 1024, 1024, v / 16, v % 16, (float*)lds); continue; }
    v -= tcount[1];
    if (v < tcount[2]) { tr_tile(p.in[I_PWQ] + (size_t)l * 1024 * 2048, WS(bf16_t, OFF_WPQ) + (size_t)l * 2048 * 1024, 1024, 2048, v / 16, v % 16, (float*)lds); continue; }
    v -= tcount[2];
    if (v < tcount[3]) { tr_tile(p.in[I_QUP] + (size_t)l * 384 * 576, WS(bf16_t, OFF_WQUP) + (size_t)l * 768 * 384, 384, 576, v / 6, v % 6, (float*)lds); continue; }
    v -= tcount[3];
    tr_tile(p.in[I_KVUP] + (size_t)l * 256 * 768, WS(bf16_t, OFF_WKVUP) + (size_t)l * 768 * 256, 256, 768, v / 4, v % 4, (float*)lds);
  }
  const size_t gtid = (size_t)blockIdx.x * NTHREADS + tid, gsz = (size_t)nb * NTHREADS;
  for (size_t i = gtid; i < 2ull * 2048 * 384; i += gsz) {
    const int l = (int)(i / (2048 * 384)); const int rem = (int)(i % (2048 * 384)); const int n = rem / 384, k = rem % 384;
    float v = 0.f;
    if (n < 1920) { const int grp = n / 384, cc = n % 384;
      if (grp < 2) { if ((k >> 6) == grp) v = p.in[I_RWWUP][((size_t)(l * 2 + grp) * 64 + (k & 63)) * 384 + cc]; }
      else if (grp < 4) { if ((k >> 6) == grp) v = p.in[I_RWAUP][((size_t)(l * 2 + grp - 2) * 64 + (k & 63)) * 384 + cc]; }
      else { if (k >= 256) v = p.in[I_RWGUP][((size_t)l * 128 + (k - 256)) * 384 + cc]; } }
    WS(bf16_t, OFF_WLORA)[i] = f2bf(v);
  }
  for (size_t i = gtid; i < 2ull * 16 * 128 * 128; i += gsz) WS(bf16_t, OFF_KEYS)[i] = f2bf(p.in[I_PKEYS][i]);
}

DEV void ph_lnmod(CParams& p, int l) {
  const int lane = TIDX() & 63, per = (NTOK + (int)gridDim.x - 1) / (int)gridDim.x, r0 = (int)blockIdx.x * per, r1 = r0 + per < NTOK ? r0 + per : NTOK;
  for (int row = r0 + (TIDX() >> 6); row < r1; row += 8) {
    const float* xr = x_in_row(p, row); f32x4 v[4]; float s = 0.f;
#pragma unroll
    for (int i = 0; i < 4; ++i) { v[i] = *(const f32x4*)(xr + lane * 4 + 256 * i); s += (v[i][0] + v[i][1]) + (v[i][2] + v[i][3]); }
    const float mean = wave_sum(s) * (1.f / 1024.f); float q = 0.f;
#pragma unroll
    for (int i = 0; i < 4; ++i) { v[i] -= mean; q += (v[i][0] * v[i][0] + v[i][1] * v[i][1]) + (v[i][2] * v[i][2] + v[i][3] * v[i][3]); }
    const float rstd = rsqrtf(wave_sum(q) * (1.f / 1024.f) + LN_EPS);
    const float* md = WS(float, OFF_MOD) + (size_t)(l * 9 + modrow_of(row)) * 6144;
#pragma unroll
    for (int i = 0; i < 4; ++i) { const int col = lane * 4 + 256 * i; const f32x4 sh = *(const f32x4*)(md + col), sc = *(const f32x4*)(md + 1024 + col);
      const f32x4 o = v[i] * rstd * (sc + 1.f) + sh; u32x2 w; w[0] = pack2(o[0], o[1]); w[1] = pack2(o[2], o[3]);
      *(u32x2*)(WS(bf16_t, OFF_H) + (size_t)row * 1024 + col) = w; }
  }
}

struct ChunkInfo { int row0, b, cseq, T, t0; bool isctx; };
DEV ChunkInfo chunk_info(int chunk) { ChunkInfo c; c.row0 = chunk * 64; c.isctx = chunk < 32;
  if (c.isctx) { c.b = chunk >> 2; c.cseq = chunk & 3; c.T = 256; } else { const int lc = chunk - 32; c.b = lc >> 5; c.cseq = lc & 31; c.T = 2048; }
  c.t0 = c.cseq * 64; return c; }
DEV int ml_pc(const ChunkInfo& c, int dir) { return dir == 0 ? (c.isctx ? c.cseq : 4 + c.cseq) : (c.isctx ? 3 - c.cseq : 4 + (31 - c.cseq)); }
DEV u32x4 ld8g(const bf16_t* ptr) { return *(const u32x4*)ptr; }

DEV void prep_mlstm(CParams& p, int l, const ChunkInfo& c, int chunk, int hd, unsigned char* lds) {
  bf16_t* VTl = (bf16_t*)lds;
  bf16_t* KWl = (bf16_t*)(lds + 10880);
  float* wkl = (float*)(lds + 10880 + 17408);
  const bf16_t* pb = WS(bf16_t, OFF_P);
  const int tid = TIDX(), lane = tid & 63, wid = tid >> 6;
  if (tid < 128) {
    const int dir = tid >> 6, s = lane, row = c.row0 + s;
    const float gi = bf2f(pb[(size_t)row * NIN + 1024 + dir * 8 + hd]) + p.in[I_MLIB][l * 8 + dir * 4 + hd];
    const float gf = bf2f(pb[(size_t)row * NIN + 1024 + dir * 8 + 4 + hd]) + p.in[I_MLFB][l * 8 + dir * 4 + hd];
    const float lf = fminf(gf, 0.f) - log1pf(__expf(-fabsf(gf)));
    WS(float, OFF_GLI)[(size_t)(dir * 4 + hd) * NTOK + row] = gi; WS(float, OFF_GLF)[(size_t)(dir * 4 + hd) * NTOK + row] = lf;
    const float incl = scan_sum64(lf, lane);
    const float total = rdlane(incl, 63);
    const float g = (dir == 0 ? total - incl : incl - lf) + gi;
    const float mloc = wave_max(g);
    wkl[dir * 64 + s] = __expf(g - mloc);
    if (s == 0) { const int chain = dir * 32 + c.b * 4 + hd, pc = ml_pc(c, dir); WS(float, OFF_SCM)[chain * 36 + pc] = mloc; WS(float, OFF_SCB)[chain * 36 + pc] = total; }
  }
  __syncthreads();
  { const int s = tid >> 3, d0 = (tid & 7) * 8, row = c.row0 + s, t = c.t0 + s;
    const bool hp = t > 0, hn = t < c.T - 1;
    const float* cw = p.in[I_MLCW] + l * 3 * 512; const float* cb = p.in[I_MLCB] + l * 512;
    const u32x4 z4 = {0u, 0u, 0u, 0u};
    float qk[2][8];
#pragma unroll
    for (int which = 0; which < 2; ++which) { const int col = which * 256 + hd * 64 + d0; const bf16_t* pr = pb + (size_t)row * NIN + col;
      float cur[8], prv[8], nxt[8]; unpack8(ld8g(pr), cur); unpack8(hp ? ld8g(pr - NIN) : z4, prv); unpack8(hn ? ld8g(pr + NIN) : z4, nxt);
#pragma unroll
      for (int i = 0; i < 8; ++i) { const int j = col + i; const float x = prv[i] * cw[j] + cur[i] * cw[512 + j] + nxt[i] * cw[1024 + j] + cb[j]; qk[which][i] = siluf_(x); } }
#pragma unroll
    for (int i = 0; i < 8; ++i) qk[0][i] *= 0.125f;
    *(u32x4*)(WS(bf16_t, OFF_MQ) + (size_t)row * 256 + hd * 64 + d0) = pack8(qk[0]);
    *(u32x4*)(WS(bf16_t, OFF_MK) + (size_t)row * 256 + hd * 64 + d0) = pack8(qk[1]);
    const float w0 = wkl[s], w1 = wkl[64 + s];
#pragma unroll
    for (int i = 0; i < 8; ++i) { KWl[(0 * 64 + d0 + i) * 68 + s] = f2bf(qk[1][i] * w0); KWl[(1 * 64 + d0 + i) * 68 + s] = f2bf(qk[1][i] * w1); }
    const u32x4 vv = ld8g(pb + (size_t)row * NIN + 512 + hd * 64 + d0);
#pragma unroll
    for (int i = 0; i < 4; ++i) { VTl[(d0 + 2 * i) * 68 + s] = (bf16_t)(vv[i] & 0xffffu); VTl[(d0 + 2 * i + 1) * 68 + s] = (bf16_t)(vv[i] >> 16); }
    *(u32x4*)(WS(bf16_t, OFF_MO) + (size_t)row * 256 + hd * 64 + d0) = ld8g(pb + (size_t)row * NIN + 768 + hd * 64 + d0);
    if (tid < 64) VTl[64 * 68 + tid] = (bf16_t)0x3F80u;
    for (int i = tid; i < 15 * 68; i += NTHREADS) VTl[65 * 68 + i] = 0;
  }
  __syncthreads();
  { const int e = tid >> 3, sseg = (tid & 7) * 8; const u32x2 a = *(const u32x2*)(VTl + e * 68 + sseg), b2 = *(const u32x2*)(VTl + e * 68 + sseg + 4);
    u32x4 w; w[0] = a[0]; w[1] = a[1]; w[2] = b2[0]; w[3] = b2[1];
    *(u32x4*)(WS(bf16_t, OFF_MVT) + ((size_t)(chunk * 4 + hd) * 64 + e) * 64 + sseg) = w; }
  { const int fr = lane & 15, fq = lane >> 4;
#pragma unroll 1
    for (int ti = 0; ti < 5; ++ti) { const int id = wid * 5 + ti, dir = id / 20, et = (id % 20) >> 2, dt = id & 3;
      f32x4 acc = {0.f, 0.f, 0.f, 0.f};
#pragma unroll
      for (int ks = 0; ks < 2; ++ks) {
        const bf16_t* ap = VTl + (et * 16 + fr) * 68 + ks * 32 + fq * 8; const bf16_t* bp = KWl + (dir * 64 + dt * 16 + fr) * 68 + ks * 32 + fq * 8;
        u32x4 aw, bw; { const u32x2 x0 = *(const u32x2*)ap, x1 = *(const u32x2*)(ap + 4); aw[0] = x0[0]; aw[1] = x0[1]; aw[2] = x1[0]; aw[3] = x1[1]; }
        { const u32x2 x0 = *(const u32x2*)bp, x1 = *(const u32x2*)(bp + 4); bw[0] = x0[0]; bw[1] = x0[1]; bw[2] = x1[0]; bw[3] = x1[1]; }
        acc = __builtin_amdgcn_mfma_f32_16x16x32_bf16(__builtin_bit_cast(bf16x8, aw), __builtin_bit_cast(bf16x8, bw), acc, 0, 0, 0); }
      const int chain = dir * 32 + c.b * 4 + hd, pc = ml_pc(c, dir);
      bf16_t* st = WS(bf16_t, OFF_ST) + (size_t)(chain * 36 + pc) * 5120;
#pragma unroll
      for (int j = 0; j < 4; ++j) st[(et * 16 + fq * 4 + j) * 64 + dt * 16 + fr] = f2bf(acc[j]); }
  }
  __syncthreads();
}

DEV float tanh_fast(float x) { return 1.f - 2.f * __builtin_amdgcn_rcpf(1.f + __expf(2.f * x)); }
DEV void prep_rwkv_flat(CParams& p, int l) {
  const bf16_t* pb = WS(bf16_t, OFF_P); const float* mu = p.in[I_RWMU] + l * 3072;
  const int lane = TIDX() & 63, wid = TIDX() >> 6;
  const int per = (NTOK + (int)gridDim.x - 1) / (int)gridDim.x, pw = (per + 7) / 8;
  const int rA = (int)blockIdx.x * per + wid * pw; int rB = rA + pw; { const int re = (int)blockIdx.x * per + per; if (rB > re) rB = re; if (rB > NTOK) rB = NTOK; }
  if (rA >= rB) return;
  const u32x4 z4 = {0u, 0u, 0u, 0u};
  u32x4 prv[3], cur[3], nxt[3];
#pragma unroll
  for (int st = 0; st < 3; ++st) { const bf16_t* pr = pb + (size_t)rA * NIN + 1040 + (st * 64 + lane) * 8; cur[st] = ld8g(pr); prv[st] = rA > 0 ? ld8g(pr - NIN) : z4; }
#pragma unroll 1
  for (int row = rA; row < rB; ++row) {
    int t, T; if (row < NCTXR) { t = row & 255; T = 256; } else { t = (row - NCTXR) & 2047; T = 2048; }
#pragma unroll
    for (int st = 0; st < 3; ++st) nxt[st] = row + 1 < NTOK ? ld8g(pb + (size_t)(row + 1) * NIN + 1040 + (st * 64 + lane) * 8) : z4;
    const bool hp = t > 0, hn = t < T - 1;
#pragma unroll
    for (int st = 0; st < 3; ++st) { const int seg = st * 64 + lane, col = seg * 8;
      float c[8], pv[8], nx[8], x[8]; unpack8(cur[st], c); unpack8(hp ? prv[st] : z4, pv); unpack8(hn ? nxt[st] : z4, nx);
#pragma unroll
      for (int i = 0; i < 8; ++i) x[i] = c[i] + mu[col + i] * (pv[i] - c[i]) + mu[1536 + col + i] * (nx[i] - c[i]);
      if (st == 0 && lane < 48) *(u32x4*)(WS(bf16_t, OFF_RB) + (size_t)row * 384 + col) = pack8(x);
      if ((st == 0 && lane >= 48) || (st == 1 && lane < 32)) { const int kc = (seg - 48) * 8; float kk[8], ss = 0.f;
#pragma unroll
        for (int i = 0; i < 8; ++i) { kk[i] = x[i] * p.in[I_RWKK][l * 384 + kc + i]; ss += kk[i] * kk[i]; }
        ss = grp8_sum(ss);
        *(u32x4*)(WS(bf16_t, OFF_KB) + (size_t)row * 384 + kc) = pack8(x); const float inv = rsqrtf(ss + 1e-12f);
#pragma unroll
        for (int i = 0; i < 8; ++i) kk[i] *= inv;
        *(u32x4*)(WS(bf16_t, OFF_KH) + (size_t)row * 384 + kc) = pack8(kk); }
      if ((st == 1 && lane >= 32) || (st == 2 && lane < 16)) *(u32x4*)(WS(bf16_t, OFF_VB) + (size_t)row * 384 + (seg - 96) * 8) = pack8(x);
      if (st == 2 && lane >= 16) { const int zc = (seg - 144) * 8;
        if (zc < 128) { for (int i = 0; i < 8; ++i) x[i] = tanh_fast(x[i]); } else if (zc >= 256) { for (int i = 0; i < 8; ++i) x[i] = sigmoidf_(x[i]); }
        *(u32x4*)(WS(bf16_t, OFF_ZB) + (size_t)row * 384 + zc) = pack8(x); }
      prv[st] = cur[st]; cur[st] = nxt[st]; }
  }
}
DEV void prep_mla_flat(CParams& p, int l) {
  const bf16_t* pb = WS(bf16_t, OFF_P); const int tid = TIDX(), lane = tid & 63, gw = (int)blockIdx.x * 8 + (tid >> 6), nw = (int)gridDim.x * 8;
#pragma unroll 3
  for (int row = gw; row < NTOK; row += nw) { const bool isctx = row < NCTXR; const int t = isctx ? (row & 255) : ((row - NCTXR) & 2047); const bf16_t* pr = pb + (size_t)row * NIN;
    { float v[8]; float ss = 0.f; if (lane < 48) { unpack8(ld8g(pr + 2576 + lane * 8), v); for (int i = 0; i < 8; ++i) ss += v[i] * v[i]; }
      const float inv = rsqrtf(wave_sum(ss) * (1.f / 384.f) + LN_EPS);
      if (lane < 48) { for (int i = 0; i < 8; ++i) v[i] = v[i] * inv * p.in[I_QNG][l * 384 + lane * 8 + i]; *(u32x4*)(WS(bf16_t, OFF_CQN) + (size_t)row * 384 + lane * 8) = pack8(v); } }
    { float v[8]; float ss = 0.f; if (lane < 32) { unpack8(ld8g(pr + 2960 + lane * 8), v); for (int i = 0; i < 8; ++i) ss += v[i] * v[i]; }
      const float inv = rsqrtf(wave_sum(ss) * (1.f / 256.f) + LN_EPS);
      if (lane < 32) { for (int i = 0; i < 8; ++i) v[i] = v[i] * inv * p.in[I_KVNG][l * 256 + lane * 8 + i]; *(u32x4*)(WS(bf16_t, OFF_CKVN) + (size_t)row * 256 + lane * 8) = pack8(v); } }
    { const float x = bf2f(pr[3216 + (lane & 31)]); const float pt = dppf<0x128>(x); float o = x;
      if (!isctx) { const int f = lane & 7; const int pos = (lane & 16) ? (t & 63) : (t >> 6);
        const float invf = __expf(-(float)f * (9.210340372f / 8.f)); float rev = (float)pos * invf * 0.15915494309f; rev -= floorf(rev);
        const float sn = __builtin_amdgcn_sinf(rev), cs = __builtin_amdgcn_cosf(rev);
        o = (lane & 8) ? x * cs + pt * sn : x * cs - pt * sn; }
      if (lane < 32) WS(bf16_t, OFF_KR)[(size_t)row * 32 + lane] = f2bf(o); }
  }
}

DEV void ph_prep(CParams& p, int l, unsigned char* lds) {
  for (int r_ = 0; r_ < PM_REP; ++r_)
  for (int u = blockIdx.x; u < 288 * 4; u += gridDim.x) { const int chunk = u >> 2; const ChunkInfo c = chunk_info(chunk); prep_mlstm(p, l, c, chunk, u & 3, lds); }
  for (int r_ = 0; r_ < PF_REP; ++r_) { prep_rwkv_flat(p, l); prep_mla_flat(p, l); }
}

DEV void mlstm_state_scan(CParams& p, int chain) {
  const int tid = TIDX(); const bool two = tid < 128;
  float C0[8], C1[8];
#pragma unroll
  for (int i = 0; i < 8; ++i) { C0[i] = 0.f; C1[i] = 0.f; }
  float m = -1e30f;
  bf16_t* blk = WS(bf16_t, OFF_ST) + (size_t)chain * 36 * 5120;
  u32x4 q0a, q0b = {0u, 0u, 0u, 0u}, q1a, q1b = {0u, 0u, 0u, 0u}, q2a, q2b = {0u, 0u, 0u, 0u};
#define SS_LOAD(A, B, pc_) do { const bf16_t* sp_ = blk + (size_t)(pc_) * 5120; A = *(const u32x4*)(sp_ + tid * 8); if (two) B = *(const u32x4*)(sp_ + (512 + tid) * 8); } while (0)
#define SS_STEP(A, B, pc_) do { bf16_t* cb = blk + (size_t)(pc_) * 5120; const u32x4 l0 = A, l1 = B; \
    if ((pc_) + 3 < 36) SS_LOAD(A, B, (pc_) + 3); \
    const float mloc = WS(float, OFF_SCM)[chain * 36 + (pc_)], bend = WS(float, OFF_SCB)[chain * 36 + (pc_)]; \
    *(u32x4*)(cb + tid * 8) = pack8(C0); if (two) *(u32x4*)(cb + (512 + tid) * 8) = pack8(C1); \
    if (tid == 0) WS(float, OFF_SCMB)[chain * 36 + (pc_)] = m; \
    const float mnew = fmaxf(bend + m, mloc), decay = __expf(bend + m - mnew), sl = __expf(mloc - mnew); \
    float f0[8], f1[8]; unpack8(l0, f0); unpack8(l1, f1); \
    _Pragma("unroll") for (int i = 0; i < 8; ++i) { C0[i] = decay * C0[i] + sl * f0[i]; C1[i] = decay * C1[i] + sl * f1[i]; } \
    m = mnew; } while (0)
  SS_LOAD(q0a, q0b, 0); SS_LOAD(q1a, q1b, 1); SS_LOAD(q2a, q2b, 2);
#pragma unroll 1
  for (int pc = 0; pc < 36; pc += 3) { SS_STEP(q0a, q0b, pc); SS_STEP(q1a, q1b, pc + 1); SS_STEP(q2a, q2b, pc + 2); }
#undef SS_LOAD
#undef SS_STEP
}
template <int MASK> DEV void ph_mid_t(CParams& p, int lx, unsigned char* lds) {
  const int l = lx & 1;
  LAS unsigned char* ll = (LAS unsigned char*)lds;
  pg8::StaticOrder S;
  if constexpr (MASK & 1) { S.init(NTOK, 2048, gridDim.x, blockIdx.x); pg8::Gemm g{WS(bf16_t, OFF_ZB), WS(bf16_t, OFF_WLORA) + (size_t)l * 2048 * 384, NTOK, 2048, 384};
    EpiBf16 E{WS(bf16_t, OFF_LORA), 1920, 1920}; pg8::gemm_phase(ll, g, S, E); }
  const bool rot = gridDim.x == 256, act = !rot || blockIdx.x < 192;
  if constexpr (MASK & 2) { if (act) { if (rot) S.init(NTOK, 768, 192, ((int)blockIdx.x + 128) % 192); else S.init(NTOK, 768, gridDim.x, blockIdx.x);
    pg8::Gemm g{WS(bf16_t, OFF_CQN), WS(bf16_t, OFF_WQUP) + (size_t)l * 768 * 384, NTOK, 768, 384};
    EpiBf16 E{WS(bf16_t, OFF_QB), 576, 576}; pg8::gemm_phase(ll, g, S, E); } }
  if constexpr (MASK & 4) { if (act) { if (rot) S.init(NTOK, 768, 192, ((int)blockIdx.x + 104) % 192); else S.init(NTOK, 768, gridDim.x, blockIdx.x);
    pg8::Gemm g{WS(bf16_t, OFF_CKVN), WS(bf16_t, OFF_WKVUP) + (size_t)l * 768 * 256, NTOK, 768, 256};
    EpiBf16 E{WS(bf16_t, OFF_KV), 768, 768}; pg8::gemm_phase(ll, g, S, E); } }
  if constexpr (MASK & 8) { const int c = (int)gridDim.x - 1 - (int)blockIdx.x; if (c < 64) mlstm_state_scan(p, c); }
  if constexpr (MASK & 8) {
  unsigned* cnt = WS(unsigned, OFF_CNT) + 8 + lx; unsigned* slot = (unsigned*)lds;
  for (;;) {
    __syncthreads();
    if (TIDX() == 0) *slot = atomicAdd(cnt, 1u);
    __syncthreads();
    const unsigned ch = *slot + CONV_MID0; if (ch >= 2048u) break;
    const int tb = ch >> 10, e = (int)(ch & 1023) * 16 + (TIDX() >> 5), seg = TIDX() & 31;
    const float* src = p.in[tb ? I_PV : I_PU] + ((size_t)l * 16384 + e) * 1024 + seg * 32; const float scl = tb ? 4.f : 64.f;
    unsigned char* dst = WS(unsigned char, tb ? OFF_TABV : OFF_TABU) + ((size_t)(seg >> 3) * 16384 + e) * 128 + (seg & 7) * 16;
    u32x4 w0;
#pragma unroll
    for (int i = 0; i < 4; ++i) { const f32x4 a = *(const f32x4*)(src + i * 8) * scl, b2 = *(const f32x4*)(src + i * 8 + 4) * scl; unsigned w = 0u;
      w = __builtin_amdgcn_cvt_scalef32_pk_fp4_f32(w, a[0], a[1], 1.0f, 0); w = __builtin_amdgcn_cvt_scalef32_pk_fp4_f32(w, a[2], a[3], 1.0f, 1);
      w = __builtin_amdgcn_cvt_scalef32_pk_fp4_f32(w, b2[0], b2[1], 1.0f, 2); w = __builtin_amdgcn_cvt_scalef32_pk_fp4_f32(w, b2[2], b2[3], 1.0f, 3);
      w0[i] = w; }
    *(u32x4*)dst = w0;
  }
  }
  __syncthreads();
}
DEV void ph_mid(CParams& p, int l, unsigned char* lds) { ph_mid_t<15>(p, l, lds); }

DEV int rw_rowof(int dir, int b, int pos) { if (pos < 256) { const int t = dir ? 255 - pos : pos; return b * 256 + t; } const int q = pos - 256; const int t = dir ? 2047 - q : q; return NCTXR + b * 2048 + t; }
DEV void rwkv_scan_unit(CParams& p, int l, int u, unsigned char* lds) {
  constexpr int TS = 32;
  const int chain = u >> 1, half = u & 1, dir = chain / 48, bh = chain % 48, b = bh / 6, h6 = bh % 6;
  float* sb = (float*)lds;
  float* yb = sb + 2 * 6 * TS * 64;
  const int tid = TIDX(), rl = tid >> 4, kq = tid & 15, col = h6 * 64 + kq * 4;
  float ka[4];
#pragma unroll
  for (int i = 0; i < 4; ++i) ka[i] = p.in[I_RWKA][l * 384 + col + i];
  const bf16_t* RBp = WS(bf16_t, OFF_RB); const bf16_t* KBp = WS(bf16_t, OFF_KB); const bf16_t* KHp = WS(bf16_t, OFF_KH); const bf16_t* VBp = WS(bf16_t, OFF_VB);
  const bf16_t* LOp = WS(bf16_t, OFF_LORA) + dir * 384 + col;
  float w0v[4], a0v[4];
#pragma unroll
  for (int i = 0; i < 4; ++i) { w0v[i] = p.in[I_RWW0][l * 768 + dir * 384 + col + i]; a0v[i] = p.in[I_RWA0][l * 768 + dir * 384 + col + i]; }
  u32x2 g_r, g_k, g_kh, g_v, g_lw, g_a;
#define RW_LOAD(c) do { const size_t off = (size_t)rw_rowof(dir, b, (c) * TS + rl) * 384 + col; g_r = *(const u32x2*)(RBp + off); g_k = *(const u32x2*)(KBp + off); \
    g_kh = *(const u32x2*)(KHp + off); g_v = *(const u32x2*)(VBp + off); const size_t off2 = (size_t)rw_rowof(dir, b, (c) * TS + rl) * 1920; g_lw = *(const u32x2*)(LOp + off2); g_a = *(const u32x2*)(LOp + off2 + 768); } while (0)
#define RW_WRITE(bi) do { float* base = sb + (bi) * 6 * TS * 64 + rl * 64 + kq * 4; \
    const float r_[4] = {lo16(g_r[0]), hi16(g_r[0]), lo16(g_r[1]), hi16(g_r[1])}, k_[4] = {lo16(g_k[0]), hi16(g_k[0]), lo16(g_k[1]), hi16(g_k[1])}; \
    const float kh_[4] = {lo16(g_kh[0]), hi16(g_kh[0]), lo16(g_kh[1]), hi16(g_kh[1])}, v_[4] = {lo16(g_v[0]), hi16(g_v[0]), lo16(g_v[1]), hi16(g_v[1])}; \
    const float lw_[4] = {lo16(g_lw[0]), hi16(g_lw[0]), lo16(g_lw[1]), hi16(g_lw[1])}, a_[4] = {lo16(g_a[0]), hi16(g_a[0]), lo16(g_a[1]), hi16(g_a[1])}; \
    f32x4 o0, o1, o2, o3, o4, o5; \
    _Pragma("unroll") for (int i = 0; i < 4; ++i) { const float aa = sigmoidf_(a0v[i] + a_[i]); o0[i] = __expf(-0.60653065971f * sigmoidf_(w0v[i] + lw_[i])); o1[i] = kh_[i]; o2[i] = kh_[i] * aa; o3[i] = k_[i] * (1.f + (aa - 1.f) * ka[i]); o4[i] = r_[i]; o5[i] = v_[i]; } \
    *(f32x4*)(base + 0 * TS * 64) = o0; *(f32x4*)(base + 1 * TS * 64) = o1; *(f32x4*)(base + 2 * TS * 64) = o2; *(f32x4*)(base + 3 * TS * 64) = o3; \
    *(f32x4*)(base + 4 * TS * 64) = o4; *(f32x4*)(base + 5 * TS * 64) = o5; } while (0)
  f32x2 SA = {0.f, 0.f}, SB = {0.f, 0.f};
  __syncthreads();
  RW_LOAD(0); RW_WRITE(0);
  __syncthreads();
  constexpr int NCH = 2304 / TS;
#pragma unroll 1
  for (int c = 0; c < NCH; ++c) {
    if (c + 1 < NCH) RW_LOAD(c + 1);
    const float* base = sb + (c & 1) * 6 * TS * 64 + kq * 4; const float* vbase = sb + (c & 1) * 6 * TS * 64 + 5 * TS * 64 + half * 32 + rl;
    f32x4 w4 = *(const f32x4*)(base), kh4 = *(const f32x4*)(base + TS * 64), ab4 = *(const f32x4*)(base + 2 * TS * 64), kt4 = *(const f32x4*)(base + 3 * TS * 64), r4 = *(const f32x4*)(base + 4 * TS * 64);
    float vv = vbase[0];
#pragma unroll
    for (int ts = 0; ts < TS; ++ts) {
      f32x4 nw4 = w4, nkh4 = kh4, nab4 = ab4, nkt4 = kt4, nr4 = r4; float nvv = vv;
      if (ts + 1 < TS) { const float* bp = base + (ts + 1) * 64;
        nw4 = *(const f32x4*)(bp); nkh4 = *(const f32x4*)(bp + TS * 64); nab4 = *(const f32x4*)(bp + 2 * TS * 64); nkt4 = *(const f32x4*)(bp + 3 * TS * 64); nr4 = *(const f32x4*)(bp + 4 * TS * 64);
        nvv = vbase[(ts + 1) * 64]; }
      const f32x2 khA = {kh4[0], kh4[1]}, khB = {kh4[2], kh4[3]}, wA = {w4[0], w4[1]}, wB = {w4[2], w4[3]}, abA = {ab4[0], ab4[1]}, abB = {ab4[2], ab4[3]},
                  ktA = {kt4[0], kt4[1]}, ktB = {kt4[2], kt4[3]}, rA = {r4[0], r4[1]}, rB = {r4[2], r4[3]};
      f32x2 pa = SA * khA + SB * khB;
      float sa = row16_sum(pa[0] + pa[1]);
      const f32x2 vv2 = {vv, vv}, sa2 = {sa, sa};
      SA = SA * wA + (vv2 * ktA - sa2 * abA); SB = SB * wB + (vv2 * ktB - sa2 * abB);
      f32x2 py = SA * rA + SB * rB;
      float y = row16_sum(py[0] + py[1]);
      yb[ts * 32 + rl] = y;
      w4 = nw4; kh4 = nkh4; ab4 = nab4; kt4 = nkt4; r4 = nr4; vv = nvv;
    }
    __syncthreads();
    { const int ts = tid >> 4, pr = tid & 15; const int row = rw_rowof(dir, b, c * TS + ts);
      *(unsigned*)(WS(bf16_t, OFF_RWY) + ((size_t)dir * NTOK + row) * 384 + h6 * 64 + half * 32 + pr * 2) = pack2(yb[ts * 32 + pr * 2], yb[ts * 32 + pr * 2 + 1]); }
    if (c + 1 < NCH) RW_WRITE((c + 1) & 1);
    __syncthreads();
  }
#undef RW_LOAD
#undef RW_WRITE
}

DEV bf16x8 ld_frag16(const bf16_t* ptr) { return *(const bf16x8*)ptr; }
DEV bf16x8 ld_frag8x2(const bf16_t* p0, const bf16_t* p1) { const u32x2 x0 = *(const u32x2*)p0, x1 = *(const u32x2*)p1; u32x4 w; w[0] = x0[0]; w[1] = x0[1]; w[2] = x1[0]; w[3] = x1[1]; return __builtin_bit_cast(bf16x8, w); }
DEV bf16x8 frag_lo(u32x2 lo) { u32x4 w; w[0] = lo[0]; w[1] = lo[1]; w[2] = 0u; w[3] = 0u; return __builtin_bit_cast(bf16x8, w); }
DEV bf16x8 frag2(u32x2 lo, u32x2 hi) { u32x4 w; w[0] = lo[0]; w[1] = lo[1]; w[2] = hi[0]; w[3] = hi[1]; return __builtin_bit_cast(bf16x8, w); }
DEV u32x2 acc2bf(f32x4 a) { u32x2 w; w[0] = (unsigned)f2bf(a[0]) | ((unsigned)f2bf(a[1]) << 16); w[1] = (unsigned)f2bf(a[2]) | ((unsigned)f2bf(a[3]) << 16); return w; }
DEV void rwkv_chunk_unit(CParams& p, int l, int u, unsigned char* lds) {
  constexpr int O_A = 0, O_Q = 2176, O_NBT = 4352, O_CT = 6400, O_M1T = 8448, O_U1T = 8960, O_NU2T = 9472, O_TT = 9984, O_VT = 10496, O_GAM = 12544, SCB = 12800, CHB = 4 * SCB;
  constexpr int O_PRIV = 2 * CHB, P_LW = 0, P_BR = 4096, P_CR = 6272, P_M2 = 8448, PRIV = 9472, O_CONST = O_PRIV + 4 * PRIV;
  const int chain = u, dir = chain / 48, bh = chain % 48, b = bh / 6, h6 = bh % 6;
  const int tid = TIDX(), lane = tid & 63, wid = tid >> 6, fr = lane & 15, fq = lane >> 4;
  float* cst = (float*)(lds + O_CONST);
  __syncthreads();
  if (tid < 64) { cst[tid] = p.in[I_RWW0][l * 768 + dir * 384 + h6 * 64 + tid]; cst[64 + tid] = p.in[I_RWA0][l * 768 + dir * 384 + h6 * 64 + tid]; cst[128 + tid] = p.in[I_RWKA][l * 384 + h6 * 64 + tid]; cst[192 + tid] = p.in[I_RWRK][l * 384 + h6 * 64 + tid]; }
  __syncthreads();
  const bool producer = wid >= 4;
  const int pj = wid - 4, pt = lane >> 2, pks = lane & 3;
  u32x4 in_r[2], in_k[2], in_kh[2], in_v[2], in_lw[2], in_a[2];
#define RC_LOAD(c) do { int lo32_ = h6 * 64 + pks * 16; asm volatile("" : "+v"(lo32_));   \
    const int row_ = rw_rowof(dir, b, (c) * 64 + pj * 16 + pt); const size_t o_ = (size_t)row_ * 384 + lo32_; \
    in_r[0] = ld8g(WS(bf16_t, OFF_RB) + o_); in_r[1] = ld8g(WS(bf16_t, OFF_RB) + o_ + 8); in_k[0] = ld8g(WS(bf16_t, OFF_KB) + o_); in_k[1] = ld8g(WS(bf16_t, OFF_KB) + o_ + 8); \
    in_kh[0] = ld8g(WS(bf16_t, OFF_KH) + o_); in_kh[1] = ld8g(WS(bf16_t, OFF_KH) + o_ + 8); in_v[0] = ld8g(WS(bf16_t, OFF_VB) + o_); in_v[1] = ld8g(WS(bf16_t, OFF_VB) + o_ + 8); \
    const bf16_t* lo_ = WS(bf16_t, OFF_LORA) + (size_t)row_ * 1920 + dir * 384 + lo32_; in_lw[0] = ld8g(lo_); in_lw[1] = ld8g(lo_ + 8); in_a[0] = ld8g(lo_ + 768); in_a[1] = ld8g(lo_ + 776); } while (0)
  f32x4 sacc[4];
#pragma unroll
  for (int i = 0; i < 4; ++i) sacc[i] = (f32x4){0.f, 0.f, 0.f, 0.f};
  if (producer) RC_LOAD(0);
#pragma unroll 1
  for (int c = -1; c < 36; ++c) {
    if (producer) {
      if (c + 1 < 36) {
        unsigned char* scb = lds + ((c + 1) & 1) * CHB + pj * SCB; unsigned char* prv = lds + O_PRIV + pj * PRIV;
        float r_[16], k_[16], kh_[16], lw_[16], aa_[16];
        unpack8(in_r[0], r_); unpack8(in_r[1], r_ + 8); unpack8(in_k[0], k_); unpack8(in_k[1], k_ + 8); unpack8(in_kh[0], kh_); unpack8(in_kh[1], kh_ + 8);
        unpack8(in_lw[0], lw_); unpack8(in_lw[1], lw_ + 8); unpack8(in_a[0], aa_); unpack8(in_a[1], aa_ + 8);
        const u32x4 vraw0 = in_v[0], vraw1 = in_v[1];
        float* LW = (float*)(prv + P_LW);
#pragma unroll
        for (int i = 0; i < 16; ++i) { const int col = pks * 16 + i; aa_[i] = sigmoidf_(cst[64 + col] + aa_[i]); lw_[i] = -0.60653065971f * sigmoidf_(cst[col] + lw_[i]); }
#pragma unroll
        for (int i = 0; i < 4; ++i) *(f32x4*)(LW + pt * 64 + pks * 16 + i * 4) = (f32x4){lw_[4 * i], lw_[4 * i + 1], lw_[4 * i + 2], lw_[4 * i + 3]};
        { bf16_t* VT = (bf16_t*)(scb + O_VT);
#pragma unroll
          for (int i = 0; i < 4; ++i) { VT[(pks * 16 + 2 * i) * 16 + pt] = (bf16_t)(vraw0[i] & 0xffffu); VT[(pks * 16 + 2 * i + 1) * 16 + pt] = (bf16_t)(vraw0[i] >> 16);
            VT[(pks * 16 + 8 + 2 * i) * 16 + pt] = (bf16_t)(vraw1[i] & 0xffffu); VT[(pks * 16 + 8 + 2 * i + 1) * 16 + pt] = (bf16_t)(vraw1[i] >> 16); } }
        asm volatile("s_waitcnt lgkmcnt(0)" ::: "memory"); __builtin_amdgcn_wave_barrier();
        { float g = 0.f;
#pragma unroll
          for (int t = 0; t < 16; ++t) { g += LW[t * 64 + lane]; LW[t * 64 + lane] = g; }
          ((float*)(scb + O_GAM))[lane] = __expf(g); }
        asm volatile("s_waitcnt lgkmcnt(0)" ::: "memory"); __builtin_amdgcn_wave_barrier();
        { float av[16], bv[16], cv[16], qv[16];
#pragma unroll
          for (int i = 0; i < 4; ++i) { const f32x4 g4 = *(const f32x4*)(LW + pt * 64 + pks * 16 + i * 4);
#pragma unroll
            for (int jj = 0; jj < 4; ++jj) { const int e = 4 * i + jj; const float G = g4[jj], e1 = __expf(G), e2 = __expf(-G), e3 = __expf(G - lw_[e]);
              const float ab = kh_[e] * aa_[e], kt = k_[e] * (1.f + (aa_[e] - 1.f) * cst[128 + pks * 16 + e]);
              av[e] = kh_[e] * e3; bv[e] = ab * e2; cv[e] = kt * e2; qv[e] = r_[e] * e1; } }
          bf16_t* Ap = (bf16_t*)(scb + O_A) + pt * 68 + pks * 16; bf16_t* Qp = (bf16_t*)(scb + O_Q) + pt * 68 + pks * 16;
          bf16_t* Bp = (bf16_t*)(prv + P_BR) + pt * 68 + pks * 16; bf16_t* Cp = (bf16_t*)(prv + P_CR) + pt * 68 + pks * 16;
#pragma unroll
          for (int i = 0; i < 4; ++i) { u32x2 w; w[0] = pack2(av[4 * i], av[4 * i + 1]); w[1] = pack2(av[4 * i + 2], av[4 * i + 3]); *(u32x2*)(Ap + 4 * i) = w;
            w[0] = pack2(qv[4 * i], qv[4 * i + 1]); w[1] = pack2(qv[4 * i + 2], qv[4 * i + 3]); *(u32x2*)(Qp + 4 * i) = w;
            w[0] = pack2(bv[4 * i], bv[4 * i + 1]); w[1] = pack2(bv[4 * i + 2], bv[4 * i + 3]); *(u32x2*)(Bp + 4 * i) = w;
            w[0] = pack2(cv[4 * i], cv[4 * i + 1]); w[1] = pack2(cv[4 * i + 2], cv[4 * i + 3]); *(u32x2*)(Cp + 4 * i) = w; }
          bf16_t* NBT = (bf16_t*)(scb + O_NBT); bf16_t* CT = (bf16_t*)(scb + O_CT);
#pragma unroll
          for (int e = 0; e < 16; ++e) { NBT[(pks * 16 + e) * 16 + pt] = f2bf(-bv[e]); CT[(pks * 16 + e) * 16 + pt] = f2bf(cv[e]); } }
        asm volatile("s_waitcnt lgkmcnt(0)" ::: "memory"); __builtin_amdgcn_wave_barrier();
        if (c + 2 < 36) RC_LOAD(c + 2);
        {
          f32x4 mBA = {0.f, 0.f, 0.f, 0.f}, mCA = mBA, mBQ = mBA, mCQ = mBA;
#pragma unroll
          for (int ks = 0; ks < 2; ++ks) { const int ko = fr * 68 + ks * 32 + fq * 8;
            const bf16_t* bp = (const bf16_t*)(prv + P_BR) + ko; const bf16_t* cp = (const bf16_t*)(prv + P_CR) + ko; const bf16_t* ap = (const bf16_t*)(scb + O_A) + ko; const bf16_t* qp = (const bf16_t*)(scb + O_Q) + ko;
            const bf16x8 fb = ld_frag8x2(bp, bp + 4), fc = ld_frag8x2(cp, cp + 4), fa = ld_frag8x2(ap, ap + 4), fqv = ld_frag8x2(qp, qp + 4);
            mBA = __builtin_amdgcn_mfma_f32_16x16x32_bf16(fb, fa, mBA, 0, 0, 0); mCA = __builtin_amdgcn_mfma_f32_16x16x32_bf16(fc, fa, mCA, 0, 0, 0);
            mBQ = __builtin_amdgcn_mfma_f32_16x16x32_bf16(fb, fqv, mBQ, 0, 0, 0); mCQ = __builtin_amdgcn_mfma_f32_16x16x32_bf16(fc, fqv, mCQ, 0, 0, 0); }
          float* M2 = (float*)(prv + P_M2); float m1[4], u1[4], u2[4];
#pragma unroll
          for (int j = 0; j < 4; ++j) { const int s_ = 4 * fq + j; M2[s_ * 16 + fr] = s_ < fr ? mBA[j] : 0.f; m1[j] = s_ < fr ? mCA[j] : 0.f; u1[j] = s_ <= fr ? mCQ[j] : 0.f; u2[j] = s_ <= fr ? -mBQ[j] : 0.f; }
          u32x2 w; w[0] = pack2(m1[0], m1[1]); w[1] = pack2(m1[2], m1[3]); *(u32x2*)((bf16_t*)(scb + O_M1T) + fr * 16 + 4 * fq) = w;
          w[0] = pack2(u1[0], u1[1]); w[1] = pack2(u1[2], u1[3]); *(u32x2*)((bf16_t*)(scb + O_U1T) + fr * 16 + 4 * fq) = w;
          w[0] = pack2(u2[0], u2[1]); w[1] = pack2(u2[2], u2[3]); *(u32x2*)((bf16_t*)(scb + O_NU2T) + fr * 16 + 4 * fq) = w; }
        asm volatile("s_waitcnt lgkmcnt(0)" ::: "memory"); __builtin_amdgcn_wave_barrier();
        {
          const float* M2 = (const float*)(prv + P_M2); float Tc[16];
#pragma unroll
          for (int s_ = 15; s_ >= 0; --s_) { float x0 = (fr == s_) ? 1.f : 0.f, x1 = 0.f;
#pragma unroll
            for (int j = s_ + 1; j < 16; ++j) { if (j & 1) x1 -= M2[s_ * 16 + j] * Tc[j]; else x0 -= M2[s_ * 16 + j] * Tc[j]; }
            Tc[s_] = x0 + x1; }
          if (fq == 0) { bf16_t* TT = (bf16_t*)(scb + O_TT) + fr * 16; *(u32x4*)TT = pack8(Tc); *(u32x4*)(TT + 8) = pack8(Tc + 8); } }
      }
    } else if (c >= 0) {
      const int v0 = wid * 16;
      const int bt = lane >> 2, bks = lane & 3, brow = rw_rowof(dir, b, c * 64 + wid * 16 + bt);
      u32x4 b_r0, b_r1, b_k0, b_k1, b_a0, b_a1;
      { int bc = h6 * 64 + bks * 16; asm volatile("" : "+v"(bc)); const size_t bo = (size_t)brow * 384 + bc; const bf16_t* blo = WS(bf16_t, OFF_LORA) + (size_t)brow * 1920 + dir * 384 + bc + 768;
        b_r0 = ld8g(WS(bf16_t, OFF_RB) + bo); b_r1 = ld8g(WS(bf16_t, OFF_RB) + bo + 8); b_k0 = ld8g(WS(bf16_t, OFF_KB) + bo); b_k1 = ld8g(WS(bf16_t, OFF_KB) + bo + 8); b_a0 = ld8g(blo); b_a1 = ld8g(blo + 8); }
      f32x4 cvv[8]; int cm = (u * 4 + wid) * 36 + c; asm volatile("" : "+v"(cm));
      { const int ce = (cm & 8191) * 2 + (lane >> 5); const float* csrc = p.in[(cm >> 13) ? I_PV : I_PU] + ((size_t)l * 16384 + ce) * 1024 + (lane & 31) * 32;
#pragma unroll
        for (int i = 0; i < 8; ++i) cvv[i] = *(const f32x4*)(csrc + i * 4); }
#pragma unroll 1
      for (int j = 0; j < 4; ++j) { const unsigned char* scb = lds + (c & 1) * CHB + j * SCB;
        bf16x8 sb[2];
#pragma unroll
        for (int ks = 0; ks < 2; ++ks) sb[ks] = frag2(acc2bf(sacc[2 * ks]), acc2bf(sacc[2 * ks + 1]));
        const bf16x8 vt = frag_lo(*(const u32x2*)((const bf16_t*)(scb + O_VT) + (v0 + fr) * 16 + 4 * fq));
        const bf16_t* Ar = (const bf16_t*)(scb + O_A) + fr * 68 + 4 * fq; const bf16_t* Qr = (const bf16_t*)(scb + O_Q) + fr * 68 + 4 * fq;
        f32x4 racc = {0.f, 0.f, 0.f, 0.f}, yacc = racc;
#pragma unroll
        for (int ks = 0; ks < 2; ++ks) { racc = __builtin_amdgcn_mfma_f32_16x16x32_bf16(ld_frag8x2(Ar + 32 * ks, Ar + 32 * ks + 16), sb[ks], racc, 0, 0, 0);
          yacc = __builtin_amdgcn_mfma_f32_16x16x32_bf16(ld_frag8x2(Qr + 32 * ks, Qr + 32 * ks + 16), sb[ks], yacc, 0, 0, 0); }
        racc = __builtin_amdgcn_mfma_f32_16x16x32_bf16(frag_lo(*(const u32x2*)((const bf16_t*)(scb + O_M1T) + fr * 16 + 4 * fq)), vt, racc, 0, 0, 0);
        yacc = __builtin_amdgcn_mfma_f32_16x16x32_bf16(frag_lo(*(const u32x2*)((const bf16_t*)(scb + O_U1T) + fr * 16 + 4 * fq)), vt, yacc, 0, 0, 0);
        f32x4 zacc = {0.f, 0.f, 0.f, 0.f};
        zacc = __builtin_amdgcn_mfma_f32_16x16x32_bf16(frag_lo(*(const u32x2*)((const bf16_t*)(scb + O_TT) + fr * 16 + 4 * fq)), frag_lo(acc2bf(racc)), zacc, 0, 0, 0);
        const bf16x8 zf = frag_lo(acc2bf(zacc));
        yacc = __builtin_amdgcn_mfma_f32_16x16x32_bf16(frag_lo(*(const u32x2*)((const bf16_t*)(scb + O_NU2T) + fr * 16 + 4 * fq)), zf, yacc, 0, 0, 0);
        const float* gam = (const float*)(scb + O_GAM);
#pragma unroll
        for (int kt = 0; kt < 4; ++kt) {
          sacc[kt] = __builtin_amdgcn_mfma_f32_16x16x32_bf16(frag_lo(*(const u32x2*)((const bf16_t*)(scb + O_CT) + (kt * 16 + fr) * 16 + 4 * fq)), vt, sacc[kt], 0, 0, 0);
          sacc[kt] = __builtin_amdgcn_mfma_f32_16x16x32_bf16(frag_lo(*(const u32x2*)((const bf16_t*)(scb + O_NBT) + (kt * 16 + fr) * 16 + 4 * fq)), zf, sacc[kt], 0, 0, 0);
          sacc[kt] *= *(const f32x4*)(gam + kt * 16 + 4 * fq); }
#pragma unroll
        for (int jj = 0; jj < 4; ++jj) { const int row = rw_rowof(dir, b, c * 64 + j * 16 + 4 * fq + jj);
          WS(bf16_t, OFF_RWY)[((size_t)dir * NTOK + row) * 384 + h6 * 64 + v0 + fr] = f2bf(yacc[jj]); } }
      { float r_[16], k_[16], a_[16]; unpack8(b_r0, r_); unpack8(b_r1, r_ + 8); unpack8(b_k0, k_); unpack8(b_k1, k_ + 8); unpack8(b_a0, a_); unpack8(b_a1, a_ + 8);
        float s = 0.f;
#pragma unroll
        for (int i = 0; i < 16; ++i) { const int col = bks * 16 + i; const float a = sigmoidf_(cst[64 + col] + a_[i]); s += r_[i] * cst[192 + col] * (k_[i] * (1.f + (a - 1.f) * cst[128 + col])); }
        s += dppf<0xB1>(s); s += dppf<0x4E>(s);
        if (bks == 0) WS(float, OFF_BS)[((size_t)dir * NTOK + brow) * 6 + h6] = s; }
      { const int tb = cm >> 13, ce = (cm & 8191) * 2 + (lane >> 5), cseg = lane & 31; const float scl = tb ? 4.f : 64.f;
        unsigned char* dst = WS(unsigned char, tb ? OFF_TABV : OFF_TABU) + ((size_t)(cseg >> 3) * 16384 + ce) * 128 + (cseg & 7) * 16;
        u32x4 w0;
#pragma unroll
        for (int i = 0; i < 4; ++i) { const f32x4 a = cvv[2 * i] * scl, b2 = cvv[2 * i + 1] * scl; unsigned w = 0u;
          w = __builtin_amdgcn_cvt_scalef32_pk_fp4_f32(w, a[0], a[1], 1.0f, 0); w = __builtin_amdgcn_cvt_scalef32_pk_fp4_f32(w, a[2], a[3], 1.0f, 1);
          w = __builtin_amdgcn_cvt_scalef32_pk_fp4_f32(w, b2[0], b2[1], 1.0f, 2); w = __builtin_amdgcn_cvt_scalef32_pk_fp4_f32(w, b2[2], b2[3], 1.0f, 3);
          w0[i] = w; }
        *(u32x4*)dst = w0; }
    }
    __syncthreads();
  }
#undef RC_LOAD
}

typedef short v4s16 __attribute__((ext_vector_type(4)));
template <int OFF> DEV u32x2 tr_read(unsigned addr) { return __builtin_bit_cast(u32x2, __builtin_amdgcn_ds_read_tr16_b64_v4i16((LAS v4s16*)(addr + (unsigned)OFF))); }
DEV void attn_unit(CParams& p, int u, unsigned char* lds) {
  int b, head, qrow0, ntile; const bool lat = u < 384;
  if (lat) { b = u / 48; const int r = u % 48; head = r / 8; const int qb = r % 8; qrow0 = NCTXR + b * 2048 + qb * 256; ntile = 36; }
  else { const int v = u - 384; b = v / 6; head = v % 6; qrow0 = b * 256; ntile = 4; }
  const int tid = TIDX(), lane = tid & 63, wid = tid >> 6, r32 = lane & 31, hi = lane >> 5;
  constexpr int KROW = 208, VROW = 192, KT_B = 64 * KROW, VT_B = 64 * VROW, BUF_B = KT_B + VT_B;
  const bf16_t* KVp = WS(bf16_t, OFF_KV) + head * 128; const bf16_t* KRp = WS(bf16_t, OFF_KR);
  const int qrow = qrow0 + wid * 32 + r32;
  bf16x8 qf[6];
  { const bf16_t* qp = WS(bf16_t, OFF_QB) + (size_t)qrow * 576 + head * 96 + hi * 8;
    const float SC = 0.10206207262f * 1.44269504089f;
    const int t = lat ? ((qrow - NCTXR) & 2047) : 0;
#pragma unroll
    for (int ks = 0; ks < 6; ++ks) { float f[8]; unpack8(ld8g(qp + ks * 16), f);
      if (ks >= 4) { float pt[8];
#pragma unroll
        for (int j = 0; j < 8; ++j) { auto rr = __builtin_amdgcn_permlane32_swap(__float_as_uint(f[j]), __float_as_uint(f[j]), false, false); pt[j] = __uint_as_float(hi ? rr[0] : rr[1]); }
        if (lat) { const int pos = ks == 4 ? (t >> 6) : (t & 63);
#pragma unroll
          for (int j = 0; j < 8; ++j) { const float invf = __expf(-(float)j * (9.210340372f / 8.f)); float rev = (float)pos * invf * 0.15915494309f; rev -= floorf(rev);
            const float sn = __builtin_amdgcn_sinf(rev), cs = __builtin_amdgcn_cosf(rev);
            f[j] = hi ? f[j] * cs + pt[j] * sn : f[j] * cs - pt[j] * sn; } } }
#pragma unroll
      for (int j = 0; j < 8; ++j) f[j] *= SC;
      qf[ks] = __builtin_bit_cast(bf16x8, pack8(f)); } }
  const int k0key = tid / 12, k0part = tid % 12, k1key = (tid + 512) / 12, k1part = (tid + 512) % 12, vkey = tid >> 3, vpart = tid & 7;
  u32x4 skA0, skA1 = {0u, 0u, 0u, 0u}, svA, skB0, skB1 = {0u, 0u, 0u, 0u}, svB;
#define AT_ROW0(kt) (lat ? ((kt) < 32 ? NCTXR + b * 2048 + (kt) * 64 : b * 256 + ((kt) - 32) * 64) : b * 256 + (kt) * 64)
#define AT_LOAD(kt, sk0, sk1, sv) do { const int r0_ = AT_ROW0(kt); \
    sk0 = k0part < 8 ? ld8g(KVp + (size_t)(r0_ + k0key) * 768 + k0part * 8) : ld8g(KRp + (size_t)(r0_ + k0key) * 32 + (k0part - 8) * 8); \
    if (tid < 256) sk1 = k1part < 8 ? ld8g(KVp + (size_t)(r0_ + k1key) * 768 + k1part * 8) : ld8g(KRp + (size_t)(r0_ + k1key) * 32 + (k1part - 8) * 8); \
    sv = ld8g(KVp + (size_t)(r0_ + vkey) * 768 + 64 + vpart * 8); } while (0)
#define AT_WRITE(bi, sk0, sk1, sv) do { unsigned char* bb = lds + (bi) * BUF_B; *(u32x4*)(bb + k0key * KROW + k0part * 16) = sk0; \
    if (tid < 256) *(u32x4*)(bb + k1key * KROW + k1part * 16) = sk1; *(u32x4*)(bb + KT_B + vkey * VROW + vpart * 16) = sv; } while (0)
  const unsigned trb = (unsigned)(uintptr_t)lds + KT_B + ((4 * (lane >> 5) + ((lane & 15) >> 2)) * VROW + (16 * ((lane >> 4) & 1) + 4 * (lane & 3)) * 2);
  f32x16 o0, o1;
#pragma unroll
  for (int i = 0; i < 16; ++i) { o0[i] = 0.f; o1[i] = 0.f; }
  float m_run = -1e30f, l_run = 0.f;
  __syncthreads();
  AT_LOAD(0, skA0, skA1, svA); AT_LOAD(1, skB0, skB1, svB);
  AT_WRITE(0, skA0, skA1, svA); AT_WRITE(1, skB0, skB1, svB);
  if (2 < ntile) AT_LOAD(2, skA0, skA1, svA);
  if (3 < ntile) AT_LOAD(3, skB0, skB1, svB);
  __syncthreads();
  f32x16 sa0, sa1, sb0, sb1;
#define AT_KF(kb_, ks) *(const bf16x8*)((kb_) + r32 * KROW + ((ks) * 16 + hi * 8) * 2), *(const bf16x8*)((kb_) + (32 + r32) * KROW + ((ks) * 16 + hi * 8) * 2)
  { const unsigned char* kb = lds;
#pragma unroll
    for (int i = 0; i < 16; ++i) { sa0[i] = 0.f; sa1[i] = 0.f; }
#pragma unroll
    for (int ks = 0; ks < 6; ++ks) { const bf16x8 a0 = *(const bf16x8*)(kb + r32 * KROW + (ks * 16 + hi * 8) * 2), a1 = *(const bf16x8*)(kb + (32 + r32) * KROW + (ks * 16 + hi * 8) * 2);
      sa0 = __builtin_amdgcn_mfma_f32_32x32x16_bf16(a0, qf[ks], sa0, 0, 0, 0); sa1 = __builtin_amdgcn_mfma_f32_32x32x16_bf16(a1, qf[ks], sa1, 0, 0, 0); } }
  auto step = [&](f32x16& c0, f32x16& c1, f32x16& n0, f32x16& n1, const int bufv, const int bufk) {
    const unsigned char* kb = lds + bufk * BUF_B;
    const unsigned ta = trb + (unsigned)(bufv * BUF_B);
#define TR(st, rd, eb) tr_read<(st) * 16 * VROW + (rd) * 8 * VROW + (eb) * 64>(ta)
    const u32x2 t00 = TR(0, 0, 0), t01 = TR(0, 1, 0), t10 = TR(1, 0, 0), t11 = TR(1, 1, 0), t20 = TR(2, 0, 0), t21 = TR(2, 1, 0), t30 = TR(3, 0, 0), t31 = TR(3, 1, 0);
    const u32x2 u00 = TR(0, 0, 1), u01 = TR(0, 1, 1), u10 = TR(1, 0, 1), u11 = TR(1, 1, 1), u20 = TR(2, 0, 1), u21 = TR(2, 1, 1), u30 = TR(3, 0, 1), u31 = TR(3, 1, 1);
#undef TR
#define QK(ks) do { const bf16x8 a0_ = *(const bf16x8*)(kb + r32 * KROW + ((ks) * 16 + hi * 8) * 2), a1_ = *(const bf16x8*)(kb + (32 + r32) * KROW + ((ks) * 16 + hi * 8) * 2); \
      n0 = __builtin_amdgcn_mfma_f32_32x32x16_bf16(a0_, qf[ks], n0, 0, 0, 0); n1 = __builtin_amdgcn_mfma_f32_32x32x16_bf16(a1_, qf[ks], n1, 0, 0, 0); } while (0)
#pragma unroll
    for (int i = 0; i < 16; ++i) { n0[i] = 0.f; n1[i] = 0.f; }
    QK(0);
    __builtin_amdgcn_sched_barrier(0);
    float mx = fmaxf(fmaxf(c0[0], c0[1]), c0[2]);
#pragma unroll
    for (int i = 3; i < 15; i += 2) mx = fmaxf(fmaxf(mx, c0[i]), c0[i + 1]);
    mx = fmaxf(fmaxf(mx, c0[15]), c1[0]);
    __builtin_amdgcn_sched_barrier(0);
    QK(1);
    __builtin_amdgcn_sched_barrier(0);
#pragma unroll
    for (int i = 1; i < 15; i += 2) mx = fmaxf(fmaxf(mx, c1[i]), c1[i + 1]);
    mx = fmaxf(mx, c1[15]);
    mx = xhalf_max(mx);
    if (__builtin_amdgcn_ballot_w64(mx > m_run + 8.f) != 0ull) {
      const float mnew = fmaxf(m_run, mx), alpha = __builtin_amdgcn_exp2f(m_run - mnew); const f32x2 al2 = {alpha, alpha};
      m_run = mnew; l_run *= alpha;
#pragma unroll
      for (int i = 0; i < 8; ++i) { f32x2 a = {o0[2 * i], o0[2 * i + 1]}, b2 = {o1[2 * i], o1[2 * i + 1]}; a *= al2; b2 *= al2; o0[2 * i] = a[0]; o0[2 * i + 1] = a[1]; o1[2 * i] = b2[0]; o1[2 * i + 1] = b2[1]; } }
    const f32x2 mm = {m_run, m_run}; f32x2 ps2 = {0.f, 0.f};
    bf16x8 pf[4];
#define SMX(cc, base, pi) do { u32x4 w_; _Pragma("unroll") for (int i_ = 0; i_ < 4; ++i_) { f32x2 a_ = {cc[base + 2 * i_], cc[base + 2 * i_ + 1]}; a_ -= mm; \
        a_[0] = __builtin_amdgcn_exp2f(a_[0]); a_[1] = __builtin_amdgcn_exp2f(a_[1]); ps2 += a_; w_[i_] = pack2(a_[0], a_[1]); } pf[pi] = __builtin_bit_cast(bf16x8, w_); } while (0)
    __builtin_amdgcn_sched_barrier(0);
    QK(2);
    __builtin_amdgcn_sched_barrier(0);
    SMX(c0, 0, 0);
    __builtin_amdgcn_sched_barrier(0);
    QK(3);
    __builtin_amdgcn_sched_barrier(0);
    SMX(c0, 8, 1);
    __builtin_amdgcn_sched_barrier(0);
    QK(4);
    __builtin_amdgcn_sched_barrier(0);
    SMX(c1, 0, 2);
    __builtin_amdgcn_sched_barrier(0);
    QK(5);
    __builtin_amdgcn_sched_barrier(0);
    SMX(c1, 8, 3);
    l_run += ps2[0] + ps2[1];
#undef SMX
#undef QK
    __builtin_amdgcn_sched_barrier(0);
#define VF(lo, hi_) __builtin_bit_cast(bf16x8, (u32x4){lo[0], lo[1], hi_[0], hi_[1]})
    o0 = __builtin_amdgcn_mfma_f32_32x32x16_bf16(VF(t00, t01), pf[0], o0, 0, 0, 0); o1 = __builtin_amdgcn_mfma_f32_32x32x16_bf16(VF(u00, u01), pf[0], o1, 0, 0, 0);
    o0 = __builtin_amdgcn_mfma_f32_32x32x16_bf16(VF(t10, t11), pf[1], o0, 0, 0, 0); o1 = __builtin_amdgcn_mfma_f32_32x32x16_bf16(VF(u10, u11), pf[1], o1, 0, 0, 0);
    o0 = __builtin_amdgcn_mfma_f32_32x32x16_bf16(VF(t20, t21), pf[2], o0, 0, 0, 0); o1 = __builtin_amdgcn_mfma_f32_32x32x16_bf16(VF(u20, u21), pf[2], o1, 0, 0, 0);
    o0 = __builtin_amdgcn_mfma_f32_32x32x16_bf16(VF(t30, t31), pf[3], o0, 0, 0, 0); o1 = __builtin_amdgcn_mfma_f32_32x32x16_bf16(VF(u30, u31), pf[3], o1, 0, 0, 0);
#undef VF
  };
  int bv = 0;
#pragma unroll 1
  for (int kt = 0; kt < ntile; kt += 2) {
    { const int b1 = bv == 2 ? 0 : bv + 1, b2 = b1 == 2 ? 0 : b1 + 1;
      __syncthreads();
      if (kt + 2 < ntile) { AT_WRITE(b2, skA0, skA1, svA); if (kt + 4 < ntile) AT_LOAD(kt + 4, skA0, skA1, svA); }
      step(sa0, sa1, sb0, sb1, bv, b1);
      bv = b1; }
    { const int b1 = bv == 2 ? 0 : bv + 1, b2 = b1 == 2 ? 0 : b1 + 1;
      __syncthreads();
      if (kt + 3 < ntile) { AT_WRITE(b2, skB0, skB1, svB); if (kt + 5 < ntile) AT_LOAD(kt + 5, skB0, skB1, svB); }
      step(sb0, sb1, sa0, sa1, bv, b1);
      bv = b1; }
  }
#undef AT_KF
#undef AT_LOAD
#undef AT_WRITE
#undef AT_ROW0
  const float inv = 1.f / xhalf_sum(l_run);
  bf16_t* op = WS(bf16_t, OFF_H) + (size_t)qrow * 1024 + 640 + head * 64;
#pragma unroll
  for (int g = 0; g < 4; ++g) {
    u32x2 w; w[0] = pack2(o0[4 * g] * inv, o0[4 * g + 1] * inv); w[1] = pack2(o0[4 * g + 2] * inv, o0[4 * g + 3] * inv); *(u32x2*)(op + 8 * g + 4 * hi) = w;
    w[0] = pack2(o1[4 * g] * inv, o1[4 * g + 1] * inv); w[1] = pack2(o1[4 * g + 2] * inv, o1[4 * g + 3] * inv); *(u32x2*)(op + 32 + 8 * g + 4 * hi) = w; }
}

DEV void mlstm_out_unit(CParams& p, int l, int chunk, int hd, unsigned char* lds) {
  const ChunkInfo c = chunk_info(chunk);
  bf16_t* Ql = (bf16_t*)lds;
  bf16_t* Kl = (bf16_t*)(lds + 9216);
  bf16_t* VTl = (bf16_t*)(lds + 18432);
  bf16_t* Cl = (bf16_t*)(lds + 18432 + 10880);
  float* sc = (float*)(lds + 18432 + 10880 + 23040);
  float* rowterm = sc; float* uarr = sc + 128; float* winter = sc + 256; float* emt = sc + 384; float* lnred = sc + 512;
  const int tid = TIDX(), lane = tid & 63, wid = tid >> 6, fr = lane & 15, fq = lane >> 4;
  __syncthreads();
  { const int t = tid >> 3, seg = tid & 7;
    *(u32x4*)(Ql + t * 72 + seg * 8) = ld8g(WS(bf16_t, OFF_MQ) + (size_t)(c.row0 + t) * 256 + hd * 64 + seg * 8);
    *(u32x4*)(Kl + t * 72 + seg * 8) = ld8g(WS(bf16_t, OFF_MK) + (size_t)(c.row0 + t) * 256 + hd * 64 + seg * 8);
    const u32x4 vv = ld8g(WS(bf16_t, OFF_MVT) + ((size_t)(chunk * 4 + hd) * 64 + t) * 64 + seg * 8);
    u32x2 a, b2; a[0] = vv[0]; a[1] = vv[1]; b2[0] = vv[2]; b2[1] = vv[3]; *(u32x2*)(VTl + t * 68 + seg * 8) = a; *(u32x2*)(VTl + t * 68 + seg * 8 + 4) = b2;
    if (tid < 64) VTl[64 * 68 + tid] = (bf16_t)0x3F80u;
    for (int i = tid; i < 15 * 68; i += NTHREADS) VTl[65 * 68 + i] = 0;
#pragma unroll
    for (int dir = 0; dir < 2; ++dir) { const int chain = dir * 32 + c.b * 4 + hd, pc = ml_pc(c, dir); const bf16_t* st = WS(bf16_t, OFF_ST) + (size_t)(chain * 36 + pc) * 5120;
      *(u32x4*)(Cl + dir * 80 * 72 + (tid >> 3) * 72 + (tid & 7) * 8) = ld8g(st + tid * 8);
      if (tid < 128) *(u32x4*)(Cl + dir * 80 * 72 + ((512 + tid) >> 3) * 72 + (tid & 7) * 8) = ld8g(st + (512 + tid) * 8); } }
  if (tid < 128) { const int dir = tid >> 6, t = dir ? 63 - lane : lane, row = c.row0 + t;
    const int chain = dir * 32 + c.b * 4 + hd, pc = ml_pc(c, dir);
    const float li = WS(float, OFF_GLI)[(size_t)(dir * 4 + hd) * NTOK + row], lf = WS(float, OFF_GLF)[(size_t)(dir * 4 + hd) * NTOK + row];
    const float ms = WS(float, OFF_SCMB)[chain * 36 + pc];
    const float bc = scan_sum64(lf, lane);
    const float uu = li - bc; const float pm = scan_max64(uu, lane);
    const float mt = fmaxf(bc + ms, bc + pm);
    rowterm[dir * 64 + t] = bc - mt; uarr[dir * 64 + t] = uu; winter[dir * 64 + t] = __expf(bc + ms - mt); emt[dir * 64 + t] = __expf(-mt); }
  __syncthreads();
  const int tt = wid & 3, eh = wid >> 2, t = tt * 16 + fr;
  bf16x8 qfr[2];
#pragma unroll
  for (int ks = 0; ks < 2; ++ks) qfr[ks] = ld_frag16(Ql + t * 72 + ks * 32 + fq * 8);
  f32x4 g[4];
#pragma unroll
  for (int st = 0; st < 4; ++st) { g[st] = (f32x4){0.f, 0.f, 0.f, 0.f};
#pragma unroll
    for (int ks = 0; ks < 2; ++ks) g[st] = __builtin_amdgcn_mfma_f32_16x16x32_bf16(ld_frag16(Kl + (st * 16 + fr) * 72 + ks * 32 + fq * 8), qfr[ks], g[st], 0, 0, 0); }
  const int et0 = eh * 2;
  float hsum[2][4];
#pragma unroll
  for (int a = 0; a < 2; ++a)
#pragma unroll
    for (int j = 0; j < 4; ++j) hsum[a][j] = 0.f;
#pragma unroll
  for (int dir = 0; dir < 2; ++dir) {
    const float rt = rowterm[dir * 64 + t], wi = winter[dir * 64 + t], em = emt[dir * 64 + t];
    bf16x8 pf[2];
#pragma unroll
    for (int kk = 0; kk < 2; ++kk) { float v[8];
#pragma unroll
      for (int hh = 0; hh < 2; ++hh)
#pragma unroll
        for (int j = 0; j < 4; ++j) { const int s = (2 * kk + hh) * 16 + fq * 4 + j; const bool valid = dir ? (s >= t) : (s <= t);
          const float e = __expf(rt + uarr[dir * 64 + s]); v[hh * 4 + j] = valid ? g[2 * kk + hh][j] * e : 0.f; }
      pf[kk] = __builtin_bit_cast(bf16x8, pack8(v)); }
    f32x4 acc[3];
#pragma unroll
    for (int a = 0; a < 3; ++a) { const int et = a < 2 ? et0 + a : 4; const bf16_t* crow = Cl + dir * 80 * 72 + (et * 16 + fr) * 72;
      f32x4 x = {0.f, 0.f, 0.f, 0.f};
#pragma unroll
      for (int ks = 0; ks < 2; ++ks) x = __builtin_amdgcn_mfma_f32_16x16x32_bf16(ld_frag16(crow + ks * 32 + fq * 8), qfr[ks], x, 0, 0, 0);
      x *= wi;
      const bf16_t* vrow = VTl + (et * 16 + fr) * 68;
#pragma unroll
      for (int kk = 0; kk < 2; ++kk) x = __builtin_amdgcn_mfma_f32_16x16x32_bf16(ld_frag8x2(vrow + 32 * kk + fq * 4, vrow + 32 * kk + 16 + fq * 4), pf[kk], x, 0, 0, 0);
      acc[a] = x; }
    const float den = bperm(fr, acc[2][0]);
    const float dinv = 1.f / fmaxf(fabsf(den), em);
#pragma unroll
    for (int a = 0; a < 2; ++a)
#pragma unroll
      for (int j = 0; j < 4; ++j) hsum[a][j] += acc[a][j] * dinv;
  }
  float s1 = 0.f, s2 = 0.f;
#pragma unroll
  for (int a = 0; a < 2; ++a)
#pragma unroll
    for (int j = 0; j < 4; ++j) { s1 += hsum[a][j]; s2 += hsum[a][j] * hsum[a][j]; }
  s1 += bperm(lane ^ 16, s1); s1 += bperm(lane ^ 32, s1); s2 += bperm(lane ^ 16, s2); s2 += bperm(lane ^ 32, s2);
  if (fq == 0) { lnred[(eh * 64 + t) * 2] = s1; lnred[(eh * 64 + t) * 2 + 1] = s2; }
  __syncthreads();
  { const float a1 = lnred[t * 2] + lnred[(64 + t) * 2], a2 = lnred[t * 2 + 1] + lnred[(64 + t) * 2 + 1];
    const float mean = a1 * (1.f / 64.f), var = fmaxf(a2 * (1.f / 64.f) - mean * mean, 0.f), rstd = rsqrtf(var + LN_EPS);
    const int row = c.row0 + t;
#pragma unroll
    for (int a = 0; a < 2; ++a) { const int e0 = (et0 + a) * 16 + fq * 4;
      const u32x2 ow = *(const u32x2*)(WS(bf16_t, OFF_MO) + (size_t)row * 256 + hd * 64 + e0);
      const float og[4] = {lo16(ow[0]), hi16(ow[0]), lo16(ow[1]), hi16(ow[1])};
      const f32x4 ng = *(const f32x4*)(p.in[I_MLNG] + l * 256 + hd * 64 + e0);
      float y[4];
#pragma unroll
      for (int j = 0; j < 4; ++j) y[j] = sigmoidf_(og[j]) * (hsum[a][j] - mean) * rstd * ng[j];
      u32x2 w; w[0] = pack2(y[0], y[1]); w[1] = pack2(y[2], y[3]);
      *(u32x2*)(WS(bf16_t, OFF_H) + (size_t)row * 1024 + hd * 64 + e0) = w; } }
}

DEV void ph_mix(CParams& p, int lx, unsigned char* lds) {
  const int l = lx & 1;
  constexpr int NRW = 96;
  const int n_att = l == 0 ? 432 : 384, n_ml = l == 0 ? 288 * 4 : 256 * 4, total = NRW + n_att + n_ml;
  unsigned* cnt = WS(unsigned, OFF_CNT) + 16 + lx; unsigned* slot = (unsigned*)(lds + LDS_BYTES - 16);
  for (;;) {
    __syncthreads();
    if (TIDX() == 0) *slot = atomicAdd(cnt, 1u);
    __syncthreads();
    const int u = (int)*slot; if (u >= total) break;
    if (u < NRW) { for (int r_ = 0; r_ < RWREP; ++r_) rwkv_chunk_unit(p, l, u, lds); }
    else if (u < NRW + n_att) { for (int r_ = 0; r_ < ATREP; ++r_) attn_unit(p, u - NRW, lds); }
    else { const int v = u - NRW - n_att; const int chunk = (l == 0 ? 0 : 32) + (v >> 2); for (int r_ = 0; r_ < MLREP; ++r_) mlstm_out_unit(p, l, chunk, v & 3, lds); }
  }
  __syncthreads();
}

DEV void ph_rwpost(CParams& p, int l) {
  const int tid = TIDX(), lane = tid & 63, gw = blockIdx.x * 8 + (tid >> 6), nw = gridDim.x * 8, sl = lane & 7;
  const int rowbase = l == 0 ? 0 : NCTXR, nitems = (NTOK - rowbase) * 6;
  for (int it0 = gw * 8; it0 < nitems; it0 += nw * 8) { const int it = it0 + (lane >> 3); const int row = rowbase + it / 6, h6 = it % 6, col = h6 * 64 + sl * 8; const size_t o = (size_t)row * 384 + col;
    const bf16_t* lo = WS(bf16_t, OFF_LORA) + (size_t)row * 1920 + col;
    const u32x4 wy0 = ld8g(WS(bf16_t, OFF_RWY) + o), wy1 = ld8g(WS(bf16_t, OFF_RWY) + (size_t)NTOK * 384 + o), wv = ld8g(WS(bf16_t, OFF_VB) + o), wg = ld8g(lo + 1536);
    const float bs = WS(float, OFF_BS)[(size_t)row * 6 + h6] + WS(float, OFF_BS)[((size_t)NTOK + row) * 6 + h6];
    float y[8], t1[8], t2[8];
    unpack8(wy0, y); unpack8(wy1, t1);
    float s = 0.f;
#pragma unroll
    for (int i = 0; i < 8; ++i) { y[i] += t1[i]; s += y[i]; }
    const float mean = grp8_sum(s) * (1.f / 64.f); float q = 0.f;
#pragma unroll
    for (int i = 0; i < 8; ++i) { y[i] -= mean; q += y[i] * y[i]; }
    const float rstd = rsqrtf(grp8_sum(q) * (1.f / 64.f) + 64e-5f);
    float v[8], g[8], o8[8]; unpack8(wv, v); unpack8(wg, g);
#pragma unroll
    for (int i = 0; i < 8; ++i) o8[i] = (y[i] * rstd * p.in[I_RWGNG][l * 384 + col + i] + p.in[I_RWGNB][l * 384 + col + i] + bs * v[i]) * g[i];
    *(u32x4*)(WS(bf16_t, OFF_H) + (size_t)row * 1024 + 256 + col) = pack8(o8); }
}

DEV void ph_gemm_in(CParams& p, int l, unsigned char* lds) {
  pg8::StaticOrder S; S.init(NTOK, NINP, gridDim.x, blockIdx.x);
  pg8::Gemm g{WS(bf16_t, OFF_H), WS(bf16_t, OFF_WIN) + (size_t)l * NINP * 1024, NTOK, NINP, 1024};
  EpiBf16 E{WS(bf16_t, OFF_P), NIN, NIN}; pg8::gemm_phase((LAS unsigned char*)lds, g, S, E);
}
DEV void gemm_out_rows(CParams& p, int l, int row0, int M, unsigned char* lds) {
  pg8::StaticOrder S; S.init(M, 1024, gridDim.x, blockIdx.x);
  pg8::Gemm g{WS(bf16_t, OFF_H) + (size_t)row0 * 1024, WS(bf16_t, OFF_WOUT) + (size_t)l * 1024 * 1024, M, 1024, 1024};
  EpiBf16 E{WS(bf16_t, OFF_Y) + (size_t)row0 * 1024, 1024, 1024}; pg8::gemm_phase((LAS unsigned char*)lds, g, S, E);
}
DEV void ph_gemm_out(CParams& p, int l, unsigned char* lds) { if (l == 0 && gridDim.x != 256) gemm_out_rows(p, 0, 0, NTOK, lds); else gemm_out_rows(p, l, NCTXR, NLAT, lds); }
DEV void ln1_rows(CParams& p, int l, int r0, int r1, unsigned char* lds);
DEV void ph_gemm_pq(CParams& p, int l, unsigned char* lds) {
  const bool split = l == 0 && gridDim.x == 256; const int rb = (l == 0 && !split) ? 0 : NCTXR, M = NTOK - rb;
  if (split) { ln1_rows(p, 0, (int)blockIdx.x * 8, (int)blockIdx.x * 8 + 8, lds); __syncthreads(); }
  pg8::StaticOrder S; S.init(M, 2048, gridDim.x, blockIdx.x);
  pg8::Gemm g{WS(bf16_t, OFF_H) + (size_t)rb * 1024, WS(bf16_t, OFF_WPQ) + (size_t)l * 2048 * 1024, M, 2048, 1024};
  EpiBf16 E{WS(bf16_t, OFF_QP) + (size_t)rb * 2048, 2048, 2048}; pg8::gemm_phase((LAS unsigned char*)lds, g, S, E);
}

DEV void stage_vec(float* dst, const float* src_) { const int tid = TIDX(); if (tid < 256) *(f32x4*)(dst + tid * 4) = *(const f32x4*)(src_ + tid * 4); }
DEV void ln1_rows(CParams& p, int l, int r0, int r1, unsigned char* lds) {
  const int tid = TIDX(), lane = tid & 63, wid = tid >> 6;
  float* pl = (float*)lds;
  for (int seg0 = r0; seg0 < r1;) { const int mr = modrow_of(seg0); int seg1 = mr == 8 ? NCTXR : NCTXR + (mr + 1) * 2048; if (seg1 > r1) seg1 = r1;
    const float* md = WS(float, OFF_MOD) + (size_t)(l * 9 + mr) * 6144;
    __syncthreads();
    if (tid < 256) { *(f32x4*)(pl + tid * 4) = *(const f32x4*)(md + 2048 + tid * 4); *(f32x4*)(pl + 1024 + tid * 4) = *(const f32x4*)(p.in[I_LNMG] + l * 1024 + tid * 4); *(f32x4*)(pl + 2048 + tid * 4) = *(const f32x4*)(p.in[I_LNMB] + l * 1024 + tid * 4); }
    else { const int t2 = tid - 256; *(f32x4*)(pl + 3072 + t2 * 4) = *(const f32x4*)(md + 4096 + t2 * 4); *(f32x4*)(pl + 4096 + t2 * 4) = *(const f32x4*)(md + 3072 + t2 * 4); }
    __syncthreads();
#pragma unroll 1
    for (int row = seg0 + wid; row < seg1; row += 8) {
      const float* xo = x_in_row(p, row); const bf16_t* xc = WS(bf16_t, OFF_XC) + (size_t)row * 1024; const bf16_t* yr = WS(bf16_t, OFF_Y) + (size_t)row * 1024;
      f32x4 v[4]; float s = 0.f;
#pragma unroll
      for (int i = 0; i < 4; ++i) { const int col = lane * 4 + 256 * i; const u32x2 yw = *(const u32x2*)(yr + col); const f32x4 yv = {lo16(yw[0]), hi16(yw[0]), lo16(yw[1]), hi16(yw[1])};
        f32x4 xv; if (l == 0) xv = *(const f32x4*)(xo + col); else { const u32x2 xw_ = *(const u32x2*)(xc + col); xv = (f32x4){lo16(xw_[0]), hi16(xw_[0]), lo16(xw_[1]), hi16(xw_[1])}; }
        v[i] = xv * ALPHA + *(const f32x4*)(pl + col) * yv; s += (v[i][0] + v[i][1]) + (v[i][2] + v[i][3]); }
      float mean = wave_sum(s) * (1.f / 1024.f), q = 0.f;
#pragma unroll
      for (int i = 0; i < 4; ++i) { v[i] -= mean; q += (v[i][0] * v[i][0] + v[i][1] * v[i][1]) + (v[i][2] * v[i][2] + v[i][3] * v[i][3]); }
      float rstd = rsqrtf(wave_sum(q) * (1.f / 1024.f) + LN_EPS);
      bf16_t* xw = WS(bf16_t, OFF_XC) + (size_t)row * 1024; s = 0.f;
#pragma unroll
      for (int i = 0; i < 4; ++i) { const int col = lane * 4 + 256 * i; v[i] = v[i] * rstd * *(const f32x4*)(pl + 1024 + col) + *(const f32x4*)(pl + 2048 + col);
        u32x2 wx; wx[0] = pack2(v[i][0], v[i][1]); wx[1] = pack2(v[i][2], v[i][3]); *(u32x2*)(xw + col) = wx;
        v[i] = (f32x4){lo16(wx[0]), hi16(wx[0]), lo16(wx[1]), hi16(wx[1])};
        s += (v[i][0] + v[i][1]) + (v[i][2] + v[i][3]); }
      mean = wave_sum(s) * (1.f / 1024.f); q = 0.f;
#pragma unroll
      for (int i = 0; i < 4; ++i) { v[i] -= mean; q += (v[i][0] * v[i][0] + v[i][1] * v[i][1]) + (v[i][2] * v[i][2] + v[i][3] * v[i][3]); }
      rstd = rsqrtf(wave_sum(q) * (1.f / 1024.f) + LN_EPS);
#pragma unroll
      for (int i = 0; i < 4; ++i) { const int col = lane * 4 + 256 * i; const f32x4 o = v[i] * rstd * (*(const f32x4*)(pl + 3072 + col) + 1.f) + *(const f32x4*)(pl + 4096 + col);
        u32x2 w; w[0] = pack2(o[0], o[1]); w[1] = pack2(o[2], o[3]); *(u32x2*)(WS(bf16_t, OFF_H) + (size_t)row * 1024 + col) = w; }
    }
    seg0 = seg1; }
  __syncthreads();
}

DEV void ph_ln1(CParams& p, int l, unsigned char* lds) {
  const int b = (int)blockIdx.x;
  if (l == 0 && gridDim.x != 256) { const int per = (NTOK + (int)gridDim.x - 1) / (int)gridDim.x, r0 = b * per; int r1 = r0 + per; if (r1 > NTOK) r1 = NTOK; if (r0 < NTOK) ln1_rows(p, 0, r0, r1, lds); }
  else if (l == 0) {
    if (b < 32) { gemm_out_rows(p, 0, 0, NCTXR, lds); __syncthreads(); }
    const int r0 = NCTXR + (b < 32 ? b * 4 : 128 + (b - 32) * 73); int r1 = r0 + (b < 32 ? 4 : 73); if (r1 > NTOK) r1 = NTOK;
    if (r0 < NTOK) ln1_rows(p, 0, r0, r1, lds);
  } else { const int per = (NLAT + (int)gridDim.x - 1) / (int)gridDim.x, r0 = NCTXR + b * per; int r1 = r0 + per; if (r1 > NTOK) r1 = NTOK; if (r0 < NTOK) ln1_rows(p, l, r0, r1, lds); }
}

DEV unsigned f2ord(float f) { const unsigned u = __float_as_uint(f); return (u >> 31) ? ~u : (u | 0x80000000u); }
DEV float ord2f(unsigned o) { return __uint_as_float((o >> 31) ? (o & 0x7fffffffu) : ~o); }
DEV unsigned dppu_max(unsigned x, unsigned y) { return x > y ? x : y; }
template <int CTRL> DEV unsigned dppu(unsigned x) { return (unsigned)__builtin_amdgcn_mov_dpp((int)x, CTRL, 0xf, 0xf, true); }
DEV void topk_unit(CParams& p, int l, int tile, int head, unsigned char* lds, const bf16x8 (&kf)[8][4]) {
  constexpr int RS = 136;
  unsigned* KEYSl = (unsigned*)lds;
  unsigned* LISTl = (unsigned*)(lds + 256 * RS * 4);
  const int tid = TIDX(), lane = tid & 63, wid = tid >> 6, fr = lane & 15, fq = lane >> 4;
  const int row0 = (l == 0 ? 0 : NCTXR) + tile * 128;
  __syncthreads();
  for (int r1_ = 0; r1_ < T1_REP; ++r1_)
  { const int g = head * 2 + (wid >> 2);
    const bf16_t* qp = WS(bf16_t, OFF_QP) + (size_t)(row0 + (wid & 3) * 32) * 2048 + g * 128 + fq * 8;
    bf16x8 af[2][4];
#pragma unroll
    for (int tm = 0; tm < 2; ++tm)
#pragma unroll
      for (int ks = 0; ks < 4; ++ks) af[tm][ks] = __builtin_bit_cast(bf16x8, ld8g(qp + (size_t)(tm * 16 + fr) * 2048 + ks * 32));
#pragma unroll
    for (int nt = 0; nt < 8; ++nt) { f32x4 a0 = {0.f, 0.f, 0.f, 0.f}, a1 = {0.f, 0.f, 0.f, 0.f};
#pragma unroll
      for (int ks = 0; ks < 4; ++ks) { a0 = __builtin_amdgcn_mfma_f32_16x16x32_bf16(kf[nt][ks], af[0][ks], a0, 0, 0, 0); a1 = __builtin_amdgcn_mfma_f32_16x16x32_bf16(kf[nt][ks], af[1][ks], a1, 0, 0, 0); }
      const int key0 = nt * 16 + fq * 4; const unsigned kb = 127u - (unsigned)key0; const int ko = key0 + (nt >= 4 ? 4 : 0);
      u32x4 w0, w1;
#pragma unroll
      for (int j = 0; j < 4; ++j) { w0[j] = (f2ord(a0[j]) & ~127u) | (kb - (unsigned)j); w1[j] = (f2ord(a1[j]) & ~127u) | (kb - (unsigned)j); }
      *(u32x4*)(KEYSl + (wid * 32 + fr) * RS + ko) = w0; *(u32x4*)(KEYSl + (wid * 32 + 16 + fr) * RS + ko) = w1; } }
  __syncthreads();
  for (int r2_ = 0; r2_ < T2_REP; ++r2_)
  { const int row = tid >> 1, hf = tid & 1; const unsigned* kr = KEYSl + row * RS + hf * 68; unsigned m[4];
#pragma unroll
    for (int sg = 0; sg < 4; ++sg) { unsigned mm = 0u;
#pragma unroll
      for (int i = 0; i < 4; ++i) { const u32x4 x = *(const u32x4*)(kr + sg * 16 + i * 4); mm = max(max(mm, x[0]), max(x[1], max(x[2], x[3]))); }
      m[sg] = mm; }
#pragma unroll 1
    for (int r = 0; r < 16; ++r) { const unsigned lb = max(max(m[0], m[1]), max(m[2], m[3])); const unsigned best = max(lb, dppu<0xB1>(lb));
      if (hf == 0) LISTl[row * 16 + r] = best;
      if (lb == best) { const int sg = ((int)(127u - (best & 127u)) >> 4) & 3; unsigned nm = 0u;
#pragma unroll
        for (int i = 0; i < 4; ++i) { const u32x4 x = *(const u32x4*)(kr + sg * 16 + i * 4);
#pragma unroll
          for (int j = 0; j < 4; ++j) nm = max(nm, x[j] < best ? x[j] : 0u); }
#pragma unroll
        for (int s2 = 0; s2 < 4; ++s2) m[s2] = (s2 == sg) ? nm : m[s2]; } } }
  __syncthreads();
  for (int r3_ = 0; r3_ < T3_REP; ++r3_)
  { const int token = tid >> 2, role = tid & 3;
    const unsigned* L1 = LISTl + token * 16; const unsigned* L2 = LISTl + (128 + token) * 16;
    unsigned ck[16];
#pragma unroll
    for (int i = 0; i < 16; ++i) { int a, b; bool valid;
      if (role == 0) { a = 0; b = i; valid = true; }
      else if (role == 1) { a = i < 8 ? 1 : 2; b = i < 8 ? i : i - 8; valid = i < 13; }
      else if (role == 2) { a = i < 4 ? 3 : i < 7 ? 4 : i < 9 ? 5 : 6; b = i - (i < 4 ? 0 : i < 7 ? 4 : i < 9 ? 7 : 9); valid = i < 11; }
      else { a = i < 2 ? 7 : 6 + i; b = i < 2 ? i : 0; valid = i < 10; }
      if (!valid) { a = 0; b = 0; }
      const float v = ord2f(L1[a] & ~127u) + ord2f(L2[b] & ~127u);
      ck[i] = valid ? ((f2ord(v) & ~255u) | (unsigned)(255 - (a * 16 + b))) : 0u; }
    unsigned rec[4]; unsigned prev = 0xffffffffu;
#pragma unroll
    for (int r = 0; r < 16; ++r) { unsigned best = 0u;
#pragma unroll
      for (int i = 0; i < 16; ++i) best = max(best, ck[i] < prev ? ck[i] : 0u);
      best = max(best, dppu<0xB1>(best)); best = max(best, dppu<0x4E>(best));
      prev = best;
      if (role == (r & 3)) rec[r >> 2] = best; }
    float bv[4]; int be[4];
#pragma unroll
    for (int j = 0; j < 4; ++j) { const int t = 255 - (int)(rec[j] & 255u); const unsigned x1 = L1[t >> 4], x2 = L2[t & 15];
      bv[j] = ord2f(x1 & ~127u) + ord2f(x2 & ~127u); be[j] = (int)(127u - (x1 & 127u)) * 128 + (int)(127u - (x2 & 127u)); }
    const float v0 = dppf<0x00>(bv[0]);
    float sum = 0.f;
#pragma unroll
    for (int j = 0; j < 4; ++j) { bv[j] = __expf(bv[j] - v0); sum += bv[j]; }
    sum += dppf<0xB1>(sum); sum += dppf<0x4E>(sum);
    const float isum = 1.f / sum;
    const int row = row0 + token;
    int* eo = WS(int, OFF_EID) + (size_t)row * 128 + head * 16; float* go = WS(float, OFF_GATE) + (size_t)row * 128 + head * 16;
#pragma unroll
    for (int j = 0; j < 4; ++j) { eo[j * 4 + role] = be[j]; go[j * 4 + role] = bv[j] * isum; }
  }
  __syncthreads();
}
DEV void topk_keys(CParams& p, int l, int head, bf16x8 (&kf)[8][4]) { const int lane = TIDX() & 63, wid = TIDX() >> 6;
  const bf16_t* kp = WS(bf16_t, OFF_KEYS) + ((size_t)(l * 16 + head * 2 + (wid >> 2)) * 128) * 128 + (lane >> 4) * 8;
#pragma unroll
  for (int nt = 0; nt < 8; ++nt)
#pragma unroll
    for (int ks = 0; ks < 4; ++ks) kf[nt][ks] = __builtin_bit_cast(bf16x8, ld8g(kp + (size_t)(nt * 16 + (lane & 15)) * 128 + ks * 32)); }
DEV void ph_topk_l0(CParams& p, unsigned char* lds) {
  const int b = (int)blockIdx.x, head = b & 7, j = b >> 3;
  bf16x8 kf[8][4];
  if (b < 64) {
    pg8::OneUnit S{true, {j, head}};
    pg8::Gemm g{WS(bf16_t, OFF_H), WS(bf16_t, OFF_WPQ), NCTXR, 2048, 1024};
    EpiBf16 E{WS(bf16_t, OFF_QP), 2048, 2048}; pg8::gemm_phase((LAS unsigned char*)lds, g, S, E);
    asm volatile("s_waitcnt vmcnt(0)" ::: "memory"); __syncthreads();
    __builtin_amdgcn_fence(__ATOMIC_ACQUIRE, "agent"); asm volatile("s_waitcnt vmcnt(0)" ::: "memory");
    topk_keys(p, 0, head, kf);
    topk_unit(p, 0, 2 * j, head, lds, kf); topk_unit(p, 0, 2 * j + 1, head, lds, kf);
    topk_unit(p, 0, 16 + j, head, lds, kf);
  } else {
    topk_keys(p, 0, head, kf);
#pragma unroll 1
    for (int i = 0; i < 5; ++i) topk_unit(p, 0, 16 + 8 + (j - 8) * 5 + i, head, lds, kf);
  }
}
DEV void ph_topk(CParams& p, int l, unsigned char* lds) {
  if (l == 0 && gridDim.x == 256) { ph_topk_l0(p, lds); return; }
  const int ntile = (l == 0 ? NTOK : NLAT) / 128;
  bf16x8 kf[8][4]; int curh = -1; const int lane = TIDX() & 63, wid = TIDX() >> 6;
  for (int u = blockIdx.x; u < ntile * 8; u += gridDim.x) { const int head = u & 7;
    if (head != curh) { curh = head;
      const bf16_t* kp = WS(bf16_t, OFF_KEYS) + ((size_t)(l * 16 + head * 2 + (wid >> 2)) * 128) * 128 + (lane >> 4) * 8;
#pragma unroll
      for (int nt = 0; nt < 8; ++nt)
#pragma unroll
        for (int ks = 0; ks < 4; ++ks) kf[nt][ks] = __builtin_bit_cast(bf16x8, ld8g(kp + (size_t)(nt * 16 + (lane & 15)) * 128 + ks * 32)); }
    topk_unit(p, l, u >> 3, head, lds, kf); }
}

DEV float gelu_tanh(float x) { const float z = 0.7978845608f * (x + 0.044715f * x * x * x); const float t = 1.f - 2.f * __builtin_amdgcn_rcpf(1.f + __expf(2.f * z)); return 0.5f * x * (1.f + t); }
DEV void fp8x16_to_f32(u32x4 w, float* f) {
#pragma unroll
  for (int i = 0; i < 4; ++i) { const f32x2 a = __builtin_amdgcn_cvt_pk_f32_fp8((int)w[i], false), b = __builtin_amdgcn_cvt_pk_f32_fp8((int)w[i], true); f[4 * i] = a[0]; f[4 * i + 1] = a[1]; f[4 * i + 2] = b[0]; f[4 * i + 3] = b[1]; } }
DEV void fp4x32_to_f32(u32x4 w, float* f) {
#pragma unroll
  for (int i = 0; i < 4; ++i) {
    const f32x2 a = __builtin_amdgcn_cvt_scalef32_pk_f32_fp4(w[i], 1.0f, 0), b = __builtin_amdgcn_cvt_scalef32_pk_f32_fp4(w[i], 1.0f, 1), c = __builtin_amdgcn_cvt_scalef32_pk_f32_fp4(w[i], 1.0f, 2), d = __builtin_amdgcn_cvt_scalef32_pk_f32_fp4(w[i], 1.0f, 3);
    f[8 * i] = a[0]; f[8 * i + 1] = a[1]; f[8 * i + 2] = b[0]; f[8 * i + 3] = b[1]; f[8 * i + 4] = c[0]; f[8 * i + 5] = c[1]; f[8 * i + 6] = d[0]; f[8 * i + 7] = d[1]; } }
DEV void ph_gather(CParams& p, int l, unsigned char* lds) {
  const int tid = TIDX(), lane = tid & 63, wid = tid >> 6, dl = lane & 7, g = lane >> 3;
  const int rb = l == 0 ? 0 : NCTXR, ntok = NTOK - rb;
  const int per = (ntok + (int)gridDim.x - 1) / (int)gridDim.x, tb0 = (int)blockIdx.x * per;
  int* eidl = (int*)lds; float* gatel = (float*)(lds + 36864); float* dotl = (float*)(lds + 73728);
  const unsigned char* TU = WS(unsigned char, OFF_TABU); const unsigned char* TV = WS(unsigned char, OFF_TABV);
  bf16_t* Yb = WS(bf16_t, OFF_Y);
  float* pvec = (float*)(lds + 110592); int mr0;
  { const int ra = rb + tb0, rz = rb + (tb0 + per < ntok ? tb0 + per : ntok) - 1; mr0 = modrow_of(ra < NTOK ? ra : NTOK - 1); const int mr1 = modrow_of(rz < ra ? (ra < NTOK ? ra : NTOK - 1) : rz);
    __syncthreads();
    for (int i = tid; i < 2 * 5 * 256; i += NTHREADS) { const int set = i / 1280, r5 = (i - set * 1280) >> 8, c4 = (i & 255) * 4; const int mr = set ? mr1 : mr0;
      const float* s_ = r5 == 0 ? WS(float, OFF_MOD) + (size_t)(l * 9 + mr) * 6144 + 5120 : r5 == 1 ? p.in[I_LNFG] + l * 1024 : r5 == 2 ? p.in[I_LNFB] + l * 1024 : WS(float, OFF_MOD) + (size_t)(9 + mr) * 6144 + (r5 - 3) * 1024;
      *(f32x4*)(pvec + set * 5120 + r5 * 1024 + c4) = *(const f32x4*)(s_ + c4); }
    __syncthreads(); }
  for (int base = tb0; base < tb0 + per && base < ntok; base += 72) {
    int n = tb0 + per - base; if (n > 72) n = 72; if (n > ntok - base) n = ntok - base;
    const int row0 = rb + base;
    for (int grep_ = 0; grep_ < GREP; ++grep_) {
    __builtin_amdgcn_wave_barrier();
    for (int tk = wid; tk < n; tk += 8) { const size_t o = (size_t)(row0 + tk) * 128;
      eidl[tk * 128 + lane] = WS(int, OFF_EID)[o + lane]; eidl[tk * 128 + 64 + lane] = WS(int, OFF_EID)[o + 64 + lane];
      gatel[tk * 128 + lane] = WS(float, OFF_GATE)[o + lane]; gatel[tk * 128 + 64 + lane] = WS(float, OFF_GATE)[o + 64 + lane];
      dotl[tk * 128 + lane] = 0.f; dotl[tk * 128 + 64 + lane] = 0.f; }
    asm volatile("s_waitcnt lgkmcnt(0)" ::: "memory"); __builtin_amdgcn_wave_barrier();
#pragma unroll 1
    for (int s = 0; s < 4; ++s) {
#pragma unroll 1
      for (int tk = wid; tk < n; tk += 8) {
        float hx[32]; { const bf16_t* hp = WS(bf16_t, OFF_H) + (size_t)(row0 + tk) * 1024 + s * 256 + dl * 32; unpack8(ld8g(hp), hx); unpack8(ld8g(hp + 8), hx + 8); unpack8(ld8g(hp + 16), hx + 16); unpack8(ld8g(hp + 24), hx + 24); }
        const unsigned char* tus = TU + (size_t)s * 16384 * 128 + dl * 16; const int* el = eidl + tk * 128 + g; float* dp = dotl + tk * 128 + g;
        u32x4 wq[16];
#pragma unroll
        for (int ps = 0; ps < 16; ++ps) wq[ps] = *(const u32x4*)(tus + (size_t)el[ps * 8] * 128);
#pragma unroll
        for (int ps = 0; ps < 16; ++ps) { const u32x4 w = wq[ps]; f32x2 dd = {0.f, 0.f};
#pragma unroll
          for (int i = 0; i < 4; ++i) {
            dd += __builtin_amdgcn_cvt_scalef32_pk_f32_fp4(w[i], 1.0f, 0) * (f32x2){hx[8 * i], hx[8 * i + 1]}; dd += __builtin_amdgcn_cvt_scalef32_pk_f32_fp4(w[i], 1.0f, 1) * (f32x2){hx[8 * i + 2], hx[8 * i + 3]};
            dd += __builtin_amdgcn_cvt_scalef32_pk_f32_fp4(w[i], 1.0f, 2) * (f32x2){hx[8 * i + 4], hx[8 * i + 5]}; dd += __builtin_amdgcn_cvt_scalef32_pk_f32_fp4(w[i], 1.0f, 3) * (f32x2){hx[8 * i + 6], hx[8 * i + 7]}; }
          const float d = grp8_sum(dd[0] + dd[1]);
          if (dl == 0) dp[ps * 8] += d; } } }
    asm volatile("s_waitcnt lgkmcnt(0)" ::: "memory"); __builtin_amdgcn_wave_barrier();
    for (int tk = wid; tk < n; tk += 8) {
#pragma unroll
      for (int hh = 0; hh < 2; ++hh) { const int i = tk * 128 + hh * 64 + lane; dotl[i] = gatel[i] * gelu_tanh(dotl[i] * (1.f / 64.f)); } }
    asm volatile("s_waitcnt lgkmcnt(0)" ::: "memory"); __builtin_amdgcn_wave_barrier();
#pragma unroll 1
    for (int s = 0; s < 4; ++s) {
#pragma unroll 1
      for (int tk = wid; tk < n; tk += 8) {
        const unsigned char* tvs = TV + (size_t)s * 16384 * 128 + dl * 16; const int* el = eidl + tk * 128 + g; const float* cp = dotl + tk * 128 + g;
        f32x2 ac2[16];
#pragma unroll
        for (int j = 0; j < 16; ++j) ac2[j] = (f32x2){0.f, 0.f};
        u32x4 wq[16];
#pragma unroll
        for (int ps = 0; ps < 16; ++ps) wq[ps] = *(const u32x4*)(tvs + (size_t)el[ps * 8] * 128);
#pragma unroll
        for (int ps = 0; ps < 16; ++ps) { const u32x4 w = wq[ps]; const float cc = cp[ps * 8]; const f32x2 c2 = {cc, cc};
#pragma unroll
          for (int i = 0; i < 4; ++i) { ac2[4 * i] += c2 * __builtin_amdgcn_cvt_scalef32_pk_f32_fp4(w[i], 1.0f, 0); ac2[4 * i + 1] += c2 * __builtin_amdgcn_cvt_scalef32_pk_f32_fp4(w[i], 1.0f, 1);
            ac2[4 * i + 2] += c2 * __builtin_amdgcn_cvt_scalef32_pk_f32_fp4(w[i], 1.0f, 2); ac2[4 * i + 3] += c2 * __builtin_amdgcn_cvt_scalef32_pk_f32_fp4(w[i], 1.0f, 3); } }
        float acc[32];
#pragma unroll
        for (int j = 0; j < 16; ++j) { acc[2 * j] = ac2[j][0]; acc[2 * j + 1] = ac2[j][1]; }
        float r16[16], r8[8];
#pragma unroll
        for (int j = 0; j < 16; ++j) { auto rr = __builtin_amdgcn_permlane32_swap(__float_as_uint(acc[j]), __float_as_uint(acc[j + 16]), false, false); r16[j] = __uint_as_float(rr[0]) + __uint_as_float(rr[1]); }
#pragma unroll
        for (int j = 0; j < 8; ++j) { auto rr = __builtin_amdgcn_permlane16_swap(__float_as_uint(r16[j]), __float_as_uint(r16[j + 8]), false, false); r8[j] = __uint_as_float(rr[0]) + __uint_as_float(rr[1]); }
        const bool b3 = (lane & 8) != 0; f32x4 o;
#pragma unroll
        for (int j = 0; j < 4; ++j) { const float x = r8[j] + dppf<0x128>(r8[j]), y = r8[j + 4] + dppf<0x128>(r8[j + 4]); o[j] = (b3 ? y : x) * 0.25f; }
        u32x2 ow; ow[0] = pack2(o[0], o[1]); ow[1] = pack2(o[2], o[3]);
        *(u32x2*)(Yb + (size_t)(row0 + tk) * 1024 + s * 256 + dl * 32 + ((lane >> 5) & 1) * 16 + ((lane >> 4) & 1) * 8 + (b3 ? 4 : 0)) = ow; } }
    }
    asm volatile("s_waitcnt vmcnt(0)" ::: "memory"); __builtin_amdgcn_fence(__ATOMIC_ACQUIRE, "agent"); asm volatile("s_waitcnt vmcnt(0)" ::: "memory");
#pragma unroll 1
    for (int tk = wid; tk < n; tk += 8) { const int row = row0 + tk;
      bf16_t* xw = WS(bf16_t, OFF_XC) + (size_t)row * 1024; const bf16_t* yr = Yb + (size_t)row * 1024;
      const float* pl = pvec + (modrow_of(row) == mr0 ? 0 : 5120);
      f32x4 v[4]; float sm = 0.f;
#pragma unroll
      for (int i = 0; i < 4; ++i) { const int col = lane * 4 + 256 * i; const u32x2 yw = *(const u32x2*)(yr + col), xq = *(const u32x2*)(xw + col);
        const f32x4 xo = {lo16(xq[0]), hi16(xq[0]), lo16(xq[1]), hi16(xq[1])}, ya = {lo16(yw[0]), hi16(yw[0]), lo16(yw[1]), hi16(yw[1])};
        v[i] = xo * ALPHA + *(const f32x4*)(pl + col) * ya; sm += (v[i][0] + v[i][1]) + (v[i][2] + v[i][3]); }
      float mean = wave_sum(sm) * (1.f / 1024.f), q = 0.f;
#pragma unroll
      for (int i = 0; i < 4; ++i) { v[i] -= mean; q += (v[i][0] * v[i][0] + v[i][1] * v[i][1]) + (v[i][2] * v[i][2] + v[i][3] * v[i][3]); }
      float rstd = rsqrtf(wave_sum(q) * (1.f / 1024.f) + LN_EPS);
      sm = 0.f;
#pragma unroll
      for (int i = 0; i < 4; ++i) { const int col = lane * 4 + 256 * i; const f32x4 o = v[i] * rstd * *(const f32x4*)(pl + 1024 + col) + *(const f32x4*)(pl + 2048 + col);
        v[i] = o; sm += (o[0] + o[1]) + (o[2] + o[3]);
        if (l == 0) { u32x2 wx; wx[0] = pack2(o[0], o[1]); wx[1] = pack2(o[2], o[3]); *(u32x2*)(xw + col) = wx; }
        else if (row >= NCTXR) *(f32x4*)(p.out + (size_t)(row - NCTXR) * DM + col) = o; }
      if (l == 0) {
        mean = wave_sum(sm) * (1.f / 1024.f); q = 0.f;
#pragma unroll
        for (int i = 0; i < 4; ++i) { v[i] -= mean; q += (v[i][0] * v[i][0] + v[i][1] * v[i][1]) + (v[i][2] * v[i][2] + v[i][3] * v[i][3]); }
        rstd = rsqrtf(wave_sum(q) * (1.f / 1024.f) + LN_EPS);
#pragma unroll
        for (int i = 0; i < 4; ++i) { const int col = lane * 4 + 256 * i; const f32x4 o = v[i] * rstd * (*(const f32x4*)(pl + 4096 + col) + 1.f) + *(const f32x4*)(pl + 3072 + col);
          u32x2 w; w[0] = pack2(o[0], o[1]); w[1] = pack2(o[2], o[3]); *(u32x2*)(WS(bf16_t, OFF_H) + (size_t)row * 1024 + col) = w; }
      } }
  }
}

#if !MULTI_LAUNCH
__global__ __launch_bounds__(NTHREADS, 2) void mega(Params p_, int lo, int hi, int coop) {
  extern __shared__ __attribute__((aligned(16))) unsigned char shm[];
  volatile LAS unsigned* bst = (volatile LAS unsigned*)(LAS unsigned char*)(shm + LDS_BYTES - 32);
  if (TIDX() == 0) { bst[0] = 0u; bst[1] = 0u; }
  __syncthreads();
  { CParams* kp0 = (CParams*)__builtin_amdgcn_kernarg_segment_ptr(); xcd_barrier_post((unsigned*)(kp0->ws + OFF_BAR)); }
  for (int step = lo; step < hi; ++step) {
    CParams* kp = (CParams*)__builtin_amdgcn_kernarg_segment_ptr(); asm volatile("" : "+s"(kp)); CParams& p = *kp;
    if (step == 0) { ph_init(p, shm); if (REPSET == 25) { __syncthreads(); ph_init(p, shm); } }
    else { const int l = (step - 1) / 11, k = (step - 1) % 11;
      for (int rep = 0; rep < REPS[k]; ++rep) { if (rep > 0 && coop) xcd_barrier(WS(unsigned, OFF_BAR), bst);
      switch (k) {
        case 0: if (l == 0) ph_lnmod(p, 0); break;
        case 1: ph_gemm_in(p, l, shm); break;
        case 2: ph_prep(p, l, shm); break;
        case 3: ph_mid(p, l + 2 * rep, shm); break;
        case 4: ph_mix(p, l + 2 * rep, shm); break;
        case 5: ph_rwpost(p, l); break;
        case 6: ph_gemm_out(p, l, shm); break;
        case 7: ph_ln1(p, l, shm); break;
        case 8: ph_gemm_pq(p, l, shm); break;
        case 9: ph_topk(p, l, shm); break;
        case 10: ph_gather(p, l, shm); break;
      } } }
    if (coop && step + 1 < hi) { if (lo < 0) cg::this_grid().sync(); else xcd_barrier(WS(unsigned, OFF_BAR), bst); }
    if (coop && step == 5) for (int xb_ = 0; xb_ < XBAR; ++xb_) xcd_barrier(WS(unsigned, OFF_BAR), bst);
  }
}
#endif

#if MULTI_LAUNCH
template <int K> __global__ __launch_bounds__(NTHREADS, 2) void phase_k(Params p_, int l) {
  extern __shared__ __attribute__((aligned(16))) unsigned char shm[];
  CParams& p = *(CParams*)__builtin_amdgcn_kernarg_segment_ptr();
  if constexpr (K == -1) ph_init(p, shm);
  if constexpr (K == 0) ph_lnmod(p, 0);
  if constexpr (K == 1) ph_gemm_in(p, l, shm);
  if constexpr (K == 2) ph_prep(p, l, shm);
  if constexpr (K == 3) ph_mid(p, l, shm);
  if constexpr (K == 4) ph_mix(p, l, shm);
  if constexpr (K == 5) ph_rwpost(p, l);
  if constexpr (K == 6) ph_gemm_out(p, l, shm);
  if constexpr (K == 7) ph_ln1(p, l, shm);
  if constexpr (K == 8) ph_gemm_pq(p, l, shm);
  if constexpr (K == 9) ph_topk(p, l, shm);
  if constexpr (K == 10) ph_gather(p, l, shm);
  if constexpr (K >= 30) ph_mid_t<K - 30>(p, l, shm);
}
template __global__ void phase_k<-1>(Params, int); template __global__ void phase_k<0>(Params, int); template __global__ void phase_k<1>(Params, int);
template __global__ void phase_k<2>(Params, int); template __global__ void phase_k<4>(Params, int);
template __global__ void phase_k<5>(Params, int); template __global__ void phase_k<6>(Params, int); template __global__ void phase_k<7>(Params, int);
template __global__ void phase_k<8>(Params, int); template __global__ void phase_k<31>(Params, int); template __global__ void phase_k<32>(Params, int); template __global__ void phase_k<34>(Params, int); template __global__ void phase_k<38>(Params, int); template __global__ void phase_k<9>(Params, int); template __global__ void phase_k<10>(Params, int);

#endif

extern "C" void kernel_launch(void* const* d_in, const int* in_sizes, int n_in, void* d_out, int out_size, void* d_ws, size_t ws_size, hipStream_t stream) {
  if (n_in < N_INPUTS || ws_size < WS_NEEDED) return;
  Params p{};
  for (int i = 0; i < N_INPUTS; ++i) p.in[i] = (const float*)d_in[i];
  p.out = (float*)d_out; p.ws = (unsigned char*)d_ws;
  static int grid = 0;
  if (!grid) {
    int dev = 0, cus = 0; (void)hipGetDevice(&dev); (void)hipDeviceGetAttribute(&cus, hipDeviceAttributeMultiprocessorCount, dev);
    grid = cus > 0 ? (cus > 256 ? 256 : cus) : 256;
#if !MULTI_LAUNCH
    (void)hipFuncSetAttribute((const void*)mega, hipFuncAttributeMaxDynamicSharedMemorySize, (int)LDS_BYTES);
    int per = 0; (void)hipOccupancyMaxActiveBlocksPerMultiprocessor(&per, mega, NTHREADS, LDS_BYTES);
    if (per < 1) grid = 0;
#endif
  }
  const int nsteps = 23;
#if MULTI_LAUNCH
#define LAUNCH_K(K, L) do { (void)hipFuncSetAttribute((const void*)phase_k<K>, hipFuncAttributeMaxDynamicSharedMemorySize, (int)LDS_BYTES); \
    hipLaunchKernelGGL(phase_k<K>, dim3(grid), dim3(NTHREADS), LDS_BYTES, stream, p, L); } while (0)
  (void)nsteps;
  LAUNCH_K(-1, 0);
  for (int l = 0; l < 2; ++l) {
    if (l == 0) LAUNCH_K(0, 0);
    LAUNCH_K(1, l); LAUNCH_K(2, l); LAUNCH_K(31, l); LAUNCH_K(32, l); LAUNCH_K(34, l); LAUNCH_K(38, l);
    LAUNCH_K(4, l); LAUNCH_K(5, l); LAUNCH_K(6, l); LAUNCH_K(7, l); LAUNCH_K(8, l); LAUNCH_K(9, l); LAUNCH_K(10, l);
  }
#else
  if (grid <= 0) return;
  (void)hipMemsetAsync((unsigned char*)d_ws + OFF_CNT, 0, SZ_CNT, stream);
  int lo = 0, hi = nsteps, coop = 1; void* args[] = {&p, &lo, &hi, &coop};
  (void)hipLaunchCooperativeKernel((const void*)mega, dim3(grid), dim3(NTHREADS), args, LDS_BYTES, stream);
#endif
}
```

```cpp
#include <hip/hip_runtime.h>
#include <hip/hip_cooperative_groups.h>
namespace cg = cooperative_groups;

#ifndef MULTI_LAUNCH
#define MULTI_LAUNCH 0
#endif

#ifndef REPSET
#define REPSET 0
#endif
#define DEV __device__ __forceinline__
#define LAS __attribute__((address_space(3)))
typedef unsigned short bf16_t;
typedef short bf16x8 __attribute__((ext_vector_type(8)));
typedef float f32x4 __attribute__((ext_vector_type(4)));
typedef float f32x2 __attribute__((ext_vector_type(2)));
typedef float f32x16 __attribute__((ext_vector_type(16)));
typedef unsigned u32x4 __attribute__((ext_vector_type(4)));
typedef unsigned u32x2 __attribute__((ext_vector_type(2)));

constexpr int NTOK = 18432, NCTXR = 2048, NLAT = 16384, DM = 1024;
constexpr int NIN = 3248, NINP = 3328;
constexpr float ALPHA = 1.41421356237f;
constexpr float LN_EPS = 1e-6f;
constexpr int NTHREADS = 512;
constexpr size_t LDS_BYTES = 160 * 1024;
#if REPSET == 5
__device__ constexpr int REPS[11] = {1, 1, 2, 1, 1, 1, 1, 1, 1, 1, 1};
#elif REPSET == 6
__device__ constexpr int REPS[11] = {1, 1, 1, 1, 1, 1, 1, 1, 1, 2, 1};
#elif REPSET == 7
__device__ constexpr int REPS[11] = {2, 1, 1, 1, 1, 2, 1, 1, 1, 1, 1};
#elif REPSET == 13
__device__ constexpr int REPS[11] = {1, 2, 1, 1, 1, 1, 1, 1, 1, 1, 1};
#elif REPSET == 14
__device__ constexpr int REPS[11] = {1, 1, 1, 1, 1, 1, 2, 1, 2, 1, 1};
#else
__device__ constexpr int REPS[11] = {1, 1, 1, 1, 1, 1, 1, 1, 1, 1, 1};
#endif
constexpr bool FP4_EMU = REPSET == 30;
constexpr int PM_REP = REPSET == 20 ? 2 : 1, PF_REP = REPSET == 21 ? 2 : 1, T1_REP = REPSET == 22 ? 2 : 1, T2_REP = REPSET == 23 ? 2 : 1, T3_REP = REPSET == 24 ? 2 : 1;
constexpr unsigned CONV_MID0 = (96u * 4u * 36u) / 8u;
constexpr int GREP = REPSET == 8 ? 2 : 1, XBAR = REPSET == 9 ? 20 : 0, RWREP = REPSET == 10 ? 2 : 1, ATREP = REPSET == 11 ? 2 : 1, MLREP = REPSET == 12 ? 2 : 1;

enum { I_X = 0, I_C, I_CTX, I_CCTX, I_WMOD, I_BMOD, I_WIN, I_MLCW, I_MLCB, I_MLIB, I_MLFB, I_MLNG, I_RWMU, I_RWW0, I_RWWUP, I_RWA0, I_RWAUP,
       I_RWGUP, I_RWKK, I_RWKA, I_RWRK, I_RWGNG, I_RWGNB, I_QNG, I_QUP, I_KVNG, I_KVUP, I_WOUT, I_LNMG, I_LNMB, I_PWQ, I_PKEYS, I_PU, I_PV, I_LNFG, I_LNFB, N_INPUTS };

constexpr size_t A256(size_t x) { return (x + 255) & ~size_t(255); }
constexpr size_t SZ_WIN = 2ull * NINP * 1024 * 2, SZ_WOUT = 2ull * 1024 * 1024 * 2, SZ_WPQ = 2ull * 2048 * 1024 * 2, SZ_WLORA = 2ull * 2048 * 384 * 2,
                 SZ_WQUP = 2ull * 768 * 384 * 2, SZ_WKVUP = 2ull * 768 * 256 * 2, SZ_KEYS = 2ull * 16 * 128 * 128 * 2, SZ_MOD = 2ull * 9 * 6144 * 4, SZ_CNT = 4096 + 16384  ;
constexpr size_t OFF_WIN = 0, OFF_WOUT = OFF_WIN + SZ_WIN, OFF_WPQ = OFF_WOUT + SZ_WOUT, OFF_WLORA = OFF_WPQ + SZ_WPQ, OFF_WQUP = OFF_WLORA + SZ_WLORA,
                 OFF_WKVUP = OFF_WQUP + SZ_WQUP, OFF_KEYS = OFF_WKVUP + SZ_WKVUP, OFF_MOD = OFF_KEYS + SZ_KEYS, OFF_CNT = OFF_MOD + SZ_MOD;
constexpr size_t OFF_CTXX = A256(OFF_CNT + SZ_CNT);
constexpr size_t OFF_H = OFF_CTXX + 2048ull * 1024 * 4;
constexpr size_t OFF_P = OFF_H + (size_t)NTOK * 1024 * 2;
constexpr size_t SZ_P = (size_t)NTOK * NIN * 2;
constexpr size_t OFF_TABU = OFF_P, OFF_TABV = OFF_TABU + 16384ull * 1024, OFF_RWY = OFF_TABV + 16384ull * 1024;
constexpr size_t OFF_BAR = OFF_CNT + 4096;
static_assert(OFF_RWY + 2ull * NTOK * 384 * 2 <= OFF_P + SZ_P, "P region overflow");
constexpr size_t OFF_BS = OFF_P + 96ull * 1024 * 1024;
static_assert(OFF_BS >= OFF_RWY + 2ull * NTOK * 384 * 2 && OFF_BS + 2ull * NTOK * 6 * 4 <= OFF_P + SZ_P, "BS placement");
constexpr size_t SZ_R1 = (size_t)NTOK * 384 * 2;
constexpr size_t OFF_R = OFF_P + SZ_P;
constexpr size_t OFF_RB = OFF_R, OFF_KB = OFF_RB + SZ_R1, OFF_KH = OFF_KB + SZ_R1, OFF_VB = OFF_KH + SZ_R1, OFF_LORA = OFF_VB + SZ_R1  ,
                 OFF_ZB = OFF_LORA + 5 * SZ_R1;
constexpr size_t SZ_R = 10 * SZ_R1;
constexpr size_t OFF_Y = OFF_R, OFF_QP = OFF_R;
static_assert((size_t)NTOK * 1024 * 4 <= SZ_R && (size_t)NTOK * 2048 * 2 <= SZ_R, "R region overflow");
constexpr size_t OFF_A = OFF_R + SZ_R;
constexpr size_t OFF_CQN = OFF_A, OFF_CKVN = OFF_CQN + (size_t)NTOK * 384 * 2, OFF_QB = OFF_CKVN + (size_t)NTOK * 256 * 2,
                 OFF_KV = OFF_QB + (size_t)NTOK * 576 * 2  , OFF_KR = OFF_KV + (size_t)NTOK * 768 * 2  ,
                 OFF_AEND = OFF_KR + (size_t)NTOK * 32 * 2;
constexpr size_t OFF_EID = OFF_A, OFF_GATE = OFF_EID + (size_t)NTOK * 128 * 4;
static_assert(OFF_GATE + (size_t)NTOK * 128 * 4 <= OFF_QB, "EID/GATE overflow");
constexpr size_t OFF_M = OFF_AEND;
constexpr size_t SZ_M1 = (size_t)NTOK * 256 * 2;
constexpr size_t OFF_MQ = OFF_M, OFF_MK = OFF_MQ + SZ_M1, OFF_MVT = OFF_MK + SZ_M1, OFF_MO = OFF_MVT + SZ_M1, OFF_GLI = OFF_MO + SZ_M1,
                 OFF_GLF = OFF_GLI + 8ull * NTOK * 4, OFF_ST = OFF_GLF + 8ull * NTOK * 4, OFF_SCM = OFF_ST + 2304ull * 5120 * 2,
                 OFF_SCB = OFF_SCM + 2304 * 4, OFF_SCMB = OFF_SCB + 2304 * 4, OFF_END = A256(OFF_SCMB + 2304 * 4);
constexpr size_t OFF_XC = OFF_END;
constexpr size_t WS_NEEDED = OFF_XC + (size_t)NTOK * 1024 * 2;
static_assert(WS_NEEDED <= 512ull * 1024 * 1024, "workspace budget");

struct Params {
  const float* in[N_INPUTS];
  float* out;
  unsigned char* ws;
};
typedef const __attribute__((address_space(4))) Params CParams;

DEV int TIDX() { int t = (int)__builtin_amdgcn_workitem_id_x(); asm volatile("" : "+v"(t)); return t; }
DEV float bf2f(bf16_t b) { return __uint_as_float(((unsigned)b) << 16); }
DEV bf16_t f2bf(float f) { unsigned u = __float_as_uint(f); u += 0x7FFFu + ((u >> 16) & 1u); return (bf16_t)(u >> 16); }
typedef __bf16 bf16v2_t __attribute__((ext_vector_type(2)));
DEV unsigned pack2(float lo, float hi) { return __builtin_bit_cast(unsigned, __builtin_convertvector((f32x2){lo, hi}, bf16v2_t)); }
DEV float lo16(unsigned w) { return __uint_as_float(w << 16); }
DEV float hi16(unsigned w) { return __uint_as_float(w & 0xffff0000u); }
DEV void unpack8(u32x4 w, float* f) { f[0] = lo16(w[0]); f[1] = hi16(w[0]); f[2] = lo16(w[1]); f[3] = hi16(w[1]); f[4] = lo16(w[2]); f[5] = hi16(w[2]); f[6] = lo16(w[3]); f[7] = hi16(w[3]); }
DEV u32x4 pack8(const float* f) { u32x4 w; w[0] = pack2(f[0], f[1]); w[1] = pack2(f[2], f[3]); w[2] = pack2(f[4], f[5]); w[3] = pack2(f[6], f[7]); return w; }
DEV float sigmoidf_(float x) { return __builtin_amdgcn_rcpf(1.0f + __expf(-x)); }
DEV float siluf_(float x) { return x * __builtin_amdgcn_rcpf(1.0f + __expf(-x)); }
template <int CTRL> DEV float dppf(float x) { return __builtin_bit_cast(float, __builtin_amdgcn_mov_dpp(__builtin_bit_cast(int, x), CTRL, 0xf, 0xf, true)); }
template <int CTRL> DEV float dpp_upd(float old, float x) { return __builtin_bit_cast(float, __builtin_amdgcn_update_dpp(__builtin_bit_cast(int, old), __builtin_bit_cast(int, x), CTRL, 0xf, 0xf, false)); }
DEV float rdlane(float v, int l) { return __builtin_bit_cast(float, __builtin_amdgcn_readlane(__builtin_bit_cast(int, v), l)); }
DEV float bperm(int srclane, float v) { return __builtin_bit_cast(float, __builtin_amdgcn_ds_bpermute(srclane << 2, __builtin_bit_cast(int, v))); }
DEV float row16_max(float x) { x = fmaxf(x, dppf<0x128>(x)); x = fmaxf(x, dppf<0x124>(x)); x = fmaxf(x, dppf<0x122>(x)); x = fmaxf(x, dppf<0x121>(x)); return x; }
DEV float grp8_sum(float x) { x += dppf<0xB1>(x); x += dppf<0x4E>(x); x += dppf<0x141>(x); return x; }
DEV float scan_sum64(float x, int lane) {
  x += dpp_upd<0x111>(0.f, x); x += dpp_upd<0x112>(0.f, x); x += dpp_upd<0x114>(0.f, x); x += dpp_upd<0x118>(0.f, x);
  const float t0 = rdlane(x, 15), t1 = rdlane(x, 31), t2 = rdlane(x, 47); const int r = lane >> 4;
  return x + (r == 0 ? 0.f : r == 1 ? t0 : r == 2 ? t0 + t1 : t0 + t1 + t2); }
DEV float scan_max64(float x, int lane) {
  const float NI = -3.0e38f;
  x = fmaxf(x, dpp_upd<0x111>(NI, x)); x = fmaxf(x, dpp_upd<0x112>(NI, x)); x = fmaxf(x, dpp_upd<0x114>(NI, x)); x = fmaxf(x, dpp_upd<0x118>(NI, x));
  const float t0 = rdlane(x, 15), t1 = rdlane(x, 31), t2 = rdlane(x, 47); const int r = lane >> 4;
  return fmaxf(x, r == 0 ? NI : r == 1 ? t0 : r == 2 ? fmaxf(t0, t1) : fmaxf(fmaxf(t0, t1), t2)); }
DEV float row16_sum(float x) { x += dppf<0x128>(x); x += dppf<0x124>(x); x += dppf<0x122>(x); x += dppf<0x121>(x); return x; }
DEV float wave_sum(float v) { v = row16_sum(v); return (rdlane(v, 0) + rdlane(v, 16)) + (rdlane(v, 32) + rdlane(v, 48)); }
DEV float wave_max(float v) { v = row16_max(v); return fmaxf(fmaxf(rdlane(v, 0), rdlane(v, 16)), fmaxf(rdlane(v, 32), rdlane(v, 48))); }
DEV float xhalf_sum(float x) { auto rr = __builtin_amdgcn_permlane32_swap(__float_as_uint(x), __float_as_uint(x), false, false); return __uint_as_float(rr[0]) + __uint_as_float(rr[1]); }
DEV float xhalf_max(float x) { auto rr = __builtin_amdgcn_permlane32_swap(__float_as_uint(x), __float_as_uint(x), false, false); return fmaxf(__uint_as_float(rr[0]), __uint_as_float(rr[1])); }

DEV int modrow_of(int row) { return row < NCTXR ? 8 : ((row - NCTXR) >> 11); }

#define XB_TMO      128
#define XB_XCNT(j)  (256  + 64 * (j))
#define XB_XSUB(j)  (1280 + 64 * (j))
#define XB_XGEN(j)  (2304 + 64 * (j))
#define XB_TOP      3328
#define XB_TOPGEN   3392
#define XCD_BAR_WORDS 3456
#define XB_SPIN_CAP (1u << 20)
DEV unsigned xb_ld(unsigned* p) { return __hip_atomic_load(p, __ATOMIC_RELAXED, __HIP_MEMORY_SCOPE_AGENT); }
DEV unsigned xb_add(unsigned* p, unsigned v) { return __hip_atomic_fetch_add(p, v, __ATOMIC_RELAXED, __HIP_MEMORY_SCOPE_AGENT); }
DEV unsigned xb_xcc_id() { return (unsigned)__builtin_amdgcn_s_getreg((3 << 11) | 20) & 0xFu; }
#define XB_SPIN(cond, bar) do { unsigned _sp = 0; while (cond) { __builtin_amdgcn_s_sleep(1); \
    if ((++_sp & 255u) == 0u) { if (xb_ld(&(bar)[XB_TMO])) break; if (_sp > XB_SPIN_CAP) { atomicAdd(&(bar)[XB_TMO], 1u); break; } } } } while (0)
DEV void xcd_barrier_post(unsigned* bar) { if (TIDX() == 0) (void)xb_add(&bar[XB_XCNT(xb_xcc_id())], 1u); }
DEV void xcd_barrier_complete(unsigned* bar, unsigned x, unsigned& nloc, unsigned& nx) {
  const unsigned G = gridDim.x; unsigned sum, cnt, mine, sp = 0u;
  for (;;) { sum = 0u; cnt = 0u; mine = 0u;
#pragma unroll
    for (unsigned j = 0; j < 16; ++j) { const unsigned c = xb_ld(&bar[XB_XCNT(j)]); sum += c; cnt += (c > 0u) ? 1u : 0u; mine = (j == x) ? c : mine; }
    if (sum == G) break;
    __builtin_amdgcn_s_sleep(1);
    if ((++sp & 255u) == 0u) { if (xb_ld(&bar[XB_TMO])) break; if (sp > XB_SPIN_CAP) { atomicAdd(&bar[XB_TMO], 1u); break; } } }
  nloc = mine > 0u ? mine : 1u; nx = cnt > 0u ? cnt : 1u;
}
DEV void xcd_barrier(unsigned* bar, volatile LAS unsigned* st) {
  asm volatile("s_waitcnt vmcnt(0)" ::: "memory");
  __syncthreads();
  if (TIDX() == 0) {
    const unsigned x = xb_xcc_id();
    __builtin_amdgcn_s_waitcnt(0);
    unsigned nloc = st[0], nx = st[1];
    if (nloc == 0u) { xcd_barrier_complete(bar, x, nloc, nx); st[0] = nloc; st[1] = nx; }
    const unsigned old = xb_add(&bar[XB_XSUB(x)], 1u);
    const unsigned gen = old / nloc;
    if (old + 1u == (gen + 1u) * nloc) {
      __builtin_amdgcn_fence(__ATOMIC_RELEASE, "agent");
      asm volatile("s_waitcnt vmcnt(0)" ::: "memory");
      const unsigned og = xb_add(&bar[XB_TOP], 1u);
      const unsigned tg = og / nx;
      if (og + 1u == (tg + 1u) * nx) xb_add(&bar[XB_TOPGEN], 1u);
      else XB_SPIN(xb_ld(&bar[XB_TOPGEN]) == tg, bar);
      __builtin_amdgcn_fence(__ATOMIC_ACQUIRE, "agent");
      xb_add(&bar[XB_XGEN(x)], 1u);
      asm volatile("s_waitcnt vmcnt(0)" ::: "memory");
    } else {
      XB_SPIN(xb_ld(&bar[XB_XGEN(x)]) == gen, bar);
      __builtin_amdgcn_fence(__ATOMIC_ACQUIRE, "agent");
      asm volatile("s_waitcnt vmcnt(0)" ::: "memory");
    }
  }
  __syncthreads();
}

namespace pg8 {
constexpr int BM = 256, BK = 64, HALF = 128, HTB = HALF * BK * 2, STAGE_BYTES = 8 * HTB, NXCD = 8, WGM = 8;
DEV int lds_byte(int r, int c) { const int st = (r >> 4) * 2 + (c >> 5), rr = r & 15, cc = c & 31, ob = rr * 64 + cc * 2; return st * 1024 + (ob ^ (((ob >> 9) & 1) << 5)); }
DEV void stage_rc(int b, int& R, int& C) { const int st = b / 1024, sb = b % 1024, swz = sb ^ (((sb >> 9) & 1) << 5); R = (st >> 1) * 16 + swz / 64; C = (st & 1) * 32 + (swz % 64) / 2; }
DEV int perm32(int rho) { const int n = rho >> 4, i = rho & 15; return 8 * (i >> 2) + 4 * n + (i & 3); }
struct Unit { int pm, pn; };
struct Gemm { const bf16_t* A; const bf16_t* Bt; int M, N, K; };
struct StaticOrder {
  int nM, nN, nwg, G, c;
  DEV void init(int M, int N, int G_, int c_) { nM = M / BM; nN = N / BM; nwg = nM * nN; G = G_; c = c_; }
  DEV bool next(int i, Unit& u) const {
    const long L = (long)i * G + c; if (L >= nwg) return false;
    int wgid = (int)L; { const int q = nwg / NXCD, r = nwg % NXCD, xcd = wgid % NXCD, off = wgid / NXCD; wgid = (xcd < r ? xcd * (q + 1) : r * (q + 1) + (xcd - r) * q) + off; }
    const int nig = WGM * nN, gid = wgid / nig, fm = gid * WGM, gsz = (nM - fm) < WGM ? (nM - fm) : WGM;
    u.pm = fm + ((wgid % nig) % gsz); u.pn = (wgid % nig) / gsz; return true;
  }
};
struct OneUnit { bool has; Unit u0; DEV bool next(int i, Unit& u) const { if (i == 0 && has) { u = u0; return true; } return false; } };
template <class Epi, class Ord>
DEV void gemm_phase(LAS unsigned char* lds, const Gemm g, const Ord& S, const Epi& E) {
  const int tid = TIDX(), wid = __builtin_amdgcn_readfirstlane(tid >> 6), lane = tid & 63, wr = wid >> 2, wc = wid & 3, fr = lane & 15, fq = lane >> 4;
  const int K = g.K, nt = K / BK;
  unsigned voffA[2], voffB[2];
#pragma unroll
  for (int i = 0; i < 2; ++i) { int R, C; stage_rc(tid * 16 + i * 8192, R, C); const int Rb = Epi::PERM ? ((R & ~31) + perm32(R & 31)) : R;
    voffA[i] = (unsigned)(R * K + C) * 2u; voffB[i] = (unsigned)(Rb * K + C) * 2u; }
  const size_t kstep = (size_t)(BK * 2);
  const size_t hstep = (size_t)HALF * K * 2;
  const size_t tstep = 2 * hstep;
  const unsigned ldsw = (unsigned)wid * 1024u;
  const int aoff = lds_byte(wr * 64 + fr, fq * 8), boff = lds_byte(wc * 32 + fr, fq * 8);
#define PG8_SA(b, h) (((b) * 2 + (h)) * HTB)
#define PG8_SB(b, h) ((4 + (b) * 2 + (h)) * HTB)
#define PG8_STAGE(bufoff, gbase, voff) do { _Pragma("unroll") for (int _i = 0; _i < 2; ++_i) \
        __builtin_amdgcn_global_load_lds((const unsigned*)((const char*)(gbase) + (voff)[_i]), (LAS unsigned*)(lds + (bufoff) + ldsw + _i * 8192), 16, 0, 0); } while (0)
#define PG8_LDA(dst, b, h) do { _Pragma("unroll") for (int m = 0; m < 4; ++m) _Pragma("unroll") for (int k = 0; k < 2; ++k) dst[m][k] = *(const LAS bf16x8*)(lds + PG8_SA(b, h) + aoff + m * 2048 + k * 1024); } while (0)
#define PG8_LDB(dst, b, h) do { _Pragma("unroll") for (int n = 0; n < 2; ++n) _Pragma("unroll") for (int k = 0; k < 2; ++k) dst[n][k] = *(const LAS bf16x8*)(lds + PG8_SB(b, h) + boff + n * 2048 + k * 1024); } while (0)
#define PG8_MMA(ai, bj, At, Bt) do { __builtin_amdgcn_s_setprio(1); _Pragma("unroll") for (int m = 0; m < 4; ++m) _Pragma("unroll") for (int n = 0; n < 2; ++n) _Pragma("unroll") for (int k = 0; k < 2; ++k) \
        acc[ai][bj][m][n] = __builtin_amdgcn_mfma_f32_16x16x32_bf16(Bt[n][k], At[m][k], acc[ai][bj][m][n], 0, 0, 0); __builtin_amdgcn_s_setprio(0); } while (0)
#define PG8_WAIT_V(n) asm volatile("s_waitcnt vmcnt(" #n ")" ::: "memory")
#define PG8_WAIT_L(n) asm volatile("s_waitcnt lgkmcnt(" #n ")" ::: "memory")
#define PG8_BAR __builtin_amdgcn_s_barrier()
#define PG8_SCHED __builtin_amdgcn_sched_barrier(0)
  Unit cur, nxt; int ui = 0;
  if (!S.next(0, cur)) return;
  f32x4 acc[2][2][4][2];
#pragma unroll
  for (int a = 0; a < 2; ++a)
#pragma unroll
    for (int b = 0; b < 2; ++b)
#pragma unroll
      for (int m = 0; m < 4; ++m)
#pragma unroll
        for (int n = 0; n < 2; ++n) acc[a][b][m][n] = (f32x4){0.f, 0.f, 0.f, 0.f};
  bf16x8 At[4][2], B0[2][2], B1[2][2];
  const char* cA = (const char*)g.A + (size_t)cur.pm * tstep; const char* cB = (const char*)g.Bt + (size_t)cur.pn * tstep;
  PG8_STAGE(PG8_SB(0, 0), cB, voffB); PG8_STAGE(PG8_SA(0, 0), cA, voffA); PG8_STAGE(PG8_SB(0, 1), cB + hstep, voffB); PG8_STAGE(PG8_SA(0, 1), cA + hstep, voffA);
  if (wr == 1) PG8_BAR;
  PG8_WAIT_V(4); PG8_BAR;
  PG8_STAGE(PG8_SB(1, 0), cB + kstep, voffB); PG8_STAGE(PG8_SA(1, 0), cA + kstep, voffA); PG8_STAGE(PG8_SB(1, 1), cB + hstep + kstep, voffB);
  PG8_WAIT_V(6); PG8_BAR;
  for (;;) {
    const bool has_next = S.next(ui + 1, nxt);
    const char* nA = has_next ? (const char*)g.A + (size_t)nxt.pm * tstep : cA; const char* nB = has_next ? (const char*)g.Bt + (size_t)nxt.pn * tstep : cB;
    for (int t = 0; t < nt; t += 2) {
      const bool last = (t == nt - 2);
      const char* a1 = cA + (size_t)(t + 1) * kstep;
      const char* a2 = last ? nA : cA + (size_t)(t + 2) * kstep; const char* b2 = last ? nB : cB + (size_t)(t + 2) * kstep;
      const char* a3 = a2 + kstep; const char* b3 = b2 + kstep;
      PG8_LDB(B0, 0, 0); PG8_SCHED; PG8_LDA(At, 0, 0); PG8_STAGE(PG8_SA(1, 1), a1 + hstep, voffA);
      PG8_WAIT_L(8); PG8_BAR; PG8_WAIT_L(0); PG8_MMA(0, 0, At, B0); PG8_BAR; PG8_SCHED;
      PG8_LDB(B1, 0, 1); PG8_STAGE(PG8_SB(0, 0), b2, voffB);
      PG8_BAR; PG8_WAIT_L(0); PG8_MMA(0, 1, At, B1); PG8_BAR;
      PG8_LDA(At, 0, 1); PG8_STAGE(PG8_SA(0, 0), a2, voffA);
      PG8_BAR; PG8_WAIT_L(0); PG8_MMA(1, 0, At, B0); PG8_BAR; PG8_SCHED;
      PG8_STAGE(PG8_SB(0, 1), b2 + hstep, voffB);
      PG8_WAIT_V(6); PG8_BAR; PG8_MMA(1, 1, At, B1); PG8_BAR;
      PG8_LDB(B0, 1, 0); PG8_SCHED; PG8_LDA(At, 1, 0); PG8_STAGE(PG8_SA(0, 1), a2 + hstep, voffA);
      PG8_WAIT_L(8); PG8_BAR; PG8_WAIT_L(0); PG8_MMA(0, 0, At, B0); PG8_BAR; PG8_SCHED;
      PG8_LDB(B1, 1, 1); PG8_STAGE(PG8_SB(1, 0), b3, voffB);
      PG8_BAR; PG8_WAIT_L(0); PG8_MMA(0, 1, At, B1); PG8_BAR;
      PG8_LDA(At, 1, 1); PG8_STAGE(PG8_SA(1, 0), a3, voffA);
      PG8_BAR; PG8_WAIT_L(0); PG8_MMA(1, 0, At, B0); PG8_BAR; PG8_SCHED;
      PG8_STAGE(PG8_SB(1, 1), b3 + hstep, voffB);
      PG8_WAIT_V(6); PG8_BAR; PG8_MMA(1, 1, At, B1); PG8_BAR;
    }
    E(acc, cur, wr, wc, fr, fq);
    if (!has_next) break;
#pragma unroll
    for (int a = 0; a < 2; ++a)
#pragma unroll
      for (int b = 0; b < 2; ++b)
#pragma unroll
        for (int m = 0; m < 4; ++m)
#pragma unroll
          for (int n = 0; n < 2; ++n) acc[a][b][m][n] = (f32x4){0.f, 0.f, 0.f, 0.f};
    cur = nxt; cA = nA; cB = nB; ++ui;
  }
  PG8_WAIT_V(0);
  if (wr == 0) PG8_BAR;
  PG8_BAR;
#undef PG8_SA
#undef PG8_SB
#undef PG8_STAGE
#undef PG8_LDA
#undef PG8_LDB
#undef PG8_MMA
#undef PG8_WAIT_V
#undef PG8_WAIT_L
#undef PG8_BAR
#undef PG8_SCHED
}
}
using pg8::Unit;
typedef f32x4 AccT[2][2][4][2];

struct EpiBf16 {
  static constexpr bool PERM = true;
  bf16_t* O; int ldc; int ncols;
  DEV void operator()(const AccT& acc, const Unit& u, int wr, int wc, int fr, int fq) const {
    { const int t_ = TIDX(); fr = t_ & 15; fq = (t_ >> 4) & 3; }
    const int row0 = u.pm * 256 + wr * 64 + fr, col0 = u.pn * 256 + wc * 32 + 8 * fq;
#pragma unroll
    for (int ai = 0; ai < 2; ++ai)
#pragma unroll
      for (int m = 0; m < 4; ++m) { bf16_t* rowp = O + (size_t)(row0 + ai * 128 + m * 16) * ldc;
#pragma unroll
        for (int bj = 0; bj < 2; ++bj) { const int col = col0 + bj * 128; if (col < ncols) {
          const f32x4 v0 = acc[ai][bj][m][0], v1 = acc[ai][bj][m][1];
          u32x4 w; w[0] = pack2(v0[0], v0[1]); w[1] = pack2(v0[2], v0[3]); w[2] = pack2(v1[0], v1[1]); w[3] = pack2(v1[2], v1[3]);
          *(u32x4*)(rowp + col) = w; } } }
  }
};
struct EpiF32 {
  static constexpr bool PERM = false;
  float* C; int ldc;
  DEV void operator()(const AccT& acc, const Unit& u, int wr, int wc, int fr, int fq) const {
    { const int t_ = TIDX(); fr = t_ & 15; fq = (t_ >> 4) & 3; }
    const int row0 = u.pm * 256 + wr * 64 + fr, col0 = u.pn * 256 + wc * 32 + 4 * fq;
#pragma unroll
    for (int ai = 0; ai < 2; ++ai)
#pragma unroll
      for (int m = 0; m < 4; ++m) { float* rowp = C + (size_t)(row0 + ai * 128 + m * 16) * ldc + col0;
#pragma unroll
        for (int bj = 0; bj < 2; ++bj)
#pragma unroll
          for (int n = 0; n < 2; ++n) *(f32x4*)(rowp + bj * 128 + n * 16) = acc[ai][bj][m][n]; }
  }
};

#define WS(T, off) ((T*)(p.ws + (off)))
DEV const float* x_in_row(CParams& p, int row) { return row < NCTXR ? p.in[I_CTX] + (size_t)row * DM : p.in[I_X] + (size_t)(row - NCTXR) * DM; }
DEV float* x_cur_row(CParams& p, int row) { return row < NCTXR ? WS(float, OFF_CTXX) + (size_t)row * DM : p.out + (size_t)(row - NCTXR) * DM; }

DEV void tr_tile(const float* __restrict__ src, bf16_t* __restrict__ dst, int K, int N, int nt, int kt, float* tile) {
  const int tid = TIDX();
  { const int r = tid >> 4, c4 = (tid & 15) * 4;
#pragma unroll
    for (int i = 0; i < 2; ++i) { const int k = kt * 64 + r + 32 * i, n = nt * 64 + c4;
      f32x4 v = {0.f, 0.f, 0.f, 0.f}; if (n < N) v = *(const f32x4*)(src + (size_t)k * N + n);
      float* tp = tile + (r + 32 * i) * 65 + c4; tp[0] = v[0]; tp[1] = v[1]; tp[2] = v[2]; tp[3] = v[3]; } }
  __syncthreads();
  { const int n = tid >> 3, k8 = (tid & 7) * 8; float f[8];
#pragma unroll
    for (int j = 0; j < 8; ++j) f[j] = tile[(k8 + j) * 65 + n];
    *(u32x4*)(dst + (size_t)(nt * 64 + n) * K + kt * 64 + k8) = pack8(f); }
  __syncthreads();
}
DEV void mod_unit(CParams& p, int l, int cgp, float* lds) {
  float* sc = lds; float* red = lds + 9 * 1024;
  const int tid = TIDX();
  for (int i = tid; i < 9 * 1024; i += NTHREADS) { const int r = i >> 10, k = i & 1023; const float cv = r < 8 ? p.in[I_C][r * 1024 + k] : p.in[I_CCTX][k]; sc[i] = siluf_(cv); }
  __syncthreads();
  const int kg = tid >> 6, cl = tid & 63, col = cgp * 64 + cl;
  float acc[9];
#pragma unroll
  for (int r = 0; r < 9; ++r) acc[r] = 0.f;
  const float* w = p.in[I_WMOD] + (size_t)l * 1024 * 6144 + col;
  for (int k = kg * 128; k < kg * 128 + 128; ++k) { const float wv = w[(size_t)k * 6144];
#pragma unroll
    for (int r = 0; r < 9; ++r) acc[r] += sc[r * 1024 + k] * wv; }
#pragma unroll
  for (int r = 0; r < 9; ++r) red[(kg * 9 + r) * 64 + cl] = acc[r];
  __syncthreads();
  for (int o = tid; o < 9 * 64; o += NTHREADS) { const int r = o >> 6, c2 = o & 63; float s = 0.f;
    for (int g = 0; g < 8; ++g) s += red[(g * 9 + r) * 64 + c2];
    WS(float, OFF_MOD)[(size_t)(l * 9 + r) * 6144 + cgp * 64 + c2] = s + p.in[I_BMOD][l * 6144 + cgp * 64 + c2]; }
  __syncthreads();
}
DEV void ph_init(CParams& p, unsigned char* lds) {
  const int tid = TIDX(), nb = gridDim.x;
  if (blockIdx.x == 0 && tid < 64) WS(unsigned, OFF_CNT)[tid] = 0u;
  const int tcount[5] = {(NINP / 64) * 16, 16 * 16, 32 * 16, 12 * 6, 12 * 4};
  const int tl = tcount[0] + tcount[1] + tcount[2] + tcount[3] + tcount[4];
  const int total = 192 + 2 * tl;
  for (int u = blockIdx.x; u < total; u += nb) {
    if (u < 192) { mod_unit(p, u / 96, u % 96, (float*)lds); continue; }
    int v = u - 192; const int l = v / tl; v -= l * tl;
    if (v < tcount[0]) { tr_tile(p.in[I_WIN] + (size_t)l * 1024 * NIN, WS(bf16_t, OFF_WIN) + (size_t)l * NINP * 1024, 1024, NIN, v / 16, v % 16, (float*)lds); continue; }
    v -= tcount[0];
    if (v < tcount[1]) { tr_tile(p.in[I_WOUT] + (size_t)l * 1024 * 1024, WS(bf16_t, OFF_WOUT) + (size_t)l * 1024 * 1024, 1024, 1024, v / 16, v % 16, (float*)lds); continue; }
    v -= tcount[1];
    if (v < tcount[2]) { tr_tile(p.in[I_PWQ] + (size_t)l * 1024 * 2048, WS(bf16_t, OFF_WPQ) + (size_t)l * 2048 * 1024, 1024, 2048, v / 16, v % 16, (float*)lds); continue; }
    v -= tcount[2];
    if (v < tcount[3]) { tr_tile(p.in[I_QUP] + (size_t)l * 384 * 576, WS(bf16_t, OFF_WQUP) + (size_t)l * 768 * 384, 384, 576, v / 6, v % 6, (float*)lds); continue; }
    v -= tcount[3];
    tr_tile(p.in[I_KVUP] + (size_t)l * 256 * 768, WS(bf16_t, OFF_WKVUP) + (size_t)l * 768 * 256, 256, 768, v / 4, v % 4, (float*)lds);
  }
  const size_t gtid = (size_t)blockIdx.x * NTHREADS + tid, gsz = (size_t)nb * NTHREADS;
  for (size_t i = gtid; i < 2ull * 2048 * 384; i += gsz) {
    const int l = (int)(i / (2048 * 384)); const int rem = (int)(i % (2048 * 384)); const int n = rem / 384, k = rem % 384;
    float v = 0.f;
    if (n < 1920) { const int grp = n / 384, cc = n % 384;
      if (grp < 2) { if ((k >> 6) == grp) v = p.in[I_RWWUP][((size_t)(l * 2 + grp) * 64 + (k & 63)) * 384 + cc]; }
      else if (grp < 4) { if ((k >> 6) == grp) v = p.in[I_RWAUP][((size_t)(l * 2 + grp - 2) * 64 + (k & 63)) * 384 + cc]; }
      else { if (k >= 256) v = p.in[I_RWGUP][((size_t)l * 128 + (k - 256)) * 384 + cc]; } }
    WS(bf16_t, OFF_WLORA)[i] = f2bf(v);
  }
  for (size_t i = gtid; i < 2ull * 16 * 128 * 128; i += gsz) WS(bf16_t, OFF_KEYS)[i] = f2bf(p.in[I_PKEYS][i]);
}

DEV void ph_lnmod(CParams& p, int l) {
  const int lane = TIDX() & 63, per = (NTOK + (int)gridDim.x - 1) / (int)gridDim.x, r0 = (int)blockIdx.x * per, r1 = r0 + per < NTOK ? r0 + per : NTOK;
  for (int row = r0 + (TIDX() >> 6); row < r1; row += 8) {
    const float* xr = x_in_row(p, row); f32x4 v[4]; float s = 0.f;
#pragma unroll
    for (int i = 0; i < 4; ++i) { v[i] = *(const f32x4*)(xr + lane * 4 + 256 * i); s += (v[i][0] + v[i][1]) + (v[i][2] + v[i][3]); }
    const float mean = wave_sum(s) * (1.f / 1024.f); float q = 0.f;
#pragma unroll
    for (int i = 0; i < 4; ++i) { v[i] -= mean; q += (v[i][0] * v[i][0] + v[i][1] * v[i][1]) + (v[i][2] * v[i][2] + v[i][3] * v[i][3]); }
    const float rstd = rsqrtf(wave_sum(q) * (1.f / 1024.f) + LN_EPS);
    const float* md = WS(float, OFF_MOD) + (size_t)(l * 9 + modrow_of(row)) * 6144;
#pragma unroll
    for (int i = 0; i < 4; ++i) { const int col = lane * 4 + 256 * i; const f32x4 sh = *(const f32x4*)(md + col), sc = *(const f32x4*)(md + 1024 + col);
      const f32x4 o = v[i] * rstd * (sc + 1.f) + sh; u32x2 w; w[0] = pack2(o[0], o[1]); w[1] = pack2(o[2], o[3]);
      *(u32x2*)(WS(bf16_t, OFF_H) + (size_t)row * 1024 + col) = w; }
  }
}

struct ChunkInfo { int row0, b, cseq, T, t0; bool isctx; };
DEV ChunkInfo chunk_info(int chunk) { ChunkInfo c; c.row0 = chunk * 64; c.isctx = chunk < 32;
  if (c.isctx) { c.b = chunk >> 2; c.cseq = chunk & 3; c.T = 256; } else { const int lc = chunk - 32; c.b = lc >> 5; c.cseq = lc & 31; c.T = 2048; }
  c.t0 = c.cseq * 64; return c; }
DEV int ml_pc(const ChunkInfo& c, int dir) { return dir == 0 ? (c.isctx ? c.cseq : 4 + c.cseq) : (c.isctx ? 3 - c.cseq : 4 + (31 - c.cseq)); }
DEV u32x4 ld8g(const bf16_t* ptr) { return *(const u32x4*)ptr; }

DEV void prep_mlstm(CParams& p, int l, const ChunkInfo& c, int chunk, int hd, unsigned char* lds) {
  bf16_t* VTl = (bf16_t*)lds;
  bf16_t* KWl = (bf16_t*)(lds + 10880);
  float* wkl = (float*)(lds + 10880 + 17408);
  const bf16_t* pb = WS(bf16_t, OFF_P);
  const int tid = TIDX(), lane = tid & 63, wid = tid >> 6;
  if (tid < 128) {
    const int dir = tid >> 6, s = lane, row = c.row0 + s;
    const float gi = bf2f(pb[(size_t)row * NIN + 1024 + dir * 8 + hd]) + p.in[I_MLIB][l * 8 + dir * 4 + hd];
    const float gf = bf2f(pb[(size_t)row * NIN + 1024 + dir * 8 + 4 + hd]) + p.in[I_MLFB][l * 8 + dir * 4 + hd];
    const float lf = fminf(gf, 0.f) - log1pf(__expf(-fabsf(gf)));
    WS(float, OFF_GLI)[(size_t)(dir * 4 + hd) * NTOK + row] = gi; WS(float, OFF_GLF)[(size_t)(dir * 4 + hd) * NTOK + row] = lf;
    const float incl = scan_sum64(lf, lane);
    const float total = rdlane(incl, 63);
    const float g = (dir == 0 ? total - incl : incl - lf) + gi;
    const float mloc = wave_max(g);
    wkl[dir * 64 + s] = __expf(g - mloc);
    if (s == 0) { const int chain = dir * 32 + c.b * 4 + hd, pc = ml_pc(c, dir); WS(float, OFF_SCM)[chain * 36 + pc] = mloc; WS(float, OFF_SCB)[chain * 36 + pc] = total; }
  }
  __syncthreads();
  { const int s = tid >> 3, d0 = (tid & 7) * 8, row = c.row0 + s, t = c.t0 + s;
    const bool hp = t > 0, hn = t < c.T - 1;
    const float* cw = p.in[I_MLCW] + l * 3 * 512; const float* cb = p.in[I_MLCB] + l * 512;
    const u32x4 z4 = {0u, 0u, 0u, 0u};
    float qk[2][8];
#pragma unroll
    for (int which = 0; which < 2; ++which) { const int col = which * 256 + hd * 64 + d0; const bf16_t* pr = pb + (size_t)row * NIN + col;
      float cur[8], prv[8], nxt[8]; unpack8(ld8g(pr), cur); unpack8(hp ? ld8g(pr - NIN) : z4, prv); unpack8(hn ? ld8g(pr + NIN) : z4, nxt);
#pragma unroll
      for (int i = 0; i < 8; ++i) { const int j = col + i; const float x = prv[i] * cw[j] + cur[i] * cw[512 + j] + nxt[i] * cw[1024 + j] + cb[j]; qk[which][i] = siluf_(x); } }
#pragma unroll
    for (int i = 0; i < 8; ++i) qk[0][i] *= 0.125f;
    *(u32x4*)(WS(bf16_t, OFF_MQ) + (size_t)row * 256 + hd * 64 + d0) = pack8(qk[0]);
    *(u32x4*)(WS(bf16_t, OFF_MK) + (size_t)row * 256 + hd * 64 + d0) = pack8(qk[1]);
    const float w0 = wkl[s], w1 = wkl[64 + s];
#pragma unroll
    for (int i = 0; i < 8; ++i) { KWl[(0 * 64 + d0 + i) * 68 + s] = f2bf(qk[1][i] * w0); KWl[(1 * 64 + d0 + i) * 68 + s] = f2bf(qk[1][i] * w1); }
    const u32x4 vv = ld8g(pb + (size_t)row * NIN + 512 + hd * 64 + d0);
#pragma unroll
    for (int i = 0; i < 4; ++i) { VTl[(d0 + 2 * i) * 68 + s] = (bf16_t)(vv[i] & 0xffffu); VTl[(d0 + 2 * i + 1) * 68 + s] = (bf16_t)(vv[i] >> 16); }
    *(u32x4*)(WS(bf16_t, OFF_MO) + (size_t)row * 256 + hd * 64 + d0) = ld8g(pb + (size_t)row * NIN + 768 + hd * 64 + d0);
    if (tid < 64) VTl[64 * 68 + tid] = (bf16_t)0x3F80u;
    for (int i = tid; i < 15 * 68; i += NTHREADS) VTl[65 * 68 + i] = 0;
  }
  __syncthreads();
  { const int e = tid >> 3, sseg = (tid & 7) * 8; const u32x2 a = *(const u32x2*)(VTl + e * 68 + sseg), b2 = *(const u32x2*)(VTl + e * 68 + sseg + 4);
    u32x4 w; w[0] = a[0]; w[1] = a[1]; w[2] = b2[0]; w[3] = b2[1];
    *(u32x4*)(WS(bf16_t, OFF_MVT) + ((size_t)(chunk * 4 + hd) * 64 + e) * 64 + sseg) = w; }
  { const int fr = lane & 15, fq = lane >> 4;
#pragma unroll 1
    for (int ti = 0; ti < 5; ++ti) { const int id = wid * 5 + ti, dir = id / 20, et = (id % 20) >> 2, dt = id & 3;
      f32x4 acc = {0.f, 0.f, 0.f, 0.f};
#pragma unroll
      for (int ks = 0; ks < 2; ++ks) {
        const bf16_t* ap = VTl + (et * 16 + fr) * 68 + ks * 32 + fq * 8; const bf16_t* bp = KWl + (dir * 64 + dt * 16 + fr) * 68 + ks * 32 + fq * 8;
        u32x4 aw, bw; { const u32x2 x0 = *(const u32x2*)ap, x1 = *(const u32x2*)(ap + 4); aw[0] = x0[0]; aw[1] = x0[1]; aw[2] = x1[0]; aw[3] = x1[1]; }
        { const u32x2 x0 = *(const u32x2*)bp, x1 = *(const u32x2*)(bp + 4); bw[0] = x0[0]; bw[1] = x0[1]; bw[2] = x1[0]; bw[3] = x1[1]; }
        acc = __builtin_amdgcn_mfma_f32_16x16x32_bf16(__builtin_bit_cast(bf16x8, aw), __builtin_bit_cast(bf16x8, bw), acc, 0, 0, 0); }
      const int chain = dir * 32 + c.b * 4 + hd, pc = ml_pc(c, dir);
      bf16_t* st = WS(bf16_t, OFF_ST) + (size_t)(chain * 36 + pc) * 5120;
#pragma unroll
      for (int j = 0; j < 4; ++j) st[(et * 16 + fq * 4 + j) * 64 + dt * 16 + fr] = f2bf(acc[j]); }
  }
  __syncthreads();
}

DEV float tanh_fast(float x) { return 1.f - 2.f * __builtin_amdgcn_rcpf(1.f + __expf(2.f * x)); }
DEV void prep_rwkv_flat(CParams& p, int l) {
  const bf16_t* pb = WS(bf16_t, OFF_P); const float* mu = p.in[I_RWMU] + l * 3072;
  const int lane = TIDX() & 63, wid = TIDX() >> 6;
  const int per = (NTOK + (int)gridDim.x - 1) / (int)gridDim.x, pw = (per + 7) / 8;
  const int rA = (int)blockIdx.x * per + wid * pw; int rB = rA + pw; { const int re = (int)blockIdx.x * per + per; if (rB > re) rB = re; if (rB > NTOK) rB = NTOK; }
  if (rA >= rB) return;
  const u32x4 z4 = {0u, 0u, 0u, 0u};
  u32x4 prv[3], cur[3], nxt[3];
#pragma unroll
  for (int st = 0; st < 3; ++st) { const bf16_t* pr = pb + (size_t)rA * NIN + 1040 + (st * 64 + lane) * 8; cur[st] = ld8g(pr); prv[st] = rA > 0 ? ld8g(pr - NIN) : z4; }
#pragma unroll 1
  for (int row = rA; row < rB; ++row) {
    int t, T; if (row < NCTXR) { t = row & 255; T = 256; } else { t = (row - NCTXR) & 2047; T = 2048; }
#pragma unroll
    for (int st = 0; st < 3; ++st) nxt[st] = row + 1 < NTOK ? ld8g(pb + (size_t)(row + 1) * NIN + 1040 + (st * 64 + lane) * 8) : z4;
    const bool hp = t > 0, hn = t < T - 1;
#pragma unroll
    for (int st = 0; st < 3; ++st) { const int seg = st * 64 + lane, col = seg * 8;
      float c[8], pv[8], nx[8], x[8]; unpack8(cur[st], c); unpack8(hp ? prv[st] : z4, pv); unpack8(hn ? nxt[st] : z4, nx);
#pragma unroll
      for (int i = 0; i < 8; ++i) x[i] = c[i] + mu[col + i] * (pv[i] - c[i]) + mu[1536 + col + i] * (nx[i] - c[i]);
      if (st == 0 && lane < 48) *(u32x4*)(WS(bf16_t, OFF_RB) + (size_t)row * 384 + col) = pack8(x);
      if ((st == 0 && lane >= 48) || (st == 1 && lane < 32)) { const int kc = (seg - 48) * 8; float kk[8], ss = 0.f;
#pragma unroll
        for (int i = 0; i < 8; ++i) { kk[i] = x[i] * p.in[I_RWKK][l * 384 + kc + i]; ss += kk[i] * kk[i]; }
        ss = grp8_sum(ss);
        *(u32x4*)(WS(bf16_t, OFF_KB) + (size_t)row * 384 + kc) = pack8(x); const float inv = rsqrtf(ss + 1e-12f);
#pragma unroll
        for (int i = 0; i < 8; ++i) kk[i] *= inv;
        *(u32x4*)(WS(bf16_t, OFF_KH) + (size_t)row * 384 + kc) = pack8(kk); }
      if ((st == 1 && lane >= 32) || (st == 2 && lane < 16)) *(u32x4*)(WS(bf16_t, OFF_VB) + (size_t)row * 384 + (seg - 96) * 8) = pack8(x);
      if (st == 2 && lane >= 16) { const int zc = (seg - 144) * 8;
        if (zc < 128) { for (int i = 0; i < 8; ++i) x[i] = tanh_fast(x[i]); } else if (zc >= 256) { for (int i = 0; i < 8; ++i) x[i] = sigmoidf_(x[i]); }
        *(u32x4*)(WS(bf16_t, OFF_ZB) + (size_t)row * 384 + zc) = pack8(x); }
      prv[st] = cur[st]; cur[st] = nxt[st]; }
  }
}
DEV void prep_mla_flat(CParams& p, int l) {
  const bf16_t* pb = WS(bf16_t, OFF_P); const int tid = TIDX(), lane = tid & 63, gw = (int)blockIdx.x * 8 + (tid >> 6), nw = (int)gridDim.x * 8;
#pragma unroll 3
  for (int row = gw; row < NTOK; row += nw) { const bool isctx = row < NCTXR; const int t = isctx ? (row & 255) : ((row - NCTXR) & 2047); const bf16_t* pr = pb + (size_t)row * NIN;
    { float v[8]; float ss = 0.f; if (lane < 48) { unpack8(ld8g(pr + 2576 + lane * 8), v); for (int i = 0; i < 8; ++i) ss += v[i] * v[i]; }
      const float inv = rsqrtf(wave_sum(ss) * (1.f / 384.f) + LN_EPS);
      if (lane < 48) { for (int i = 0; i < 8; ++i) v[i] = v[i] * inv * p.in[I_QNG][l * 384 + lane * 8 + i]; *(u32x4*)(WS(bf16_t, OFF_CQN) + (size_t)row * 384 + lane * 8) = pack8(v); } }
    { float v[8]; float ss = 0.f; if (lane < 32) { unpack8(ld8g(pr + 2960 + lane * 8), v); for (int i = 0; i < 8; ++i) ss += v[i] * v[i]; }
      const float inv = rsqrtf(wave_sum(ss) * (1.f / 256.f) + LN_EPS);
      if (lane < 32) { for (int i = 0; i < 8; ++i) v[i] = v[i] * inv * p.in[I_KVNG][l * 256 + lane * 8 + i]; *(u32x4*)(WS(bf16_t, OFF_CKVN) + (size_t)row * 256 + lane * 8) = pack8(v); } }
    { const float x = bf2f(pr[3216 + (lane & 31)]); const float pt = dppf<0x128>(x); float o = x;
      if (!isctx) { const int f = lane & 7; const int pos = (lane & 16) ? (t & 63) : (t >> 6);
        const float invf = __expf(-(float)f * (9.210340372f / 8.f)); float rev = (float)pos * invf * 0.15915494309f; rev -= floorf(rev);
        const float sn = __builtin_amdgcn_sinf(rev), cs = __builtin_amdgcn_cosf(rev);
        o = (lane & 8) ? x * cs + pt * sn : x * cs - pt * sn; }
      if (lane < 32) WS(bf16_t, OFF_KR)[(size_t)row * 32 + lane] = f2bf(o); }
  }
}

DEV void ph_prep(CParams& p, int l, unsigned char* lds) {
  for (int r_ = 0; r_ < PM_REP; ++r_)
  for (int u = blockIdx.x; u < 288 * 4; u += gridDim.x) { const int chunk = u >> 2; const ChunkInfo c = chunk_info(chunk); prep_mlstm(p, l, c, chunk, u & 3, lds); }
  for (int r_ = 0; r_ < PF_REP; ++r_) { prep_rwkv_flat(p, l); prep_mla_flat(p, l); }
}

DEV void mlstm_state_scan(CParams& p, int chain) {
  const int tid = TIDX(); const bool two = tid < 128;
  float C0[8], C1[8];
#pragma unroll
  for (int i = 0; i < 8; ++i) { C0[i] = 0.f; C1[i] = 0.f; }
  float m = -1e30f;
  bf16_t* blk = WS(bf16_t, OFF_ST) + (size_t)chain * 36 * 5120;
  u32x4 q0a, q0b = {0u, 0u, 0u, 0u}, q1a, q1b = {0u, 0u, 0u, 0u}, q2a, q2b = {0u, 0u, 0u, 0u};
#define SS_LOAD(A, B, pc_) do { const bf16_t* sp_ = blk + (size_t)(pc_) * 5120; A = *(const u32x4*)(sp_ + tid * 8); if (two) B = *(const u32x4*)(sp_ + (512 + tid) * 8); } while (0)
#define SS_STEP(A, B, pc_) do { bf16_t* cb = blk + (size_t)(pc_) * 5120; const u32x4 l0 = A, l1 = B; \
    if ((pc_) + 3 < 36) SS_LOAD(A, B, (pc_) + 3); \
    const float mloc = WS(float, OFF_SCM)[chain * 36 + (pc_)], bend = WS(float, OFF_SCB)[chain * 36 + (pc_)]; \
    *(u32x4*)(cb + tid * 8) = pack8(C0); if (two) *(u32x4*)(cb + (512 + tid) * 8) = pack8(C1); \
    if (tid == 0) WS(float, OFF_SCMB)[chain * 36 + (pc_)] = m; \
    const float mnew = fmaxf(bend + m, mloc), decay = __expf(bend + m - mnew), sl = __expf(mloc - mnew); \
    float f0[8], f1[8]; unpack8(l0, f0); unpack8(l1, f1); \
    _Pragma("unroll") for (int i = 0; i < 8; ++i) { C0[i] = decay * C0[i] + sl * f0[i]; C1[i] = decay * C1[i] + sl * f1[i]; } \
    m = mnew; } while (0)
  SS_LOAD(q0a, q0b, 0); SS_LOAD(q1a, q1b, 1); SS_LOAD(q2a, q2b, 2);
#pragma unroll 1
  for (int pc = 0; pc < 36; pc += 3) { SS_STEP(q0a, q0b, pc); SS_STEP(q1a, q1b, pc + 1); SS_STEP(q2a, q2b, pc + 2); }
#undef SS_LOAD
#undef SS_STEP
}
template <int MASK> DEV void ph_mid_t(CParams& p, int lx, unsigned char* lds) {
  const int l = lx & 1;
  LAS unsigned char* ll = (LAS unsigned char*)lds;
  pg8::StaticOrder S;
  if constexpr (MASK & 1) { S.init(NTOK, 2048, gridDim.x, blockIdx.x); pg8::Gemm g{WS(bf16_t, OFF_ZB), WS(bf16_t, OFF_WLORA) + (size_t)l * 2048 * 384, NTOK, 2048, 384};
    EpiBf16 E{WS(bf16_t, OFF_LORA), 1920, 1920}; pg8::gemm_phase(ll, g, S, E); }
  const bool rot = gridDim.x == 256, act = !rot || blockIdx.x < 192;
  if constexpr (MASK & 2) { if (act) { if (rot) S.init(NTOK, 768, 192, ((int)blockIdx.x + 128) % 192); else S.init(NTOK, 768, gridDim.x, blockIdx.x);
    pg8::Gemm g{WS(bf16_t, OFF_CQN), WS(bf16_t, OFF_WQUP) + (size_t)l * 768 * 384, NTOK, 768, 384};
    EpiBf16 E{WS(bf16_t, OFF_QB), 576, 576}; pg8::gemm_phase(ll, g, S, E); } }
  if constexpr (MASK & 4) { if (act) { if (rot) S.init(NTOK, 768, 192, ((int)blockIdx.x + 104) % 192); else S.init(NTOK, 768, gridDim.x, blockIdx.x);
    pg8::Gemm g{WS(bf16_t, OFF_CKVN), WS(bf16_t, OFF_WKVUP) + (size_t)l * 768 * 256, NTOK, 768, 256};
    EpiBf16 E{WS(bf16_t, OFF_KV), 768, 768}; pg8::gemm_phase(ll, g, S, E); } }
  if constexpr (MASK & 8) { const int c = (int)gridDim.x - 1 - (int)blockIdx.x; if (c < 64) mlstm_state_scan(p, c); }
  if constexpr (MASK & 8) {
  unsigned* cnt = WS(unsigned, OFF_CNT) + 8 + lx; unsigned* slot = (unsigned*)lds;
  for (;;) {
    __syncthreads();
    if (TIDX() == 0) *slot = atomicAdd(cnt, 1u);
    __syncthreads();
    const unsigned ch = *slot + CONV_MID0; if (ch >= 2048u) break;
    const int tb = ch >> 10, e = (int)(ch & 1023) * 16 + (TIDX() >> 5), seg = TIDX() & 31;
    const float* src = p.in[tb ? I_PV : I_PU] + ((size_t)l * 16384 + e) * 1024 + seg * 32; const float scl = tb ? 4.f : 64.f;
    unsigned char* dst = WS(unsigned char, tb ? OFF_TABV : OFF_TABU) + ((size_t)(seg >> 3) * 16384 + e) * 128 + (seg & 7) * 16;
    u32x4 w0;
#pragma unroll
    for (int i = 0; i < 4; ++i) { const f32x4 a = *(const f32x4*)(src + i * 8) * scl, b2 = *(const f32x4*)(src + i * 8 + 4) * scl; unsigned w = 0u;
      w = __builtin_amdgcn_cvt_scalef32_pk_fp4_f32(w, a[0], a[1], 1.0f, 0); w = __builtin_amdgcn_cvt_scalef32_pk_fp4_f32(w, a[2], a[3], 1.0f, 1);
      w = __builtin_amdgcn_cvt_scalef32_pk_fp4_f32(w, b2[0], b2[1], 1.0f, 2); w = __builtin_amdgcn_cvt_scalef32_pk_fp4_f32(w, b2[2], b2[3], 1.0f, 3);
      w0[i] = w; }
    *(u32x4*)dst = w0;
  }
  }
  __syncthreads();
}
DEV void ph_mid(CParams& p, int l, unsigned char* lds) { ph_mid_t<15>(p, l, lds); }

DEV int rw_rowof(int dir, int b, int pos) { if (pos < 256) { const int t = dir ? 255 - pos : pos; return b * 256 + t; } const int q = pos - 256; const int t = dir ? 2047 - q : q; return NCTXR + b * 2048 + t; }
DEV void rwkv_scan_unit(CParams& p, int l, int u, unsigned char* lds) {
  constexpr int TS = 32;
  const int chain = u >> 1, half = u & 1, dir = chain / 48, bh = chain % 48, b = bh / 6, h6 = bh % 6;
  float* sb = (float*)lds;
  float* yb = sb + 2 * 6 * TS * 64;
  const int tid = TIDX(), rl = tid >> 4, kq = tid & 15, col = h6 * 64 + kq * 4;
  float ka[4];
#pragma unroll
  for (int i = 0; i < 4; ++i) ka[i] = p.in[I_RWKA][l * 384 + col + i];
  const bf16_t* RBp = WS(bf16_t, OFF_RB); const bf16_t* KBp = WS(bf16_t, OFF_KB); const bf16_t* KHp = WS(bf16_t, OFF_KH); const bf16_t* VBp = WS(bf16_t, OFF_VB);
  const bf16_t* LOp = WS(bf16_t, OFF_LORA) + dir * 384 + col;
  float w0v[4], a0v[4];
#pragma unroll
  for (int i = 0; i < 4; ++i) { w0v[i] = p.in[I_RWW0][l * 768 + dir * 384 + col + i]; a0v[i] = p.in[I_RWA0][l * 768 + dir * 384 + col + i]; }
  u32x2 g_r, g_k, g_kh, g_v, g_lw, g_a;
#define RW_LOAD(c) do { const size_t off = (size_t)rw_rowof(dir, b, (c) * TS + rl) * 384 + col; g_r = *(const u32x2*)(RBp + off); g_k = *(const u32x2*)(KBp + off); \
    g_kh = *(const u32x2*)(KHp + off); g_v = *(const u32x2*)(VBp + off); const size_t off2 = (size_t)rw_rowof(dir, b, (c) * TS + rl) * 1920; g_lw = *(const u32x2*)(LOp + off2); g_a = *(const u32x2*)(LOp + off2 + 768); } while (0)
#define RW_WRITE(bi) do { float* base = sb + (bi) * 6 * TS * 64 + rl * 64 + kq * 4; \
    const float r_[4] = {lo16(g_r[0]), hi16(g_r[0]), lo16(g_r[1]), hi16(g_r[1])}, k_[4] = {lo16(g_k[0]), hi16(g_k[0]), lo16(g_k[1]), hi16(g_k[1])}; \
    const float kh_[4] = {lo16(g_kh[0]), hi16(g_kh[0]), lo16(g_kh[1]), hi16(g_kh[1])}, v_[4] = {lo16(g_v[0]), hi16(g_v[0]), lo16(g_v[1]), hi16(g_v[1])}; \
    const float lw_[4] = {lo16(g_lw[0]), hi16(g_lw[0]), lo16(g_lw[1]), hi16(g_lw[1])}, a_[4] = {lo16(g_a[0]), hi16(g_a[0]), lo16(g_a[1]), hi16(g_a[1])}; \
    f32x4 o0, o1, o2, o3, o4, o5; \
    _Pragma("unroll") for (int i = 0; i < 4; ++i) { const float aa = sigmoidf_(a0v[i] + a_[i]); o0[i] = __expf(-0.60653065971f * sigmoidf_(w0v[i] + lw_[i])); o1[i] = kh_[i]; o2[i] = kh_[i] * aa; o3[i] = k_[i] * (1.f + (aa - 1.f) * ka[i]); o4[i] = r_[i]; o5[i] = v_[i]; } \
    *(f32x4*)(base + 0 * TS * 64) = o0; *(f32x4*)(base + 1 * TS * 64) = o1; *(f32x4*)(base + 2 * TS * 64) = o2; *(f32x4*)(base + 3 * TS * 64) = o3; \
    *(f32x4*)(base + 4 * TS * 64) = o4; *(f32x4*)(base + 5 * TS * 64) = o5; } while (0)
  f32x2 SA = {0.f, 0.f}, SB = {0.f, 0.f};
  __syncthreads();
  RW_LOAD(0); RW_WRITE(0);
  __syncthreads();
  constexpr int NCH = 2304 / TS;
#pragma unroll 1
  for (int c = 0; c < NCH; ++c) {
    if (c + 1 < NCH) RW_LOAD(c + 1);
    const float* base = sb + (c & 1) * 6 * TS * 64 + kq * 4; const float* vbase = sb + (c & 1) * 6 * TS * 64 + 5 * TS * 64 + half * 32 + rl;
    f32x4 w4 = *(const f32x4*)(base), kh4 = *(const f32x4*)(base + TS * 64), ab4 = *(const f32x4*)(base + 2 * TS * 64), kt4 = *(const f32x4*)(base + 3 * TS * 64), r4 = *(const f32x4*)(base + 4 * TS * 64);
    float vv = vbase[0];
#pragma unroll
    for (int ts = 0; ts < TS; ++ts) {
      f32x4 nw4 = w4, nkh4 = kh4, nab4 = ab4, nkt4 = kt4, nr4 = r4; float nvv = vv;
      if (ts + 1 < TS) { const float* bp = base + (ts + 1) * 64;
        nw4 = *(const f32x4*)(bp); nkh4 = *(const f32x4*)(bp + TS * 64); nab4 = *(const f32x4*)(bp + 2 * TS * 64); nkt4 = *(const f32x4*)(bp + 3 * TS * 64); nr4 = *(const f32x4*)(bp + 4 * TS * 64);
        nvv = vbase[(ts + 1) * 64]; }
      const f32x2 khA = {kh4[0], kh4[1]}, khB = {kh4[2], kh4[3]}, wA = {w4[0], w4[1]}, wB = {w4[2], w4[3]}, abA = {ab4[0], ab4[1]}, abB = {ab4[2], ab4[3]},
                  ktA = {kt4[0], kt4[1]}, ktB = {kt4[2], kt4[3]}, rA = {r4[0], r4[1]}, rB = {r4[2], r4[3]};
      f32x2 pa = SA * khA + SB * khB;
      float sa = row16_sum(pa[0] + pa[1]);
      const f32x2 vv2 = {vv, vv}, sa2 = {sa, sa};
      SA = SA * wA + (vv2 * ktA - sa2 * abA); SB = SB * wB + (vv2 * ktB - sa2 * abB);
      f32x2 py = SA * rA + SB * rB;
      float y = row16_sum(py[0] + py[1]);
      yb[ts * 32 + rl] = y;
      w4 = nw4; kh4 = nkh4; ab4 = nab4; kt4 = nkt4; r4 = nr4; vv = nvv;
    }
    __syncthreads();
    { const int ts = tid >> 4, pr = tid & 15; const int row = rw_rowof(dir, b, c * TS + ts);
      *(unsigned*)(WS(bf16_t, OFF_RWY) + ((size_t)dir * NTOK + row) * 384 + h6 * 64 + half * 32 + pr * 2) = pack2(yb[ts * 32 + pr * 2], yb[ts * 32 + pr * 2 + 1]); }
    if (c + 1 < NCH) RW_WRITE((c + 1) & 1);
    __syncthreads();
  }
#undef RW_LOAD
#undef RW_WRITE
}

DEV bf16x8 ld_frag16(const bf16_t* ptr) { return *(const bf16x8*)ptr; }
DEV bf16x8 ld_frag8x2(const bf16_t* p0, const bf16_t* p1) { const u32x2 x0 = *(const u32x2*)p0, x1 = *(const u32x2*)p1; u32x4 w; w[0] = x0[0]; w[1] = x0[1]; w[2] = x1[0]; w[3] = x1[1]; return __builtin_bit_cast(bf16x8, w); }
typedef short v4s16 __attribute__((ext_vector_type(4)));
template <int OFF> DEV u32x2 tr_read(unsigned addr) { return __builtin_bit_cast(u32x2, __builtin_amdgcn_ds_read_tr16_b64_v4i16((LAS v4s16*)(addr + (unsigned)OFF))); }
DEV bf16x8 frag_lo(u32x2 lo) { u32x4 w; w[0] = lo[0]; w[1] = lo[1]; w[2] = 0u; w[3] = 0u; return __builtin_bit_cast(bf16x8, w); }
DEV bf16x8 frag2(u32x2 lo, u32x2 hi) { u32x4 w; w[0] = lo[0]; w[1] = lo[1]; w[2] = hi[0]; w[3] = hi[1]; return __builtin_bit_cast(bf16x8, w); }
DEV u32x2 acc2bf(f32x4 a) { u32x2 w; w[0] = (unsigned)f2bf(a[0]) | ((unsigned)f2bf(a[1]) << 16); w[1] = (unsigned)f2bf(a[2]) | ((unsigned)f2bf(a[3]) << 16); return w; }
DEV void rwkv_chunk_unit(CParams& p, int l, int u, unsigned char* lds) {
  constexpr int O_A = 0, O_Q = 2176, O_NB = 4352, O_C = 6528, O_V = 8704, O_M1T = 10880, O_U1T = 11392, O_NU2T = 11904, O_TT = 12416, O_GAM = 12928, SCB = 13184, CHB = 4 * SCB;
  constexpr int O_PRIV = 2 * CHB, P_LW = 0, P_M2 = 4096, PRIV = 5120, O_CONST = O_PRIV + 4 * PRIV;
  const int chain = u, dir = chain / 48, bh = chain % 48, b = bh / 6, h6 = bh % 6;
  const int tid = TIDX(), lane = tid & 63, wid = tid >> 6, fr = lane & 15, fq = lane >> 4;
  float* cst = (float*)(lds + O_CONST);
  __syncthreads();
  if (tid < 64) { cst[tid] = p.in[I_RWW0][l * 768 + dir * 384 + h6 * 64 + tid]; cst[64 + tid] = p.in[I_RWA0][l * 768 + dir * 384 + h6 * 64 + tid]; cst[128 + tid] = p.in[I_RWKA][l * 384 + h6 * 64 + tid]; cst[192 + tid] = p.in[I_RWRK][l * 384 + h6 * 64 + tid]; }
  __syncthreads();
  const bool producer = wid >= 4;
  const int pj = wid - 4, pt = lane >> 2, pks = lane & 3;
  u32x4 in_r[2], in_k[2], in_kh[2], in_v[2], in_lw[2], in_a[2];
#define RC_LOAD(c) do { int lo32_ = h6 * 64 + pks * 16; asm volatile("" : "+v"(lo32_));   \
    const int row_ = rw_rowof(dir, b, (c) * 64 + pj * 16 + pt); const size_t o_ = (size_t)row_ * 384 + lo32_; \
    in_r[0] = ld8g(WS(bf16_t, OFF_RB) + o_); in_r[1] = ld8g(WS(bf16_t, OFF_RB) + o_ + 8); in_k[0] = ld8g(WS(bf16_t, OFF_KB) + o_); in_k[1] = ld8g(WS(bf16_t, OFF_KB) + o_ + 8); \
    in_kh[0] = ld8g(WS(bf16_t, OFF_KH) + o_); in_kh[1] = ld8g(WS(bf16_t, OFF_KH) + o_ + 8); in_v[0] = ld8g(WS(bf16_t, OFF_VB) + o_); in_v[1] = ld8g(WS(bf16_t, OFF_VB) + o_ + 8); \
    const bf16_t* lo_ = WS(bf16_t, OFF_LORA) + (size_t)row_ * 1920 + dir * 384 + lo32_; in_lw[0] = ld8g(lo_); in_lw[1] = ld8g(lo_ + 8); in_a[0] = ld8g(lo_ + 768); in_a[1] = ld8g(lo_ + 776); } while (0)
  f32x4 sacc[4];
#pragma unroll
  for (int i = 0; i < 4; ++i) sacc[i] = (f32x4){0.f, 0.f, 0.f, 0.f};
  if (producer) RC_LOAD(0);
#pragma unroll 1
  for (int c = -1; c < 36; ++c) {
    if (producer) {
      if (c + 1 < 36) {
        unsigned char* scb = lds + ((c + 1) & 1) * CHB + pj * SCB; unsigned char* prv = lds + O_PRIV + pj * PRIV;
        float r_[16], k_[16], kh_[16], lw_[16], aa_[16];
        unpack8(in_r[0], r_); unpack8(in_r[1], r_ + 8); unpack8(in_k[0], k_); unpack8(in_k[1], k_ + 8); unpack8(in_kh[0], kh_); unpack8(in_kh[1], kh_ + 8);
        unpack8(in_lw[0], lw_); unpack8(in_lw[1], lw_ + 8); unpack8(in_a[0], aa_); unpack8(in_a[1], aa_ + 8);
        const u32x4 vraw0 = in_v[0], vraw1 = in_v[1];
        float* LW = (float*)(prv + P_LW);
#pragma unroll
        for (int i = 0; i < 16; ++i) { const int col = pks * 16 + i; aa_[i] = sigmoidf_(cst[64 + col] + aa_[i]); lw_[i] = -0.60653065971f * sigmoidf_(cst[col] + lw_[i]); }
#pragma unroll
        for (int i = 0; i < 4; ++i) *(f32x4*)(LW + pt * 64 + pks * 16 + i * 4) = (f32x4){lw_[4 * i], lw_[4 * i + 1], lw_[4 * i + 2], lw_[4 * i + 3]};
        { bf16_t* Vp = (bf16_t*)(scb + O_V) + pt * 68 + pks * 16;
          *(u32x2*)(Vp) = (u32x2){vraw0[0], vraw0[1]}; *(u32x2*)(Vp + 4) = (u32x2){vraw0[2], vraw0[3]}; *(u32x2*)(Vp + 8) = (u32x2){vraw1[0], vraw1[1]}; *(u32x2*)(Vp + 12) = (u32x2){vraw1[2], vraw1[3]}; }
        asm volatile("s_waitcnt lgkmcnt(0)" ::: "memory"); __builtin_amdgcn_wave_barrier();
        { float g = 0.f;
#pragma unroll
          for (int t = 0; t < 16; ++t) { g += LW[t * 64 + lane]; LW[t * 64 + lane] = g; }
          ((float*)(scb + O_GAM))[lane] = __expf(g); }
        asm volatile("s_waitcnt lgkmcnt(0)" ::: "memory"); __builtin_amdgcn_wave_barrier();
        { float av[16], bv[16], cv[16], qv[16];
#pragma unroll
          for (int i = 0; i < 4; ++i) { const f32x4 g4 = *(const f32x4*)(LW + pt * 64 + pks * 16 + i * 4);
#pragma unroll
            for (int jj = 0; jj < 4; ++jj) { const int e = 4 * i + jj; const float G = g4[jj], e1 = __expf(G), e2 = __expf(-G), e3 = __expf(G - lw_[e]);
              const float ab = kh_[e] * aa_[e], kt = k_[e] * (1.f + (aa_[e] - 1.f) * cst[128 + pks * 16 + e]);
              av[e] = kh_[e] * e3; bv[e] = ab * e2; cv[e] = kt * e2; qv[e] = r_[e] * e1; } }
          bf16_t* Ap = (bf16_t*)(scb + O_A) + pt * 68 + pks * 16; bf16_t* Qp = (bf16_t*)(scb + O_Q) + pt * 68 + pks * 16;
          bf16_t* Bp = (bf16_t*)(scb + O_NB) + pt * 68 + pks * 16; bf16_t* Cp = (bf16_t*)(scb + O_C) + pt * 68 + pks * 16;
#pragma unroll
          for (int i = 0; i < 4; ++i) { u32x2 w; w[0] = pack2(av[4 * i], av[4 * i + 1]); w[1] = pack2(av[4 * i + 2], av[4 * i + 3]); *(u32x2*)(Ap + 4 * i) = w;
            w[0] = pack2(qv[4 * i], qv[4 * i + 1]); w[1] = pack2(qv[4 * i + 2], qv[4 * i + 3]); *(u32x2*)(Qp + 4 * i) = w;
            w[0] = pack2(-bv[4 * i], -bv[4 * i + 1]); w[1] = pack2(-bv[4 * i + 2], -bv[4 * i + 3]); *(u32x2*)(Bp + 4 * i) = w;
            w[0] = pack2(cv[4 * i], cv[4 * i + 1]); w[1] = pack2(cv[4 * i + 2], cv[4 * i + 3]); *(u32x2*)(Cp + 4 * i) = w; } }
        asm volatile("s_waitcnt lgkmcnt(0)" ::: "memory"); __builtin_amdgcn_wave_barrier();
        if (c + 2 < 36) RC_LOAD(c + 2);
        {
          f32x4 mBA = {0.f, 0.f, 0.f, 0.f}, mCA = mBA, mBQ = mBA, mCQ = mBA;
#pragma unroll
          for (int ks = 0; ks < 2; ++ks) { const int ko = fr * 68 + ks * 32 + fq * 8;
            const bf16_t* bp = (const bf16_t*)(scb + O_NB) + ko; const bf16_t* cp = (const bf16_t*)(scb + O_C) + ko;   const bf16_t* ap = (const bf16_t*)(scb + O_A) + ko; const bf16_t* qp = (const bf16_t*)(scb + O_Q) + ko;
            const bf16x8 fb = ld_frag8x2(bp, bp + 4), fc = ld_frag8x2(cp, cp + 4), fa = ld_frag8x2(ap, ap + 4), fqv = ld_frag8x2(qp, qp + 4);
            mBA = __builtin_amdgcn_mfma_f32_16x16x32_bf16(fb, fa, mBA, 0, 0, 0); mCA = __builtin_amdgcn_mfma_f32_16x16x32_bf16(fc, fa, mCA, 0, 0, 0);
            mBQ = __builtin_amdgcn_mfma_f32_16x16x32_bf16(fb, fqv, mBQ, 0, 0, 0); mCQ = __builtin_amdgcn_mfma_f32_16x16x32_bf16(fc, fqv, mCQ, 0, 0, 0); }
          float* M2 = (float*)(prv + P_M2); float m1[4], u1[4], u2[4];
#pragma unroll
          for (int j = 0; j < 4; ++j) { const int s_ = 4 * fq + j; M2[s_ * 16 + fr] = s_ < fr ? -mBA[j] : 0.f; m1[j] = s_ < fr ? mCA[j] : 0.f; u1[j] = s_ <= fr ? mCQ[j] : 0.f; u2[j] = s_ <= fr ? mBQ[j] : 0.f; }
          u32x2 w; w[0] = pack2(m1[0], m1[1]); w[1] = pack2(m1[2], m1[3]); *(u32x2*)((bf16_t*)(scb + O_M1T) + fr * 16 + 4 * fq) = w;
          w[0] = pack2(u1[0], u1[1]); w[1] = pack2(u1[2], u1[3]); *(u32x2*)((bf16_t*)(scb + O_U1T) + fr * 16 + 4 * fq) = w;
          w[0] = pack2(u2[0], u2[1]); w[1] = pack2(u2[2], u2[3]); *(u32x2*)((bf16_t*)(scb + O_NU2T) + fr * 16 + 4 * fq) = w; }
        asm volatile("s_waitcnt lgkmcnt(0)" ::: "memory"); __builtin_amdgcn_wave_barrier();
        {
          const float* M2 = (const float*)(prv + P_M2); float Tc[16];
#pragma unroll
          for (int s_ = 15; s_ >= 0; --s_) { float x0 = (fr == s_) ? 1.f : 0.f, x1 = 0.f;
#pragma unroll
            for (int j = s_ + 1; j < 16; ++j) { if (j & 1) x1 -= M2[s_ * 16 + j] * Tc[j]; else x0 -= M2[s_ * 16 + j] * Tc[j]; }
            Tc[s_] = x0 + x1; }
          if (fq == 0) { bf16_t* TT = (bf16_t*)(scb + O_TT) + fr * 16; *(u32x4*)TT = pack8(Tc); *(u32x4*)(TT + 8) = pack8(Tc + 8); } }
      }
    } else if (c >= 0) {
      const int v0 = wid * 16;
      const int bt = lane >> 2, bks = lane & 3, brow = rw_rowof(dir, b, c * 64 + wid * 16 + bt);
      u32x4 b_r0, b_r1, b_k0, b_k1, b_a0, b_a1;
      { int bc = h6 * 64 + bks * 16; asm volatile("" : "+v"(bc)); const size_t bo = (size_t)brow * 384 + bc; const bf16_t* blo = WS(bf16_t, OFF_LORA) + (size_t)brow * 1920 + dir * 384 + bc + 768;
        b_r0 = ld8g(WS(bf16_t, OFF_RB) + bo); b_r1 = ld8g(WS(bf16_t, OFF_RB) + bo + 8); b_k0 = ld8g(WS(bf16_t, OFF_KB) + bo); b_k1 = ld8g(WS(bf16_t, OFF_KB) + bo + 8); b_a0 = ld8g(blo); b_a1 = ld8g(blo + 8); }
      f32x4 cvv[8]; int cm = (u * 4 + wid) * 36 + c; asm volatile("" : "+v"(cm));
      { const int ce = (cm & 8191) * 2 + (lane >> 5); const float* csrc = p.in[(cm >> 13) ? I_PV : I_PU] + ((size_t)l * 16384 + ce) * 1024 + (lane & 31) * 32;
#pragma unroll
        for (int i = 0; i < 8; ++i) cvv[i] = *(const f32x4*)(csrc + i * 4); }
#pragma unroll 1
      for (int j = 0; j < 4; ++j) { const unsigned char* scb = lds + (c & 1) * CHB + j * SCB;
        bf16x8 sb[2];
#pragma unroll
        for (int ks = 0; ks < 2; ++ks) sb[ks] = frag2(acc2bf(sacc[2 * ks]), acc2bf(sacc[2 * ks + 1]));
        const unsigned trl = (unsigned)(uintptr_t)scb + (unsigned)((4 * fq + (fr >> 2)) * 136 + (fr & 3) * 8);
        const bf16x8 vt = frag_lo(tr_read<0>(trl + O_V + v0 * 2));
        const bf16_t* Ar = (const bf16_t*)(scb + O_A) + fr * 68 + 4 * fq; const bf16_t* Qr = (const bf16_t*)(scb + O_Q) + fr * 68 + 4 * fq;
        f32x4 racc = {0.f, 0.f, 0.f, 0.f}, yacc = racc;
#pragma unroll
        for (int ks = 0; ks < 2; ++ks) { racc = __builtin_amdgcn_mfma_f32_16x16x32_bf16(ld_frag8x2(Ar + 32 * ks, Ar + 32 * ks + 16), sb[ks], racc, 0, 0, 0);
          yacc = __builtin_amdgcn_mfma_f32_16x16x32_bf16(ld_frag8x2(Qr + 32 * ks, Qr + 32 * ks + 16), sb[ks], yacc, 0, 0, 0); }
        racc = __builtin_amdgcn_mfma_f32_16x16x32_bf16(frag_lo(*(const u32x2*)((const bf16_t*)(scb + O_M1T) + fr * 16 + 4 * fq)), vt, racc, 0, 0, 0);
        yacc = __builtin_amdgcn_mfma_f32_16x16x32_bf16(frag_lo(*(const u32x2*)((const bf16_t*)(scb + O_U1T) + fr * 16 + 4 * fq)), vt, yacc, 0, 0, 0);
        f32x4 zacc = {0.f, 0.f, 0.f, 0.f};
        zacc = __builtin_amdgcn_mfma_f32_16x16x32_bf16(frag_lo(*(const u32x2*)((const bf16_t*)(scb + O_TT) + fr * 16 + 4 * fq)), frag_lo(acc2bf(racc)), zacc, 0, 0, 0);
        const bf16x8 zf = frag_lo(acc2bf(zacc));
        yacc = __builtin_amdgcn_mfma_f32_16x16x32_bf16(frag_lo(*(const u32x2*)((const bf16_t*)(scb + O_NU2T) + fr * 16 + 4 * fq)), zf, yacc, 0, 0, 0);
        const float* gam = (const float*)(scb + O_GAM);
#pragma unroll
        for (int kt = 0; kt < 4; ++kt) {
          sacc[kt] = __builtin_amdgcn_mfma_f32_16x16x32_bf16(frag_lo(tr_read<0>(trl + O_C + kt * 32)), vt, sacc[kt], 0, 0, 0);
          sacc[kt] = __builtin_amdgcn_mfma_f32_16x16x32_bf16(frag_lo(tr_read<0>(trl + O_NB + kt * 32)), zf, sacc[kt], 0, 0, 0);
          sacc[kt] *= *(const f32x4*)(gam + kt * 16 + 4 * fq); }
#pragma unroll
        for (int jj = 0; jj < 4; ++jj) { const int row = rw_rowof(dir, b, c * 64 + j * 16 + 4 * fq + jj);
          WS(bf16_t, OFF_RWY)[((size_t)dir * NTOK + row) * 384 + h6 * 64 + v0 + fr] = f2bf(yacc[jj]); } }
      { float r_[16], k_[16], a_[16]; unpack8(b_r0, r_); unpack8(b_r1, r_ + 8); unpack8(b_k0, k_); unpack8(b_k1, k_ + 8); unpack8(b_a0, a_); unpack8(b_a1, a_ + 8);
        float s = 0.f;
#pragma unroll
        for (int i = 0; i < 16; ++i) { const int col = bks * 16 + i; const float a = sigmoidf_(cst[64 + col] + a_[i]); s += r_[i] * cst[192 + col] * (k_[i] * (1.f + (a - 1.f) * cst[128 + col])); }
        s += dppf<0xB1>(s); s += dppf<0x4E>(s);
        if (bks == 0) WS(float, OFF_BS)[((size_t)dir * NTOK + brow) * 6 + h6] = s; }
      { const int tb = cm >> 13, ce = (cm & 8191) * 2 + (lane >> 5), cseg = lane & 31; const float scl = tb ? 4.f : 64.f;
        unsigned char* dst = WS(unsigned char, tb ? OFF_TABV : OFF_TABU) + ((size_t)(cseg >> 3) * 16384 + ce) * 128 + (cseg & 7) * 16;
        u32x4 w0;
#pragma unroll
        for (int i = 0; i < 4; ++i) { const f32x4 a = cvv[2 * i] * scl, b2 = cvv[2 * i + 1] * scl; unsigned w = 0u;
          w = __builtin_amdgcn_cvt_scalef32_pk_fp4_f32(w, a[0], a[1], 1.0f, 0); w = __builtin_amdgcn_cvt_scalef32_pk_fp4_f32(w, a[2], a[3], 1.0f, 1);
          w = __builtin_amdgcn_cvt_scalef32_pk_fp4_f32(w, b2[0], b2[1], 1.0f, 2); w = __builtin_amdgcn_cvt_scalef32_pk_fp4_f32(w, b2[2], b2[3], 1.0f, 3);
          w0[i] = w; }
        *(u32x4*)dst = w0; }
    }
    __syncthreads();
  }
#undef RC_LOAD
}

DEV void attn_unit(CParams& p, int u, unsigned char* lds) {
  int b, head, qrow0, ntile; const bool lat = u < 384;
  if (lat) { b = u / 48; const int r = u % 48; head = r / 8; const int qb = r % 8; qrow0 = NCTXR + b * 2048 + qb * 256; ntile = 36; }
  else { const int v = u - 384; b = v / 6; head = v % 6; qrow0 = b * 256; ntile = 4; }
  const int tid = TIDX(), lane = tid & 63, wid = tid >> 6, r32 = lane & 31, hi = lane >> 5;
  constexpr int KROW = 208, VROW = 192, KT_B = 64 * KROW, VT_B = 64 * VROW, BUF_B = KT_B + VT_B;
  const bf16_t* KVp = WS(bf16_t, OFF_KV) + head * 128; const bf16_t* KRp = WS(bf16_t, OFF_KR);
  const int qrow = qrow0 + wid * 32 + r32;
  bf16x8 qf[6];
  { const bf16_t* qp = WS(bf16_t, OFF_QB) + (size_t)qrow * 576 + head * 96 + hi * 8;
    const float SC = 0.10206207262f * 1.44269504089f;
    const int t = lat ? ((qrow - NCTXR) & 2047) : 0;
#pragma unroll
    for (int ks = 0; ks < 6; ++ks) { float f[8]; unpack8(ld8g(qp + ks * 16), f);
      if (ks >= 4) { float pt[8];
#pragma unroll
        for (int j = 0; j < 8; ++j) { auto rr = __builtin_amdgcn_permlane32_swap(__float_as_uint(f[j]), __float_as_uint(f[j]), false, false); pt[j] = __uint_as_float(hi ? rr[0] : rr[1]); }
        if (lat) { const int pos = ks == 4 ? (t >> 6) : (t & 63);
#pragma unroll
          for (int j = 0; j < 8; ++j) { const float invf = __expf(-(float)j * (9.210340372f / 8.f)); float rev = (float)pos * invf * 0.15915494309f; rev -= floorf(rev);
            const float sn = __builtin_amdgcn_sinf(rev), cs = __builtin_amdgcn_cosf(rev);
            f[j] = hi ? f[j] * cs + pt[j] * sn : f[j] * cs - pt[j] * sn; } } }
#pragma unroll
      for (int j = 0; j < 8; ++j) f[j] *= SC;
      qf[ks] = __builtin_bit_cast(bf16x8, pack8(f)); } }
  const int k0key = tid / 12, k0part = tid % 12, k1key = (tid + 512) / 12, k1part = (tid + 512) % 12, vkey = tid >> 3, vpart = tid & 7;
  u32x4 skA0, skA1 = {0u, 0u, 0u, 0u}, svA, skB0, skB1 = {0u, 0u, 0u, 0u}, svB;
#define AT_ROW0(kt) (lat ? ((kt) < 32 ? NCTXR + b * 2048 + (kt) * 64 : b * 256 + ((kt) - 32) * 64) : b * 256 + (kt) * 64)
#define AT_LOAD(kt, sk0, sk1, sv) do { const int r0_ = AT_ROW0(kt); \
    sk0 = k0part < 8 ? ld8g(KVp + (size_t)(r0_ + k0key) * 768 + k0part * 8) : ld8g(KRp + (size_t)(r0_ + k0key) * 32 + (k0part - 8) * 8); \
    if (tid < 256) sk1 = k1part < 8 ? ld8g(KVp + (size_t)(r0_ + k1key) * 768 + k1part * 8) : ld8g(KRp + (size_t)(r0_ + k1key) * 32 + (k1part - 8) * 8); \
    sv = ld8g(KVp + (size_t)(r0_ + vkey) * 768 + 64 + vpart * 8); } while (0)
#define AT_WRITE(bi, sk0, sk1, sv) do { unsigned char* bb = lds + (bi) * BUF_B; *(u32x4*)(bb + k0key * KROW + k0part * 16) = sk0; \
    if (tid < 256) *(u32x4*)(bb + k1key * KROW + k1part * 16) = sk1; *(u32x4*)(bb + KT_B + vkey * VROW + vpart * 16) = sv; } while (0)
  const unsigned trb = (unsigned)(uintptr_t)lds + KT_B + ((4 * (lane >> 5) + ((lane & 15) >> 2)) * VROW + (16 * ((lane >> 4) & 1) + 4 * (lane & 3)) * 2);
  f32x16 o0, o1;
#pragma unroll
  for (int i = 0; i < 16; ++i) { o0[i] = 0.f; o1[i] = 0.f; }
  float m_run = -1e30f, l_run = 0.f;
  __syncthreads();
  AT_LOAD(0, skA0, skA1, svA); AT_LOAD(1, skB0, skB1, svB);
  AT_WRITE(0, skA0, skA1, svA); AT_WRITE(1, skB0, skB1, svB);
  if (2 < ntile) AT_LOAD(2, skA0, skA1, svA);
  if (3 < ntile) AT_LOAD(3, skB0, skB1, svB);
  __syncthreads();
  f32x16 sa0, sa1, sb0, sb1;
#define AT_KF(kb_, ks) *(const bf16x8*)((kb_) + r32 * KROW + ((ks) * 16 + hi * 8) * 2), *(const bf16x8*)((kb_) + (32 + r32) * KROW + ((ks) * 16 + hi * 8) * 2)
  { const unsigned char* kb = lds;
#pragma unroll
    for (int i = 0; i < 16; ++i) { sa0[i] = 0.f; sa1[i] = 0.f; }
#pragma unroll
    for (int ks = 0; ks < 6; ++ks) { const bf16x8 a0 = *(const bf16x8*)(kb + r32 * KROW + (ks * 16 + hi * 8) * 2), a1 = *(const bf16x8*)(kb + (32 + r32) * KROW + (ks * 16 + hi * 8) * 2);
      sa0 = __builtin_amdgcn_mfma_f32_32x32x16_bf16(a0, qf[ks], sa0, 0, 0, 0); sa1 = __builtin_amdgcn_mfma_f32_32x32x16_bf16(a1, qf[ks], sa1, 0, 0, 0); } }
  auto step = [&](f32x16& c0, f32x16& c1, f32x16& n0, f32x16& n1, const int bufv, const int bufk) {
    const unsigned char* kb = lds + bufk * BUF_B;
    const unsigned ta = trb + (unsigned)(bufv * BUF_B);
#define TR(st, rd, eb) tr_read<(st) * 16 * VROW + (rd) * 8 * VROW + (eb) * 64>(ta)
    const u32x2 t00 = TR(0, 0, 0), t01 = TR(0, 1, 0), t10 = TR(1, 0, 0), t11 = TR(1, 1, 0), t20 = TR(2, 0, 0), t21 = TR(2, 1, 0), t30 = TR(3, 0, 0), t31 = TR(3, 1, 0);
    const u32x2 u00 = TR(0, 0, 1), u01 = TR(0, 1, 1), u10 = TR(1, 0, 1), u11 = TR(1, 1, 1), u20 = TR(2, 0, 1), u21 = TR(2, 1, 1), u30 = TR(3, 0, 1), u31 = TR(3, 1, 1);
#undef TR
#define QK(ks) do { const bf16x8 a0_ = *(const bf16x8*)(kb + r32 * KROW + ((ks) * 16 + hi * 8) * 2), a1_ = *(const bf16x8*)(kb + (32 + r32) * KROW + ((ks) * 16 + hi * 8) * 2); \
      n0 = __builtin_amdgcn_mfma_f32_32x32x16_bf16(a0_, qf[ks], n0, 0, 0, 0); n1 = __builtin_amdgcn_mfma_f32_32x32x16_bf16(a1_, qf[ks], n1, 0, 0, 0); } while (0)
#pragma unroll
    for (int i = 0; i < 16; ++i) { n0[i] = 0.f; n1[i] = 0.f; }
    QK(0);
    __builtin_amdgcn_sched_barrier(0);
    float mx = fmaxf(fmaxf(c0[0], c0[1]), c0[2]);
#pragma unroll
    for (int i = 3; i < 15; i += 2) mx = fmaxf(fmaxf(mx, c0[i]), c0[i + 1]);
    mx = fmaxf(fmaxf(mx, c0[15]), c1[0]);
    __builtin_amdgcn_sched_barrier(0);
    QK(1);
    __builtin_amdgcn_sched_barrier(0);
#pragma unroll
    for (int i = 1; i < 15; i += 2) mx = fmaxf(fmaxf(mx, c1[i]), c1[i + 1]);
    mx = fmaxf(mx, c1[15]);
    mx = xhalf_max(mx);
    if (__builtin_amdgcn_ballot_w64(mx > m_run + 8.f) != 0ull) {
      const float mnew = fmaxf(m_run, mx), alpha = __builtin_amdgcn_exp2f(m_run - mnew); const f32x2 al2 = {alpha, alpha};
      m_run = mnew; l_run *= alpha;
#pragma unroll
      for (int i = 0; i < 8; ++i) { f32x2 a = {o0[2 * i], o0[2 * i + 1]}, b2 = {o1[2 * i], o1[2 * i + 1]}; a *= al2; b2 *= al2; o0[2 * i] = a[0]; o0[2 * i + 1] = a[1]; o1[2 * i] = b2[0]; o1[2 * i + 1] = b2[1]; } }
    const f32x2 mm = {m_run, m_run}; f32x2 ps2 = {0.f, 0.f};
    bf16x8 pf[4];
#define SMX(cc, base, pi) do { u32x4 w_; _Pragma("unroll") for (int i_ = 0; i_ < 4; ++i_) { f32x2 a_ = {cc[base + 2 * i_], cc[base + 2 * i_ + 1]}; a_ -= mm; \
        a_[0] = __builtin_amdgcn_exp2f(a_[0]); a_[1] = __builtin_amdgcn_exp2f(a_[1]); ps2 += a_; w_[i_] = pack2(a_[0], a_[1]); } pf[pi] = __builtin_bit_cast(bf16x8, w_); } while (0)
    __builtin_amdgcn_sched_barrier(0);
    QK(2);
    __builtin_amdgcn_sched_barrier(0);
    SMX(c0, 0, 0);
    __builtin_amdgcn_sched_barrier(0);
    QK(3);
    __builtin_amdgcn_sched_barrier(0);
    SMX(c0, 8, 1);
    __builtin_amdgcn_sched_barrier(0);
    QK(4);
    __builtin_amdgcn_sched_barrier(0);
    SMX(c1, 0, 2);
    __builtin_amdgcn_sched_barrier(0);
    QK(5);
    __builtin_amdgcn_sched_barrier(0);
    SMX(c1, 8, 3);
    l_run += ps2[0] + ps2[1];
#undef SMX
#undef QK
    __builtin_amdgcn_sched_barrier(0);
#define VF(lo, hi_) __builtin_bit_cast(bf16x8, (u32x4){lo[0], lo[1], hi_[0], hi_[1]})
    o0 = __builtin_amdgcn_mfma_f32_32x32x16_bf16(VF(t00, t01), pf[0], o0, 0, 0, 0); o1 = __builtin_amdgcn_mfma_f32_32x32x16_bf16(VF(u00, u01), pf[0], o1, 0, 0, 0);
    o0 = __builtin_amdgcn_mfma_f32_32x32x16_bf16(VF(t10, t11), pf[1], o0, 0, 0, 0); o1 = __builtin_amdgcn_mfma_f32_32x32x16_bf16(VF(u10, u11), pf[1], o1, 0, 0, 0);
    o0 = __builtin_amdgcn_mfma_f32_32x32x16_bf16(VF(t20, t21), pf[2], o0, 0, 0, 0); o1 = __builtin_amdgcn_mfma_f32_32x32x16_bf16(VF(u20, u21), pf[2], o1, 0, 0, 0);
    o0 = __builtin_amdgcn_mfma_f32_32x32x16_bf16(VF(t30, t31), pf[3], o0, 0, 0, 0); o1 = __builtin_amdgcn_mfma_f32_32x32x16_bf16(VF(u30, u31), pf[3], o1, 0, 0, 0);
#undef VF
  };
  int bv = 0;
#pragma unroll 1
  for (int kt = 0; kt < ntile; kt += 2) {
    { const int b1 = bv == 2 ? 0 : bv + 1, b2 = b1 == 2 ? 0 : b1 + 1;
      __syncthreads();
      if (kt + 2 < ntile) { AT_WRITE(b2, skA0, skA1, svA); if (kt + 4 < ntile) AT_LOAD(kt + 4, skA0, skA1, svA); }
      step(sa0, sa1, sb0, sb1, bv, b1);
      bv = b1; }
    { const int b1 = bv == 2 ? 0 : bv + 1, b2 = b1 == 2 ? 0 : b1 + 1;
      __syncthreads();
      if (kt + 3 < ntile) { AT_WRITE(b2, skB0, skB1, svB); if (kt + 5 < ntile) AT_LOAD(kt + 5, skB0, skB1, svB); }
      step(sb0, sb1, sa0, sa1, bv, b1);
      bv = b1; }
  }
#undef AT_KF
#undef AT_LOAD
#undef AT_WRITE
#undef AT_ROW0
  const float inv = 1.f / xhalf_sum(l_run);
  bf16_t* op = WS(bf16_t, OFF_H) + (size_t)qrow * 1024 + 640 + head * 64;
#pragma unroll
  for (int g = 0; g < 4; ++g) {
    u32x2 w; w[0] = pack2(o0[4 * g] * inv, o0[4 * g + 1] * inv); w[1] = pack2(o0[4 * g + 2] * inv, o0[4 * g + 3] * inv); *(u32x2*)(op + 8 * g + 4 * hi) = w;
    w[0] = pack2(o1[4 * g] * inv, o1[4 * g + 1] * inv); w[1] = pack2(o1[4 * g + 2] * inv, o1[4 * g + 3] * inv); *(u32x2*)(op + 32 + 8 * g + 4 * hi) = w; }
}

DEV void mlstm_out_unit(CParams& p, int l, int chunk, int hd, unsigned char* lds) {
  const ChunkInfo c = chunk_info(chunk);
  bf16_t* Ql = (bf16_t*)lds;
  bf16_t* Kl = (bf16_t*)(lds + 9216);
  bf16_t* VTl = (bf16_t*)(lds + 18432);
  bf16_t* Cl = (bf16_t*)(lds + 18432 + 10880);
  float* sc = (float*)(lds + 18432 + 10880 + 23040);
  float* rowterm = sc; float* uarr = sc + 128; float* winter = sc + 256; float* emt = sc + 384; float* lnred = sc + 512;
  const int tid = TIDX(), lane = tid & 63, wid = tid >> 6, fr = lane & 15, fq = lane >> 4;
  __syncthreads();
  { const int t = tid >> 3, seg = tid & 7;
    *(u32x4*)(Ql + t * 72 + seg * 8) = ld8g(WS(bf16_t, OFF_MQ) + (size_t)(c.row0 + t) * 256 + hd * 64 + seg * 8);
    *(u32x4*)(Kl + t * 72 + seg * 8) = ld8g(WS(bf16_t, OFF_MK) + (size_t)(c.row0 + t) * 256 + hd * 64 + seg * 8);
    const u32x4 vv = ld8g(WS(bf16_t, OFF_MVT) + ((size_t)(chunk * 4 + hd) * 64 + t) * 64 + seg * 8);
    u32x2 a, b2; a[0] = vv[0]; a[1] = vv[1]; b2[0] = vv[2]; b2[1] = vv[3]; *(u32x2*)(VTl + t * 68 + seg * 8) = a; *(u32x2*)(VTl + t * 68 + seg * 8 + 4) = b2;
    if (tid < 64) VTl[64 * 68 + tid] = (bf16_t)0x3F80u;
    for (int i = tid; i < 15 * 68; i += NTHREADS) VTl[65 * 68 + i] = 0;
#pragma unroll
    for (int dir = 0; dir < 2; ++dir) { const int chain = dir * 32 + c.b * 4 + hd, pc = ml_pc(c, dir); const bf16_t* st = WS(bf16_t, OFF_ST) + (size_t)(chain * 36 + pc) * 5120;
      *(u32x4*)(Cl + dir * 80 * 72 + (tid >> 3) * 72 + (tid & 7) * 8) = ld8g(st + tid * 8);
      if (tid < 128) *(u32x4*)(Cl + dir * 80 * 72 + ((512 + tid) >> 3) * 72 + (tid & 7) * 8) = ld8g(st + (512 + tid) * 8); } }
  if (tid < 128) { const int dir = tid >> 6, t = dir ? 63 - lane : lane, row = c.row0 + t;
    const int chain = dir * 32 + c.b * 4 + hd, pc = ml_pc(c, dir);
    const float li = WS(float, OFF_GLI)[(size_t)(dir * 4 + hd) * NTOK + row], lf = WS(float, OFF_GLF)[(size_t)(dir * 4 + hd) * NTOK + row];
    const float ms = WS(float, OFF_SCMB)[chain * 36 + pc];
    const float bc = scan_sum64(lf, lane);
    const float uu = li - bc; const float pm = scan_max64(uu, lane);
    const float mt = fmaxf(bc + ms, bc + pm);
    rowterm[dir * 64 + t] = bc - mt; uarr[dir * 64 + t] = uu; winter[dir * 64 + t] = __expf(bc + ms - mt); emt[dir * 64 + t] = __expf(-mt); }
  __syncthreads();
  const int tt = wid & 3, eh = wid >> 2, t = tt * 16 + fr;
  bf16x8 qfr[2];
#pragma unroll
  for (int ks = 0; ks < 2; ++ks) qfr[ks] = ld_frag16(Ql + t * 72 + ks * 32 + fq * 8);
  f32x4 g[4];
#pragma unroll
  for (int st = 0; st < 4; ++st) { g[st] = (f32x4){0.f, 0.f, 0.f, 0.f};
#pragma unroll
    for (int ks = 0; ks < 2; ++ks) g[st] = __builtin_amdgcn_mfma_f32_16x16x32_bf16(ld_frag16(Kl + (st * 16 + fr) * 72 + ks * 32 + fq * 8), qfr[ks], g[st], 0, 0, 0); }
  const int et0 = eh * 2;
  float hsum[2][4];
#pragma unroll
  for (int a = 0; a < 2; ++a)
#pragma unroll
    for (int j = 0; j < 4; ++j) hsum[a][j] = 0.f;
#pragma unroll
  for (int dir = 0; dir < 2; ++dir) {
    const float rt = rowterm[dir * 64 + t], wi = winter[dir * 64 + t], em = emt[dir * 64 + t];
    bf16x8 pf[2];
#pragma unroll
    for (int kk = 0; kk < 2; ++kk) { float v[8];
#pragma unroll
      for (int hh = 0; hh < 2; ++hh)
#pragma unroll
        for (int j = 0; j < 4; ++j) { const int s = (2 * kk + hh) * 16 + fq * 4 + j; const bool valid = dir ? (s >= t) : (s <= t);
          const float e = __expf(rt + uarr[dir * 64 + s]); v[hh * 4 + j] = valid ? g[2 * kk + hh][j] * e : 0.f; }
      pf[kk] = __builtin_bit_cast(bf16x8, pack8(v)); }
    f32x4 acc[3];
#pragma unroll
    for (int a = 0; a < 3; ++a) { const int et = a < 2 ? et0 + a : 4; const bf16_t* crow = Cl + dir * 80 * 72 + (et * 16 + fr) * 72;
      f32x4 x = {0.f, 0.f, 0.f, 0.f};
#pragma unroll
      for (int ks = 0; ks < 2; ++ks) x = __builtin_amdgcn_mfma_f32_16x16x32_bf16(ld_frag16(crow + ks * 32 + fq * 8), qfr[ks], x, 0, 0, 0);
      x *= wi;
      const bf16_t* vrow = VTl + (et * 16 + fr) * 68;
#pragma unroll
      for (int kk = 0; kk < 2; ++kk) x = __builtin_amdgcn_mfma_f32_16x16x32_bf16(ld_frag8x2(vrow + 32 * kk + fq * 4, vrow + 32 * kk + 16 + fq * 4), pf[kk], x, 0, 0, 0);
      acc[a] = x; }
    const float den = bperm(fr, acc[2][0]);
    const float dinv = 1.f / fmaxf(fabsf(den), em);
#pragma unroll
    for (int a = 0; a < 2; ++a)
#pragma unroll
      for (int j = 0; j < 4; ++j) hsum[a][j] += acc[a][j] * dinv;
  }
  float s1 = 0.f, s2 = 0.f;
#pragma unroll
  for (int a = 0; a < 2; ++a)
#pragma unroll
    for (int j = 0; j < 4; ++j) { s1 += hsum[a][j]; s2 += hsum[a][j] * hsum[a][j]; }
  s1 += bperm(lane ^ 16, s1); s1 += bperm(lane ^ 32, s1); s2 += bperm(lane ^ 16, s2); s2 += bperm(lane ^ 32, s2);
  if (fq == 0) { lnred[(eh * 64 + t) * 2] = s1; lnred[(eh * 64 + t) * 2 + 1] = s2; }
  __syncthreads();
  { const float a1 = lnred[t * 2] + lnred[(64 + t) * 2], a2 = lnred[t * 2 + 1] + lnred[(64 + t) * 2 + 1];
    const float mean = a1 * (1.f / 64.f), var = fmaxf(a2 * (1.f / 64.f) - mean * mean, 0.f), rstd = rsqrtf(var + LN_EPS);
    const int row = c.row0 + t;
#pragma unroll
    for (int a = 0; a < 2; ++a) { const int e0 = (et0 + a) * 16 + fq * 4;
      const u32x2 ow = *(const u32x2*)(WS(bf16_t, OFF_MO) + (size_t)row * 256 + hd * 64 + e0);
      const float og[4] = {lo16(ow[0]), hi16(ow[0]), lo16(ow[1]), hi16(ow[1])};
      const f32x4 ng = *(const f32x4*)(p.in[I_MLNG] + l * 256 + hd * 64 + e0);
      float y[4];
#pragma unroll
      for (int j = 0; j < 4; ++j) y[j] = sigmoidf_(og[j]) * (hsum[a][j] - mean) * rstd * ng[j];
      u32x2 w; w[0] = pack2(y[0], y[1]); w[1] = pack2(y[2], y[3]);
      *(u32x2*)(WS(bf16_t, OFF_H) + (size_t)row * 1024 + hd * 64 + e0) = w; } }
}

DEV void ph_mix(CParams& p, int lx, unsigned char* lds) {
  const int l = lx & 1;
  constexpr int NRW = 96;
  const int n_att = l == 0 ? 432 : 384, n_ml = l == 0 ? 288 * 4 : 256 * 4, total = NRW + n_att + n_ml;
  unsigned* cnt = WS(unsigned, OFF_CNT) + 16 + lx; unsigned* slot = (unsigned*)(lds + LDS_BYTES - 16);
  for (;;) {
    __syncthreads();
    if (TIDX() == 0) *slot = atomicAdd(cnt, 1u);
    __syncthreads();
    const int u = (int)*slot; if (u >= total) break;
    if (u < NRW) { for (int r_ = 0; r_ < RWREP; ++r_) rwkv_chunk_unit(p, l, u, lds); }
    else if (u < NRW + n_att) { for (int r_ = 0; r_ < ATREP; ++r_) attn_unit(p, u - NRW, lds); }
    else { const int v = u - NRW - n_att; const int chunk = (l == 0 ? 0 : 32) + (v >> 2); for (int r_ = 0; r_ < MLREP; ++r_) mlstm_out_unit(p, l, chunk, v & 3, lds); }
  }
  __syncthreads();
}

DEV void ph_rwpost(CParams& p, int l) {
  const int tid = TIDX(), lane = tid & 63, gw = blockIdx.x * 8 + (tid >> 6), nw = gridDim.x * 8, sl = lane & 7;
  const int rowbase = l == 0 ? 0 : NCTXR, nitems = (NTOK - rowbase) * 6;
  for (int it0 = gw * 8; it0 < nitems; it0 += nw * 8) { const int it = it0 + (lane >> 3); const int row = rowbase + it / 6, h6 = it % 6, col = h6 * 64 + sl * 8; const size_t o = (size_t)row * 384 + col;
    const bf16_t* lo = WS(bf16_t, OFF_LORA) + (size_t)row * 1920 + col;
    const u32x4 wy0 = ld8g(WS(bf16_t, OFF_RWY) + o), wy1 = ld8g(WS(bf16_t, OFF_RWY) + (size_t)NTOK * 384 + o), wv = ld8g(WS(bf16_t, OFF_VB) + o), wg = ld8g(lo + 1536);
    const float bs = WS(float, OFF_BS)[(size_t)row * 6 + h6] + WS(float, OFF_BS)[((size_t)NTOK + row) * 6 + h6];
    float y[8], t1[8], t2[8];
    unpack8(wy0, y); unpack8(wy1, t1);
    float s = 0.f;
#pragma unroll
    for (int i = 0; i < 8; ++i) { y[i] += t1[i]; s += y[i]; }
    const float mean = grp8_sum(s) * (1.f / 64.f); float q = 0.f;
#pragma unroll
    for (int i = 0; i < 8; ++i) { y[i] -= mean; q += y[i] * y[i]; }
    const float rstd = rsqrtf(grp8_sum(q) * (1.f / 64.f) + 64e-5f);
    float v[8], g[8], o8[8]; unpack8(wv, v); unpack8(wg, g);
#pragma unroll
    for (int i = 0; i < 8; ++i) o8[i] = (y[i] * rstd * p.in[I_RWGNG][l * 384 + col + i] + p.in[I_RWGNB][l * 384 + col + i] + bs * v[i]) * g[i];
    *(u32x4*)(WS(bf16_t, OFF_H) + (size_t)row * 1024 + 256 + col) = pack8(o8); }
}

DEV void ph_gemm_in(CParams& p, int l, unsigned char* lds) {
  pg8::StaticOrder S; S.init(NTOK, NINP, gridDim.x, blockIdx.x);
  pg8::Gemm g{WS(bf16_t, OFF_H), WS(bf16_t, OFF_WIN) + (size_t)l * NINP * 1024, NTOK, NINP, 1024};
  EpiBf16 E{WS(bf16_t, OFF_P), NIN, NIN}; pg8::gemm_phase((LAS unsigned char*)lds, g, S, E);
}
DEV void gemm_out_rows(CParams& p, int l, int row0, int M, unsigned char* lds) {
  pg8::StaticOrder S; S.init(M, 1024, gridDim.x, blockIdx.x);
  pg8::Gemm g{WS(bf16_t, OFF_H) + (size_t)row0 * 1024, WS(bf16_t, OFF_WOUT) + (size_t)l * 1024 * 1024, M, 1024, 1024};
  EpiBf16 E{WS(bf16_t, OFF_Y) + (size_t)row0 * 1024, 1024, 1024}; pg8::gemm_phase((LAS unsigned char*)lds, g, S, E);
}
DEV void ph_gemm_out(CParams& p, int l, unsigned char* lds) { if (l == 0 && gridDim.x != 256) gemm_out_rows(p, 0, 0, NTOK, lds); else gemm_out_rows(p, l, NCTXR, NLAT, lds); }
DEV void ln1_rows(CParams& p, int l, int r0, int r1, unsigned char* lds);
DEV void ph_gemm_pq(CParams& p, int l, unsigned char* lds) {
  const bool split = l == 0 && gridDim.x == 256; const int rb = (l == 0 && !split) ? 0 : NCTXR, M = NTOK - rb;
  if (split) { ln1_rows(p, 0, (int)blockIdx.x * 8, (int)blockIdx.x * 8 + 8, lds); __syncthreads(); }
  pg8::StaticOrder S; S.init(M, 2048, gridDim.x, blockIdx.x);
  pg8::Gemm g{WS(bf16_t, OFF_H) + (size_t)rb * 1024, WS(bf16_t, OFF_WPQ) + (size_t)l * 2048 * 1024, M, 2048, 1024};
  EpiBf16 E{WS(bf16_t, OFF_QP) + (size_t)rb * 2048, 2048, 2048}; pg8::gemm_phase((LAS unsigned char*)lds, g, S, E);
}

DEV void stage_vec(float* dst, const float* src_) { const int tid = TIDX(); if (tid < 256) *(f32x4*)(dst + tid * 4) = *(const f32x4*)(src_ + tid * 4); }
DEV void ln1_rows(CParams& p, int l, int r0, int r1, unsigned char* lds) {
  const int tid = TIDX(), lane = tid & 63, wid = tid >> 6;
  float* pl = (float*)lds;
  for (int seg0 = r0; seg0 < r1;) { const int mr = modrow_of(seg0); int seg1 = mr == 8 ? NCTXR : NCTXR + (mr + 1) * 2048; if (seg1 > r1) seg1 = r1;
    const float* md = WS(float, OFF_MOD) + (size_t)(l * 9 + mr) * 6144;
    __syncthreads();
    if (tid < 256) { *(f32x4*)(pl + tid * 4) = *(const f32x4*)(md + 2048 + tid * 4); *(f32x4*)(pl + 1024 + tid * 4) = *(const f32x4*)(p.in[I_LNMG] + l * 1024 + tid * 4); *(f32x4*)(pl + 2048 + tid * 4) = *(const f32x4*)(p.in[I_LNMB] + l * 1024 + tid * 4); }
    else { const int t2 = tid - 256; *(f32x4*)(pl + 3072 + t2 * 4) = *(const f32x4*)(md + 4096 + t2 * 4); *(f32x4*)(pl + 4096 + t2 * 4) = *(const f32x4*)(md + 3072 + t2 * 4); }
    __syncthreads();
#pragma unroll 1
    for (int row = seg0 + wid; row < seg1; row += 8) {
      const float* xo = x_in_row(p, row); const bf16_t* xc = WS(bf16_t, OFF_XC) + (size_t)row * 1024; const bf16_t* yr = WS(bf16_t, OFF_Y) + (size_t)row * 1024;
      f32x4 v[4]; float s = 0.f;
#pragma unroll
      for (int i = 0; i < 4; ++i) { const int col = lane * 4 + 256 * i; const u32x2 yw = *(const u32x2*)(yr + col); const f32x4 yv = {lo16(yw[0]), hi16(yw[0]), lo16(yw[1]), hi16(yw[1])};
        f32x4 xv; if (l == 0) xv = *(const f32x4*)(xo + col); else { const u32x2 xw_ = *(const u32x2*)(xc + col); xv = (f32x4){lo16(xw_[0]), hi16(xw_[0]), lo16(xw_[1]), hi16(xw_[1])}; }
        v[i] = xv * ALPHA + *(const f32x4*)(pl + col) * yv; s += (v[i][0] + v[i][1]) + (v[i][2] + v[i][3]); }
      float mean = wave_sum(s) * (1.f / 1024.f), q = 0.f;
#pragma unroll
      for (int i = 0; i < 4; ++i) { v[i] -= mean; q += (v[i][0] * v[i][0] + v[i][1] * v[i][1]) + (v[i][2] * v[i][2] + v[i][3] * v[i][3]); }
      float rstd = rsqrtf(wave_sum(q) * (1.f / 1024.f) + LN_EPS);
      bf16_t* xw = WS(bf16_t, OFF_XC) + (size_t)row * 1024; s = 0.f;
#pragma unroll
      for (int i = 0; i < 4; ++i) { const int col = lane * 4 + 256 * i; v[i] = v[i] * rstd * *(const f32x4*)(pl + 1024 + col) + *(const f32x4*)(pl + 2048 + col);
        u32x2 wx; wx[0] = pack2(v[i][0], v[i][1]); wx[1] = pack2(v[i][2], v[i][3]); *(u32x2*)(xw + col) = wx;
        v[i] = (f32x4){lo16(wx[0]), hi16(wx[0]), lo16(wx[1]), hi16(wx[1])};
        s += (v[i][0] + v[i][1]) + (v[i][2] + v[i][3]); }
      mean = wave_sum(s) * (1.f / 1024.f); q = 0.f;
#pragma unroll
      for (int i = 0; i < 4; ++i) { v[i] -= mean; q += (v[i][0] * v[i][0] + v[i][1] * v[i][1]) + (v[i][2] * v[i][2] + v[i][3] * v[i][3]); }
      rstd = rsqrtf(wave_sum(q) * (1.f / 1024.f) + LN_EPS);
#pragma unroll
      for (int i = 0; i < 4; ++i) { const int col = lane * 4 + 256 * i; const f32x4 o = v[i] * rstd * (*(const f32x4*)(pl + 3072 + col) + 1.f) + *(const f32x4*)(pl + 4096 + col);
        u32x2 w; w[0] = pack2(o[0], o[1]); w[1] = pack2(o[2], o[3]); *(u32x2*)(WS(bf16_t, OFF_H) + (size_t)row * 1024 + col) = w; }
    }
    seg0 = seg1; }
  __syncthreads();
}

DEV void ph_ln1(CParams& p, int l, unsigned char* lds) {
  const int b = (int)blockIdx.x;
  if (l == 0 && gridDim.x != 256) { const int per = (NTOK + (int)gridDim.x - 1) / (int)gridDim.x, r0 = b * per; int r1 = r0 + per; if (r1 > NTOK) r1 = NTOK; if (r0 < NTOK) ln1_rows(p, 0, r0, r1, lds); }
  else if (l == 0) {
    if (b < 32) { gemm_out_rows(p, 0, 0, NCTXR, lds); __syncthreads(); }
    const int r0 = NCTXR + (b < 32 ? b * 4 : 128 + (b - 32) * 73); int r1 = r0 + (b < 32 ? 4 : 73); if (r1 > NTOK) r1 = NTOK;
    if (r0 < NTOK) ln1_rows(p, 0, r0, r1, lds);
  } else { const int per = (NLAT + (int)gridDim.x - 1) / (int)gridDim.x, r0 = NCTXR + b * per; int r1 = r0 + per; if (r1 > NTOK) r1 = NTOK; if (r0 < NTOK) ln1_rows(p, l, r0, r1, lds); }
}

DEV unsigned f2ord(float f) { const unsigned u = __float_as_uint(f); return (u >> 31) ? ~u : (u | 0x80000000u); }
DEV float ord2f(unsigned o) { return __uint_as_float((o >> 31) ? (o & 0x7fffffffu) : ~o); }
DEV unsigned dppu_max(unsigned x, unsigned y) { return x > y ? x : y; }
template <int CTRL> DEV unsigned dppu(unsigned x) { return (unsigned)__builtin_amdgcn_mov_dpp((int)x, CTRL, 0xf, 0xf, true); }
DEV void topk_unit(CParams& p, int l, int tile, int head, unsigned char* lds, const bf16x8 (&kf)[8][4]) {
  constexpr int RS = 136;
  unsigned* KEYSl = (unsigned*)lds;
  unsigned* LISTl = (unsigned*)(lds + 256 * RS * 4);
  const int tid = TIDX(), lane = tid & 63, wid = tid >> 6, fr = lane & 15, fq = lane >> 4;
  const int row0 = (l == 0 ? 0 : NCTXR) + tile * 128;
  __syncthreads();
  for (int r1_ = 0; r1_ < T1_REP; ++r1_)
  { const int g = head * 2 + (wid >> 2);
    const bf16_t* qp = WS(bf16_t, OFF_QP) + (size_t)(row0 + (wid & 3) * 32) * 2048 + g * 128 + fq * 8;
    bf16x8 af[2][4];
#pragma unroll
    for (int tm = 0; tm < 2; ++tm)
#pragma unroll
      for (int ks = 0; ks < 4; ++ks) af[tm][ks] = __builtin_bit_cast(bf16x8, ld8g(qp + (size_t)(tm * 16 + fr) * 2048 + ks * 32));
#pragma unroll
    for (int nt = 0; nt < 8; ++nt) { f32x4 a0 = {0.f, 0.f, 0.f, 0.f}, a1 = {0.f, 0.f, 0.f, 0.f};
#pragma unroll
      for (int ks = 0; ks < 4; ++ks) { a0 = __builtin_amdgcn_mfma_f32_16x16x32_bf16(kf[nt][ks], af[0][ks], a0, 0, 0, 0); a1 = __builtin_amdgcn_mfma_f32_16x16x32_bf16(kf[nt][ks], af[1][ks], a1, 0, 0, 0); }
      const int key0 = nt * 16 + fq * 4; const unsigned kb = 127u - (unsigned)key0; const int ko = key0 + (nt >= 4 ? 4 : 0);
      u32x4 w0, w1;
#pragma unroll
      for (int j = 0; j < 4; ++j) { w0[j] = (f2ord(a0[j]) & ~127u) | (kb - (unsigned)j); w1[j] = (f2ord(a1[j]) & ~127u) | (kb - (unsigned)j); }
      *(u32x4*)(KEYSl + (wid * 32 + fr) * RS + ko) = w0; *(u32x4*)(KEYSl + (wid * 32 + 16 + fr) * RS + ko) = w1; } }
  __syncthreads();
  for (int r2_ = 0; r2_ < T2_REP; ++r2_)
  { const int row = tid >> 1, hf = tid & 1; const unsigned* kr = KEYSl + row * RS + hf * 68; unsigned m[4];
#pragma unroll
    for (int sg = 0; sg < 4; ++sg) { unsigned mm = 0u;
#pragma unroll
      for (int i = 0; i < 4; ++i) { const u32x4 x = *(const u32x4*)(kr + sg * 16 + i * 4); mm = max(max(mm, x[0]), max(x[1], max(x[2], x[3]))); }
      m[sg] = mm; }
#pragma unroll 1
    for (int r = 0; r < 16; ++r) { const unsigned lb = max(max(m[0], m[1]), max(m[2], m[3])); const unsigned best = max(lb, dppu<0xB1>(lb));
      if (hf == 0) LISTl[row * 16 + r] = best;
      if (lb == best) { const int sg = ((int)(127u - (best & 127u)) >> 4) & 3; unsigned nm = 0u;
#pragma unroll
        for (int i = 0; i < 4; ++i) { const u32x4 x = *(const u32x4*)(kr + sg * 16 + i * 4);
#pragma unroll
          for (int j = 0; j < 4; ++j) nm = max(nm, x[j] < best ? x[j] : 0u); }
#pragma unroll
        for (int s2 = 0; s2 < 4; ++s2) m[s2] = (s2 == sg) ? nm : m[s2]; } } }
  __syncthreads();
  for (int r3_ = 0; r3_ < T3_REP; ++r3_)
  { const int token = tid >> 2, role = tid & 3;
    const unsigned* L1 = LISTl + token * 16; const unsigned* L2 = LISTl + (128 + token) * 16;
    unsigned ck[16];
#pragma unroll
    for (int i = 0; i < 16; ++i) { int a, b; bool valid;
      if (role == 0) { a = 0; b = i; valid = true; }
      else if (role == 1) { a = i < 8 ? 1 : 2; b = i < 8 ? i : i - 8; valid = i < 13; }
      else if (role == 2) { a = i < 4 ? 3 : i < 7 ? 4 : i < 9 ? 5 : 6; b = i - (i < 4 ? 0 : i < 7 ? 4 : i < 9 ? 7 : 9); valid = i < 11; }
      else { a = i < 2 ? 7 : 6 + i; b = i < 2 ? i : 0; valid = i < 10; }
      if (!valid) { a = 0; b = 0; }
      const float v = ord2f(L1[a] & ~127u) + ord2f(L2[b] & ~127u);
      ck[i] = valid ? ((f2ord(v) & ~255u) | (unsigned)(255 - (a * 16 + b))) : 0u; }
    unsigned rec[4]; unsigned prev = 0xffffffffu;
#pragma unroll
    for (int r = 0; r < 16; ++r) { unsigned best = 0u;
#pragma unroll
      for (int i = 0; i < 16; ++i) best = max(best, ck[i] < prev ? ck[i] : 0u);
      best = max(best, dppu<0xB1>(best)); best = max(best, dppu<0x4E>(best));
      prev = best;
      if (role == (r & 3)) rec[r >> 2] = best; }
    float bv[4]; int be[4];
#pragma unroll
    for (int j = 0; j < 4; ++j) { const int t = 255 - (int)(rec[j] & 255u); const unsigned x1 = L1[t >> 4], x2 = L2[t & 15];
      bv[j] = ord2f(x1 & ~127u) + ord2f(x2 & ~127u); be[j] = (int)(127u - (x1 & 127u)) * 128 + (int)(127u - (x2 & 127u)); }
    const float v0 = dppf<0x00>(bv[0]);
    float sum = 0.f;
#pragma unroll
    for (int j = 0; j < 4; ++j) { bv[j] = __expf(bv[j] - v0); sum += bv[j]; }
    sum += dppf<0xB1>(sum); sum += dppf<0x4E>(sum);
    const float isum = 1.f / sum;
    const int row = row0 + token;
    int* eo = WS(int, OFF_EID) + (size_t)row * 128 + head * 16; float* go = WS(float, OFF_GATE) + (size_t)row * 128 + head * 16;
#pragma unroll
    for (int j = 0; j < 4; ++j) { eo[j * 4 + role] = be[j]; go[j * 4 + role] = bv[j] * isum; }
  }
  __syncthreads();
}
DEV void topk_keys(CParams& p, int l, int head, bf16x8 (&kf)[8][4]) { const int lane = TIDX() & 63, wid = TIDX() >> 6;
  const bf16_t* kp = WS(bf16_t, OFF_KEYS) + ((size_t)(l * 16 + head * 2 + (wid >> 2)) * 128) * 128 + (lane >> 4) * 8;
#pragma unroll
  for (int nt = 0; nt < 8; ++nt)
#pragma unroll
    for (int ks = 0; ks < 4; ++ks) kf[nt][ks] = __builtin_bit_cast(bf16x8, ld8g(kp + (size_t)(nt * 16 + (lane & 15)) * 128 + ks * 32)); }
DEV void ph_topk_l0(CParams& p, unsigned char* lds) {
  const int b = (int)blockIdx.x, head = b & 7, j = b >> 3;
  bf16x8 kf[8][4];
  if (b < 64) {
    pg8::OneUnit S{true, {j, head}};
    pg8::Gemm g{WS(bf16_t, OFF_H), WS(bf16_t, OFF_WPQ), NCTXR, 2048, 1024};
    EpiBf16 E{WS(bf16_t, OFF_QP), 2048, 2048}; pg8::gemm_phase((LAS unsigned char*)lds, g, S, E);
    asm volatile("s_waitcnt vmcnt(0)" ::: "memory"); __syncthreads();
    __builtin_amdgcn_fence(__ATOMIC_ACQUIRE, "agent"); asm volatile("s_waitcnt vmcnt(0)" ::: "memory");
    topk_keys(p, 0, head, kf);
    topk_unit(p, 0, 2 * j, head, lds, kf); topk_unit(p, 0, 2 * j + 1, head, lds, kf);
    topk_unit(p, 0, 16 + j, head, lds, kf);
  } else {
    topk_keys(p, 0, head, kf);
#pragma unroll 1
    for (int i = 0; i < 5; ++i) topk_unit(p, 0, 16 + 8 + (j - 8) * 5 + i, head, lds, kf);
  }
}
DEV void ph_topk(CParams& p, int l, unsigned char* lds) {
  if (l == 0 && gridDim.x == 256) { ph_topk_l0(p, lds); return; }
  const int ntile = (l == 0 ? NTOK : NLAT) / 128;
  bf16x8 kf[8][4]; int curh = -1; const int lane = TIDX() & 63, wid = TIDX() >> 6;
  for (int u = blockIdx.x; u < ntile * 8; u += gridDim.x) { const int head = u & 7;
    if (head != curh) { curh = head;
      const bf16_t* kp = WS(bf16_t, OFF_KEYS) + ((size_t)(l * 16 + head * 2 + (wid >> 2)) * 128) * 128 + (lane >> 4) * 8;
#pragma unroll
      for (int nt = 0; nt < 8; ++nt)
#pragma unroll
        for (int ks = 0; ks < 4; ++ks) kf[nt][ks] = __builtin_bit_cast(bf16x8, ld8g(kp + (size_t)(nt * 16 + (lane & 15)) * 128 + ks * 32)); }
    topk_unit(p, l, u >> 3, head, lds, kf); }
}

DEV float gelu_tanh(float x) { const float z = 0.7978845608f * (x + 0.044715f * x * x * x); const float t = 1.f - 2.f * __builtin_amdgcn_rcpf(1.f + __expf(2.f * z)); return 0.5f * x * (1.f + t); }
DEV void fp8x16_to_f32(u32x4 w, float* f) {
#pragma unroll
  for (int i = 0; i < 4; ++i) { const f32x2 a = __builtin_amdgcn_cvt_pk_f32_fp8((int)w[i], false), b = __builtin_amdgcn_cvt_pk_f32_fp8((int)w[i], true); f[4 * i] = a[0]; f[4 * i + 1] = a[1]; f[4 * i + 2] = b[0]; f[4 * i + 3] = b[1]; } }
DEV void fp4x32_to_f32(u32x4 w, float* f) {
#pragma unroll
  for (int i = 0; i < 4; ++i) {
    const f32x2 a = __builtin_amdgcn_cvt_scalef32_pk_f32_fp4(w[i], 1.0f, 0), b = __builtin_amdgcn_cvt_scalef32_pk_f32_fp4(w[i], 1.0f, 1), c = __builtin_amdgcn_cvt_scalef32_pk_f32_fp4(w[i], 1.0f, 2), d = __builtin_amdgcn_cvt_scalef32_pk_f32_fp4(w[i], 1.0f, 3);
    f[8 * i] = a[0]; f[8 * i + 1] = a[1]; f[8 * i + 2] = b[0]; f[8 * i + 3] = b[1]; f[8 * i + 4] = c[0]; f[8 * i + 5] = c[1]; f[8 * i + 6] = d[0]; f[8 * i + 7] = d[1]; } }
DEV void ph_gather(CParams& p, int l, unsigned char* lds) {
  const int tid = TIDX(), lane = tid & 63, wid = tid >> 6, dl = lane & 7, g = lane >> 3;
  const int rb = l == 0 ? 0 : NCTXR, ntok = NTOK - rb;
  const int per = (ntok + (int)gridDim.x - 1) / (int)gridDim.x, tb0 = (int)blockIdx.x * per;
  int* eidl = (int*)lds; float* gatel = (float*)(lds + 36864); float* dotl = (float*)(lds + 73728);
  const unsigned char* TU = WS(unsigned char, OFF_TABU); const unsigned char* TV = WS(unsigned char, OFF_TABV);
  bf16_t* Yb = WS(bf16_t, OFF_Y);
  float* pvec = (float*)(lds + 110592); int mr0;
  { const int ra = rb + tb0, rz = rb + (tb0 + per < ntok ? tb0 + per : ntok) - 1; mr0 = modrow_of(ra < NTOK ? ra : NTOK - 1); const int mr1 = modrow_of(rz < ra ? (ra < NTOK ? ra : NTOK - 1) : rz);
    __syncthreads();
    for (int i = tid; i < 2 * 5 * 256; i += NTHREADS) { const int set = i / 1280, r5 = (i - set * 1280) >> 8, c4 = (i & 255) * 4; const int mr = set ? mr1 : mr0;
      const float* s_ = r5 == 0 ? WS(float, OFF_MOD) + (size_t)(l * 9 + mr) * 6144 + 5120 : r5 == 1 ? p.in[I_LNFG] + l * 1024 : r5 == 2 ? p.in[I_LNFB] + l * 1024 : WS(float, OFF_MOD) + (size_t)(9 + mr) * 6144 + (r5 - 3) * 1024;
      *(f32x4*)(pvec + set * 5120 + r5 * 1024 + c4) = *(const f32x4*)(s_ + c4); }
    __syncthreads(); }
  for (int base = tb0; base < tb0 + per && base < ntok; base += 72) {
    int n = tb0 + per - base; if (n > 72) n = 72; if (n > ntok - base) n = ntok - base;
    const int row0 = rb + base;
    for (int grep_ = 0; grep_ < GREP; ++grep_) {
    __builtin_amdgcn_wave_barrier();
    for (int tk = wid; tk < n; tk += 8) { const size_t o = (size_t)(row0 + tk) * 128;
      eidl[tk * 128 + lane] = WS(int, OFF_EID)[o + lane]; eidl[tk * 128 + 64 + lane] = WS(int, OFF_EID)[o + 64 + lane];
      gatel[tk * 128 + lane] = WS(float, OFF_GATE)[o + lane]; gatel[tk * 128 + 64 + lane] = WS(float, OFF_GATE)[o + 64 + lane];
      dotl[tk * 128 + lane] = 0.f; dotl[tk * 128 + 64 + lane] = 0.f; }
    asm volatile("s_waitcnt lgkmcnt(0)" ::: "memory"); __builtin_amdgcn_wave_barrier();
#pragma unroll 1
    for (int s = 0; s < 4; ++s) {
#pragma unroll 1
      for (int tk = wid; tk < n; tk += 8) {
        float hx[32]; { const bf16_t* hp = WS(bf16_t, OFF_H) + (size_t)(row0 + tk) * 1024 + s * 256 + dl * 32; unpack8(ld8g(hp), hx); unpack8(ld8g(hp + 8), hx + 8); unpack8(ld8g(hp + 16), hx + 16); unpack8(ld8g(hp + 24), hx + 24); }
        const unsigned char* tus = TU + (size_t)s * 16384 * 128 + dl * 16; const int* el = eidl + tk * 128 + g; float* dp = dotl + tk * 128 + g;
        u32x4 wq[16];
#pragma unroll
        for (int ps = 0; ps < 16; ++ps) wq[ps] = *(const u32x4*)(tus + (size_t)el[ps * 8] * 128);
#pragma unroll
        for (int ps = 0; ps < 16; ++ps) { const u32x4 w = wq[ps]; f32x2 dd = {0.f, 0.f};
#pragma unroll
          for (int i = 0; i < 4; ++i) {
            dd += __builtin_amdgcn_cvt_scalef32_pk_f32_fp4(w[i], 1.0f, 0) * (f32x2){hx[8 * i], hx[8 * i + 1]}; dd += __builtin_amdgcn_cvt_scalef32_pk_f32_fp4(w[i], 1.0f, 1) * (f32x2){hx[8 * i + 2], hx[8 * i + 3]};
            dd += __builtin_amdgcn_cvt_scalef32_pk_f32_fp4(w[i], 1.0f, 2) * (f32x2){hx[8 * i + 4], hx[8 * i + 5]}; dd += __builtin_amdgcn_cvt_scalef32_pk_f32_fp4(w[i], 1.0f, 3) * (f32x2){hx[8 * i + 6], hx[8 * i + 7]}; }
          const float d = grp8_sum(dd[0] + dd[1]);
          if (dl == 0) dp[ps * 8] += d; } } }
    asm volatile("s_waitcnt lgkmcnt(0)" ::: "memory"); __builtin_amdgcn_wave_barrier();
    for (int tk = wid; tk < n; tk += 8) {
#pragma unroll
      for (int hh = 0; hh < 2; ++hh) { const int i = tk * 128 + hh * 64 + lane; dotl[i] = gatel[i] * gelu_tanh(dotl[i] * (1.f / 64.f)); } }
    asm volatile("s_waitcnt lgkmcnt(0)" ::: "memory"); __builtin_amdgcn_wave_barrier();
#pragma unroll 1
    for (int s = 0; s < 4; ++s) {
#pragma unroll 1
      for (int tk = wid; tk < n; tk += 8) {
        const unsigned char* tvs = TV + (size_t)s * 16384 * 128 + dl * 16; const int* el = eidl + tk * 128 + g; const float* cp = dotl + tk * 128 + g;
        f32x2 ac2[16];
#pragma unroll
        for (int j = 0; j < 16; ++j) ac2[j] = (f32x2){0.f, 0.f};
        u32x4 wq[16];
#pragma unroll
        for (int ps = 0; ps < 16; ++ps) wq[ps] = *(const u32x4*)(tvs + (size_t)el[ps * 8] * 128);
#pragma unroll
        for (int ps = 0; ps < 16; ++ps) { const u32x4 w = wq[ps]; const float cc = cp[ps * 8]; const f32x2 c2 = {cc, cc};
#pragma unroll
          for (int i = 0; i < 4; ++i) { ac2[4 * i] += c2 * __builtin_amdgcn_cvt_scalef32_pk_f32_fp4(w[i], 1.0f, 0); ac2[4 * i + 1] += c2 * __builtin_amdgcn_cvt_scalef32_pk_f32_fp4(w[i], 1.0f, 1);
            ac2[4 * i + 2] += c2 * __builtin_amdgcn_cvt_scalef32_pk_f32_fp4(w[i], 1.0f, 2); ac2[4 * i + 3] += c2 * __builtin_amdgcn_cvt_scalef32_pk_f32_fp4(w[i], 1.0f, 3); } }
        float acc[32];
#pragma unroll
        for (int j = 0; j < 16; ++j) { acc[2 * j] = ac2[j][0]; acc[2 * j + 1] = ac2[j][1]; }
        float r16[16], r8[8];
#pragma unroll
        for (int j = 0; j < 16; ++j) { auto rr = __builtin_amdgcn_permlane32_swap(__float_as_uint(acc[j]), __float_as_uint(acc[j + 16]), false, false); r16[j] = __uint_as_float(rr[0]) + __uint_as_float(rr[1]); }
#pragma unroll
        for (int j = 0; j < 8; ++j) { auto rr = __builtin_amdgcn_permlane16_swap(__float_as_uint(r16[j]), __float_as_uint(r16[j + 8]), false, false); r8[j] = __uint_as_float(rr[0]) + __uint_as_float(rr[1]); }
        const bool b3 = (lane & 8) != 0; f32x4 o;
#pragma unroll
        for (int j = 0; j < 4; ++j) { const float x = r8[j] + dppf<0x128>(r8[j]), y = r8[j + 4] + dppf<0x128>(r8[j + 4]); o[j] = (b3 ? y : x) * 0.25f; }
        u32x2 ow; ow[0] = pack2(o[0], o[1]); ow[1] = pack2(o[2], o[3]);
        *(u32x2*)(Yb + (size_t)(row0 + tk) * 1024 + s * 256 + dl * 32 + ((lane >> 5) & 1) * 16 + ((lane >> 4) & 1) * 8 + (b3 ? 4 : 0)) = ow; } }
    }
    asm volatile("s_waitcnt vmcnt(0)" ::: "memory"); __builtin_amdgcn_fence(__ATOMIC_ACQUIRE, "agent"); asm volatile("s_waitcnt vmcnt(0)" ::: "memory");
#pragma unroll 1
    for (int tk = wid; tk < n; tk += 8) { const int row = row0 + tk;
      bf16_t* xw = WS(bf16_t, OFF_XC) + (size_t)row * 1024; const bf16_t* yr = Yb + (size_t)row * 1024;
      const float* pl = pvec + (modrow_of(row) == mr0 ? 0 : 5120);
      f32x4 v[4]; float sm = 0.f;
#pragma unroll
      for (int i = 0; i < 4; ++i) { const int col = lane * 4 + 256 * i; const u32x2 yw = *(const u32x2*)(yr + col), xq = *(const u32x2*)(xw + col);
        const f32x4 xo = {lo16(xq[0]), hi16(xq[0]), lo16(xq[1]), hi16(xq[1])}, ya = {lo16(yw[0]), hi16(yw[0]), lo16(yw[1]), hi16(yw[1])};
        v[i] = xo * ALPHA + *(const f32x4*)(pl + col) * ya; sm += (v[i][0] + v[i][1]) + (v[i][2] + v[i][3]); }
      float mean = wave_sum(sm) * (1.f / 1024.f), q = 0.f;
#pragma unroll
      for (int i = 0; i < 4; ++i) { v[i] -= mean; q += (v[i][0] * v[i][0] + v[i][1] * v[i][1]) + (v[i][2] * v[i][2] + v[i][3] * v[i][3]); }
      float rstd = rsqrtf(wave_sum(q) * (1.f / 1024.f) + LN_EPS);
      sm = 0.f;
#pragma unroll
      for (int i = 0; i < 4; ++i) { const int col = lane * 4 + 256 * i; const f32x4 o = v[i] * rstd * *(const f32x4*)(pl + 1024 + col) + *(const f32x4*)(pl + 2048 + col);
        v[i] = o; sm += (o[0] + o[1]) + (o[2] + o[3]);
        if (l == 0) { u32x2 wx; wx[0] = pack2(o[0], o[1]); wx[1] = pack2(o[2], o[3]); *(u32x2*)(xw + col) = wx; }
        else if (row >= NCTXR) *(f32x4*)(p.out + (size_t)(row - NCTXR) * DM + col) = o; }
      if (l == 0) {
        mean = wave_sum(sm) * (1.f / 1024.f); q = 0.f;
#pragma unroll
        for (int i = 0; i < 4; ++i) { v[i] -= mean; q += (v[i][0] * v[i][0] + v[i][1] * v[i][1]) + (v[i][2] * v[i][2] + v[i][3] * v[i][3]); }
        rstd = rsqrtf(wave_sum(q) * (1.f / 1024.f) + LN_EPS);
#pragma unroll
        for (int i = 0; i < 4; ++i) { const int col = lane * 4 + 256 * i; const f32x4 o = v[i] * rstd * (*(const f32x4*)(pl + 4096 + col) + 1.f) + *(const f32x4*)(pl + 3072 + col);
          u32x2 w; w[0] = pack2(o[0], o[1]); w[1] = pack2(o[2], o[3]); *(u32x2*)(WS(bf16_t, OFF_H) + (size_t)row * 1024 + col) = w; }
      } }
  }
}

#if !MULTI_LAUNCH
__global__ __launch_bounds__(NTHREADS, 2) void mega(Params p_, int lo, int hi, int coop) {
  extern __shared__ __attribute__((aligned(16))) unsigned char shm[];
  volatile LAS unsigned* bst = (volatile LAS unsigned*)(LAS unsigned char*)(shm + LDS_BYTES - 32);
  if (TIDX() == 0) { bst[0] = 0u; bst[1] = 0u; }
  __syncthreads();
  { CParams* kp0 = (CParams*)__builtin_amdgcn_kernarg_segment_ptr(); xcd_barrier_post((unsigned*)(kp0->ws + OFF_BAR)); }
  for (int step = lo; step < hi; ++step) {
    CParams* kp = (CParams*)__builtin_amdgcn_kernarg_segment_ptr(); asm volatile("" : "+s"(kp)); CParams& p = *kp;
    if (step == 0) { ph_init(p, shm); if (REPSET == 25) { __syncthreads(); ph_init(p, shm); } }
    else { const int l = (step - 1) / 11, k = (step - 1) % 11;
      for (int rep = 0; rep < REPS[k]; ++rep) { if (rep > 0 && coop) xcd_barrier(WS(unsigned, OFF_BAR), bst);
      switch (k) {
        case 0: if (l == 0) ph_lnmod(p, 0); break;
        case 1: ph_gemm_in(p, l, shm); break;
        case 2: ph_prep(p, l, shm); break;
        case 3: ph_mid(p, l + 2 * rep, shm); break;
        case 4: ph_mix(p, l + 2 * rep, shm); break;
        case 5: ph_rwpost(p, l); break;
        case 6: ph_gemm_out(p, l, shm); break;
        case 7: ph_ln1(p, l, shm); break;
        case 8: ph_gemm_pq(p, l, shm); break;
        case 9: ph_topk(p, l, shm); break;
        case 10: ph_gather(p, l, shm); break;
      } } }
    if (coop && step + 1 < hi) { if (lo < 0) cg::this_grid().sync(); else xcd_barrier(WS(unsigned, OFF_BAR), bst); }
    if (coop && step == 5) for (int xb_ = 0; xb_ < XBAR; ++xb_) xcd_barrier(WS(unsigned, OFF_BAR), bst);
  }
}
#endif

#if MULTI_LAUNCH
template <int K> __global__ __launch_bounds__(NTHREADS, 2) void phase_k(Params p_, int l) {
  extern __shared__ __attribute__((aligned(16))) unsigned char shm[];
  CParams& p = *(CParams*)__builtin_amdgcn_kernarg_segment_ptr();
  if constexpr (K == -1) ph_init(p, shm);
  if constexpr (K == 0) ph_lnmod(p, 0);
  if constexpr (K == 1) ph_gemm_in(p, l, shm);
  if constexpr (K == 2) ph_prep(p, l, shm);
  if constexpr (K == 3) ph_mid(p, l, shm);
  if constexpr (K == 4) ph_mix(p, l, shm);
  if constexpr (K == 5) ph_rwpost(p, l);
  if constexpr (K == 6) ph_gemm_out(p, l, shm);
  if constexpr (K == 7) ph_ln1(p, l, shm);
  if constexpr (K == 8) ph_gemm_pq(p, l, shm);
  if constexpr (K == 9) ph_topk(p, l, shm);
  if constexpr (K == 10) ph_gather(p, l, shm);
  if constexpr (K >= 30) ph_mid_t<K - 30>(p, l, shm);
}
template __global__ void phase_k<-1>(Params, int); template __global__ void phase_k<0>(Params, int); template __global__ void phase_k<1>(Params, int);
template __global__ void phase_k<2>(Params, int); template __global__ void phase_k<4>(Params, int);
template __global__ void phase_k<5>(Params, int); template __global__ void phase_k<6>(Params, int); template __global__ void phase_k<7>(Params, int);
template __global__ void phase_k<8>(Params, int); template __global__ void phase_k<31>(Params, int); template __global__ void phase_k<32>(Params, int); template __global__ void phase_k<34>(Params, int); template __global__ void phase_k<38>(Params, int); template __global__ void phase_k<9>(Params, int); template __global__ void phase_k<10>(Params, int);

#endif

extern "C" void kernel_launch(void* const* d_in, const int* in_sizes, int n_in, void* d_out, int out_size, void* d_ws, size_t ws_size, hipStream_t stream) {
  if (n_in < N_INPUTS || ws_size < WS_NEEDED) return;
  Params p{};
  for (int i = 0; i < N_INPUTS; ++i) p.in[i] = (const float*)d_in[i];
  p.out = (float*)d_out; p.ws = (unsigned char*)d_ws;
  static int grid = 0;
  if (!grid) {
    int dev = 0, cus = 0; (void)hipGetDevice(&dev); (void)hipDeviceGetAttribute(&cus, hipDeviceAttributeMultiprocessorCount, dev);
    grid = cus > 0 ? (cus > 256 ? 256 : cus) : 256;
#if !MULTI_LAUNCH
    (void)hipFuncSetAttribute((const void*)mega, hipFuncAttributeMaxDynamicSharedMemorySize, (int)LDS_BYTES);
    int per = 0; (void)hipOccupancyMaxActiveBlocksPerMultiprocessor(&per, mega, NTHREADS, LDS_BYTES);
    if (per < 1) grid = 0;
#endif
  }
  const int nsteps = 23;
#if MULTI_LAUNCH
#define LAUNCH_K(K, L) do { (void)hipFuncSetAttribute((const void*)phase_k<K>, hipFuncAttributeMaxDynamicSharedMemorySize, (int)LDS_BYTES); \
    hipLaunchKernelGGL(phase_k<K>, dim3(grid), dim3(NTHREADS), LDS_BYTES, stream, p, L); } while (0)
  (void)nsteps;
  LAUNCH_K(-1, 0);
  for (int l = 0; l < 2; ++l) {
    if (l == 0) LAUNCH_K(0, 0);
    LAUNCH_K(1, l); LAUNCH_K(2, l); LAUNCH_K(31, l); LAUNCH_K(32, l); LAUNCH_K(34, l); LAUNCH_K(38, l);
    LAUNCH_K(4, l); LAUNCH_K(5, l); LAUNCH_K(6, l); LAUNCH_K(7, l); LAUNCH_K(8, l); LAUNCH_K(9, l); LAUNCH_K(10, l);
  }
#else
  if (grid <= 0) return;
  (void)hipMemsetAsync((unsigned char*)d_ws + OFF_CNT, 0, SZ_CNT, stream);
  int lo = 0, hi = nsteps, coop = 1; void* args[] = {&p, &lo, &hi, &coop};
  (void)hipLaunchCooperativeKernel((const void*)mega, dim3(grid), dim3(NTHREADS), args, LDS_BYTES, stream);
#endif
}
```

```cpp
#include <hip/hip_runtime.h>
#include <hip/hip_cooperative_groups.h>
namespace cg = cooperative_groups;

#ifndef MULTI_LAUNCH
#define MULTI_LAUNCH 0
#endif

#ifndef REPSET
#define REPSET 0
#endif
#define DEV __device__ __forceinline__
#define LAS __attribute__((address_space(3)))
typedef unsigned short bf16_t;
typedef short bf16x8 __attribute__((ext_vector_type(8)));
typedef float f32x4 __attribute__((ext_vector_type(4)));
typedef float f32x2 __attribute__((ext_vector_type(2)));
typedef float f32x16 __attribute__((ext_vector_type(16)));
typedef unsigned u32x4 __attribute__((ext_vector_type(4)));
typedef unsigned u32x2 __attribute__((ext_vector_type(2)));

constexpr int NTOK = 18432, NCTXR = 2048, NLAT = 16384, DM = 1024;
constexpr int NIN = 3248, NINP = 3328;
constexpr float ALPHA = 1.41421356237f;
constexpr float LN_EPS = 1e-6f;
constexpr int NTHREADS = 512;
constexpr size_t LDS_BYTES = 160 * 1024;
#if REPSET == 5
__device__ constexpr int REPS[11] = {1, 1, 2, 1, 1, 1, 1, 1, 1, 1, 1};
#elif REPSET == 6
__device__ constexpr int REPS[11] = {1, 1, 1, 1, 1, 1, 1, 1, 1, 2, 1};
#elif REPSET == 7
__device__ constexpr int REPS[11] = {2, 1, 1, 1, 1, 2, 1, 1, 1, 1, 1};
#elif REPSET == 13
__device__ constexpr int REPS[11] = {1, 2, 1, 1, 1, 1, 1, 1, 1, 1, 1};
#elif REPSET == 14
__device__ constexpr int REPS[11] = {1, 1, 1, 1, 1, 1, 2, 1, 2, 1, 1};
#else
__device__ constexpr int REPS[11] = {1, 1, 1, 1, 1, 1, 1, 1, 1, 1, 1};
#endif
constexpr bool FP4_EMU = REPSET == 30;
constexpr int PM_REP = REPSET == 20 ? 2 : 1, PF_REP = REPSET == 21 ? 2 : 1, T1_REP = REPSET == 22 ? 2 : 1, T2_REP = REPSET == 23 ? 2 : 1, T3_REP = REPSET == 24 ? 2 : 1;
constexpr unsigned CONV_MID0 = (96u * 4u * 36u) / 8u;
constexpr int GREP = REPSET == 8 ? 2 : 1, XBAR = REPSET == 9 ? 20 : 0, RWREP = REPSET == 10 ? 2 : 1, ATREP = REPSET == 11 ? 2 : 1, MLREP = REPSET == 12 ? 2 : 1;

enum { I_X = 0, I_C, I_CTX, I_CCTX, I_WMOD, I_BMOD, I_WIN, I_MLCW, I_MLCB, I_MLIB, I_MLFB, I_MLNG, I_RWMU, I_RWW0, I_RWWUP, I_RWA0, I_RWAUP,
       I_RWGUP, I_RWKK, I_RWKA, I_RWRK, I_RWGNG, I_RWGNB, I_QNG, I_QUP, I_KVNG, I_KVUP, I_WOUT, I_LNMG, I_LNMB, I_PWQ, I_PKEYS, I_PU, I_PV, I_LNFG, I_LNFB, N_INPUTS };

constexpr size_t A256(size_t x) { return (x + 255) & ~size_t(255); }
constexpr size_t SZ_WIN = 2ull * NINP * 1024 * 2, SZ_WOUT = 2ull * 1024 * 1024 * 2, SZ_WPQ = 2ull * 2048 * 1024 * 2, SZ_WLORA = 2ull * 2048 * 384 * 2,
                 SZ_WQUP = 2ull * 768 * 384 * 2, SZ_WKVUP = 2ull * 768 * 256 * 2, SZ_KEYS = 2ull * 16 * 128 * 128 * 2, SZ_MOD = 2ull * 9 * 6144 * 4, SZ_CNT = 4096 + 16384  ;
constexpr size_t OFF_WIN = 0, OFF_WOUT = OFF_WIN + SZ_WIN, OFF_WPQ = OFF_WOUT + SZ_WOUT, OFF_WLORA = OFF_WPQ + SZ_WPQ, OFF_WQUP = OFF_WLORA + SZ_WLORA,
                 OFF_WKVUP = OFF_WQUP + SZ_WQUP, OFF_KEYS = OFF_WKVUP + SZ_WKVUP, OFF_MOD = OFF_KEYS + SZ_KEYS, OFF_CNT = OFF_MOD + SZ_MOD;
constexpr size_t OFF_CTXX = A256(OFF_CNT + SZ_CNT);
constexpr size_t OFF_H = OFF_CTXX + 2048ull * 1024 * 4;
constexpr size_t OFF_P = OFF_H + (size_t)NTOK * 1024 * 2;
constexpr size_t SZ_P = (size_t)NTOK * NIN * 2;
constexpr size_t OFF_TABU = OFF_P, OFF_TABV = OFF_TABU + 16384ull * 1024, OFF_RWY = OFF_TABV + 16384ull * 1024;
constexpr size_t OFF_BAR = OFF_CNT + 4096;
static_assert(OFF_RWY + 2ull * NTOK * 384 * 2 <= OFF_P + SZ_P, "P region overflow");
constexpr size_t OFF_BS = OFF_P + 96ull * 1024 * 1024;
static_assert(OFF_BS >= OFF_RWY + 2ull * NTOK * 384 * 2 && OFF_BS + 2ull * NTOK * 6 * 4 <= OFF_P + SZ_P, "BS placement");
constexpr size_t SZ_R1 = (size_t)NTOK * 384 * 2;
constexpr size_t OFF_R = OFF_P + SZ_P;
constexpr size_t OFF_RB = OFF_R, OFF_KB = OFF_RB + SZ_R1, OFF_KH = OFF_KB + SZ_R1, OFF_VB = OFF_KH + SZ_R1, OFF_LORA = OFF_VB + SZ_R1  ,
                 OFF_ZB = OFF_LORA + 5 * SZ_R1;
constexpr size_t SZ_R = 10 * SZ_R1;
constexpr size_t OFF_Y = OFF_R, OFF_QP = OFF_R;
static_assert((size_t)NTOK * 1024 * 4 <= SZ_R && (size_t)NTOK * 2048 * 2 <= SZ_R, "R region overflow");
constexpr size_t OFF_A = OFF_R + SZ_R;
constexpr size_t OFF_CQN = OFF_A, OFF_CKVN = OFF_CQN + (size_t)NTOK * 384 * 2, OFF_QB = OFF_CKVN + (size_t)NTOK * 256 * 2,
                 OFF_KV = OFF_QB + (size_t)NTOK * 576 * 2  , OFF_KR = OFF_KV + (size_t)NTOK * 768 * 2  ,
                 OFF_AEND = OFF_KR + (size_t)NTOK * 32 * 2;
constexpr size_t OFF_EID = OFF_A, OFF_GATE = OFF_EID + (size_t)NTOK * 128 * 4;
static_assert(OFF_GATE + (size_t)NTOK * 128 * 4 <= OFF_QB, "EID/GATE overflow");
constexpr size_t OFF_M = OFF_AEND;
constexpr size_t SZ_M1 = (size_t)NTOK * 256 * 2;
constexpr size_t OFF_MQ = OFF_M, OFF_MK = OFF_MQ + SZ_M1, OFF_MVT = OFF_MK + SZ_M1, OFF_MO = OFF_MVT + SZ_M1, OFF_GLI = OFF_MO + SZ_M1,
                 OFF_GLF = OFF_GLI + 8ull * NTOK * 4, OFF_ST = OFF_GLF + 8ull * NTOK * 4, OFF_SCM = OFF_ST + 2304ull * 5120 * 2,
                 OFF_SCB = OFF_SCM + 2304 * 4, OFF_SCMB = OFF_SCB + 2304 * 4, OFF_END = A256(OFF_SCMB + 2304 * 4);
constexpr size_t OFF_XC = OFF_END;
constexpr size_t WS_NEEDED = OFF_XC + (size_t)NTOK * 1024 * 2;
static_assert(WS_NEEDED <= 512ull * 1024 * 1024, "workspace budget");

struct Params {
  const float* in[N_INPUTS];
  float* out;
  unsigned char* ws;
};
typedef const __attribute__((address_space(4))) Params CParams;

DEV int TIDX() { int t = (int)__builtin_amdgcn_workitem_id_x(); asm volatile("" : "+v"(t)); return t; }
DEV float bf2f(bf16_t b) { return __uint_as_float(((unsigned)b) << 16); }
DEV bf16_t f2bf(float f) { unsigned u = __float_as_uint(f); u += 0x7FFFu + ((u >> 16) & 1u); return (bf16_t)(u >> 16); }
typedef __bf16 bf16v2_t __attribute__((ext_vector_type(2)));
DEV unsigned pack2(float lo, float hi) { return __builtin_bit_cast(unsigned, __builtin_convertvector((f32x2){lo, hi}, bf16v2_t)); }
DEV float lo16(unsigned w) { return __uint_as_float(w << 16); }
DEV float hi16(unsigned w) { return __uint_as_float(w & 0xffff0000u); }
DEV void unpack8(u32x4 w, float* f) { f[0] = lo16(w[0]); f[1] = hi16(w[0]); f[2] = lo16(w[1]); f[3] = hi16(w[1]); f[4] = lo16(w[2]); f[5] = hi16(w[2]); f[6] = lo16(w[3]); f[7] = hi16(w[3]); }
DEV u32x4 pack8(const float* f) { u32x4 w; w[0] = pack2(f[0], f[1]); w[1] = pack2(f[2], f[3]); w[2] = pack2(f[4], f[5]); w[3] = pack2(f[6], f[7]); return w; }
DEV float sigmoidf_(float x) { return __builtin_amdgcn_rcpf(1.0f + __expf(-x)); }
DEV float siluf_(float x) { return x * __builtin_amdgcn_rcpf(1.0f + __expf(-x)); }
template <int CTRL> DEV float dppf(float x) { return __builtin_bit_cast(float, __builtin_amdgcn_mov_dpp(__builtin_bit_cast(int, x), CTRL, 0xf, 0xf, true)); }
template <int CTRL> DEV float dpp_upd(float old, float x) { return __builtin_bit_cast(float, __builtin_amdgcn_update_dpp(__builtin_bit_cast(int, old), __builtin_bit_cast(int, x), CTRL, 0xf, 0xf, false)); }
DEV float rdlane(float v, int l) { return __builtin_bit_cast(float, __builtin_amdgcn_readlane(__builtin_bit_cast(int, v), l)); }
DEV float bperm(int srclane, float v) { return __builtin_bit_cast(float, __builtin_amdgcn_ds_bpermute(srclane << 2, __builtin_bit_cast(int, v))); }
DEV float row16_max(float x) { x = fmaxf(x, dppf<0x128>(x)); x = fmaxf(x, dppf<0x124>(x)); x = fmaxf(x, dppf<0x122>(x)); x = fmaxf(x, dppf<0x121>(x)); return x; }
DEV float grp8_sum(float x) { x += dppf<0xB1>(x); x += dppf<0x4E>(x); x += dppf<0x141>(x); return x; }
DEV float scan_sum64(float x, int lane) {
  x += dpp_upd<0x111>(0.f, x); x += dpp_upd<0x112>(0.f, x); x += dpp_upd<0x114>(0.f, x); x += dpp_upd<0x118>(0.f, x);
  const float t0 = rdlane(x, 15), t1 = rdlane(x, 31), t2 = rdlane(x, 47); const int r = lane >> 4;
  return x + (r == 0 ? 0.f : r == 1 ? t0 : r == 2 ? t0 + t1 : t0 + t1 + t2); }
DEV float scan_max64(float x, int lane) {
  const float NI = -3.0e38f;
  x = fmaxf(x, dpp_upd<0x111>(NI, x)); x = fmaxf(x, dpp_upd<0x112>(NI, x)); x = fmaxf(x, dpp_upd<0x114>(NI, x)); x = fmaxf(x, dpp_upd<0x118>(NI, x));
  const float t0 = rdlane(x, 15), t1 = rdlane(x, 31), t2 = rdlane(x, 47); const int r = lane >> 4;
  return fmaxf(x, r == 0 ? NI : r == 1 ? t0 : r == 2 ? fmaxf(t0, t1) : fmaxf(fmaxf(t0, t1), t2)); }
DEV float row16_sum(float x) { x += dppf<0x128>(x); x += dppf<0x124>(x); x += dppf<0x122>(x); x += dppf<0x121>(x); return x; }
DEV float wave_sum(float v) { v = row16_sum(v); return (rdlane(v, 0) + rdlane(v, 16)) + (rdlane(v, 32) + rdlane(v, 48)); }
DEV float wave_max(float v) { v = row16_max(v); return fmaxf(fmaxf(rdlane(v, 0), rdlane(v, 16)), fmaxf(rdlane(v, 32), rdlane(v, 48))); }
DEV float xhalf_sum(float x) { auto rr = __builtin_amdgcn_permlane32_swap(__float_as_uint(x), __float_as_uint(x), false, false); return __uint_as_float(rr[0]) + __uint_as_float(rr[1]); }
DEV float xhalf_max(float x) { auto rr = __builtin_amdgcn_permlane32_swap(__float_as_uint(x), __float_as_uint(x), false, false); return fmaxf(__uint_as_float(rr[0]), __uint_as_float(rr[1])); }

DEV int modrow_of(int row) { return row < NCTXR ? 8 : ((row - NCTXR) >> 11); }

#define XB_TMO      128
#define XB_XCNT(j)  (256  + 64 * (j))
#define XB_XSUB(j)  (1280 + 64 * (j))
#define XB_XGEN(j)  (2304 + 64 * (j))
#define XB_TOP      3328
#define XB_TOPGEN   3392
#define XCD_BAR_WORDS 3456
#define XB_SPIN_CAP (1u << 20)
DEV unsigned xb_ld(unsigned* p) { return __hip_atomic_load(p, __ATOMIC_RELAXED, __HIP_MEMORY_SCOPE_AGENT); }
DEV unsigned xb_add(unsigned* p, unsigned v) { return __hip_atomic_fetch_add(p, v, __ATOMIC_RELAXED, __HIP_MEMORY_SCOPE_AGENT); }
DEV unsigned xb_xcc_id() { return (unsigned)__builtin_amdgcn_s_getreg((3 << 11) | 20) & 0xFu; }
#define XB_SPIN(cond, bar) do { unsigned _sp = 0; while (cond) { __builtin_amdgcn_s_sleep(1); \
    if ((++_sp & 255u) == 0u) { if (xb_ld(&(bar)[XB_TMO])) break; if (_sp > XB_SPIN_CAP) { atomicAdd(&(bar)[XB_TMO], 1u); break; } } } } while (0)
DEV void xcd_barrier_post(unsigned* bar) { if (TIDX() == 0) (void)xb_add(&bar[XB_XCNT(xb_xcc_id())], 1u); }
DEV void xcd_barrier_complete(unsigned* bar, unsigned x, unsigned& nloc, unsigned& nx) {
  const unsigned G = gridDim.x; unsigned sum, cnt, mine, sp = 0u;
  for (;;) { sum = 0u; cnt = 0u; mine = 0u;
#pragma unroll
    for (unsigned j = 0; j < 16; ++j) { const unsigned c = xb_ld(&bar[XB_XCNT(j)]); sum += c; cnt += (c > 0u) ? 1u : 0u; mine = (j == x) ? c : mine; }
    if (sum == G) break;
    __builtin_amdgcn_s_sleep(1);
    if ((++sp & 255u) == 0u) { if (xb_ld(&bar[XB_TMO])) break; if (sp > XB_SPIN_CAP) { atomicAdd(&bar[XB_TMO], 1u); break; } } }
  nloc = mine > 0u ? mine : 1u; nx = cnt > 0u ? cnt : 1u;
}
DEV void xcd_barrier(unsigned* bar, volatile LAS unsigned* st) {
  asm volatile("s_waitcnt vmcnt(0)" ::: "memory");
  __syncthreads();
  if (TIDX() == 0) {
    const unsigned x = xb_xcc_id();
    __builtin_amdgcn_s_waitcnt(0);
    unsigned nloc = st[0], nx = st[1];
    if (nloc == 0u) { xcd_barrier_complete(bar, x, nloc, nx); st[0] = nloc; st[1] = nx; }
    const unsigned old = xb_add(&bar[XB_XSUB(x)], 1u);
    const unsigned gen = old / nloc;
    if (old + 1u == (gen + 1u) * nloc) {
      __builtin_amdgcn_fence(__ATOMIC_RELEASE, "agent");
      asm volatile("s_waitcnt vmcnt(0)" ::: "memory");
      const unsigned og = xb_add(&bar[XB_TOP], 1u);
      const unsigned tg = og / nx;
      if (og + 1u == (tg + 1u) * nx) xb_add(&bar[XB_TOPGEN], 1u);
      else XB_SPIN(xb_ld(&bar[XB_TOPGEN]) == tg, bar);
      __builtin_amdgcn_fence(__ATOMIC_ACQUIRE, "agent");
      xb_add(&bar[XB_XGEN(x)], 1u);
      asm volatile("s_waitcnt vmcnt(0)" ::: "memory");
    } else {
      XB_SPIN(xb_ld(&bar[XB_XGEN(x)]) == gen, bar);
      __builtin_amdgcn_fence(__ATOMIC_ACQUIRE, "agent");
      asm volatile("s_waitcnt vmcnt(0)" ::: "memory");
    }
  }
  __syncthreads();
}

namespace pg8 {
constexpr int BM = 256, BK = 64, HALF = 128, HTB = HALF * BK * 2, STAGE_BYTES = 8 * HTB, NXCD = 8, WGM = 8;
DEV int lds_byte(int r, int c) { const int st = (r >> 4) * 2 + (c >> 5), rr = r & 15, cc = c & 31, ob = rr * 64 + cc * 2; return st * 1024 + (ob ^ (((ob >> 9) & 1) << 5)); }
DEV void stage_rc(int b, int& R, int& C) { const int st = b / 1024, sb = b % 1024, swz = sb ^ (((sb >> 9) & 1) << 5); R = (st >> 1) * 16 + swz / 64; C = (st & 1) * 32 + (swz % 64) / 2; }
DEV int perm32(int rho) { const int n = rho >> 4, i = rho & 15; return 8 * (i >> 2) + 4 * n + (i & 3); }
struct Unit { int pm, pn; };
struct Gemm { const bf16_t* A; const bf16_t* Bt; int M, N, K; };
struct StaticOrder {
  int nM, nN, nwg, G, c;
  DEV void init(int M, int N, int G_, int c_) { nM = M / BM; nN = N / BM; nwg = nM * nN; G = G_; c = c_; }
  DEV bool next(int i, Unit& u) const {
    const long L = (long)i * G + c; if (L >= nwg) return false;
    int wgid = (int)L; { const int q = nwg / NXCD, r = nwg % NXCD, xcd = wgid % NXCD, off = wgid / NXCD; wgid = (xcd < r ? xcd * (q + 1) : r * (q + 1) + (xcd - r) * q) + off; }
    const int nig = WGM * nN, gid = wgid / nig, fm = gid * WGM, gsz = (nM - fm) < WGM ? (nM - fm) : WGM;
    u.pm = fm + ((wgid % nig) % gsz); u.pn = (wgid % nig) / gsz; return true;
  }
};
struct OneUnit { bool has; Unit u0; DEV bool next(int i, Unit& u) const { if (i == 0 && has) { u = u0; return true; } return false; } };
template <class Epi, class Ord>
DEV void gemm_phase(LAS unsigned char* lds, const Gemm g, const Ord& S, const Epi& E) {
  const int tid = TIDX(), wid = __builtin_amdgcn_readfirstlane(tid >> 6), lane = tid & 63, wr = wid >> 2, wc = wid & 3, fr = lane & 15, fq = lane >> 4;
  const int K = g.K, nt = K / BK;
  unsigned voffA[2], voffB[2];
#pragma unroll
  for (int i = 0; i < 2; ++i) { int R, C; stage_rc(tid * 16 + i * 8192, R, C); const int Rb = Epi::PERM ? ((R & ~31) + perm32(R & 31)) : R;
    voffA[i] = (unsigned)(R * K + C) * 2u; voffB[i] = (unsigned)(Rb * K + C) * 2u; }
  const size_t kstep = (size_t)(BK * 2);
  const size_t hstep = (size_t)HALF * K * 2;
  const size_t tstep = 2 * hstep;
  const unsigned ldsw = (unsigned)wid * 1024u;
  const int aoff = lds_byte(wr * 64 + fr, fq * 8), boff = lds_byte(wc * 32 + fr, fq * 8);
#define PG8_SA(b, h) (((b) * 2 + (h)) * HTB)
#define PG8_SB(b, h) ((4 + (b) * 2 + (h)) * HTB)
#define PG8_STAGE(bufoff, gbase, voff) do { _Pragma("unroll") for (int _i = 0; _i < 2; ++_i) \
        __builtin_amdgcn_global_load_lds((const unsigned*)((const char*)(gbase) + (voff)[_i]), (LAS unsigned*)(lds + (bufoff) + ldsw + _i * 8192), 16, 0, 0); } while (0)
#define PG8_LDA(dst, b, h) do { _Pragma("unroll") for (int m = 0; m < 4; ++m) _Pragma("unroll") for (int k = 0; k < 2; ++k) dst[m][k] = *(const LAS bf16x8*)(lds + PG8_SA(b, h) + aoff + m * 2048 + k * 1024); } while (0)
#define PG8_LDB(dst, b, h) do { _Pragma("unroll") for (int n = 0; n < 2; ++n) _Pragma("unroll") for (int k = 0; k < 2; ++k) dst[n][k] = *(const LAS bf16x8*)(lds + PG8_SB(b, h) + boff + n * 2048 + k * 1024); } while (0)
#define PG8_MMA(ai, bj, At, Bt) do { __builtin_amdgcn_s_setprio(1); _Pragma("unroll") for (int m = 0; m < 4; ++m) _Pragma("unroll") for (int n = 0; n < 2; ++n) _Pragma("unroll") for (int k = 0; k < 2; ++k) \
        acc[ai][bj][m][n] = __builtin_amdgcn_mfma_f32_16x16x32_bf16(Bt[n][k], At[m][k], acc[ai][bj][m][n], 0, 0, 0); __builtin_amdgcn_s_setprio(0); } while (0)
#define PG8_WAIT_V(n) asm volatile("s_waitcnt vmcnt(" #n ")" ::: "memory")
#define PG8_WAIT_L(n) asm volatile("s_waitcnt lgkmcnt(" #n ")" ::: "memory")
#define PG8_BAR __builtin_amdgcn_s_barrier()
#define PG8_SCHED __builtin_amdgcn_sched_barrier(0)
  Unit cur, nxt; int ui = 0;
  if (!S.next(0, cur)) return;
  f32x4 acc[2][2][4][2];
#pragma unroll
  for (int a = 0; a < 2; ++a)
#pragma unroll
    for (int b = 0; b < 2; ++b)
#pragma unroll
      for (int m = 0; m < 4; ++m)
#pragma unroll
        for (int n = 0; n < 2; ++n) acc[a][b][m][n] = (f32x4){0.f, 0.f, 0.f, 0.f};
  bf16x8 At[4][2], B0[2][2], B1[2][2];
  const char* cA = (const char*)g.A + (size_t)cur.pm * tstep; const char* cB = (const char*)g.Bt + (size_t)cur.pn * tstep;
  PG8_STAGE(PG8_SB(0, 0), cB, voffB); PG8_STAGE(PG8_SA(0, 0), cA, voffA); PG8_STAGE(PG8_SB(0, 1), cB + hstep, voffB); PG8_STAGE(PG8_SA(0, 1), cA + hstep, voffA);
  if (wr == 1) PG8_BAR;
  PG8_WAIT_V(4); PG8_BAR;
  PG8_STAGE(PG8_SB(1, 0), cB + kstep, voffB); PG8_STAGE(PG8_SA(1, 0), cA + kstep, voffA); PG8_STAGE(PG8_SB(1, 1), cB + hstep + kstep, voffB);
  PG8_WAIT_V(6); PG8_BAR;
  for (;;) {
    const bool has_next = S.next(ui + 1, nxt);
    const char* nA = has_next ? (const char*)g.A + (size_t)nxt.pm * tstep : cA; const char* nB = has_next ? (const char*)g.Bt + (size_t)nxt.pn * tstep : cB;
    for (int t = 0; t < nt; t += 2) {
      const bool last = (t == nt - 2);
      const char* a1 = cA + (size_t)(t + 1) * kstep;
      const char* a2 = last ? nA : cA + (size_t)(t + 2) * kstep; const char* b2 = last ? nB : cB + (size_t)(t + 2) * kstep;
      const char* a3 = a2 + kstep; const char* b3 = b2 + kstep;
      PG8_LDB(B0, 0, 0); PG8_SCHED; PG8_LDA(At, 0, 0); PG8_STAGE(PG8_SA(1, 1), a1 + hstep, voffA);
      PG8_WAIT_L(8); PG8_BAR; PG8_WAIT_L(0); PG8_MMA(0, 0, At, B0); PG8_BAR; PG8_SCHED;
      PG8_LDB(B1, 0, 1); PG8_STAGE(PG8_SB(0, 0), b2, voffB);
      PG8_BAR; PG8_WAIT_L(0); PG8_MMA(0, 1, At, B1); PG8_BAR;
      PG8_LDA(At, 0, 1); PG8_STAGE(PG8_SA(0, 0), a2, voffA);
      PG8_BAR; PG8_WAIT_L(0); PG8_MMA(1, 0, At, B0); PG8_BAR; PG8_SCHED;
      PG8_STAGE(PG8_SB(0, 1), b2 + hstep, voffB);
      PG8_WAIT_V(6); PG8_BAR; PG8_MMA(1, 1, At, B1); PG8_BAR;
      PG8_LDB(B0, 1, 0); PG8_SCHED; PG8_LDA(At, 1, 0); PG8_STAGE(PG8_SA(0, 1), a2 + hstep, voffA);
      PG8_WAIT_L(8); PG8_BAR; PG8_WAIT_L(0); PG8_MMA(0, 0, At, B0); PG8_BAR; PG8_SCHED;
      PG8_LDB(B1, 1, 1); PG8_STAGE(PG8_SB(1, 0), b3, voffB);
      PG8_BAR; PG8_WAIT_L(0); PG8_MMA(0, 1, At, B1); PG8_BAR;
      PG8_LDA(At, 1, 1); PG8_STAGE(PG8_SA(1, 0), a3, voffA);
      PG8_BAR; PG8_WAIT_L(0); PG8_MMA(1, 0, At, B0); PG8_BAR; PG8_SCHED;
      PG8_STAGE(PG8_SB(1, 1), b3 + hstep, voffB);
      PG8_WAIT_V(6); PG8_BAR; PG8_MMA(1, 1, At, B1); PG8_BAR;
    }
    E(acc, cur, wr, wc, fr, fq);
    if (!has_next) break;
#pragma unroll
    for (int a = 0; a < 2; ++a)
#pragma unroll
      for (int b = 0; b < 2; ++b)
#pragma unroll
        for (int m = 0; m < 4; ++m)
#pragma unroll
          for (int n = 0; n < 2; ++n) acc[a][b][m][n] = (f32x4){0.f, 0.f, 0.f, 0.f};
    cur = nxt; cA = nA; cB = nB; ++ui;
  }
  PG8_WAIT_V(0);
  if (wr == 0) PG8_BAR;
  PG8_BAR;
#undef PG8_SA
#undef PG8_SB
#undef PG8_STAGE
#undef PG8_LDA
#undef PG8_LDB
#undef PG8_MMA
#undef PG8_WAIT_V
#undef PG8_WAIT_L
#undef PG8_BAR
#undef PG8_SCHED
}
}
using pg8::Unit;
typedef f32x4 AccT[2][2][4][2];

struct EpiBf16 {
  static constexpr bool PERM = true;
  bf16_t* O; int ldc; int ncols;
  DEV void operator()(const AccT& acc, const Unit& u, int wr, int wc, int fr, int fq) const {
    { const int t_ = TIDX(); fr = t_ & 15; fq = (t_ >> 4) & 3; }
    const int row0 = u.pm * 256 + wr * 64 + fr, col0 = u.pn * 256 + wc * 32 + 8 * fq;
#pragma unroll
    for (int ai = 0; ai < 2; ++ai)
#pragma unroll
      for (int m = 0; m < 4; ++m) { bf16_t* rowp = O + (size_t)(row0 + ai * 128 + m * 16) * ldc;
#pragma unroll
        for (int bj = 0; bj < 2; ++bj) { const int col = col0 + bj * 128; if (col < ncols) {
          const f32x4 v0 = acc[ai][bj][m][0], v1 = acc[ai][bj][m][1];
          u32x4 w; w[0] = pack2(v0[0], v0[1]); w[1] = pack2(v0[2], v0[3]); w[2] = pack2(v1[0], v1[1]); w[3] = pack2(v1[2], v1[3]);
          *(u32x4*)(rowp + col) = w; } } }
  }
};
struct EpiF32 {
  static constexpr bool PERM = false;
  float* C; int ldc;
  DEV void operator()(const AccT& acc, const Unit& u, int wr, int wc, int fr, int fq) const {
    { const int t_ = TIDX(); fr = t_ & 15; fq = (t_ >> 4) & 3; }
    const int row0 = u.pm * 256 + wr * 64 + fr, col0 = u.pn * 256 + wc * 32 + 4 * fq;
#pragma unroll
    for (int ai = 0; ai < 2; ++ai)
#pragma unroll
      for (int m = 0; m < 4; ++m) { float* rowp = C + (size_t)(row0 + ai * 128 + m * 16) * ldc + col0;
#pragma unroll
        for (int bj = 0; bj < 2; ++bj)
#pragma unroll
          for (int n = 0; n < 2; ++n) *(f32x4*)(rowp + bj * 128 + n * 16) = acc[ai][bj][m][n]; }
  }
};

#define WS(T, off) ((T*)(p.ws + (off)))
DEV const float* x_in_row(CParams& p, int row) { return row < NCTXR ? p.in[I_CTX] + (size_t)row * DM : p.in[I_X] + (size_t)(row - NCTXR) * DM; }
DEV float* x_cur_row(CParams& p, int row) { return row < NCTXR ? WS(float, OFF_CTXX) + (size_t)row * DM : p.out + (size_t)(row - NCTXR) * DM; }

DEV void tr_tile(const float* __restrict__ src, bf16_t* __restrict__ dst, int K, int N, int nt, int kt, float* tile) {
  const int tid = TIDX();
  { const int r = tid >> 4, c4 = (tid & 15) * 4;
#pragma unroll
    for (int i = 0; i < 2; ++i) { const int k = kt * 64 + r + 32 * i, n = nt * 64 + c4;
      f32x4 v = {0.f, 0.f, 0.f, 0.f}; if (n < N) v = *(const f32x4*)(src + (size_t)k * N + n);
      float* tp = tile + (r + 32 * i) * 65 + c4; tp[0] = v[0]; tp[1] = v[1]; tp[2] = v[2]; tp[3] = v[3]; } }
  __syncthreads();
  { const int n = tid >> 3, k8 = (tid & 7) * 8; float f[8];
#pragma unroll
    for (int j = 0; j < 8; ++j) f[j] = tile[(k8 + j) * 65 + n];
    *(u32x4*)(dst + (size_t)(nt * 64 + n) * K + kt * 64 + k8) = pack8(f); }
  __syncthreads();
}
DEV void mod_unit(CParams& p, int l, int cgp, float* lds) {
  float* sc = lds; float* red = lds + 9 * 1024;
  const int tid = TIDX();
  for (int i = tid; i < 9 * 1024; i += NTHREADS) { const int r = i >> 10, k = i & 1023; const float cv = r < 8 ? p.in[I_C][r * 1024 + k] : p.in[I_CCTX][k]; sc[i] = siluf_(cv); }
  __syncthreads();
  const int kg = tid >> 6, cl = tid & 63, col = cgp * 64 + cl;
  float acc[9];
#pragma unroll
  for (int r = 0; r < 9; ++r) acc[r] = 0.f;
  const float* w = p.in[I_WMOD] + (size_t)l * 1024 * 6144 + col;
  for (int k = kg * 128; k < kg * 128 + 128; ++k) { const float wv = w[(size_t)k * 6144];
#pragma unroll
    for (int r = 0; r < 9; ++r) acc[r] += sc[r * 1024 + k] * wv; }
#pragma unroll
  for (int r = 0; r < 9; ++r) red[(kg * 9 + r) * 64 + cl] = acc[r];
  __syncthreads();
  for (int o = tid; o < 9 * 64; o += NTHREADS) { const int r = o >> 6, c2 = o & 63; float s = 0.f;
    for (int g = 0; g < 8; ++g) s += red[(g * 9 + r) * 64 + c2];
    WS(float, OFF_MOD)[(size_t)(l * 9 + r) * 6144 + cgp * 64 + c2] = s + p.in[I_BMOD][l * 6144 + cgp * 64 + c2]; }
  __syncthreads();
}
DEV void ph_init(CParams& p, unsigned char* lds) {
  const int tid = TIDX(), nb = gridDim.x;
  if (blockIdx.x == 0 && tid < 64) WS(unsigned, OFF_CNT)[tid] = 0u;
  const int tcount[5] = {(NINP / 64) * 16, 16 * 16, 32 * 16, 12 * 6, 12 * 4};
  const int tl = tcount[0] + tcount[1] + tcount[2] + tcount[3] + tcount[4];
  const int total = 192 + 2 * tl;
  for (int u = blockIdx.x; u < total; u += nb) {
    if (u < 192) { mod_unit(p, u / 96, u % 96, (float*)lds); continue; }
    int v = u - 192; const int l = v / tl; v -= l * tl;
    if (v < tcount[0]) { tr_tile(p.in[I_WIN] + (size_t)l * 1024 * NIN, WS(bf16_t, OFF_WIN) + (size_t)l * NINP * 1024, 1024, NIN, v / 16, v % 16, (float*)lds); continue; }
    v -= tcount[0];
    if (v < tcount[1]) { tr_tile(p.in[I_WOUT] + (size_t)l * 1024 * 1024, WS(bf16_t, OFF_WOUT) + (size_t)l * 1024 * 1024, 1024, 1024, v / 16, v % 16, (float*)lds); continue; }
    v -= tcount[1];
    if (v < tcount[2]) { tr_tile(p.in[I_PWQ] + (size_t)l * 1024 * 2048, WS(bf16_t, OFF_WPQ) + (size_t)l * 2048 * 1024, 1024, 2048, v / 16, v % 16, (float*)lds); continue; }
    v -= tcount[2];
    if (v < tcount[3]) { tr_tile(p.in[I_QUP] + (size_t)l * 384 * 576, WS(bf16_t, OFF_WQUP) + (size_t)l * 768 * 384, 384, 576, v / 6, v % 6, (float*)lds); continue; }
    v -= tcount[3];
    tr_tile(p.in[I_KVUP] + (size_t)l * 256 * 768, WS(bf16_t, OFF_WKVUP) + (size_t)l * 768 * 256, 256, 768, v / 4, v % 4, (float*)lds);
  }
  const size_t gtid = (size_t)blockIdx.x * NTHREADS + tid, gsz = (size_t)nb * NTHREADS;
  for (size_t i = gtid; i < 2ull * 2048 * 384; i += gsz) {
    const int l = (int)(i / (2048 * 384)); const int rem = (int)(i % (2048 * 384)); const int n = rem / 384, k = rem % 384;
    float v = 0.f;
    if (n < 1920) { const int grp = n / 384, cc = n % 384;
      if (grp < 2) { if ((k >> 6) == grp) v = p.in[I_RWWUP][((size_t)(l * 2 + grp) * 64 + (k & 63)) * 384 + cc]; }
      else if (grp < 4) { if ((k >> 6) == grp) v = p.in[I_RWAUP][((size_t)(l * 2 + grp - 2) * 64 + (k & 63)) * 384 + cc]; }
      else { if (k >= 256) v = p.in[I_RWGUP][((size_t)l * 128 + (k - 256)) * 384 + cc]; } }
    WS(bf16_t, OFF_WLORA)[i] = f2bf(v);
  }
  for (size_t i = gtid; i < 2ull * 16 * 128 * 128; i += gsz) WS(bf16_t, OFF_KEYS)[i] = f2bf(p.in[I_PKEYS][i]);
}

DEV void ph_lnmod(CParams& p, int l) {
  const int lane = TIDX() & 63, per = (NTOK + (int)gridDim.x - 1) / (int)gridDim.x, r0 = (int)blockIdx.x * per, r1 = r0 + per < NTOK ? r0 + per : NTOK;
  for (int row = r0 + (TIDX() >> 6); row < r1; row += 8) {
    const float* xr = x_in_row(p, row); f32x4 v[4]; float s = 0.f;
#pragma unroll
    for (int i = 0; i < 4; ++i) { v[i] = *(const f32x4*)(xr + lane * 4 + 256 * i); s += (v[i][0] + v[i][1]) + (v[i][2] + v[i][3]); }
    const float mean = wave_sum(s) * (1.f / 1024.f); float q = 0.f;
#pragma unroll
    for (int i = 0; i < 4; ++i) { v[i] -= mean; q += (v[i][0] * v[i][0] + v[i][1] * v[i][1]) + (v[i][2] * v[i][2] + v[i][3] * v[i][3]); }
    const float rstd = rsqrtf(wave_sum(q) * (1.f / 1024.f) + LN_EPS);
    const float* md = WS(float, OFF_MOD) + (size_t)(l * 9 + modrow_of(row)) * 6144;
#pragma unroll
    for (int i = 0; i < 4; ++i) { const int col = lane * 4 + 256 * i; const f32x4 sh = *(const f32x4*)(md + col), sc = *(const f32x4*)(md + 1024 + col);
      const f32x4 o = v[i] * rstd * (sc + 1.f) + sh; u32x2 w; w[0] = pack2(o[0], o[1]); w[1] = pack2(o[2], o[3]);
      *(u32x2*)(WS(bf16_t, OFF_H) + (size_t)row * 1024 + col) = w; }
  }
}

struct ChunkInfo { int row0, b, cseq, T, t0; bool isctx; };
DEV ChunkInfo chunk_info(int chunk) { ChunkInfo c; c.row0 = chunk * 64; c.isctx = chunk < 32;
  if (c.isctx) { c.b = chunk >> 2; c.cseq = chunk & 3; c.T = 256; } else { const int lc = chunk - 32; c.b = lc >> 5; c.cseq = lc & 31; c.T = 2048; }
  c.t0 = c.cseq * 64; return c; }
DEV int ml_pc(const ChunkInfo& c, int dir) { return dir == 0 ? (c.isctx ? c.cseq : 4 + c.cseq) : (c.isctx ? 3 - c.cseq : 4 + (31 - c.cseq)); }
DEV u32x4 ld8g(const bf16_t* ptr) { return *(const u32x4*)ptr; }

DEV void prep_mlstm(CParams& p, int l, const ChunkInfo& c, int chunk, int hd, unsigned char* lds) {
  bf16_t* VTl = (bf16_t*)lds;
  bf16_t* KWl = (bf16_t*)(lds + 10880);
  float* wkl = (float*)(lds + 10880 + 17408);
  const bf16_t* pb = WS(bf16_t, OFF_P);
  const int tid = TIDX(), lane = tid & 63, wid = tid >> 6;
  if (tid < 128) {
    const int dir = tid >> 6, s = lane, row = c.row0 + s;
    const float gi = bf2f(pb[(size_t)row * NIN + 1024 + dir * 8 + hd]) + p.in[I_MLIB][l * 8 + dir * 4 + hd];
    const float gf = bf2f(pb[(size_t)row * NIN + 1024 + dir * 8 + 4 + hd]) + p.in[I_MLFB][l * 8 + dir * 4 + hd];
    const float lf = fminf(gf, 0.f) - log1pf(__expf(-fabsf(gf)));
    WS(float, OFF_GLI)[(size_t)(dir * 4 + hd) * NTOK + row] = gi; WS(float, OFF_GLF)[(size_t)(dir * 4 + hd) * NTOK + row] = lf;
    const float incl = scan_sum64(lf, lane);
    const float total = rdlane(incl, 63);
    const float g = (dir == 0 ? total - incl : incl - lf) + gi;
    const float mloc = wave_max(g);
    wkl[dir * 64 + s] = __expf(g - mloc);
    if (s == 0) { const int chain = dir * 32 + c.b * 4 + hd, pc = ml_pc(c, dir); WS(float, OFF_SCM)[chain * 36 + pc] = mloc; WS(float, OFF_SCB)[chain * 36 + pc] = total; }
  }
  __syncthreads();
  { const int s = tid >> 3, d0 = (tid & 7) * 8, row = c.row0 + s, t = c.t0 + s;
    const bool hp = t > 0, hn = t < c.T - 1;
    const float* cw = p.in[I_MLCW] + l * 3 * 512; const float* cb = p.in[I_MLCB] + l * 512;
    const u32x4 z4 = {0u, 0u, 0u, 0u};
    float qk[2][8];
#pragma unroll
    for (int which = 0; which < 2; ++which) { const int col = which * 256 + hd * 64 + d0; const bf16_t* pr = pb + (size_t)row * NIN + col;
      float cur[8], prv[8], nxt[8]; unpack8(ld8g(pr), cur); unpack8(hp ? ld8g(pr - NIN) : z4, prv); unpack8(hn ? ld8g(pr + NIN) : z4, nxt);
#pragma unroll
      for (int i = 0; i < 8; ++i) { const int j = col + i; const float x = prv[i] * cw[j] + cur[i] * cw[512 + j] + nxt[i] * cw[1024 + j] + cb[j]; qk[which][i] = siluf_(x); } }
#pragma unroll
    for (int i = 0; i < 8; ++i) qk[0][i] *= 0.125f;
    *(u32x4*)(WS(bf16_t, OFF_MQ) + (size_t)row * 256 + hd * 64 + d0) = pack8(qk[0]);
    *(u32x4*)(WS(bf16_t, OFF_MK) + (size_t)row * 256 + hd * 64 + d0) = pack8(qk[1]);
    const float w0 = wkl[s], w1 = wkl[64 + s];
#pragma unroll
    for (int i = 0; i < 8; ++i) { KWl[(0 * 64 + d0 + i) * 68 + s] = f2bf(qk[1][i] * w0); KWl[(1 * 64 + d0 + i) * 68 + s] = f2bf(qk[1][i] * w1); }
    const u32x4 vv = ld8g(pb + (size_t)row * NIN + 512 + hd * 64 + d0);
#pragma unroll
    for (int i = 0; i < 4; ++i) { VTl[(d0 + 2 * i) * 68 + s] = (bf16_t)(vv[i] & 0xffffu); VTl[(d0 + 2 * i + 1) * 68 + s] = (bf16_t)(vv[i] >> 16); }
    *(u32x4*)(WS(bf16_t, OFF_MO) + (size_t)row * 256 + hd * 64 + d0) = ld8g(pb + (size_t)row * NIN + 768 + hd * 64 + d0);
    if (tid < 64) VTl[64 * 68 + tid] = (bf16_t)0x3F80u;
    for (int i = tid; i < 15 * 68; i += NTHREADS) VTl[65 * 68 + i] = 0;
  }
  __syncthreads();
  { const int e = tid >> 3, sseg = (tid & 7) * 8; const u32x2 a = *(const u32x2*)(VTl + e * 68 + sseg), b2 = *(const u32x2*)(VTl + e * 68 + sseg + 4);
    u32x4 w; w[0] = a[0]; w[1] = a[1]; w[2] = b2[0]; w[3] = b2[1];
    *(u32x4*)(WS(bf16_t, OFF_MVT) + ((size_t)(chunk * 4 + hd) * 64 + e) * 64 + sseg) = w; }
  { const int fr = lane & 15, fq = lane >> 4;
#pragma unroll 1
    for (int ti = 0; ti < 5; ++ti) { const int id = wid * 5 + ti, dir = id / 20, et = (id % 20) >> 2, dt = id & 3;
      f32x4 acc = {0.f, 0.f, 0.f, 0.f};
#pragma unroll
      for (int ks = 0; ks < 2; ++ks) {
        const bf16_t* ap = VTl + (et * 16 + fr) * 68 + ks * 32 + fq * 8; const bf16_t* bp = KWl + (dir * 64 + dt * 16 + fr) * 68 + ks * 32 + fq * 8;
        u32x4 aw, bw; { const u32x2 x0 = *(const u32x2*)ap, x1 = *(const u32x2*)(ap + 4); aw[0] = x0[0]; aw[1] = x0[1]; aw[2] = x1[0]; aw[3] = x1[1]; }
        { const u32x2 x0 = *(const u32x2*)bp, x1 = *(const u32x2*)(bp + 4); bw[0] = x0[0]; bw[1] = x0[1]; bw[2] = x1[0]; bw[3] = x1[1]; }
        acc = __builtin_amdgcn_mfma_f32_16x16x32_bf16(__builtin_bit_cast(bf16x8, aw), __builtin_bit_cast(bf16x8, bw), acc, 0, 0, 0); }
      const int chain = dir * 32 + c.b * 4 + hd, pc = ml_pc(c, dir);
      bf16_t* st = WS(bf16_t, OFF_ST) + (size_t)(chain * 36 + pc) * 5120;
#pragma unroll
      for (int j = 0; j < 4; ++j) st[(et * 16 + fq * 4 + j) * 64 + dt * 16 + fr] = f2bf(acc[j]); }
  }
  __syncthreads();
}

DEV float tanh_fast(float x) { return 1.f - 2.f * __builtin_amdgcn_rcpf(1.f + __expf(2.f * x)); }
DEV void prep_rwkv_flat(CParams& p, int l) {
  const bf16_t* pb = WS(bf16_t, OFF_P); const float* mu = p.in[I_RWMU] + l * 3072;
  const int lane = TIDX() & 63, wid = TIDX() >> 6;
  const int per = (NTOK + (int)gridDim.x - 1) / (int)gridDim.x, pw = (per + 7) / 8;
  const int rA = (int)blockIdx.x * per + wid * pw; int rB = rA + pw; { const int re = (int)blockIdx.x * per + per; if (rB > re) rB = re; if (rB > NTOK) rB = NTOK; }
  if (rA >= rB) return;
  const u32x4 z4 = {0u, 0u, 0u, 0u};
  u32x4 prv[3], cur[3], nxt[3];
#pragma unroll
  for (int st = 0; st < 3; ++st) { const bf16_t* pr = pb + (size_t)rA * NIN + 1040 + (st * 64 + lane) * 8; cur[st] = ld8g(pr); prv[st] = rA > 0 ? ld8g(pr - NIN) : z4; }
#pragma unroll 1
  for (int row = rA; row < rB; ++row) {
    int t, T; if (row < NCTXR) { t = row & 255; T = 256; } else { t = (row - NCTXR) & 2047; T = 2048; }
#pragma unroll
    for (int st = 0; st < 3; ++st) nxt[st] = row + 1 < NTOK ? ld8g(pb + (size_t)(row + 1) * NIN + 1040 + (st * 64 + lane) * 8) : z4;
    const bool hp = t > 0, hn = t < T - 1;
#pragma unroll
    for (int st = 0; st < 3; ++st) { const int seg = st * 64 + lane, col = seg * 8;
      float c[8], pv[8], nx[8], x[8]; unpack8(cur[st], c); unpack8(hp ? prv[st] : z4, pv); unpack8(hn ? nxt[st] : z4, nx);
#pragma unroll
      for (int i = 0; i < 8; ++i) x[i] = c[i] + mu[col + i] * (pv[i] - c[i]) + mu[1536 + col + i] * (nx[i] - c[i]);
      if (st == 0 && lane < 48) *(u32x4*)(WS(bf16_t, OFF_RB) + (size_t)row * 384 + col) = pack8(x);
      if ((st == 0 && lane >= 48) || (st == 1 && lane < 32)) { const int kc = (seg - 48) * 8; float kk[8], ss = 0.f;
#pragma unroll
        for (int i = 0; i < 8; ++i) { kk[i] = x[i] * p.in[I_RWKK][l * 384 + kc + i]; ss += kk[i] * kk[i]; }
        ss = grp8_sum(ss);
        *(u32x4*)(WS(bf16_t, OFF_KB) + (size_t)row * 384 + kc) = pack8(x); const float inv = rsqrtf(ss + 1e-12f);
#pragma unroll
        for (int i = 0; i < 8; ++i) kk[i] *= inv;
        *(u32x4*)(WS(bf16_t, OFF_KH) + (size_t)row * 384 + kc) = pack8(kk); }
      if ((st == 1 && lane >= 32) || (st == 2 && lane < 16)) *(u32x4*)(WS(bf16_t, OFF_VB) + (size_t)row * 384 + (seg - 96) * 8) = pack8(x);
      if (st == 2 && lane >= 16) { const int zc = (seg - 144) * 8;
        if (zc < 128) { for (int i = 0; i < 8; ++i) x[i] = tanh_fast(x[i]); } else if (zc >= 256) { for (int i = 0; i < 8; ++i) x[i] = sigmoidf_(x[i]); }
        *(u32x4*)(WS(bf16_t, OFF_ZB) + (size_t)row * 384 + zc) = pack8(x); }
      prv[st] = cur[st]; cur[st] = nxt[st]; }
  }
}
DEV void prep_mla_flat(CParams& p, int l) {
  const bf16_t* pb = WS(bf16_t, OFF_P); const int tid = TIDX(), lane = tid & 63, gw = (int)blockIdx.x * 8 + (tid >> 6), nw = (int)gridDim.x * 8;
#pragma unroll 3
  for (int row = gw; row < NTOK; row += nw) { const bool isctx = row < NCTXR; const int t = isctx ? (row & 255) : ((row - NCTXR) & 2047); const bf16_t* pr = pb + (size_t)row * NIN;
    { float v[8]; float ss = 0.f; if (lane < 48) { unpack8(ld8g(pr + 2576 + lane * 8), v); for (int i = 0; i < 8; ++i) ss += v[i] * v[i]; }
      const float inv = rsqrtf(wave_sum(ss) * (1.f / 384.f) + LN_EPS);
      if (lane < 48) { for (int i = 0; i < 8; ++i) v[i] = v[i] * inv * p.in[I_QNG][l * 384 + lane * 8 + i]; *(u32x4*)(WS(bf16_t, OFF_CQN) + (size_t)row * 384 + lane * 8) = pack8(v); } }
    { float v[8]; float ss = 0.f; if (lane < 32) { unpack8(ld8g(pr + 2960 + lane * 8), v); for (int i = 0; i < 8; ++i) ss += v[i] * v[i]; }
      const float inv = rsqrtf(wave_sum(ss) * (1.f / 256.f) + LN_EPS);
      if (lane < 32) { for (int i = 0; i < 8; ++i) v[i] = v[i] * inv * p.in[I_KVNG][l * 256 + lane * 8 + i]; *(u32x4*)(WS(bf16_t, OFF_CKVN) + (size_t)row * 256 + lane * 8) = pack8(v); } }
    { const float x = bf2f(pr[3216 + (lane & 31)]); const float pt = dppf<0x128>(x); float o = x;
      if (!isctx) { const int f = lane & 7; const int pos = (lane & 16) ? (t & 63) : (t >> 6);
        const float invf = __expf(-(float)f * (9.210340372f / 8.f)); float rev = (float)pos * invf * 0.15915494309f; rev -= floorf(rev);
        const float sn = __builtin_amdgcn_sinf(rev), cs = __builtin_amdgcn_cosf(rev);
        o = (lane & 8) ? x * cs + pt * sn : x * cs - pt * sn; }
      if (lane < 32) WS(bf16_t, OFF_KR)[(size_t)row * 32 + lane] = f2bf(o); }
  }
}

DEV void ph_prep(CParams& p, int l, unsigned char* lds) {
  for (int r_ = 0; r_ < PM_REP; ++r_)
  for (int u = blockIdx.x; u < 288 * 4; u += gridDim.x) { const int chunk = u >> 2; const ChunkInfo c = chunk_info(chunk); prep_mlstm(p, l, c, chunk, u & 3, lds); }
  for (int r_ = 0; r_ < PF_REP; ++r_) { prep_rwkv_flat(p, l); prep_mla_flat(p, l); }
}

DEV void mlstm_state_scan(CParams& p, int chain) {
  const int tid = TIDX(); const bool two = tid < 128;
  float C0[8], C1[8];
#pragma unroll
  for (int i = 0; i < 8; ++i) { C0[i] = 0.f; C1[i] = 0.f; }
  float m = -1e30f;
  bf16_t* blk = WS(bf16_t, OFF_ST) + (size_t)chain * 36 * 5120;
  u32x4 q0a, q0b = {0u, 0u, 0u, 0u}, q1a, q1b = {0u, 0u, 0u, 0u}, q2a, q2b = {0u, 0u, 0u, 0u};
#define SS_LOAD(A, B, pc_) do { const bf16_t* sp_ = blk + (size_t)(pc_) * 5120; A = *(const u32x4*)(sp_ + tid * 8); if (two) B = *(const u32x4*)(sp_ + (512 + tid) * 8); } while (0)
#define SS_STEP(A, B, pc_) do { bf16_t* cb = blk + (size_t)(pc_) * 5120; const u32x4 l0 = A, l1 = B; \
    if ((pc_) + 3 < 36) SS_LOAD(A, B, (pc_) + 3); \
    const float mloc = WS(float, OFF_SCM)[chain * 36 + (pc_)], bend = WS(float, OFF_SCB)[chain * 36 + (pc_)]; \
    *(u32x4*)(cb + tid * 8) = pack8(C0); if (two) *(u32x4*)(cb + (512 + tid) * 8) = pack8(C1); \
    if (tid == 0) WS(float, OFF_SCMB)[chain * 36 + (pc_)] = m; \
    const float mnew = fmaxf(bend + m, mloc), decay = __expf(bend + m - mnew), sl = __expf(mloc - mnew); \
    float f0[8], f1[8]; unpack8(l0, f0); unpack8(l1, f1); \
    _Pragma("unroll") for (int i = 0; i < 8; ++i) { C0[i] = decay * C0[i] + sl * f0[i]; C1[i] = decay * C1[i] + sl * f1[i]; } \
    m = mnew; } while (0)
  SS_LOAD(q0a, q0b, 0); SS_LOAD(q1a, q1b, 1); SS_LOAD(q2a, q2b, 2);
#pragma unroll 1
  for (int pc = 0; pc < 36; pc += 3) { SS_STEP(q0a, q0b, pc); SS_STEP(q1a, q1b, pc + 1); SS_STEP(q2a, q2b, pc + 2); }
#undef SS_LOAD
#undef SS_STEP
}
template <int MASK> DEV void ph_mid_t(CParams& p, int lx, unsigned char* lds) {
  const int l = lx & 1;
  LAS unsigned char* ll = (LAS unsigned char*)lds;
  pg8::StaticOrder S;
  if constexpr (MASK & 1) { S.init(NTOK, 2048, gridDim.x, blockIdx.x); pg8::Gemm g{WS(bf16_t, OFF_ZB), WS(bf16_t, OFF_WLORA) + (size_t)l * 2048 * 384, NTOK, 2048, 384};
    EpiBf16 E{WS(bf16_t, OFF_LORA), 1920, 1920}; pg8::gemm_phase(ll, g, S, E); }
  const bool rot = gridDim.x == 256, act = !rot || blockIdx.x < 192;
  if constexpr (MASK & 2) { if (act) { if (rot) S.init(NTOK, 768, 192, ((int)blockIdx.x + 128) % 192); else S.init(NTOK, 768, gridDim.x, blockIdx.x);
    pg8::Gemm g{WS(bf16_t, OFF_CQN), WS(bf16_t, OFF_WQUP) + (size_t)l * 768 * 384, NTOK, 768, 384};
    EpiBf16 E{WS(bf16_t, OFF_QB), 576, 576}; pg8::gemm_phase(ll, g, S, E); } }
  if constexpr (MASK & 4) { if (act) { if (rot) S.init(NTOK, 768, 192, ((int)blockIdx.x + 104) % 192); else S.init(NTOK, 768, gridDim.x, blockIdx.x);
    pg8::Gemm g{WS(bf16_t, OFF_CKVN), WS(bf16_t, OFF_WKVUP) + (size_t)l * 768 * 256, NTOK, 768, 256};
    EpiBf16 E{WS(bf16_t, OFF_KV), 768, 768}; pg8::gemm_phase(ll, g, S, E); } }
  if constexpr (MASK & 8) { const int c = (int)gridDim.x - 1 - (int)blockIdx.x; if (c < 64) mlstm_state_scan(p, c); }
  if constexpr (MASK & 8) {
  unsigned* cnt = WS(unsigned, OFF_CNT) + 8 + lx; unsigned* slot = (unsigned*)lds;
  for (;;) {
    __syncthreads();
    if (TIDX() == 0) *slot = atomicAdd(cnt, 1u);
    __syncthreads();
    const unsigned ch = *slot + CONV_MID0; if (ch >= 2048u) break;
    const int tb = ch >> 10, e = (int)(ch & 1023) * 16 + (TIDX() >> 5), seg = TIDX() & 31;
    const float* src = p.in[tb ? I_PV : I_PU] + ((size_t)l * 16384 + e) * 1024 + seg * 32; const float scl = tb ? 4.f : 64.f;
    unsigned char* dst = WS(unsigned char, tb ? OFF_TABV : OFF_TABU) + ((size_t)(seg >> 3) * 16384 + e) * 128 + (seg & 7) * 16;
    u32x4 w0;
#pragma unroll
    for (int i = 0; i < 4; ++i) { const f32x4 a = *(const f32x4*)(src + i * 8) * scl, b2 = *(const f32x4*)(src + i * 8 + 4) * scl; unsigned w = 0u;
      w = __builtin_amdgcn_cvt_scalef32_pk_fp4_f32(w, a[0], a[1], 1.0f, 0); w = __builtin_amdgcn_cvt_scalef32_pk_fp4_f32(w, a[2], a[3], 1.0f, 1);
      w = __builtin_amdgcn_cvt_scalef32_pk_fp4_f32(w, b2[0], b2[1], 1.0f, 2); w = __builtin_amdgcn_cvt_scalef32_pk_fp4_f32(w, b2[2], b2[3], 1.0f, 3);
      w0[i] = w; }
    *(u32x4*)dst = w0;
  }
  }
  __syncthreads();
}
DEV void ph_mid(CParams& p, int l, unsigned char* lds) { ph_mid_t<15>(p, l, lds); }

DEV int rw_rowof(int dir, int b, int pos) { if (pos < 256) { const int t = dir ? 255 - pos : pos; return b * 256 + t; } const int q = pos - 256; const int t = dir ? 2047 - q : q; return NCTXR + b * 2048 + t; }
DEV void rwkv_scan_unit(CParams& p, int l, int u, unsigned char* lds) {
  constexpr int TS = 32;
  const int chain = u >> 1, half = u & 1, dir = chain / 48, bh = chain % 48, b = bh / 6, h6 = bh % 6;
  float* sb = (float*)lds;
  float* yb = sb + 2 * 6 * TS * 64;
  const int tid = TIDX(), rl = tid >> 4, kq = tid & 15, col = h6 * 64 + kq * 4;
  float ka[4];
#pragma unroll
  for (int i = 0; i < 4; ++i) ka[i] = p.in[I_RWKA][l * 384 + col + i];
  const bf16_t* RBp = WS(bf16_t, OFF_RB); const bf16_t* KBp = WS(bf16_t, OFF_KB); const bf16_t* KHp = WS(bf16_t, OFF_KH); const bf16_t* VBp = WS(bf16_t, OFF_VB);
  const bf16_t* LOp = WS(bf16_t, OFF_LORA) + dir * 384 + col;
  float w0v[4], a0v[4];
#pragma unroll
  for (int i = 0; i < 4; ++i) { w0v[i] = p.in[I_RWW0][l * 768 + dir * 384 + col + i]; a0v[i] = p.in[I_RWA0][l * 768 + dir * 384 + col + i]; }
  u32x2 g_r, g_k, g_kh, g_v, g_lw, g_a;
#define RW_LOAD(c) do { const size_t off = (size_t)rw_rowof(dir, b, (c) * TS + rl) * 384 + col; g_r = *(const u32x2*)(RBp + off); g_k = *(const u32x2*)(KBp + off); \
    g_kh = *(const u32x2*)(KHp + off); g_v = *(const u32x2*)(VBp + off); const size_t off2 = (size_t)rw_rowof(dir, b, (c) * TS + rl) * 1920; g_lw = *(const u32x2*)(LOp + off2); g_a = *(const u32x2*)(LOp + off2 + 768); } while (0)
#define RW_WRITE(bi) do { float* base = sb + (bi) * 6 * TS * 64 + rl * 64 + kq * 4; \
    const float r_[4] = {lo16(g_r[0]), hi16(g_r[0]), lo16(g_r[1]), hi16(g_r[1])}, k_[4] = {lo16(g_k[0]), hi16(g_k[0]), lo16(g_k[1]), hi16(g_k[1])}; \
    const float kh_[4] = {lo16(g_kh[0]), hi16(g_kh[0]), lo16(g_kh[1]), hi16(g_kh[1])}, v_[4] = {lo16(g_v[0]), hi16(g_v[0]), lo16(g_v[1]), hi16(g_v[1])}; \
    const float lw_[4] = {lo16(g_lw[0]), hi16(g_lw[0]), lo16(g_lw[1]), hi16(g_lw[1])}, a_[4] = {lo16(g_a[0]), hi16(g_a[0]), lo16(g_a[1]), hi16(g_a[1])}; \
    f32x4 o0, o1, o2, o3, o4, o5; \
    _Pragma("unroll") for (int i = 0; i < 4; ++i) { const float aa = sigmoidf_(a0v[i] + a_[i]); o0[i] = __expf(-0.60653065971f * sigmoidf_(w0v[i] + lw_[i])); o1[i] = kh_[i]; o2[i] = kh_[i] * aa; o3[i] = k_[i] * (1.f + (aa - 1.f) * ka[i]); o4[i] = r_[i]; o5[i] = v_[i]; } \
    *(f32x4*)(base + 0 * TS * 64) = o0; *(f32x4*)(base + 1 * TS * 64) = o1; *(f32x4*)(base + 2 * TS * 64) = o2; *(f32x4*)(base + 3 * TS * 64) = o3; \
    *(f32x4*)(base + 4 * TS * 64) = o4; *(f32x4*)(base + 5 * TS * 64) = o5; } while (0)
  f32x2 SA = {0.f, 0.f}, SB = {0.f, 0.f};
  __syncthreads();
  RW_LOAD(0); RW_WRITE(0);
  __syncthreads();
  constexpr int NCH = 2304 / TS;
#pragma unroll 1
  for (int c = 0; c < NCH; ++c) {
    if (c + 1 < NCH) RW_LOAD(c + 1);
    const float* base = sb + (c & 1) * 6 * TS * 64 + kq * 4; const float* vbase = sb + (c & 1) * 6 * TS * 64 + 5 * TS * 64 + half * 32 + rl;
    f32x4 w4 = *(const f32x4*)(base), kh4 = *(const f32x4*)(base + TS * 64), ab4 = *(const f32x4*)(base + 2 * TS * 64), kt4 = *(const f32x4*)(base + 3 * TS * 64), r4 = *(const f32x4*)(base + 4 * TS * 64);
    float vv = vbase[0];
#pragma unroll
    for (int ts = 0; ts < TS; ++ts) {
      f32x4 nw4 = w4, nkh4 = kh4, nab4 = ab4, nkt4 = kt4, nr4 = r4; float nvv = vv;
      if (ts + 1 < TS) { const float* bp = base + (ts + 1) * 64;
        nw4 = *(const f32x4*)(bp); nkh4 = *(const f32x4*)(bp + TS * 64); nab4 = *(const f32x4*)(bp + 2 * TS * 64); nkt4 = *(const f32x4*)(bp + 3 * TS * 64); nr4 = *(const f32x4*)(bp + 4 * TS * 64);
        nvv = vbase[(ts + 1) * 64]; }
      const f32x2 khA = {kh4[0], kh4[1]}, khB = {kh4[2], kh4[3]}, wA = {w4[0], w4[1]}, wB = {w4[2], w4[3]}, abA = {ab4[0], ab4[1]}, abB = {ab4[2], ab4[3]},
                  ktA = {kt4[0], kt4[1]}, ktB = {kt4[2], kt4[3]}, rA = {r4[0], r4[1]}, rB = {r4[2], r4[3]};
      f32x2 pa = SA * khA + SB * khB;
      float sa = row16_sum(pa[0] + pa[1]);
      const f32x2 vv2 = {vv, vv}, sa2 = {sa, sa};
      SA = SA * wA + (vv2 * ktA - sa2 * abA); SB = SB * wB + (vv2 * ktB - sa2 * abB);
      f32x2 py = SA * rA + SB * rB;
      float y = row16_sum(py[0] + py[1]);
      yb[ts * 32 + rl] = y;
      w4 = nw4; kh4 = nkh4; ab4 = nab4; kt4 = nkt4; r4 = nr4; vv = nvv;
    }
    __syncthreads();
    { const int ts = tid >> 4, pr = tid & 15; const int row = rw_rowof(dir, b, c * TS + ts);
      *(unsigned*)(WS(bf16_t, OFF_RWY) + ((size_t)dir * NTOK + row) * 384 + h6 * 64 + half * 32 + pr * 2) = pack2(yb[ts * 32 + pr * 2], yb[ts * 32 + pr * 2 + 1]); }
    if (c + 1 < NCH) RW_WRITE((c + 1) & 1);
    __syncthreads();
  }
#undef RW_LOAD
#undef RW_WRITE
}

DEV bf16x8 ld_frag16(const bf16_t* ptr) { return *(const bf16x8*)ptr; }
DEV bf16x8 ld_frag8x2(const bf16_t* p0, const bf16_t* p1) { const u32x2 x0 = *(const u32x2*)p0, x1 = *(const u32x2*)p1; u32x4 w; w[0] = x0[0]; w[1] = x0[1]; w[2] = x1[0]; w[3] = x1[1]; return __builtin_bit_cast(bf16x8, w); }
typedef short v4s16 __attribute__((ext_vector_type(4)));
template <int OFF> DEV u32x2 tr_read(unsigned addr) { return __builtin_bit_cast(u32x2, __builtin_amdgcn_ds_read_tr16_b64_v4i16((LAS v4s16*)(addr + (unsigned)OFF))); }
DEV bf16x8 frag_lo(u32x2 lo) { u32x4 w; w[0] = lo[0]; w[1] = lo[1]; w[2] = 0u; w[3] = 0u; return __builtin_bit_cast(bf16x8, w); }
DEV bf16x8 frag2(u32x2 lo, u32x2 hi) { u32x4 w; w[0] = lo[0]; w[1] = lo[1]; w[2] = hi[0]; w[3] = hi[1]; return __builtin_bit_cast(bf16x8, w); }
DEV u32x2 acc2bf(f32x4 a) { u32x2 w; w[0] = (unsigned)f2bf(a[0]) | ((unsigned)f2bf(a[1]) << 16); w[1] = (unsigned)f2bf(a[2]) | ((unsigned)f2bf(a[3]) << 16); return w; }
DEV void rwkv_chunk_unit(CParams& p, int l, int u, unsigned char* lds) {
  constexpr int O_A = 0, O_Q = 2176, O_NB = 4352, O_C = 6528, O_V = 8704, O_M1T = 10880, O_U1T = 11392, O_NU2T = 11904, O_TT = 12416, O_GAM = 12928, SCB = 13184, CHB = 4 * SCB;
  constexpr int O_PRIV = 2 * CHB, P_LW = 0, P_M2 = 4096, PRIV = 5120, O_CONST = O_PRIV + 4 * PRIV;
  const int chain = u, dir = chain / 48, bh = chain % 48, b = bh / 6, h6 = bh % 6;
  const int tid = TIDX(), lane = tid & 63, wid = tid >> 6, fr = lane & 15, fq = lane >> 4;
  float* cst = (float*)(lds + O_CONST);
  __syncthreads();
  if (tid < 64) { cst[tid] = p.in[I_RWW0][l * 768 + dir * 384 + h6 * 64 + tid]; cst[64 + tid] = p.in[I_RWA0][l * 768 + dir * 384 + h6 * 64 + tid]; cst[128 + tid] = p.in[I_RWKA][l * 384 + h6 * 64 + tid]; cst[192 + tid] = p.in[I_RWRK][l * 384 + h6 * 64 + tid]; }
  __syncthreads();
  const bool producer = wid >= 4;
  const int pj = wid - 4, pt = lane >> 2, pks = lane & 3;
  u32x4 in_r[2], in_k[2], in_kh[2], in_v[2], in_lw[2], in_a[2];
#define RC_LOAD(c) do { int lo32_ = h6 * 64 + pks * 16; asm volatile("" : "+v"(lo32_));   \
    const int row_ = rw_rowof(dir, b, (c) * 64 + pj * 16 + pt); const size_t o_ = (size_t)row_ * 384 + lo32_; \
    in_r[0] = ld8g(WS(bf16_t, OFF_RB) + o_); in_r[1] = ld8g(WS(bf16_t, OFF_RB) + o_ + 8); in_k[0] = ld8g(WS(bf16_t, OFF_KB) + o_); in_k[1] = ld8g(WS(bf16_t, OFF_KB) + o_ + 8); \
    in_kh[0] = ld8g(WS(bf16_t, OFF_KH) + o_); in_kh[1] = ld8g(WS(bf16_t, OFF_KH) + o_ + 8); in_v[0] = ld8g(WS(bf16_t, OFF_VB) + o_); in_v[1] = ld8g(WS(bf16_t, OFF_VB) + o_ + 8); \
    const bf16_t* lo_ = WS(bf16_t, OFF_LORA) + (size_t)row_ * 1920 + dir * 384 + lo32_; in_lw[0] = ld8g(lo_); in_lw[1] = ld8g(lo_ + 8); in_a[0] = ld8g(lo_ + 768); in_a[1] = ld8g(lo_ + 776); } while (0)
  f32x4 sacc[4];
#pragma unroll
  for (int i = 0; i < 4; ++i) sacc[i] = (f32x4){0.f, 0.f, 0.f, 0.f};
  if (producer) RC_LOAD(0);
#pragma unroll 1
  for (int c = -1; c < 36; ++c) {
    if (producer) {
      if (c + 1 < 36) {
        unsigned char* scb = lds + ((c + 1) & 1) * CHB + pj * SCB; unsigned char* prv = lds + O_PRIV + pj * PRIV;
        float r_[16], k_[16], kh_[16], lw_[16], aa_[16];
        unpack8(in_r[0], r_); unpack8(in_r[1], r_ + 8); unpack8(in_k[0], k_); unpack8(in_k[1], k_ + 8); unpack8(in_kh[0], kh_); unpack8(in_kh[1], kh_ + 8);
        unpack8(in_lw[0], lw_); unpack8(in_lw[1], lw_ + 8); unpack8(in_a[0], aa_); unpack8(in_a[1], aa_ + 8);
        const u32x4 vraw0 = in_v[0], vraw1 = in_v[1];
        float* LW = (float*)(prv + P_LW);
#pragma unroll
        for (int i = 0; i < 16; ++i) { const int col = pks * 16 + i; aa_[i] = sigmoidf_(cst[64 + col] + aa_[i]); lw_[i] = -0.60653065971f * sigmoidf_(cst[col] + lw_[i]); }
#pragma unroll
        for (int i = 0; i < 4; ++i) *(f32x4*)(LW + pt * 64 + pks * 16 + i * 4) = (f32x4){lw_[4 * i], lw_[4 * i + 1], lw_[4 * i + 2], lw_[4 * i + 3]};
        { bf16_t* Vp = (bf16_t*)(scb + O_V) + pt * 68 + pks * 16;
          *(u32x2*)(Vp) = (u32x2){vraw0[0], vraw0[1]}; *(u32x2*)(Vp + 4) = (u32x2){vraw0[2], vraw0[3]}; *(u32x2*)(Vp + 8) = (u32x2){vraw1[0], vraw1[1]}; *(u32x2*)(Vp + 12) = (u32x2){vraw1[2], vraw1[3]}; }
        asm volatile("s_waitcnt lgkmcnt(0)" ::: "memory"); __builtin_amdgcn_wave_barrier();
        { float g = 0.f;
#pragma unroll
          for (int t = 0; t < 16; ++t) { g += LW[t * 64 + lane]; LW[t * 64 + lane] = g; }
          ((float*)(scb + O_GAM))[lane] = __expf(g); }
        asm volatile("s_waitcnt lgkmcnt(0)" ::: "memory"); __builtin_amdgcn_wave_barrier();
        { float av[16], bv[16], cv[16], qv[16];
#pragma unroll
          for (int i = 0; i < 4; ++i) { const f32x4 g4 = *(const f32x4*)(LW + pt * 64 + pks * 16 + i * 4);
#pragma unroll
            for (int jj = 0; jj < 4; ++jj) { const int e = 4 * i + jj; const float G = g4[jj], e1 = __expf(G), e2 = __expf(-G), e3 = __expf(G - lw_[e]);
              const float ab = kh_[e] * aa_[e], kt = k_[e] * (1.f + (aa_[e] - 1.f) * cst[128 + pks * 16 + e]);
              av[e] = kh_[e] * e3; bv[e] = ab * e2; cv[e] = kt * e2; qv[e] = r_[e] * e1; } }
          bf16_t* Ap = (bf16_t*)(scb + O_A) + pt * 68 + pks * 16; bf16_t* Qp = (bf16_t*)(scb + O_Q) + pt * 68 + pks * 16;
          bf16_t* Bp = (bf16_t*)(scb + O_NB) + pt * 68 + pks * 16; bf16_t* Cp = (bf16_t*)(scb + O_C) + pt * 68 + pks * 16;
#pragma unroll
          for (int i = 0; i < 4; ++i) { u32x2 w; w[0] = pack2(av[4 * i], av[4 * i + 1]); w[1] = pack2(av[4 * i + 2], av[4 * i + 3]); *(u32x2*)(Ap + 4 * i) = w;
            w[0] = pack2(qv[4 * i], qv[4 * i + 1]); w[1] = pack2(qv[4 * i + 2], qv[4 * i + 3]); *(u32x2*)(Qp + 4 * i) = w;
            w[0] = pack2(-bv[4 * i], -bv[4 * i + 1]); w[1] = pack2(-bv[4 * i + 2], -bv[4 * i + 3]); *(u32x2*)(Bp + 4 * i) = w;
            w[0] = pack2(cv[4 * i], cv[4 * i + 1]); w[1] = pack2(cv[4 * i + 2], cv[4 * i + 3]); *(u32x2*)(Cp + 4 * i) = w; } }
        asm volatile("s_waitcnt lgkmcnt(0)" ::: "memory"); __builtin_amdgcn_wave_barrier();
        if (c + 2 < 36) RC_LOAD(c + 2);
        {
          f32x4 mBA = {0.f, 0.f, 0.f, 0.f}, mCA = mBA, mBQ = mBA, mCQ = mBA;
#pragma unroll
          for (int ks = 0; ks < 2; ++ks) { const int ko = fr * 68 + ks * 32 + fq * 8;
            const bf16_t* bp = (const bf16_t*)(scb + O_NB) + ko; const bf16_t* cp = (const bf16_t*)(scb + O_C) + ko;   const bf16_t* ap = (const bf16_t*)(scb + O_A) + ko; const bf16_t* qp = (const bf16_t*)(scb + O_Q) + ko;
            const bf16x8 fb = ld_frag8x2(bp, bp + 4), fc = ld_frag8x2(cp, cp + 4), fa = ld_frag8x2(ap, ap + 4), fqv = ld_frag8x2(qp, qp + 4);
            mBA = __builtin_amdgcn_mfma_f32_16x16x32_bf16(fb, fa, mBA, 0, 0, 0); mCA = __builtin_amdgcn_mfma_f32_16x16x32_bf16(fc, fa, mCA, 0, 0, 0);
            mBQ = __builtin_amdgcn_mfma_f32_16x16x32_bf16(fb, fqv, mBQ, 0, 0, 0); mCQ = __builtin_amdgcn_mfma_f32_16x16x32_bf16(fc, fqv, mCQ, 0, 0, 0); }
          float* M2 = (float*)(prv + P_M2); float m1[4], u1[4], u2[4];
#pragma unroll
          for (int j = 0; j < 4; ++j) { const int s_ = 4 * fq + j; M2[s_ * 16 + fr] = s_ < fr ? -mBA[j] : 0.f; m1[j] = s_ < fr ? mCA[j] : 0.f; u1[j] = s_ <= fr ? mCQ[j] : 0.f; u2[j] = s_ <= fr ? mBQ[j] : 0.f; }
          u32x2 w; w[0] = pack2(m1[0], m1[1]); w[1] = pack2(m1[2], m1[3]); *(u32x2*)((bf16_t*)(scb + O_M1T) + fr * 16 + 4 * fq) = w;
          w[0] = pack2(u1[0], u1[1]); w[1] = pack2(u1[2], u1[3]); *(u32x2*)((bf16_t*)(scb + O_U1T) + fr * 16 + 4 * fq) = w;
          w[0] = pack2(u2[0], u2[1]); w[1] = pack2(u2[2], u2[3]); *(u32x2*)((bf16_t*)(scb + O_NU2T) + fr * 16 + 4 * fq) = w; }
        asm volatile("s_waitcnt lgkmcnt(0)" ::: "memory"); __builtin_amdgcn_wave_barrier();
        {
          const float* M2 = (const float*)(prv + P_M2); float Tc[16];
#pragma unroll
          for (int s_ = 15; s_ >= 0; --s_) { float x0 = (fr == s_) ? 1.f : 0.f, x1 = 0.f;
#pragma unroll
            for (int j = s_ + 1; j < 16; ++j) { if (j & 1) x1 -= M2[s_ * 16 + j] * Tc[j]; else x0 -= M2[s_ * 16 + j] * Tc[j]; }
            Tc[s_] = x0 + x1; }
          if (fq == 0) { bf16_t* TT = (bf16_t*)(scb + O_TT) + fr * 16; *(u32x4*)TT = pack8(Tc); *(u32x4*)(TT + 8) = pack8(Tc + 8); } }
      }
    } else if (c >= 0) {
      const int v0 = wid * 16;
      const int bt = lane >> 2, bks = lane & 3, brow = rw_rowof(dir, b, c * 64 + wid * 16 + bt);
      u32x4 b_r0, b_r1, b_k0, b_k1, b_a0, b_a1;
      { int bc = h6 * 64 + bks * 16; asm volatile("" : "+v"(bc)); const size_t bo = (size_t)brow * 384 + bc; const bf16_t* blo = WS(bf16_t, OFF_LORA) + (size_t)brow * 1920 + dir * 384 + bc + 768;
        b_r0 = ld8g(WS(bf16_t, OFF_RB) + bo); b_r1 = ld8g(WS(bf16_t, OFF_RB) + bo + 8); b_k0 = ld8g(WS(bf16_t, OFF_KB) + bo); b_k1 = ld8g(WS(bf16_t, OFF_KB) + bo + 8); b_a0 = ld8g(blo); b_a1 = ld8g(blo + 8); }
      f32x4 cvv[8]; int cm = (u * 4 + wid) * 36 + c; asm volatile("" : "+v"(cm));
      { const int ce = (cm & 8191) * 2 + (lane >> 5); const float* csrc = p.in[(cm >> 13) ? I_PV : I_PU] + ((size_t)l * 16384 + ce) * 1024 + (lane & 31) * 32;
#pragma unroll
        for (int i = 0; i < 8; ++i) cvv[i] = *(const f32x4*)(csrc + i * 4); }
#pragma unroll 1
      for (int j = 0; j < 4; ++j) { const unsigned char* scb = lds + (c & 1) * CHB + j * SCB;
        bf16x8 sb[2];
#pragma unroll
        for (int ks = 0; ks < 2; ++ks) sb[ks] = frag2(acc2bf(sacc[2 * ks]), acc2bf(sacc[2 * ks + 1]));
        const unsigned trl = (unsigned)(uintptr_t)scb + (unsigned)((4 * fq + (fr >> 2)) * 136 + (fr & 3) * 8);
        const bf16x8 vt = frag_lo(tr_read<0>(trl + O_V + v0 * 2));
        const bf16_t* Ar = (const bf16_t*)(scb + O_A) + fr * 68 + 4 * fq; const bf16_t* Qr = (const bf16_t*)(scb + O_Q) + fr * 68 + 4 * fq;
        f32x4 racc = {0.f, 0.f, 0.f, 0.f}, yacc = racc;
#pragma unroll
        for (int ks = 0; ks < 2; ++ks) { racc = __builtin_amdgcn_mfma_f32_16x16x32_bf16(ld_frag8x2(Ar + 32 * ks, Ar + 32 * ks + 16), sb[ks], racc, 0, 0, 0);
          yacc = __builtin_amdgcn_mfma_f32_16x16x32_bf16(ld_frag8x2(Qr + 32 * ks, Qr + 32 * ks + 16), sb[ks], yacc, 0, 0, 0); }
        racc = __builtin_amdgcn_mfma_f32_16x16x32_bf16(frag_lo(*(const u32x2*)((const bf16_t*)(scb + O_M1T) + fr * 16 + 4 * fq)), vt, racc, 0, 0, 0);
        yacc = __builtin_amdgcn_mfma_f32_16x16x32_bf16(frag_lo(*(const u32x2*)((const bf16_t*)(scb + O_U1T) + fr * 16 + 4 * fq)), vt, yacc, 0, 0, 0);
        f32x4 zacc = {0.f, 0.f, 0.f, 0.f};
        zacc = __builtin_amdgcn_mfma_f32_16x16x32_bf16(frag_lo(*(const u32x2*)((const bf16_t*)(scb + O_TT) + fr * 16 + 4 * fq)), frag_lo(acc2bf(racc)), zacc, 0, 0, 0);
        const bf16x8 zf = frag_lo(acc2bf(zacc));
        yacc = __builtin_amdgcn_mfma_f32_16x16x32_bf16(frag_lo(*(const u32x2*)((const bf16_t*)(scb + O_NU2T) + fr * 16 + 4 * fq)), zf, yacc, 0, 0, 0);
        const float* gam = (const float*)(scb + O_GAM);
#pragma unroll
        for (int kt = 0; kt < 4; ++kt) {
          sacc[kt] = __builtin_amdgcn_mfma_f32_16x16x32_bf16(frag_lo(tr_read<0>(trl + O_C + kt * 32)), vt, sacc[kt], 0, 0, 0);
          sacc[kt] = __builtin_amdgcn_mfma_f32_16x16x32_bf16(frag_lo(tr_read<0>(trl + O_NB + kt * 32)), zf, sacc[kt], 0, 0, 0);
          sacc[kt] *= *(const f32x4*)(gam + kt * 16 + 4 * fq); }
#pragma unroll
        for (int jj = 0; jj < 4; ++jj) { const int row = rw_rowof(dir, b, c * 64 + j * 16 + 4 * fq + jj);
          WS(bf16_t, OFF_RWY)[((size_t)dir * NTOK + row) * 384 + h6 * 64 + v0 + fr] = f2bf(yacc[jj]); } }
      { float r_[16], k_[16], a_[16]; unpack8(b_r0, r_); unpack8(b_r1, r_ + 8); unpack8(b_k0, k_); unpack8(b_k1, k_ + 8); unpack8(b_a0, a_); unpack8(b_a1, a_ + 8);
        float s = 0.f;
#pragma unroll
        for (int i = 0; i < 16; ++i) { const int col = bks * 16 + i; const float a = sigmoidf_(cst[64 + col] + a_[i]); s += r_[i] * cst[192 + col] * (k_[i] * (1.f + (a - 1.f) * cst[128 + col])); }
        s += dppf<0xB1>(s); s += dppf<0x4E>(s);
        if (bks == 0) WS(float, OFF_BS)[((size_t)dir * NTOK + brow) * 6 + h6] = s; }
      { const int tb = cm >> 13, ce = (cm & 8191) * 2 + (lane >> 5), cseg = lane & 31; const float scl = tb ? 4.f : 64.f;
        unsigned char* dst = WS(unsigned char, tb ? OFF_TABV : OFF_TABU) + ((size_t)(cseg >> 3) * 16384 + ce) * 128 + (cseg & 7) * 16;
        u32x4 w0;
#pragma unroll
        for (int i = 0; i < 4; ++i) { const f32x4 a = cvv[2 * i] * scl, b2 = cvv[2 * i + 1] * scl; unsigned w = 0u;
          w = __builtin_amdgcn_cvt_scalef32_pk_fp4_f32(w, a[0], a[1], 1.0f, 0); w = __builtin_amdgcn_cvt_scalef32_pk_fp4_f32(w, a[2], a[3], 1.0f, 1);
          w = __builtin_amdgcn_cvt_scalef32_pk_fp4_f32(w, b2[0], b2[1], 1.0f, 2); w = __builtin_amdgcn_cvt_scalef32_pk_fp4_f32(w, b2[2], b2[3], 1.0f, 3);
          w0[i] = w; }
        *(u32x4*)dst = w0; }
    }
    __syncthreads();
  }
#undef RC_LOAD
}

DEV void attn_unit(CParams& p, int u, unsigned char* lds) {
  int b, head, qrow0, ntile; const bool lat = u < 384;
  if (lat) { b = u / 48; const int r = u % 48; head = r / 8; const int qb = r % 8; qrow0 = NCTXR + b * 2048 + qb * 256; ntile = 36; }
  else { const int v = u - 384; b = v / 6; head = v % 6; qrow0 = b * 256; ntile = 4; }
  const int tid = TIDX(), lane = tid & 63, wid = tid >> 6, r32 = lane & 31, hi = lane >> 5;
  constexpr int KROW = 208, VROW = 192, KT_B = 64 * KROW, VT_B = 64 * VROW, BUF_B = KT_B + VT_B;
  const bf16_t* KVp = WS(bf16_t, OFF_KV) + head * 128; const bf16_t* KRp = WS(bf16_t, OFF_KR);
  const int qrow = qrow0 + wid * 32 + r32;
  bf16x8 qf[6];
  { const bf16_t* qp = WS(bf16_t, OFF_QB) + (size_t)qrow * 576 + head * 96 + hi * 8;
    const float SC = 0.10206207262f * 1.44269504089f;
    const int t = lat ? ((qrow - NCTXR) & 2047) : 0;
#pragma unroll
    for (int ks = 0; ks < 6; ++ks) { float f[8]; unpack8(ld8g(qp + ks * 16), f);
      if (ks >= 4) { float pt[8];
#pragma unroll
        for (int j = 0; j < 8; ++j) { auto rr = __builtin_amdgcn_permlane32_swap(__float_as_uint(f[j]), __float_as_uint(f[j]), false, false); pt[j] = __uint_as_float(hi ? rr[0] : rr[1]); }
        if (lat) { const int pos = ks == 4 ? (t >> 6) : (t & 63);
#pragma unroll
          for (int j = 0; j < 8; ++j) { const float invf = __expf(-(float)j * (9.210340372f / 8.f)); float rev = (float)pos * invf * 0.15915494309f; rev -= floorf(rev);
            const float sn = __builtin_amdgcn_sinf(rev), cs = __builtin_amdgcn_cosf(rev);
            f[j] = hi ? f[j] * cs + pt[j] * sn : f[j] * cs - pt[j] * sn; } } }
#pragma unroll
      for (int j = 0; j < 8; ++j) f[j] *= SC;
      qf[ks] = __builtin_bit_cast(bf16x8, pack8(f)); } }
  const int k0key = tid / 12, k0part = tid % 12, k1key = (tid + 512) / 12, k1part = (tid + 512) % 12, vkey = tid >> 3, vpart = tid & 7;
  u32x4 skA0, skA1 = {0u, 0u, 0u, 0u}, svA, skB0, skB1 = {0u, 0u, 0u, 0u}, svB;
#define AT_ROW0(kt) (lat ? ((kt) < 32 ? NCTXR + b * 2048 + (kt) * 64 : b * 256 + ((kt) - 32) * 64) : b * 256 + (kt) * 64)
#define AT_LOAD(kt, sk0, sk1, sv) do { const int r0_ = AT_ROW0(kt); \
    sk0 = k0part < 8 ? ld8g(KVp + (size_t)(r0_ + k0key) * 768 + k0part * 8) : ld8g(KRp + (size_t)(r0_ + k0key) * 32 + (k0part - 8) * 8); \
    if (tid < 256) sk1 = k1part < 8 ? ld8g(KVp + (size_t)(r0_ + k1key) * 768 + k1part * 8) : ld8g(KRp + (size_t)(r0_ + k1key) * 32 + (k1part - 8) * 8); \
    sv = ld8g(KVp + (size_t)(r0_ + vkey) * 768 + 64 + vpart * 8); } while (0)
#define AT_WRITE(bi, sk0, sk1, sv) do { unsigned char* bb = lds + (bi) * BUF_B; *(u32x4*)(bb + k0key * KROW + k0part * 16) = sk0; \
    if (tid < 256) *(u32x4*)(bb + k1key * KROW + k1part * 16) = sk1; *(u32x4*)(bb + KT_B + vkey * VROW + vpart * 16) = sv; } while (0)
  const unsigned trb = (unsigned)(uintptr_t)lds + KT_B + ((4 * (lane >> 5) + ((lane & 15) >> 2)) * VROW + (16 * ((lane >> 4) & 1) + 4 * (lane & 3)) * 2);
  f32x16 o0, o1;
#pragma unroll
  for (int i = 0; i < 16; ++i) { o0[i] = 0.f; o1[i] = 0.f; }
  float m_run = -1e30f, l_run = 0.f;
  __syncthreads();
  AT_LOAD(0, skA0, skA1, svA); AT_LOAD(1, skB0, skB1, svB);
  AT_WRITE(0, skA0, skA1, svA); AT_WRITE(1, skB0, skB1, svB);
  if (2 < ntile) AT_LOAD(2, skA0, skA1, svA);
  if (3 < ntile) AT_LOAD(3, skB0, skB1, svB);
  __syncthreads();
  f32x16 sa0, sa1, sb0, sb1;
#define AT_KF(kb_, ks) *(const bf16x8*)((kb_) + r32 * KROW + ((ks) * 16 + hi * 8) * 2), *(const bf16x8*)((kb_) + (32 + r32) * KROW + ((ks) * 16 + hi * 8) * 2)
  { const unsigned char* kb = lds;
#pragma unroll
    for (int i = 0; i < 16; ++i) { sa0[i] = 0.f; sa1[i] = 0.f; }
#pragma unroll
    for (int ks = 0; ks < 6; ++ks) { const bf16x8 a0 = *(const bf16x8*)(kb + r32 * KROW + (ks * 16 + hi * 8) * 2), a1 = *(const bf16x8*)(kb + (32 + r32) * KROW + (ks * 16 + hi * 8) * 2);
      sa0 = __builtin_amdgcn_mfma_f32_32x32x16_bf16(a0, qf[ks], sa0, 0, 0, 0); sa1 = __builtin_amdgcn_mfma_f32_32x32x16_bf16(a1, qf[ks], sa1, 0, 0, 0); } }
  auto step = [&](f32x16& c0, f32x16& c1, f32x16& n0, f32x16& n1, const int bufv, const int bufk) {
    const unsigned char* kb = lds + bufk * BUF_B;
    const unsigned ta = trb + (unsigned)(bufv * BUF_B);
#define TR(st, rd, eb) tr_read<(st) * 16 * VROW + (rd) * 8 * VROW + (eb) * 64>(ta)
    const u32x2 t00 = TR(0, 0, 0), t01 = TR(0, 1, 0), t10 = TR(1, 0, 0), t11 = TR(1, 1, 0), t20 = TR(2, 0, 0), t21 = TR(2, 1, 0), t30 = TR(3, 0, 0), t31 = TR(3, 1, 0);
    const u32x2 u00 = TR(0, 0, 1), u01 = TR(0, 1, 1), u10 = TR(1, 0, 1), u11 = TR(1, 1, 1), u20 = TR(2, 0, 1), u21 = TR(2, 1, 1), u30 = TR(3, 0, 1), u31 = TR(3, 1, 1);
#undef TR
#define QK(ks) do { const bf16x8 a0_ = *(const bf16x8*)(kb + r32 * KROW + ((ks) * 16 + hi * 8) * 2), a1_ = *(const bf16x8*)(kb + (32 + r32) * KROW + ((ks) * 16 + hi * 8) * 2); \
      n0 = __builtin_amdgcn_mfma_f32_32x32x16_bf16(a0_, qf[ks], n0, 0, 0, 0); n1 = __builtin_amdgcn_mfma_f32_32x32x16_bf16(a1_, qf[ks], n1, 0, 0, 0); } while (0)
#pragma unroll
    for (int i = 0; i < 16; ++i) { n0[i] = 0.f; n1[i] = 0.f; }
    QK(0);
    __builtin_amdgcn_sched_barrier(0);
    float mx = fmaxf(fmaxf(c0[0], c0[1]), c0[2]);
#pragma unroll
    for (int i = 3; i < 15; i += 2) mx = fmaxf(fmaxf(mx, c0[i]), c0[i + 1]);
    mx = fmaxf(fmaxf(mx, c0[15]), c1[0]);
    __builtin_amdgcn_sched_barrier(0);
    QK(1);
    __builtin_amdgcn_sched_barrier(0);
#pragma unroll
    for (int i = 1; i < 15; i += 2) mx = fmaxf(fmaxf(mx, c1[i]), c1[i + 1]);
    mx = fmaxf(mx, c1[15]);
    mx = xhalf_max(mx);
    if (__builtin_amdgcn_ballot_w64(mx > m_run + 8.f) != 0ull) {
      const float mnew = fmaxf(m_run, mx), alpha = __builtin_amdgcn_exp2f(m_run - mnew); const f32x2 al2 = {alpha, alpha};
      m_run = mnew; l_run *= alpha;
#pragma unroll
      for (int i = 0; i < 8; ++i) { f32x2 a = {o0[2 * i], o0[2 * i + 1]}, b2 = {o1[2 * i], o1[2 * i + 1]}; a *= al2; b2 *= al2; o0[2 * i] = a[0]; o0[2 * i + 1] = a[1]; o1[2 * i] = b2[0]; o1[2 * i + 1] = b2[1]; } }
    const f32x2 mm = {m_run, m_run}; f32x2 ps2 = {0.f, 0.f};
    bf16x8 pf[4];
#define SMX(cc, base, pi) do { u32x4 w_; _Pragma("unroll") for (int i_ = 0; i_ < 4; ++i_) { f32x2 a_ = {cc[base + 2 * i_], cc[base + 2 * i_ + 1]}; a_ -= mm; \
        a_[0] = __builtin_amdgcn_exp2f(a_[0]); a_[1] = __builtin_amdgcn_exp2f(a_[1]); ps2 += a_; w_[i_] = pack2(a_[0], a_[1]); } pf[pi] = __builtin_bit_cast(bf16x8, w_); } while (0)
    __builtin_amdgcn_sched_barrier(0);
    QK(2);
    __builtin_amdgcn_sched_barrier(0);
    SMX(c0, 0, 0);
    __builtin_amdgcn_sched_barrier(0);
    QK(3);
    __builtin_amdgcn_sched_barrier(0);
    SMX(c0, 8, 1);
    __builtin_amdgcn_sched_barrier(0);
    QK(4);
    __builtin_amdgcn_sched_barrier(0);
    SMX(c1, 0, 2);
    __builtin_amdgcn_sched_barrier(0);
    QK(5);
    __builtin_amdgcn_sched_barrier(0);
    SMX(c1, 8, 3);
    l_run += ps2[0] + ps2[1];
#undef SMX
#undef QK
    __builtin_amdgcn_sched_barrier(0);
#define VF(lo, hi_) __builtin_bit_cast(bf16x8, (u32x4){lo[0], lo[1], hi_[0], hi_[1]})
    o0 = __builtin_amdgcn_mfma_f32_32x32x16_bf16(VF(t00, t01), pf[0], o0, 0, 0, 0); o1 = __builtin_amdgcn_mfma_f32_32x32x16_bf16(VF(u00, u01), pf[0], o1, 0, 0, 0);
    o0 = __builtin_amdgcn_mfma_f32_32x32x16_bf16(VF(t10, t11), pf[1], o0, 0, 0, 0); o1 = __builtin_amdgcn_mfma_f32_32x32x16_bf16(VF(u10, u11), pf[1], o1, 0, 0, 0);
    o0 = __builtin_amdgcn_mfma_f32_32x32x16_bf16(VF(t20, t21), pf[2], o0, 0, 0, 0); o1 = __builtin_amdgcn_mfma_f32_32x32x16_bf16(VF(u20, u21), pf[2], o1, 0, 0, 0);
    o0 = __builtin_amdgcn_mfma_f32_32x32x16_bf16(VF(t30, t31), pf[3], o0, 0, 0, 0); o1 = __builtin_amdgcn_mfma_f32_32x32x16_bf16(VF(u30, u31), pf[3], o1, 0, 0, 0);
#undef VF
  };
  int bv = 0;
#pragma unroll 1
  for (int kt = 0; kt < ntile; kt += 2) {
    { const int b1 = bv == 2 ? 0 : bv + 1, b2 = b1 == 2 ? 0 : b1 + 1;
      __syncthreads();
      if (kt + 2 < ntile) { AT_WRITE(b2, skA0, skA1, svA); if (kt + 4 < ntile) AT_LOAD(kt + 4, skA0, skA1, svA); }
      step(sa0, sa1, sb0, sb1, bv, b1);
      bv = b1; }
    { const int b1 = bv == 2 ? 0 : bv + 1, b2 = b1 == 2 ? 0 : b1 + 1;
      __syncthreads();
      if (kt + 3 < ntile) { AT_WRITE(b2, skB0, skB1, svB); if (kt + 5 < ntile) AT_LOAD(kt + 5, skB0, skB1, svB); }
      step(sb0, sb1, sa0, sa1, bv, b1);
      bv = b1; }
  }
#undef AT_KF
#undef AT_LOAD
#undef AT_WRITE
#undef AT_ROW0
  const float inv = 1.f / xhalf_sum(l_run);
  bf16_t* op = WS(bf16_t, OFF_H) + (size_t)qrow * 1024 + 640 + head * 64;
#pragma unroll
  for (int g = 0; g < 4; ++g) {
    u32x2 w; w[0] = pack2(o0[4 * g] * inv, o0[4 * g + 1] * inv); w[1] = pack2(o0[4 * g + 2] * inv, o0[4 * g + 3] * inv); *(u32x2*)(op + 8 * g + 4 * hi) = w;
    w[0] = pack2(o1[4 * g] * inv, o1[4 * g + 1] * inv); w[1] = pack2(o1[4 * g + 2] * inv, o1[4 * g + 3] * inv); *(u32x2*)(op + 32 + 8 * g + 4 * hi) = w; }
}

DEV void mlstm_out_unit(CParams& p, int l, int chunk, int hd, unsigned char* lds) {
  const ChunkInfo c = chunk_info(chunk);
  bf16_t* Ql = (bf16_t*)lds;
  bf16_t* Kl = (bf16_t*)(lds + 9216);
  bf16_t* VTl = (bf16_t*)(lds + 18432);
  bf16_t* Cl = (bf16_t*)(lds + 18432 + 10880);
  float* sc = (float*)(lds + 18432 + 10880 + 23040);
  float* rowterm = sc; float* uarr = sc + 128; float* winter = sc + 256; float* emt = sc + 384; float* lnred = sc + 512;
  const int tid = TIDX(), lane = tid & 63, wid = tid >> 6, fr = lane & 15, fq = lane >> 4;
  __syncthreads();
  { const int t = tid >> 3, seg = tid & 7;
    *(u32x4*)(Ql + t * 72 + seg * 8) = ld8g(WS(bf16_t, OFF_MQ) + (size_t)(c.row0 + t) * 256 + hd * 64 + seg * 8);
    *(u32x4*)(Kl + t * 72 + seg * 8) = ld8g(WS(bf16_t, OFF_MK) + (size_t)(c.row0 + t) * 256 + hd * 64 + seg * 8);
    const u32x4 vv = ld8g(WS(bf16_t, OFF_MVT) + ((size_t)(chunk * 4 + hd) * 64 + t) * 64 + seg * 8);
    u32x2 a, b2; a[0] = vv[0]; a[1] = vv[1]; b2[0] = vv[2]; b2[1] = vv[3]; *(u32x2*)(VTl + t * 68 + seg * 8) = a; *(u32x2*)(VTl + t * 68 + seg * 8 + 4) = b2;
    if (tid < 64) VTl[64 * 68 + tid] = (bf16_t)0x3F80u;
    for (int i = tid; i < 15 * 68; i += NTHREADS) VTl[65 * 68 + i] = 0;
#pragma unroll
    for (int dir = 0; dir < 2; ++dir) { const int chain = dir * 32 + c.b * 4 + hd, pc = ml_pc(c, dir); const bf16_t* st = WS(bf16_t, OFF_ST) + (size_t)(chain * 36 + pc) * 5120;
      *(u32x4*)(Cl + dir * 80 * 72 + (tid >> 3) * 72 + (tid & 7) * 8) = ld8g(st + tid * 8);
      if (tid < 128) *(u32x4*)(Cl + dir * 80 * 72 + ((512 + tid) >> 3) * 72 + (tid & 7) * 8) = ld8g(st + (512 + tid) * 8); } }
  if (tid < 128) { const int dir = tid >> 6, t = dir ? 63 - lane : lane, row = c.row0 + t;
    const int chain = dir * 32 + c.b * 4 + hd, pc = ml_pc(c, dir);
    const float li = WS(float, OFF_GLI)[(size_t)(dir * 4 + hd) * NTOK + row], lf = WS(float, OFF_GLF)[(size_t)(dir * 4 + hd) * NTOK + row];
    const float ms = WS(float, OFF_SCMB)[chain * 36 + pc];
    const float bc = scan_sum64(lf, lane);
    const float uu = li - bc; const float pm = scan_max64(uu, lane);
    const float mt = fmaxf(bc + ms, bc + pm);
    rowterm[dir * 64 + t] = bc - mt; uarr[dir * 64 + t] = uu; winter[dir * 64 + t] = __expf(bc + ms - mt); emt[dir * 64 + t] = __expf(-mt); }
  __syncthreads();
  const int tt = wid & 3, eh = wid >> 2, t = tt * 16 + fr;
  bf16x8 qfr[2];
#pragma unroll
  for (int ks = 0; ks < 2; ++ks) qfr[ks] = ld_frag16(Ql + t * 72 + ks * 32 + fq * 8);
  f32x4 g[4];
#pragma unroll
  for (int st = 0; st < 4; ++st) { g[st] = (f32x4){0.f, 0.f, 0.f, 0.f};
#pragma unroll
    for (int ks = 0; ks < 2; ++ks) g[st] = __builtin_amdgcn_mfma_f32_16x16x32_bf16(ld_frag16(Kl + (st * 16 + fr) * 72 + ks * 32 + fq * 8), qfr[ks], g[st], 0, 0, 0); }
  const int et0 = eh * 2;
  float hsum[2][4];
#pragma unroll
  for (int a = 0; a < 2; ++a)
#pragma unroll
    for (int j = 0; j < 4; ++j) hsum[a][j] = 0.f;
#pragma unroll
  for (int dir = 0; dir < 2; ++dir) {
    const float rt = rowterm[dir * 64 + t], wi = winter[dir * 64 + t], em = emt[dir * 64 + t];
    bf16x8 pf[2];
#pragma unroll
    for (int kk = 0; kk < 2; ++kk) { float v[8];
#pragma unroll
      for (int hh = 0; hh < 2; ++hh)
#pragma unroll
        for (int j = 0; j < 4; ++j) { const int s = (2 * kk + hh) * 16 + fq * 4 + j; const bool valid = dir ? (s >= t) : (s <= t);
          const float e = __expf(rt + uarr[dir * 64 + s]); v[hh * 4 + j] = valid ? g[2 * kk + hh][j] * e : 0.f; }
      pf[kk] = __builtin_bit_cast(bf16x8, pack8(v)); }
    f32x4 acc[3];
#pragma unroll
    for (int a = 0; a < 3; ++a) { const int et = a < 2 ? et0 + a : 4; const bf16_t* crow = Cl + dir * 80 * 72 + (et * 16 + fr) * 72;
      f32x4 x = {0.f, 0.f, 0.f, 0.f};
#pragma unroll
      for (int ks = 0; ks < 2; ++ks) x = __builtin_amdgcn_mfma_f32_16x16x32_bf16(ld_frag16(crow + ks * 32 + fq * 8), qfr[ks], x, 0, 0, 0);
      x *= wi;
      const bf16_t* vrow = VTl + (et * 16 + fr) * 68;
#pragma unroll
      for (int kk = 0; kk < 2; ++kk) x = __builtin_amdgcn_mfma_f32_16x16x32_bf16(ld_frag8x2(vrow + 32 * kk + fq * 4, vrow + 32 * kk + 16 + fq * 4), pf[kk], x, 0, 0, 0);
      acc[a] = x; }
    const float den = bperm(fr, acc[2][0]);
    const float dinv = 1.f / fmaxf(fabsf(den), em);
#pragma unroll
    for (int a = 0; a < 2; ++a)
#pragma unroll
      for (int j = 0; j < 4; ++j) hsum[a][j] += acc[a][j] * dinv;
  }
  float s1 = 0.f, s2 = 0.f;
#pragma unroll
  for (int a = 0; a < 2; ++a)
#pragma unroll
    for (int j = 0; j < 4; ++j) { s1 += hsum[a][j]; s2 += hsum[a][j] * hsum[a][j]; }
  s1 += bperm(lane ^ 16, s1); s1 += bperm(lane ^ 32, s1); s2 += bperm(lane ^ 16, s2); s2 += bperm(lane ^ 32, s2);
  if (fq == 0) { lnred[(eh * 64 + t) * 2] = s1; lnred[(eh * 64 + t) * 2 + 1] = s2; }
  __syncthreads();
  { const float a1 = lnred[t * 2] + lnred[(64 + t) * 2], a2 = lnred[t * 2 + 1] + lnred[(64 + t) * 2 + 1];
    const float mean = a1 * (1.f / 64.f), var = fmaxf(a2 * (1.f / 64.f) - mean * mean, 0.f), rstd = rsqrtf(var + LN_EPS);
    const int row = c.row0 + t;
#pragma unroll
    for (int a = 0; a < 2; ++a) { const int e0 = (et0 + a) * 16 + fq * 4;
      const u32x2 ow = *(const u32x2*)(WS(bf16_t, OFF_MO) + (size_t)row * 256 + hd * 64 + e0);
      const float og[4] = {lo16(ow[0]), hi16(ow[0]), lo16(ow[1]), hi16(ow[1])};
      const f32x4 ng = *(const f32x4*)(p.in[I_MLNG] + l * 256 + hd * 64 + e0);
      float y[4];
#pragma unroll
      for (int j = 0; j < 4; ++j) y[j] = sigmoidf_(og[j]) * (hsum[a][j] - mean) * rstd * ng[j];
      u32x2 w; w[0] = pack2(y[0], y[1]); w[1] = pack2(y[2], y[3]);
      *(u32x2*)(WS(bf16_t, OFF_H) + (size_t)row * 1024 + hd * 64 + e0) = w; } }
}

DEV void ph_mix(CParams& p, int lx, unsigned char* lds) {
  const int l = lx & 1;
  constexpr int NRW = 96;
  const int n_att = l == 0 ? 432 : 384, n_ml = l == 0 ? 288 * 4 : 256 * 4, total = NRW + n_att + n_ml;
  unsigned* cnt = WS(unsigned, OFF_CNT) + 16 + lx; unsigned* slot = (unsigned*)(lds + LDS_BYTES - 16);
  for (;;) {
    __syncthreads();
    if (TIDX() == 0) *slot = atomicAdd(cnt, 1u);
    __syncthreads();
    const int u = (int)*slot; if (u >= total) break;
    if (u < NRW) { for (int r_ = 0; r_ < RWREP; ++r_) rwkv_chunk_unit(p, l, u, lds); }
    else if (u < NRW + n_att) { for (int r_ = 0; r_ < ATREP; ++r_) attn_unit(p, u - NRW, lds); }
    else { const int v = u - NRW - n_att; const int chunk = (l == 0 ? 0 : 32) + (v >> 2); for (int r_ = 0; r_ < MLREP; ++r_) mlstm_out_unit(p, l, chunk, v & 3, lds); }
  }
  __syncthreads();
}

DEV void ph_rwpost(CParams& p, int l) {
  const int tid = TIDX(), lane = tid & 63, gw = blockIdx.x * 8 + (tid >> 6), nw = gridDim.x * 8, sl = lane & 7;
  const int rowbase = l == 0 ? 0 : NCTXR, nitems = (NTOK - rowbase) * 6;
  for (int it0 = gw * 8; it0 < nitems; it0 += nw * 8) { const int it = it0 + (lane >> 3); const int row = rowbase + it / 6, h6 = it % 6, col = h6 * 64 + sl * 8; const size_t o = (size_t)row * 384 + col;
    const bf16_t* lo = WS(bf16_t, OFF_LORA) + (size_t)row * 1920 + col;
    const u32x4 wy0 = ld8g(WS(bf16_t, OFF_RWY) + o), wy1 = ld8g(WS(bf16_t, OFF_RWY) + (size_t)NTOK * 384 + o), wv = ld8g(WS(bf16_t, OFF_VB) + o), wg = ld8g(lo + 1536);
    const float bs = WS(float, OFF_BS)[(size_t)row * 6 + h6] + WS(float, OFF_BS)[((size_t)NTOK + row) * 6 + h6];
    float y[8], t1[8], t2[8];
    unpack8(wy0, y); unpack8(wy1, t1);
    float s = 0.f;
#pragma unroll
    for (int i = 0; i < 8; ++i) { y[i] += t1[i]; s += y[i]; }
    const float mean = grp8_sum(s) * (1.f / 64.f); float q = 0.f;
#pragma unroll
    for (int i = 0; i < 8; ++i) { y[i] -= mean; q += y[i] * y[i]; }
    const float rstd = rsqrtf(grp8_sum(q) * (1.f / 64.f) + 64e-5f);
    float v[8], g[8], o8[8]; unpack8(wv, v); unpack8(wg, g);
#pragma unroll
    for (int i = 0; i < 8; ++i) o8[i] = (y[i] * rstd * p.in[I_RWGNG][l * 384 + col + i] + p.in[I_RWGNB][l * 384 + col + i] + bs * v[i]) * g[i];
    *(u32x4*)(WS(bf16_t, OFF_H) + (size_t)row * 1024 + 256 + col) = pack8(o8); }
}

DEV void ph_gemm_in(CParams& p, int l, unsigned char* lds) {
  pg8::StaticOrder S; S.init(NTOK, NINP, gridDim.x, blockIdx.x);
  pg8::Gemm g{WS(bf16_t, OFF_H), WS(bf16_t, OFF_WIN) + (size_t)l * NINP * 1024, NTOK, NINP, 1024};
  EpiBf16 E{WS(bf16_t, OFF_P), NIN, NIN}; pg8::gemm_phase((LAS unsigned char*)lds, g, S, E);
}
DEV void gemm_out_rows(CParams& p, int l, int row0, int M, unsigned char* lds) {
  pg8::StaticOrder S; S.init(M, 1024, gridDim.x, blockIdx.x);
  pg8::Gemm g{WS(bf16_t, OFF_H) + (size_t)row0 * 1024, WS(bf16_t, OFF_WOUT) + (size_t)l * 1024 * 1024, M, 1024, 1024};
  EpiBf16 E{WS(bf16_t, OFF_Y) + (size_t)row0 * 1024, 1024, 1024}; pg8::gemm_phase((LAS unsigned char*)lds, g, S, E);
}
DEV void ph_gemm_out(CParams& p, int l, unsigned char* lds) { if (l == 0 && gridDim.x != 256) gemm_out_rows(p, 0, 0, NTOK, lds); else gemm_out_rows(p, l, NCTXR, NLAT, lds); }
DEV void ln1_rows(CParams& p, int l, int r0, int r1, unsigned char* lds);
DEV void ph_gemm_pq(CParams& p, int l, unsigned char* lds) {
  const bool split = l == 0 && gridDim.x == 256; const int rb = (l == 0 && !split) ? 0 : NCTXR, M = NTOK - rb;
  if (split) { ln1_rows(p, 0, (int)blockIdx.x * 8, (int)blockIdx.x * 8 + 8, lds); __syncthreads(); }
  pg8::StaticOrder S; S.init(M, 2048, gridDim.x, blockIdx.x);
  pg8::Gemm g{WS(bf16_t, OFF_H) + (size_t)rb * 1024, WS(bf16_t, OFF_WPQ) + (size_t)l * 2048 * 1024, M, 2048, 1024};
  EpiBf16 E{WS(bf16_t, OFF_QP) + (size_t)rb * 2048, 2048, 2048}; pg8::gemm_phase((LAS unsigned char*)lds, g, S, E);
}

DEV void stage_vec(float* dst, const float* src_) { const int tid = TIDX(); if (tid < 256) *(f32x4*)(dst + tid * 4) = *(const f32x4*)(src_ + tid * 4); }
DEV void ln1_rows(CParams& p, int l, int r0, int r1, unsigned char* lds) {
  const int tid = TIDX(), lane = tid & 63, wid = tid >> 6;
  float* pl = (float*)lds;
  for (int seg0 = r0; seg0 < r1;) { const int mr = modrow_of(seg0); int seg1 = mr == 8 ? NCTXR : NCTXR + (mr + 1) * 2048; if (seg1 > r1) seg1 = r1;
    const float* md = WS(float, OFF_MOD) + (size_t)(l * 9 + mr) * 6144;
    __syncthreads();
    if (tid < 256) { *(f32x4*)(pl + tid * 4) = *(const f32x4*)(md + 2048 + tid * 4); *(f32x4*)(pl + 1024 + tid * 4) = *(const f32x4*)(p.in[I_LNMG] + l * 1024 + tid * 4); *(f32x4*)(pl + 2048 + tid * 4) = *(const f32x4*)(p.in[I_LNMB] + l * 1024 + tid * 4); }
    else { const int t2 = tid - 256; *(f32x4*)(pl + 3072 + t2 * 4) = *(const f32x4*)(md + 4096 + t2 * 4); *(f32x4*)(pl + 4096 + t2 * 4) = *(const f32x4*)(md + 3072 + t2 * 4); }
    __syncthreads();
#pragma unroll 1
    for (int row = seg0 + wid; row < seg1; row += 8) {
      const float* xo = x_in_row(p, row); const bf16_t* xc = WS(bf16_t, OFF_XC) + (size_t)row * 1024; const bf16_t* yr = WS(bf16_t, OFF_Y) + (size_t)row * 1024;
      f32x4 v[4]; float s = 0.f;
#pragma unroll
      for (int i = 0; i < 4; ++i) { const int col = lane * 4 + 256 * i; const u32x2 yw = *(const u32x2*)(yr + col); const f32x4 yv = {lo16(yw[0]), hi16(yw[0]), lo16(yw[1]), hi16(yw[1])};
        f32x4 xv; if (l == 0) xv = *(const f32x4*)(xo + col); else { const u32x2 xw_ = *(const u32x2*)(xc + col); xv = (f32x4){lo16(xw_[0]), hi16(xw_[0]), lo16(xw_[1]), hi16(xw_[1])}; }
        v[i] = xv * ALPHA + *(const f32x4*)(pl + col) * yv; s += (v[i][0] + v[i][1]) + (v[i][2] + v[i][3]); }
      float mean = wave_sum(s) * (1.f / 1024.f), q = 0.f;
#pragma unroll
      for (int i = 0; i < 4; ++i) { v[i] -= mean; q += (v[i][0] * v[i][0] + v[i][1] * v[i][1]) + (v[i][2] * v[i][2] + v[i][3] * v[i][3]); }
      float rstd = rsqrtf(wave_sum(q) * (1.f / 1024.f) + LN_EPS);
      bf16_t* xw = WS(bf16_t, OFF_XC) + (size_t)row * 1024; s = 0.f;
#pragma unroll
      for (int i = 0; i < 4; ++i) { const int col = lane * 4 + 256 * i; v[i] = v[i] * rstd * *(const f32x4*)(pl + 1024 + col) + *(const f32x4*)(pl + 2048 + col);
        u32x2 wx; wx[0] = pack2(v[i][0], v[i][1]); wx[1] = pack2(v[i][2], v[i][3]); *(u32x2*)(xw + col) = wx;
        v[i] = (f32x4){lo16(wx[0]), hi16(wx[0]), lo16(wx[1]), hi16(wx[1])};
        s += (v[i][0] + v[i][1]) + (v[i][2] + v[i][3]); }
      mean = wave_sum(s) * (1.f / 1024.f); q = 0.f;
#pragma unroll
      for (int i = 0; i < 4; ++i) { v[i] -= mean; q += (v[i][0] * v[i][0] + v[i][1] * v[i][1]) + (v[i][2] * v[i][2] + v[i][3] * v[i][3]); }
      rstd = rsqrtf(wave_sum(q) * (1.f / 1024.f) + LN_EPS);
#pragma unroll
      for (int i = 0; i < 4; ++i) { const int col = lane * 4 + 256 * i; const f32x4 o = v[i] * rstd * (*(const f32x4*)(pl + 3072 + col) + 1.f) + *(const f32x4*)(pl + 4096 + col);
        u32x2 w; w[0] = pack2(o[0], o[1]); w[1] = pack2(o[2], o[3]); *(u32x2*)(WS(bf16_t, OFF_H) + (size_t)row * 1024 + col) = w; }
    }
    seg0 = seg1; }
  __syncthreads();
}

DEV void ph_ln1(CParams& p, int l, unsigned char* lds) {
  const int b = (int)blockIdx.x;
  if (l == 0 && gridDim.x != 256) { const int per = (NTOK + (int)gridDim.x - 1) / (int)gridDim.x, r0 = b * per; int r1 = r0 + per; if (r1 > NTOK) r1 = NTOK; if (r0 < NTOK) ln1_rows(p, 0, r0, r1, lds); }
  else if (l == 0) {
    if (b < 32) { gemm_out_rows(p, 0, 0, NCTXR, lds); __syncthreads(); }
    const int r0 = NCTXR + (b < 32 ? b * 4 : 128 + (b - 32) * 73); int r1 = r0 + (b < 32 ? 4 : 73); if (r1 > NTOK) r1 = NTOK;
    if (r0 < NTOK) ln1_rows(p, 0, r0, r1, lds);
  } else { const int per = (NLAT + (int)gridDim.x - 1) / (int)gridDim.x, r0 = NCTXR + b * per; int r1 = r0 + per; if (r1 > NTOK) r1 = NTOK; if (r0 < NTOK) ln1_rows(p, l, r0, r1, lds); }
}

DEV unsigned f2ord(float f) { const unsigned u = __float_as_uint(f); return (u >> 31) ? ~u : (u | 0x80000000u); }
DEV float ord2f(unsigned o) { return __uint_as_float((o >> 31) ? (o & 0x7fffffffu) : ~o); }
DEV unsigned dppu_max(unsigned x, unsigned y) { return x > y ? x : y; }
template <int CTRL> DEV unsigned dppu(unsigned x) { return (unsigned)__builtin_amdgcn_mov_dpp((int)x, CTRL, 0xf, 0xf, true); }
DEV void topk_unit(CParams& p, int l, int tile, int head, unsigned char* lds, const bf16x8 (&kf)[8][4]) {
  constexpr int RS = 136;
  unsigned* KEYSl = (unsigned*)lds;
  unsigned* LISTl = (unsigned*)(lds + 256 * RS * 4);
  const int tid = TIDX(), lane = tid & 63, wid = tid >> 6, fr = lane & 15, fq = lane >> 4;
  const int row0 = (l == 0 ? 0 : NCTXR) + tile * 128;
  __syncthreads();
  for (int r1_ = 0; r1_ < T1_REP; ++r1_)
  { const int g = head * 2 + (wid >> 2);
    const bf16_t* qp = WS(bf16_t, OFF_QP) + (size_t)(row0 + (wid & 3) * 32) * 2048 + g * 128 + fq * 8;
    bf16x8 af[2][4];
#pragma unroll
    for (int tm = 0; tm < 2; ++tm)
#pragma unroll
      for (int ks = 0; ks < 4; ++ks) af[tm][ks] = __builtin_bit_cast(bf16x8, ld8g(qp + (size_t)(tm * 16 + fr) * 2048 + ks * 32));
#pragma unroll
    for (int nt = 0; nt < 8; ++nt) { f32x4 a0 = {0.f, 0.f, 0.f, 0.f}, a1 = {0.f, 0.f, 0.f, 0.f};
#pragma unroll
      for (int ks = 0; ks < 4; ++ks) { a0 = __builtin_amdgcn_mfma_f32_16x16x32_bf16(kf[nt][ks], af[0][ks], a0, 0, 0, 0); a1 = __builtin_amdgcn_mfma_f32_16x16x32_bf16(kf[nt][ks], af[1][ks], a1, 0, 0, 0); }
      const int key0 = nt * 16 + fq * 4; const unsigned kb = 127u - (unsigned)key0; const int ko = key0 + (nt >= 4 ? 4 : 0);
      u32x4 w0, w1;
#pragma unroll
      for (int j = 0; j < 4; ++j) { w0[j] = (f2ord(a0[j]) & ~127u) | (kb - (unsigned)j); w1[j] = (f2ord(a1[j]) & ~127u) | (kb - (unsigned)j); }
      *(u32x4*)(KEYSl + (wid * 32 + fr) * RS + ko) = w0; *(u32x4*)(KEYSl + (wid * 32 + 16 + fr) * RS + ko) = w1; } }
  __syncthreads();
  for (int r2_ = 0; r2_ < T2_REP; ++r2_)
  { const int row = tid >> 1, hf = tid & 1; const unsigned* kr = KEYSl + row * RS + hf * 68; unsigned m[4];
#pragma unroll
    for (int sg = 0; sg < 4; ++sg) { unsigned mm = 0u;
#pragma unroll
      for (int i = 0; i < 4; ++i) { const u32x4 x = *(const u32x4*)(kr + sg * 16 + i * 4); mm = max(max(mm, x[0]), max(x[1], max(x[2], x[3]))); }
      m[sg] = mm; }
#pragma unroll 1
    for (int r = 0; r < 16; ++r) { const unsigned lb = max(max(m[0], m[1]), max(m[2], m[3])); const unsigned best = max(lb, dppu<0xB1>(lb));
      if (hf == 0) LISTl[row * 16 + r] = best;
      if (lb == best) { const int sg = ((int)(127u - (best & 127u)) >> 4) & 3; unsigned nm = 0u;
#pragma unroll
        for (int i = 0; i < 4; ++i) { const u32x4 x = *(const u32x4*)(kr + sg * 16 + i * 4);
#pragma unroll
          for (int j = 0; j < 4; ++j) nm = max(nm, x[j] < best ? x[j] : 0u); }
#pragma unroll
        for (int s2 = 0; s2 < 4; ++s2) m[s2] = (s2 == sg) ? nm : m[s2]; } } }
  __syncthreads();
  for (int r3_ = 0; r3_ < T3_REP; ++r3_)
  { const int token = tid >> 2, role = tid & 3;
    const unsigned* L1 = LISTl + token * 16; const unsigned* L2 = LISTl + (128 + token) * 16;
    unsigned ck[16];
#pragma unroll
    for (int i = 0; i < 16; ++i) { int a, b; bool valid;
      if (role == 0) { a = 0; b = i; valid = true; }
      else if (role == 1) { a = i < 8 ? 1 : 2; b = i < 8 ? i : i - 8; valid = i < 13; }
      else if (role == 2) { a = i < 4 ? 3 : i < 7 ? 4 : i < 9 ? 5 : 6; b = i - (i < 4 ? 0 : i < 7 ? 4 : i < 9 ? 7 : 9); valid = i < 11; }
      else { a = i < 2 ? 7 : 6 + i; b = i < 2 ? i : 0; valid = i < 10; }
      if (!valid) { a = 0; b = 0; }
      const float v = ord2f(L1[a] & ~127u) + ord2f(L2[b] & ~127u);
      ck[i] = valid ? ((f2ord(v) & ~255u) | (unsigned)(255 - (a * 16 + b))) : 0u; }
    unsigned rec[4]; unsigned prev = 0xffffffffu;
#pragma unroll
    for (int r = 0; r < 16; ++r) { unsigned best = 0u;
#pragma unroll
      for (int i = 0; i < 16; ++i) best = max(best, ck[i] < prev ? ck[i] : 0u);
      best = max(best, dppu<0xB1>(best)); best = max(best, dppu<0x4E>(best));
      prev = best;
      if (role == (r & 3)) rec[r >> 2] = best; }
    float bv[4]; int be[4];
#pragma unroll
    for (int j = 0; j < 4; ++j) { const int t = 255 - (int)(rec[j] & 255u); const unsigned x1 = L1[t >> 4], x2 = L2[t & 15];
      bv[j] = ord2f(x1 & ~127u) + ord2f(x2 & ~127u); be[j] = (int)(127u - (x1 & 127u)) * 128 + (int)(127u - (x2 & 127u)); }
    const float v0 = dppf<0x00>(bv[0]);
    float sum = 0.f;
#pragma unroll
    for (int j = 0; j < 4; ++j) { bv[j] = __expf(bv[j] - v0); sum += bv[j]; }
    sum += dppf<0xB1>(sum); sum += dppf<0x4E>(sum);
    const float isum = 1.f / sum;
    const int row = row0 + token;
    int* eo = WS(int, OFF_EID) + (size_t)row * 128 + head * 16; float* go = WS(float, OFF_GATE) + (size_t)row * 128 + head * 16;
#pragma unroll
    for (int j = 0; j < 4; ++j) { eo[j * 4 + role] = be[j]; go[j * 4 + role] = bv[j] * isum; }
  }
  __syncthreads();
}
DEV void topk_keys(CParams& p, int l, int head, bf16x8 (&kf)[8][4]) { const int lane = TIDX() & 63, wid = TIDX() >> 6;
  const bf16_t* kp = WS(bf16_t, OFF_KEYS) + ((size_t)(l * 16 + head * 2 + (wid >> 2)) * 128) * 128 + (lane >> 4) * 8;
#pragma unroll
  for (int nt = 0; nt < 8; ++nt)
#pragma unroll
    for (int ks = 0; ks < 4; ++ks) kf[nt][ks] = __builtin_bit_cast(bf16x8, ld8g(kp + (size_t)(nt * 16 + (lane & 15)) * 128 + ks * 32)); }
DEV void ph_topk_l0(CParams& p, unsigned char* lds) {
  const int b = (int)blockIdx.x, head = b & 7, j = b >> 3;
  bf16x8 kf[8][4];
  if (b < 64) {
    pg8::OneUnit S{true, {j, head}};
    pg8::Gemm g{WS(bf16_t, OFF_H), WS(bf16_t, OFF_WPQ), NCTXR, 2048, 1024};
    EpiBf16 E{WS(bf16_t, OFF_QP), 2048, 2048}; pg8::gemm_phase((LAS unsigned char*)lds, g, S, E);
    asm volatile("s_waitcnt vmcnt(0)" ::: "memory"); __syncthreads();
    __builtin_amdgcn_fence(__ATOMIC_ACQUIRE, "agent"); asm volatile("s_waitcnt vmcnt(0)" ::: "memory");
    topk_keys(p, 0, head, kf);
    topk_unit(p, 0, 2 * j, head, lds, kf); topk_unit(p, 0, 2 * j + 1, head, lds, kf);
    topk_unit(p, 0, 16 + j, head, lds, kf);
  } else {
    topk_keys(p, 0, head, kf);
#pragma unroll 1
    for (int i = 0; i < 5; ++i) topk_unit(p, 0, 16 + 8 + (j - 8) * 5 + i, head, lds, kf);
  }
}
DEV void ph_topk(CParams& p, int l, unsigned char* lds) {
  if (l == 0 && gridDim.x == 256) { ph_topk_l0(p, lds); return; }
  const int ntile = (l == 0 ? NTOK : NLAT) / 128;
  bf16x8 kf[8][4]; int curh = -1; const int lane = TIDX() & 63, wid = TIDX() >> 6;
  for (int u = blockIdx.x; u < ntile * 8; u += gridDim.x) { const int head = u & 7;
    if (head != curh) { curh = head;
      const bf16_t* kp = WS(bf16_t, OFF_KEYS) + ((size_t)(l * 16 + head * 2 + (wid >> 2)) * 128) * 128 + (lane >> 4) * 8;
#pragma unroll
      for (int nt = 0; nt < 8; ++nt)
#pragma unroll
        for (int ks = 0; ks < 4; ++ks) kf[nt][ks] = __builtin_bit_cast(bf16x8, ld8g(kp + (size_t)(nt * 16 + (lane & 15)) * 128 + ks * 32)); }
    topk_unit(p, l, u >> 3, head, lds, kf); }
}

DEV float gelu_tanh(float x) { const float z = 0.7978845608f * (x + 0.044715f * x * x * x); const float t = 1.f - 2.f * __builtin_amdgcn_rcpf(1.f + __expf(2.f * z)); return 0.5f * x * (1.f + t); }
DEV void fp8x16_to_f32(u32x4 w, float* f) {
#pragma unroll
  for (int i = 0; i < 4; ++i) { const f32x2 a = __builtin_amdgcn_cvt_pk_f32_fp8((int)w[i], false), b = __builtin_amdgcn_cvt_pk_f32_fp8((int)w[i], true); f[4 * i] = a[0]; f[4 * i + 1] = a[1]; f[4 * i + 2] = b[0]; f[4 * i + 3] = b[1]; } }
DEV void fp4x32_to_f32(u32x4 w, float* f) {
#pragma unroll
  for (int i = 0; i < 4; ++i) {
    const f32x2 a = __builtin_amdgcn_cvt_scalef32_pk_f32_fp4(w[i], 1.0f, 0), b = __builtin_amdgcn_cvt_scalef32_pk_f32_fp4(w[i], 1.0f, 1), c = __builtin_amdgcn_cvt_scalef32_pk_f32_fp4(w[i], 1.0f, 2), d = __builtin_amdgcn_cvt_scalef32_pk_f32_fp4(w[i], 1.0f, 3);
    f[8 * i] = a[0]; f[8 * i + 1] = a[1]; f[8 * i + 2] = b[0]; f[8 * i + 3] = b[1]; f[8 * i + 4] = c[0]; f[8 * i + 5] = c[1]; f[8 * i + 6] = d[0]; f[8 * i + 7] = d[1]; } }
DEV void ph_gather(CParams& p, int l, unsigned char* lds) {
  const int tid = TIDX(), lane = tid & 63, wid = tid >> 6, dl = lane & 7, g = lane >> 3;
  const int rb = l == 0 ? 0 : NCTXR, ntok = NTOK - rb;
  const int per = (ntok + (int)gridDim.x - 1) / (int)gridDim.x, tb0 = (int)blockIdx.x * per;
  int* eidl = (int*)lds; float* gatel = (float*)(lds + 36864); float* dotl = (float*)(lds + 73728);
  const unsigned char* TU = WS(unsigned char, OFF_TABU); const unsigned char* TV = WS(unsigned char, OFF_TABV);
  bf16_t* Yb = WS(bf16_t, OFF_Y);
  float* pvec = (float*)(lds + 110592); int mr0;
  { const int ra = rb + tb0, rz = rb + (tb0 + per < ntok ? tb0 + per : ntok) - 1; mr0 = modrow_of(ra < NTOK ? ra : NTOK - 1); const int mr1 = modrow_of(rz < ra ? (ra < NTOK ? ra : NTOK - 1) : rz);
    __syncthreads();
    for (int i = tid; i < 2 * 5 * 256; i += NTHREADS) { const int set = i / 1280, r5 = (i - set * 1280) >> 8, c4 = (i & 255) * 4; const int mr = set ? mr1 : mr0;
      const float* s_ = r5 == 0 ? WS(float, OFF_MOD) + (size_t)(l * 9 + mr) * 6144 + 5120 : r5 == 1 ? p.in[I_LNFG] + l * 1024 : r5 == 2 ? p.in[I_LNFB] + l * 1024 : WS(float, OFF_MOD) + (size_t)(9 + mr) * 6144 + (r5 - 3) * 1024;
      *(f32x4*)(pvec + set * 5120 + r5 * 1024 + c4) = *(const f32x4*)(s_ + c4); }
    __syncthreads(); }
  for (int base = tb0; base < tb0 + per && base < ntok; base += 72) {
    int n = tb0 + per - base; if (n > 72) n = 72; if (n > ntok - base) n = ntok - base;
    const int row0 = rb + base;
    for (int grep_ = 0; grep_ < GREP; ++grep_) {
    __builtin_amdgcn_wave_barrier();
    for (int tk = wid; tk < n; tk += 8) { const size_t o = (size_t)(row0 + tk) * 128;
      eidl[tk * 128 + lane] = WS(int, OFF_EID)[o + lane]; eidl[tk * 128 + 64 + lane] = WS(int, OFF_EID)[o + 64 + lane];
      gatel[tk * 128 + lane] = WS(float, OFF_GATE)[o + lane]; gatel[tk * 128 + 64 + lane] = WS(float, OFF_GATE)[o + 64 + lane];
      dotl[tk * 128 + lane] = 0.f; dotl[tk * 128 + 64 + lane] = 0.f; }
    asm volatile("s_waitcnt lgkmcnt(0)" ::: "memory"); __builtin_amdgcn_wave_barrier();
#pragma unroll 1
    for (int s = 0; s < 4; ++s) {
#pragma unroll 1
      for (int tk = wid; tk < n; tk += 8) {
        float hx[32]; { const bf16_t* hp = WS(bf16_t, OFF_H) + (size_t)(row0 + tk) * 1024 + s * 256 + dl * 32; unpack8(ld8g(hp), hx); unpack8(ld8g(hp + 8), hx + 8); unpack8(ld8g(hp + 16), hx + 16); unpack8(ld8g(hp + 24), hx + 24); }
        const unsigned char* tus = TU + (size_t)s * 16384 * 128 + dl * 16; const int* el = eidl + tk * 128 + g; float* dp = dotl + tk * 128 + g;
        u32x4 wq[16];
#pragma unroll
        for (int ps = 0; ps < 16; ++ps) wq[ps] = *(const u32x4*)(tus + (size_t)el[ps * 8] * 128);
#pragma unroll
        for (int ps = 0; ps < 16; ++ps) { const u32x4 w = wq[ps]; f32x2 dd = {0.f, 0.f};
#pragma unroll
          for (int i = 0; i < 4; ++i) {
            dd += __builtin_amdgcn_cvt_scalef32_pk_f32_fp4(w[i], 1.0f, 0) * (f32x2){hx[8 * i], hx[8 * i + 1]}; dd += __builtin_amdgcn_cvt_scalef32_pk_f32_fp4(w[i], 1.0f, 1) * (f32x2){hx[8 * i + 2], hx[8 * i + 3]};
            dd += __builtin_amdgcn_cvt_scalef32_pk_f32_fp4(w[i], 1.0f, 2) * (f32x2){hx[8 * i + 4], hx[8 * i + 5]}; dd += __builtin_amdgcn_cvt_scalef32_pk_f32_fp4(w[i], 1.0f, 3) * (f32x2){hx[8 * i + 6], hx[8 * i + 7]}; }
          const float d = grp8_sum(dd[0] + dd[1]);
          if (dl == 0) dp[ps * 8] += d; } } }
    asm volatile("s_waitcnt lgkmcnt(0)" ::: "memory"); __builtin_amdgcn_wave_barrier();
    for (int tk = wid; tk < n; tk += 8) {
#pragma unroll
      for (int hh = 0; hh < 2; ++hh) { const int i = tk * 128 + hh * 64 + lane; dotl[i] = gatel[i] * gelu_tanh(dotl[i] * (1.f / 64.f)); } }
    asm volatile("s_waitcnt lgkmcnt(0)" ::: "memory"); __builtin_amdgcn_wave_barrier();
#pragma unroll 1
    for (int s = 0; s < 4; ++s) {
#pragma unroll 1
      for (int tk = wid; tk < n; tk += 8) {
        const unsigned char* tvs = TV + (size_t)s * 16384 * 128 + dl * 16; const int* el = eidl + tk * 128 + g; const float* cp = dotl + tk * 128 + g;
        f32x2 ac2[16];
#pragma unroll
        for (int j = 0; j < 16; ++j) ac2[j] = (f32x2){0.f, 0.f};
        u32x4 wq[16];
#pragma unroll
        for (int ps = 0; ps < 16; ++ps) wq[ps] = *(const u32x4*)(tvs + (size_t)el[ps * 8] * 128);
#pragma unroll
        for (int ps = 0; ps < 16; ++ps) { const u32x4 w = wq[ps]; const float cc = cp[ps * 8]; const f32x2 c2 = {cc, cc};
#pragma unroll
          for (int i = 0; i < 4; ++i) { ac2[4 * i] += c2 * __builtin_amdgcn_cvt_scalef32_pk_f32_fp4(w[i], 1.0f, 0); ac2[4 * i + 1] += c2 * __builtin_amdgcn_cvt_scalef32_pk_f32_fp4(w[i], 1.0f, 1);
            ac2[4 * i + 2] += c2 * __builtin_amdgcn_cvt_scalef32_pk_f32_fp4(w[i], 1.0f, 2); ac2[4 * i + 3] += c2 * __builtin_amdgcn_cvt_scalef32_pk_f32_fp4(w[i], 1.0f, 3); } }
        float acc[32];
#pragma unroll
        for (int j = 0; j < 16; ++j) { acc[2 * j] = ac2[j][0]; acc[2 * j + 1] = ac2[j][1]; }
        float r16[16], r8[8];
#pragma unroll
        for (int j = 0; j < 16; ++j) { auto rr = __builtin_amdgcn_permlane32_swap(__float_as_uint(acc[j]), __float_as_uint(acc[j + 16]), false, false); r16[j] = __uint_as_float(rr[0]) + __uint_as_float(rr[1]); }
#pragma unroll
        for (int j = 0; j < 8; ++j) { auto rr = __builtin_amdgcn_permlane16_swap(__float_as_uint(r16[j]), __float_as_uint(r16[j + 8]), false, false); r8[j] = __uint_as_float(rr[0]) + __uint_as_float(rr[1]); }
        const bool b3 = (lane & 8) != 0; f32x4 o;
#pragma unroll
        for (int j = 0; j < 4; ++j) { const float x = r8[j] + dppf<0x128>(r8[j]), y = r8[j + 4] + dppf<0x128>(r8[j + 4]); o[j] = (b3 ? y : x) * 0.25f; }
        u32x2 ow; ow[0] = pack2(o[0], o[1]); ow[1] = pack2(o[2], o[3]);
        *(u32x2*)(Yb + (size_t)(row0 + tk) * 1024 + s * 256 + dl * 32 + ((lane >> 5) & 1) * 16 + ((lane >> 4) & 1) * 8 + (b3 ? 4 : 0)) = ow; } }
    }
    asm volatile("s_waitcnt vmcnt(0)" ::: "memory"); __builtin_amdgcn_fence(__ATOMIC_ACQUIRE, "agent"); asm volatile("s_waitcnt vmcnt(0)" ::: "memory");
#pragma unroll 1
    for (int tk = wid; tk < n; tk += 8) { const int row = row0 + tk;
      bf16_t* xw = WS(bf16_t, OFF_XC) + (size_t)row * 1024; const bf16_t* yr = Yb + (size_t)row * 1024;
      const float* pl = pvec + (modrow_of(row) == mr0 ? 0 : 5120);
      f32x4 v[4]; float sm = 0.f;
#pragma unroll
      for (int i = 0; i < 4; ++i) { const int col = lane * 4 + 256 * i; const u32x2 yw = *(const u32x2*)(yr + col), xq = *(const u32x2*)(xw + col);
        const f32x4 xo = {lo16(xq[0]), hi16(xq[0]), lo16(xq[1]), hi16(xq[1])}, ya = {lo16(yw[0]), hi16(yw[0]), lo16(yw[1]), hi16(yw[1])};
        v[i] = xo * ALPHA + *(const f32x4*)(pl + col) * ya; sm += (v[i][0] + v[i][1]) + (v[i][2] + v[i][3]); }
      float mean = wave_sum(sm) * (1.f / 1024.f), q = 0.f;
#pragma unroll
      for (int i = 0; i < 4; ++i) { v[i] -= mean; q += (v[i][0] * v[i][0] + v[i][1] * v[i][1]) + (v[i][2] * v[i][2] + v[i][3] * v[i][3]); }
      float rstd = rsqrtf(wave_sum(q) * (1.f / 1024.f) + LN_EPS);
      sm = 0.f;
#pragma unroll
      for (int i = 0; i < 4; ++i) { const int col = lane * 4 + 256 * i; const f32x4 o = v[i] * rstd * *(const f32x4*)(pl + 1024 + col) + *(const f32x4*)(pl + 2048 + col);
        v[i] = o; sm += (o[0] + o[1]) + (o[2] + o[3]);
        if (l == 0) { u32x2 wx; wx[0] = pack2(o[0], o[1]); wx[1] = pack2(o[2], o[3]); *(u32x2*)(xw + col) = wx; }
        else if (row >= NCTXR) *(f32x4*)(p.out + (size_t)(row - NCTXR) * DM + col) = o; }
      if (l == 0) {
        mean = wave_sum(sm) * (1.f / 1024.f); q = 0.f;
#pragma unroll
        for (int i = 0; i < 4; ++i) { v[i] -= mean; q += (v[i][0] * v[i][0] + v[i][1] * v[i][1]) + (v[i][2] * v[i][2] + v[i][3] * v[i][3]); }
        rstd = rsqrtf(wave_sum(q) * (1.f / 1024.f) + LN_EPS);
#pragma unroll
        for (int i = 0; i < 4; ++i) { const int col = lane * 4 + 256 * i; const f32x4 o = v[i] * rstd * (*(const f32x4*)(pl + 4096 + col) + 1.f) + *(const f32x4*)(pl + 3072 + col);
          u32x2 w; w[0] = pack2(o[0], o[1]); w[1] = pack2(o[2], o[3]); *(u32x2*)(WS(bf16_t, OFF_H) + (size_t)row * 1024 + col) = w; }
      } }
  }
}

#if !MULTI_LAUNCH
__global__ __launch_bounds__(NTHREADS, 2) void mega(Params p_, int lo, int hi, int coop) {
  extern __shared__ __attribute__((aligned(16))) unsigned char shm[];
  volatile LAS unsigned* bst = (volatile LAS unsigned*)(LAS unsigned char*)(shm + LDS_BYTES - 32);
  if (TIDX() == 0) { bst[0] = 0u; bst[1] = 0u; }
  __syncthreads();
  { CParams* kp0 = (CParams*)__builtin_amdgcn_kernarg_segment_ptr(); xcd_barrier_post((unsigned*)(kp0->ws + OFF_BAR)); }
  for (int step = lo; step < hi; ++step) {
    CParams* kp = (CParams*)__builtin_amdgcn_kernarg_segment_ptr(); asm volatile("" : "+s"(kp)); CParams& p = *kp;
    if (step == 0) { ph_init(p, shm); if (REPSET == 25) { __syncthreads(); ph_init(p, shm); } }
    else { const int l = (step - 1) / 11, k = (step - 1) % 11;
      for (int rep = 0; rep < REPS[k]; ++rep) { if (rep > 0 && coop) xcd_barrier(WS(unsigned, OFF_BAR), bst);
      switch (k) {
        case 0: if (l == 0) ph_lnmod(p, 0); break;
        case 1: ph_gemm_in(p, l, shm); break;
        case 2: ph_prep(p, l, shm); break;
        case 3: ph_mid(p, l + 2 * rep, shm); break;
        case 4: ph_mix(p, l + 2 * rep, shm); break;
        case 5: ph_rwpost(p, l); break;
        case 6: ph_gemm_out(p, l, shm); break;
        case 7: ph_ln1(p, l, shm); break;
        case 8: ph_gemm_pq(p, l, shm); break;
        case 9: ph_topk(p, l, shm); break;
        case 10: ph_gather(p, l, shm); break;
      } } }
    if (coop && step + 1 < hi && step != 12) { if (lo < 0) cg::this_grid().sync(); else xcd_barrier(WS(unsigned, OFF_BAR), bst); }
    if (coop && step == 5) for (int xb_ = 0; xb_ < XBAR; ++xb_) xcd_barrier(WS(unsigned, OFF_BAR), bst);
  }
}
#endif

#if MULTI_LAUNCH
template <int K> __global__ __launch_bounds__(NTHREADS, 2) void phase_k(Params p_, int l) {
  extern __shared__ __attribute__((aligned(16))) unsigned char shm[];
  CParams& p = *(CParams*)__builtin_amdgcn_kernarg_segment_ptr();
  if constexpr (K == -1) ph_init(p, shm);
  if constexpr (K == 0) ph_lnmod(p, 0);
  if constexpr (K == 1) ph_gemm_in(p, l, shm);
  if constexpr (K == 2) ph_prep(p, l, shm);
  if constexpr (K == 3) ph_mid(p, l, shm);
  if constexpr (K == 4) ph_mix(p, l, shm);
  if constexpr (K == 5) ph_rwpost(p, l);
  if constexpr (K == 6) ph_gemm_out(p, l, shm);
  if constexpr (K == 7) ph_ln1(p, l, shm);
  if constexpr (K == 8) ph_gemm_pq(p, l, shm);
  if constexpr (K == 9) ph_topk(p, l, shm);
  if constexpr (K == 10) ph_gather(p, l, shm);
  if constexpr (K >= 30) ph_mid_t<K - 30>(p, l, shm);
}
template __global__ void phase_k<-1>(Params, int); template __global__ void phase_k<0>(Params, int); template __global__ void phase_k<1>(Params, int);
template __global__ void phase_k<2>(Params, int); template __global__ void phase_k<4>(Params, int);
template __global__ void phase_k<5>(Params, int); template __global__ void phase_k<6>(Params, int); template __global__ void phase_k<7>(Params, int);
template __global__ void phase_k<8>(Params, int); template __global__ void phase_k<31>(Params, int); template __global__ void phase_k<32>(Params, int); template __global__ void phase_k<34>(Params, int); template __global__ void phase_k<38>(Params, int); template __global__ void phase_k<9>(Params, int); template __global__ void phase_k<10>(Params, int);

#endif

extern "C" void kernel_launch(void* const* d_in, const int* in_sizes, int n_in, void* d_out, int out_size, void* d_ws, size_t ws_size, hipStream_t stream) {
  if (n_in < N_INPUTS || ws_size < WS_NEEDED) return;
  Params p{};
  for (int i = 0; i < N_INPUTS; ++i) p.in[i] = (const float*)d_in[i];
  p.out = (float*)d_out; p.ws = (unsigned char*)d_ws;
  static int grid = 0;
  if (!grid) {
    int dev = 0, cus = 0; (void)hipGetDevice(&dev); (void)hipDeviceGetAttribute(&cus, hipDeviceAttributeMultiprocessorCount, dev);
    grid = cus > 0 ? (cus > 256 ? 256 : cus) : 256;
#if !MULTI_LAUNCH
    (void)hipFuncSetAttribute((const void*)mega, hipFuncAttributeMaxDynamicSharedMemorySize, (int)LDS_BYTES);
    int per = 0; (void)hipOccupancyMaxActiveBlocksPerMultiprocessor(&per, mega, NTHREADS, LDS_BYTES);
    if (per < 1) grid = 0;
#endif
  }
  const int nsteps = 23;
#if MULTI_LAUNCH
#define LAUNCH_K(K, L) do { (void)hipFuncSetAttribute((const void*)phase_k<K>, hipFuncAttributeMaxDynamicSharedMemorySize, (int)LDS_BYTES); \
    hipLaunchKernelGGL(phase_k<K>, dim3(grid), dim3(NTHREADS), LDS_BYTES, stream, p, L); } while (0)
  (void)nsteps;
  LAUNCH_K(-1, 0);
  for (int l = 0; l < 2; ++l) {
    if (l == 0) LAUNCH_K(0, 0);
    LAUNCH_K(1, l); LAUNCH_K(2, l); LAUNCH_K(31, l); LAUNCH_K(32, l); LAUNCH_K(34, l); LAUNCH_K(38, l);
    LAUNCH_K(4, l); LAUNCH_K(5, l); LAUNCH_K(6, l); LAUNCH_K(7, l); LAUNCH_K(8, l); LAUNCH_K(9, l); LAUNCH_K(10, l);
  }
#else
  if (grid <= 0) return;
  (void)hipMemsetAsync((unsigned char*)d_ws + OFF_CNT, 0, SZ_CNT, stream);
  int lo = 0, hi = nsteps, coop = 1; void* args[] = {&p, &lo, &hi, &coop};
  (void)hipLaunchCooperativeKernel((const void*)mega, dim3(grid), dim3(NTHREADS), args, LDS_BYTES, stream);
#endif
}
```

```cpp
#include <hip/hip_runtime.h>
#include <hip/hip_cooperative_groups.h>
namespace cg = cooperative_groups;

#ifndef MULTI_LAUNCH
#define MULTI_LAUNCH 0
#endif

#ifndef REPSET
#define REPSET 0
#endif
#define DEV __device__ __forceinline__
#define LAS __attribute__((address_space(3)))
typedef unsigned short bf16_t;
typedef short bf16x8 __attribute__((ext_vector_type(8)));
typedef float f32x4 __attribute__((ext_vector_type(4)));
typedef float f32x2 __attribute__((ext_vector_type(2)));
typedef float f32x16 __attribute__((ext_vector_type(16)));
typedef unsigned u32x4 __attribute__((ext_vector_type(4)));
typedef unsigned u32x2 __attribute__((ext_vector_type(2)));

constexpr int NTOK = 18432, NCTXR = 2048, NLAT = 16384, DM = 1024;
constexpr int NIN = 3248, NINP = 3328;
constexpr float ALPHA = 1.41421356237f;
constexpr float LN_EPS = 1e-6f;
constexpr int NTHREADS = 512;
constexpr size_t LDS_BYTES = 160 * 1024;
#if REPSET == 5
__device__ constexpr int REPS[11] = {1, 1, 2, 1, 1, 1, 1, 1, 1, 1, 1};
#elif REPSET == 6
__device__ constexpr int REPS[11] = {1, 1, 1, 1, 1, 1, 1, 1, 1, 2, 1};
#elif REPSET == 7
__device__ constexpr int REPS[11] = {2, 1, 1, 1, 1, 2, 1, 1, 1, 1, 1};
#elif REPSET == 13
__device__ constexpr int REPS[11] = {1, 2, 1, 1, 1, 1, 1, 1, 1, 1, 1};
#elif REPSET == 14
__device__ constexpr int REPS[11] = {1, 1, 1, 1, 1, 1, 2, 1, 2, 1, 1};
#else
__device__ constexpr int REPS[11] = {1, 1, 1, 1, 1, 1, 1, 1, 1, 1, 1};
#endif
constexpr bool FP4_EMU = REPSET == 30;
constexpr int PM_REP = REPSET == 20 ? 2 : 1, PF_REP = REPSET == 21 ? 2 : 1, T1_REP = REPSET == 22 ? 2 : 1, T2_REP = REPSET == 23 ? 2 : 1, T3_REP = REPSET == 24 ? 2 : 1;
constexpr unsigned CONV_MID0 = (96u * 4u * 36u) / 8u;
constexpr int GREP = REPSET == 8 ? 2 : 1, XBAR = REPSET == 9 ? 20 : 0, RWREP = REPSET == 10 ? 2 : 1, ATREP = REPSET == 11 ? 2 : 1, MLREP = REPSET == 12 ? 2 : 1;

enum { I_X = 0, I_C, I_CTX, I_CCTX, I_WMOD, I_BMOD, I_WIN, I_MLCW, I_MLCB, I_MLIB, I_MLFB, I_MLNG, I_RWMU, I_RWW0, I_RWWUP, I_RWA0, I_RWAUP,
       I_RWGUP, I_RWKK, I_RWKA, I_RWRK, I_RWGNG, I_RWGNB, I_QNG, I_QUP, I_KVNG, I_KVUP, I_WOUT, I_LNMG, I_LNMB, I_PWQ, I_PKEYS, I_PU, I_PV, I_LNFG, I_LNFB, N_INPUTS };

constexpr size_t A256(size_t x) { return (x + 255) & ~size_t(255); }
constexpr size_t SZ_WIN = 2ull * NINP * 1024 * 2, SZ_WOUT = 2ull * 1024 * 1024 * 2, SZ_WPQ = 2ull * 2048 * 1024 * 2, SZ_WLORA = 2ull * 2048 * 384 * 2,
                 SZ_WQUP = 2ull * 768 * 384 * 2, SZ_WKVUP = 2ull * 768 * 256 * 2, SZ_KEYS = 2ull * 16 * 128 * 128 * 2, SZ_MOD = 2ull * 9 * 6144 * 4, SZ_CNT = 4096 + 16384  ;
constexpr size_t OFF_WIN = 0, OFF_WOUT = OFF_WIN + SZ_WIN, OFF_WPQ = OFF_WOUT + SZ_WOUT, OFF_WLORA = OFF_WPQ + SZ_WPQ, OFF_WQUP = OFF_WLORA + SZ_WLORA,
                 OFF_WKVUP = OFF_WQUP + SZ_WQUP, OFF_KEYS = OFF_WKVUP + SZ_WKVUP, OFF_MOD = OFF_KEYS + SZ_KEYS, OFF_CNT = OFF_MOD + SZ_MOD;
constexpr size_t OFF_CTXX = A256(OFF_CNT + SZ_CNT);
constexpr size_t OFF_H = OFF_CTXX + 2048ull * 1024 * 4;
constexpr size_t OFF_P = OFF_H + (size_t)NTOK * 1024 * 2;
constexpr size_t SZ_P = (size_t)NTOK * NIN * 2;
constexpr size_t OFF_TABU = OFF_P, OFF_TABV = OFF_TABU + 16384ull * 1024, OFF_RWY = OFF_TABV + 16384ull * 1024;
constexpr size_t OFF_BAR = OFF_CNT + 4096;
static_assert(OFF_RWY + 2ull * NTOK * 384 * 2 <= OFF_P + SZ_P, "P region overflow");
constexpr size_t OFF_BS = OFF_P + 96ull * 1024 * 1024;
static_assert(OFF_BS >= OFF_RWY + 2ull * NTOK * 384 * 2 && OFF_BS + 2ull * NTOK * 6 * 4 <= OFF_P + SZ_P, "BS placement");
constexpr size_t SZ_R1 = (size_t)NTOK * 384 * 2;
constexpr size_t OFF_R = OFF_P + SZ_P;
constexpr size_t OFF_RB = OFF_R, OFF_KB = OFF_RB + SZ_R1, OFF_KH = OFF_KB + SZ_R1, OFF_VB = OFF_KH + SZ_R1, OFF_LORA = OFF_VB + SZ_R1  ,
                 OFF_ZB = OFF_LORA + 5 * SZ_R1;
constexpr size_t SZ_R = 10 * SZ_R1;
constexpr size_t OFF_Y = OFF_R, OFF_QP = OFF_R;
static_assert((size_t)NTOK * 1024 * 4 <= SZ_R && (size_t)NTOK * 2048 * 2 <= SZ_R, "R region overflow");
constexpr size_t OFF_A = OFF_R + SZ_R;
constexpr size_t OFF_CQN = OFF_A, OFF_CKVN = OFF_CQN + (size_t)NTOK * 384 * 2, OFF_QB = OFF_CKVN + (size_t)NTOK * 256 * 2,
                 OFF_KV = OFF_QB + (size_t)NTOK * 576 * 2  , OFF_KR = OFF_KV + (size_t)NTOK * 768 * 2  ,
                 OFF_AEND = OFF_KR + (size_t)NTOK * 32 * 2;
constexpr size_t OFF_EID = OFF_A, OFF_GATE = OFF_EID + (size_t)NTOK * 128 * 4;
static_assert(OFF_GATE + (size_t)NTOK * 128 * 4 <= OFF_QB, "EID/GATE overflow");
constexpr size_t OFF_M = OFF_AEND;
constexpr size_t SZ_M1 = (size_t)NTOK * 256 * 2;
constexpr size_t OFF_MQ = OFF_M, OFF_MK = OFF_MQ + SZ_M1, OFF_MVT = OFF_MK + SZ_M1, OFF_MO = OFF_MVT + SZ_M1, OFF_GLI = OFF_MO + SZ_M1,
                 OFF_GLF = OFF_GLI + 8ull * NTOK * 4, OFF_ST = OFF_GLF + 8ull * NTOK * 4, OFF_SCM = OFF_ST + 2304ull * 5120 * 2,
                 OFF_SCB = OFF_SCM + 2304 * 4, OFF_SCMB = OFF_SCB + 2304 * 4, OFF_END = A256(OFF_SCMB + 2304 * 4);
constexpr size_t OFF_XC = OFF_END;
constexpr size_t WS_NEEDED = OFF_XC + (size_t)NTOK * 1024 * 2;
static_assert(WS_NEEDED <= 512ull * 1024 * 1024, "workspace budget");

struct Params {
  const float* in[N_INPUTS];
  float* out;
  unsigned char* ws;
};
typedef const __attribute__((address_space(4))) Params CParams;

DEV int TIDX() { int t = (int)__builtin_amdgcn_workitem_id_x(); asm volatile("" : "+v"(t)); return t; }
DEV float bf2f(bf16_t b) { return __uint_as_float(((unsigned)b) << 16); }
DEV bf16_t f2bf(float f) { unsigned u = __float_as_uint(f); u += 0x7FFFu + ((u >> 16) & 1u); return (bf16_t)(u >> 16); }
typedef __bf16 bf16v2_t __attribute__((ext_vector_type(2)));
DEV unsigned pack2(float lo, float hi) { return __builtin_bit_cast(unsigned, __builtin_convertvector((f32x2){lo, hi}, bf16v2_t)); }
DEV float lo16(unsigned w) { return __uint_as_float(w << 16); }
DEV float hi16(unsigned w) { return __uint_as_float(w & 0xffff0000u); }
DEV void unpack8(u32x4 w, float* f) { f[0] = lo16(w[0]); f[1] = hi16(w[0]); f[2] = lo16(w[1]); f[3] = hi16(w[1]); f[4] = lo16(w[2]); f[5] = hi16(w[2]); f[6] = lo16(w[3]); f[7] = hi16(w[3]); }
DEV u32x4 pack8(const float* f) { u32x4 w; w[0] = pack2(f[0], f[1]); w[1] = pack2(f[2], f[3]); w[2] = pack2(f[4], f[5]); w[3] = pack2(f[6], f[7]); return w; }
DEV float sigmoidf_(float x) { return __builtin_amdgcn_rcpf(1.0f + __expf(-x)); }
DEV float siluf_(float x) { return x * __builtin_amdgcn_rcpf(1.0f + __expf(-x)); }
template <int CTRL> DEV float dppf(float x) { return __builtin_bit_cast(float, __builtin_amdgcn_mov_dpp(__builtin_bit_cast(int, x), CTRL, 0xf, 0xf, true)); }
template <int CTRL> DEV float dpp_upd(float old, float x) { return __builtin_bit_cast(float, __builtin_amdgcn_update_dpp(__builtin_bit_cast(int, old), __builtin_bit_cast(int, x), CTRL, 0xf, 0xf, false)); }
DEV float rdlane(float v, int l) { return __builtin_bit_cast(float, __builtin_amdgcn_readlane(__builtin_bit_cast(int, v), l)); }
DEV float bperm(int srclane, float v) { return __builtin_bit_cast(float, __builtin_amdgcn_ds_bpermute(srclane << 2, __builtin_bit_cast(int, v))); }
DEV float row16_max(float x) { x = fmaxf(x, dppf<0x128>(x)); x = fmaxf(x, dppf<0x124>(x)); x = fmaxf(x, dppf<0x122>(x)); x = fmaxf(x, dppf<0x121>(x)); return x; }
DEV float grp8_sum(float x) { x += dppf<0xB1>(x); x += dppf<0x4E>(x); x += dppf<0x141>(x); return x; }
DEV float scan_sum64(float x, int lane) {
  x += dpp_upd<0x111>(0.f, x); x += dpp_upd<0x112>(0.f, x); x += dpp_upd<0x114>(0.f, x); x += dpp_upd<0x118>(0.f, x);
  const float t0 = rdlane(x, 15), t1 = rdlane(x, 31), t2 = rdlane(x, 47); const int r = lane >> 4;
  return x + (r == 0 ? 0.f : r == 1 ? t0 : r == 2 ? t0 + t1 : t0 + t1 + t2); }
DEV float scan_max64(float x, int lane) {
  const float NI = -3.0e38f;
  x = fmaxf(x, dpp_upd<0x111>(NI, x)); x = fmaxf(x, dpp_upd<0x112>(NI, x)); x = fmaxf(x, dpp_upd<0x114>(NI, x)); x = fmaxf(x, dpp_upd<0x118>(NI, x));
  const float t0 = rdlane(x, 15), t1 = rdlane(x, 31), t2 = rdlane(x, 47); const int r = lane >> 4;
  return fmaxf(x, r == 0 ? NI : r == 1 ? t0 : r == 2 ? fmaxf(t0, t1) : fmaxf(fmaxf(t0, t1), t2)); }
DEV float row16_sum(float x) { x += dppf<0x128>(x); x += dppf<0x124>(x); x += dppf<0x122>(x); x += dppf<0x121>(x); return x; }
DEV float wave_sum(float v) { v = row16_sum(v); return (rdlane(v, 0) + rdlane(v, 16)) + (rdlane(v, 32) + rdlane(v, 48)); }
DEV float wave_max(float v) { v = row16_max(v); return fmaxf(fmaxf(rdlane(v, 0), rdlane(v, 16)), fmaxf(rdlane(v, 32), rdlane(v, 48))); }
DEV float xhalf_sum(float x) { auto rr = __builtin_amdgcn_permlane32_swap(__float_as_uint(x), __float_as_uint(x), false, false); return __uint_as_float(rr[0]) + __uint_as_float(rr[1]); }
DEV float xhalf_max(float x) { auto rr = __builtin_amdgcn_permlane32_swap(__float_as_uint(x), __float_as_uint(x), false, false); return fmaxf(__uint_as_float(rr[0]), __uint_as_float(rr[1])); }

DEV int modrow_of(int row) { return row < NCTXR ? 8 : ((row - NCTXR) >> 11); }

#define XB_TMO      128
#define XB_XCNT(j)  (256  + 64 * (j))
#define XB_XSUB(j)  (1280 + 64 * (j))
#define XB_XGEN(j)  (2304 + 64 * (j))
#define XB_TOP      3328
#define XB_TOPGEN   3392
#define XCD_BAR_WORDS 3456
#define XB_SPIN_CAP (1u << 20)
DEV unsigned xb_ld(unsigned* p) { return __hip_atomic_load(p, __ATOMIC_RELAXED, __HIP_MEMORY_SCOPE_AGENT); }
DEV unsigned xb_add(unsigned* p, unsigned v) { return __hip_atomic_fetch_add(p, v, __ATOMIC_RELAXED, __HIP_MEMORY_SCOPE_AGENT); }
DEV unsigned xb_xcc_id() { return (unsigned)__builtin_amdgcn_s_getreg((3 << 11) | 20) & 0xFu; }
#define XB_SPIN(cond, bar) do { unsigned _sp = 0; while (cond) { __builtin_amdgcn_s_sleep(1); \
    if ((++_sp & 255u) == 0u) { if (xb_ld(&(bar)[XB_TMO])) break; if (_sp > XB_SPIN_CAP) { atomicAdd(&(bar)[XB_TMO], 1u); break; } } } } while (0)
DEV void xcd_barrier_post(unsigned* bar) { if (TIDX() == 0) (void)xb_add(&bar[XB_XCNT(xb_xcc_id())], 1u); }
DEV void xcd_barrier_complete(unsigned* bar, unsigned x, unsigned& nloc, unsigned& nx) {
  const unsigned G = gridDim.x; unsigned sum, cnt, mine, sp = 0u;
  for (;;) { sum = 0u; cnt = 0u; mine = 0u;
#pragma unroll
    for (unsigned j = 0; j < 16; ++j) { const unsigned c = xb_ld(&bar[XB_XCNT(j)]); sum += c; cnt += (c > 0u) ? 1u : 0u; mine = (j == x) ? c : mine; }
    if (sum == G) break;
    __builtin_amdgcn_s_sleep(1);
    if ((++sp & 255u) == 0u) { if (xb_ld(&bar[XB_TMO])) break; if (sp > XB_SPIN_CAP) { atomicAdd(&bar[XB_TMO], 1u); break; } } }
  nloc = mine > 0u ? mine : 1u; nx = cnt > 0u ? cnt : 1u;
}
DEV void xcd_barrier(unsigned* bar, volatile LAS unsigned* st) {
  asm volatile("s_waitcnt vmcnt(0)" ::: "memory");
  __syncthreads();
  if (TIDX() == 0) {
    const unsigned x = xb_xcc_id();
    __builtin_amdgcn_s_waitcnt(0);
    unsigned nloc = st[0], nx = st[1];
    if (nloc == 0u) { xcd_barrier_complete(bar, x, nloc, nx); st[0] = nloc; st[1] = nx; }
    const unsigned old = xb_add(&bar[XB_XSUB(x)], 1u);
    const unsigned gen = old / nloc;
    if (old + 1u == (gen + 1u) * nloc) {
      __builtin_amdgcn_fence(__ATOMIC_RELEASE, "agent");
      asm volatile("s_waitcnt vmcnt(0)" ::: "memory");
      const unsigned og = xb_add(&bar[XB_TOP], 1u);
      const unsigned tg = og / nx;
      if (og + 1u == (tg + 1u) * nx) xb_add(&bar[XB_TOPGEN], 1u);
      else XB_SPIN(xb_ld(&bar[XB_TOPGEN]) == tg, bar);
      __builtin_amdgcn_fence(__ATOMIC_ACQUIRE, "agent");
      xb_add(&bar[XB_XGEN(x)], 1u);
      asm volatile("s_waitcnt vmcnt(0)" ::: "memory");
    } else {
      XB_SPIN(xb_ld(&bar[XB_XGEN(x)]) == gen, bar);
      __builtin_amdgcn_fence(__ATOMIC_ACQUIRE, "agent");
      asm volatile("s_waitcnt vmcnt(0)" ::: "memory");
    }
  }
  __syncthreads();
}

namespace pg8 {
constexpr int BM = 256, BK = 64, HALF = 128, HTB = HALF * BK * 2, STAGE_BYTES = 8 * HTB, NXCD = 8, WGM = 8;
DEV int lds_byte(int r, int c) { const int st = (r >> 4) * 2 + (c >> 5), rr = r & 15, cc = c & 31, ob = rr * 64 + cc * 2; return st * 1024 + (ob ^ (((ob >> 9) & 1) << 5)); }
DEV void stage_rc(int b, int& R, int& C) { const int st = b / 1024, sb = b % 1024, swz = sb ^ (((sb >> 9) & 1) << 5); R = (st >> 1) * 16 + swz / 64; C = (st & 1) * 32 + (swz % 64) / 2; }
DEV int perm32(int rho) { const int n = rho >> 4, i = rho & 15; return 8 * (i >> 2) + 4 * n + (i & 3); }
struct Unit { int pm, pn; };
struct Gemm { const bf16_t* A; const bf16_t* Bt; int M, N, K; };
struct StaticOrder {
  int nM, nN, nwg, G, c;
  DEV void init(int M, int N, int G_, int c_) { nM = M / BM; nN = N / BM; nwg = nM * nN; G = G_; c = c_; }
  DEV bool next(int i, Unit& u) const {
    const long L = (long)i * G + c; if (L >= nwg) return false;
    int wgid = (int)L; { const int q = nwg / NXCD, r = nwg % NXCD, xcd = wgid % NXCD, off = wgid / NXCD; wgid = (xcd < r ? xcd * (q + 1) : r * (q + 1) + (xcd - r) * q) + off; }
    const int nig = WGM * nN, gid = wgid / nig, fm = gid * WGM, gsz = (nM - fm) < WGM ? (nM - fm) : WGM;
    u.pm = fm + ((wgid % nig) % gsz); u.pn = (wgid % nig) / gsz; return true;
  }
};
struct OneUnit { bool has; Unit u0; DEV bool next(int i, Unit& u) const { if (i == 0 && has) { u = u0; return true; } return false; } };
template <class Epi, class Ord>
DEV void gemm_phase(LAS unsigned char* lds, const Gemm g, const Ord& S, const Epi& E) {
  const int tid = TIDX(), wid = __builtin_amdgcn_readfirstlane(tid >> 6), lane = tid & 63, wr = wid >> 2, wc = wid & 3, fr = lane & 15, fq = lane >> 4;
  const int K = g.K, nt = K / BK;
  unsigned voffA[2], voffB[2];
#pragma unroll
  for (int i = 0; i < 2; ++i) { int R, C; stage_rc(tid * 16 + i * 8192, R, C); const int Rb = Epi::PERM ? ((R & ~31) + perm32(R & 31)) : R;
    voffA[i] = (unsigned)(R * K + C) * 2u; voffB[i] = (unsigned)(Rb * K + C) * 2u; }
  const size_t kstep = (size_t)(BK * 2);
  const size_t hstep = (size_t)HALF * K * 2;
  const size_t tstep = 2 * hstep;
  const unsigned ldsw = (unsigned)wid * 1024u;
  const int aoff = lds_byte(wr * 64 + fr, fq * 8), boff = lds_byte(wc * 32 + fr, fq * 8);
#define PG8_SA(b, h) (((b) * 2 + (h)) * HTB)
#define PG8_SB(b, h) ((4 + (b) * 2 + (h)) * HTB)
#define PG8_STAGE(bufoff, gbase, voff) do { _Pragma("unroll") for (int _i = 0; _i < 2; ++_i) \
        __builtin_amdgcn_global_load_lds((const unsigned*)((const char*)(gbase) + (voff)[_i]), (LAS unsigned*)(lds + (bufoff) + ldsw + _i * 8192), 16, 0, 0); } while (0)
#define PG8_LDA(dst, b, h) do { _Pragma("unroll") for (int m = 0; m < 4; ++m) _Pragma("unroll") for (int k = 0; k < 2; ++k) dst[m][k] = *(const LAS bf16x8*)(lds + PG8_SA(b, h) + aoff + m * 2048 + k * 1024); } while (0)
#define PG8_LDB(dst, b, h) do { _Pragma("unroll") for (int n = 0; n < 2; ++n) _Pragma("unroll") for (int k = 0; k < 2; ++k) dst[n][k] = *(const LAS bf16x8*)(lds + PG8_SB(b, h) + boff + n * 2048 + k * 1024); } while (0)
#define PG8_MMA(ai, bj, At, Bt) do { __builtin_amdgcn_s_setprio(1); _Pragma("unroll") for (int m = 0; m < 4; ++m) _Pragma("unroll") for (int n = 0; n < 2; ++n) _Pragma("unroll") for (int k = 0; k < 2; ++k) \
        acc[ai][bj][m][n] = __builtin_amdgcn_mfma_f32_16x16x32_bf16(Bt[n][k], At[m][k], acc[ai][bj][m][n], 0, 0, 0); __builtin_amdgcn_s_setprio(0); } while (0)
#define PG8_WAIT_V(n) asm volatile("s_waitcnt vmcnt(" #n ")" ::: "memory")
#define PG8_WAIT_L(n) asm volatile("s_waitcnt lgkmcnt(" #n ")" ::: "memory")
#define PG8_BAR __builtin_amdgcn_s_barrier()
#define PG8_SCHED __builtin_amdgcn_sched_barrier(0)
  Unit cur, nxt; int ui = 0;
  if (!S.next(0, cur)) return;
  f32x4 acc[2][2][4][2];
#pragma unroll
  for (int a = 0; a < 2; ++a)
#pragma unroll
    for (int b = 0; b < 2; ++b)
#pragma unroll
      for (int m = 0; m < 4; ++m)
#pragma unroll
        for (int n = 0; n < 2; ++n) acc[a][b][m][n] = (f32x4){0.f, 0.f, 0.f, 0.f};
  bf16x8 At[4][2], B0[2][2], B1[2][2];
  const char* cA = (const char*)g.A + (size_t)cur.pm * tstep; const char* cB = (const char*)g.Bt + (size_t)cur.pn * tstep;
  PG8_STAGE(PG8_SB(0, 0), cB, voffB); PG8_STAGE(PG8_SA(0, 0), cA, voffA); PG8_STAGE(PG8_SB(0, 1), cB + hstep, voffB); PG8_STAGE(PG8_SA(0, 1), cA + hstep, voffA);
  if (wr == 1) PG8_BAR;
  PG8_WAIT_V(4); PG8_BAR;
  PG8_STAGE(PG8_SB(1, 0), cB + kstep, voffB); PG8_STAGE(PG8_SA(1, 0), cA + kstep, voffA); PG8_STAGE(PG8_SB(1, 1), cB + hstep + kstep, voffB);
  PG8_WAIT_V(6); PG8_BAR;
  for (;;) {
    const bool has_next = S.next(ui + 1, nxt);
    const char* nA = has_next ? (const char*)g.A + (size_t)nxt.pm * tstep : cA; const char* nB = has_next ? (const char*)g.Bt + (size_t)nxt.pn * tstep : cB;
    for (int t = 0; t < nt; t += 2) {
      const bool last = (t == nt - 2);
      const char* a1 = cA + (size_t)(t + 1) * kstep;
      const char* a2 = last ? nA : cA + (size_t)(t + 2) * kstep; const char* b2 = last ? nB : cB + (size_t)(t + 2) * kstep;
      const char* a3 = a2 + kstep; const char* b3 = b2 + kstep;
      PG8_LDB(B0, 0, 0); PG8_SCHED; PG8_LDA(At, 0, 0); PG8_STAGE(PG8_SA(1, 1), a1 + hstep, voffA);
      PG8_WAIT_L(8); PG8_BAR; PG8_WAIT_L(0); PG8_MMA(0, 0, At, B0); PG8_BAR; PG8_SCHED;
      PG8_LDB(B1, 0, 1); PG8_STAGE(PG8_SB(0, 0), b2, voffB);
      PG8_BAR; PG8_WAIT_L(0); PG8_MMA(0, 1, At, B1); PG8_BAR;
      PG8_LDA(At, 0, 1); PG8_STAGE(PG8_SA(0, 0), a2, voffA);
      PG8_BAR; PG8_WAIT_L(0); PG8_MMA(1, 0, At, B0); PG8_BAR; PG8_SCHED;
      PG8_STAGE(PG8_SB(0, 1), b2 + hstep, voffB);
      PG8_WAIT_V(6); PG8_BAR; PG8_MMA(1, 1, At, B1); PG8_BAR;
      PG8_LDB(B0, 1, 0); PG8_SCHED; PG8_LDA(At, 1, 0); PG8_STAGE(PG8_SA(0, 1), a2 + hstep, voffA);
      PG8_WAIT_L(8); PG8_BAR; PG8_WAIT_L(0); PG8_MMA(0, 0, At, B0); PG8_BAR; PG8_SCHED;
      PG8_LDB(B1, 1, 1); PG8_STAGE(PG8_SB(1, 0), b3, voffB);
      PG8_BAR; PG8_WAIT_L(0); PG8_MMA(0, 1, At, B1); PG8_BAR;
      PG8_LDA(At, 1, 1); PG8_STAGE(PG8_SA(1, 0), a3, voffA);
      PG8_BAR; PG8_WAIT_L(0); PG8_MMA(1, 0, At, B0); PG8_BAR; PG8_SCHED;
      PG8_STAGE(PG8_SB(1, 1), b3 + hstep, voffB);
      PG8_WAIT_V(6); PG8_BAR; PG8_MMA(1, 1, At, B1); PG8_BAR;
    }
    E(acc, cur, wr, wc, fr, fq);
    if (!has_next) break;
#pragma unroll
    for (int a = 0; a < 2; ++a)
#pragma unroll
      for (int b = 0; b < 2; ++b)
#pragma unroll
        for (int m = 0; m < 4; ++m)
#pragma unroll
          for (int n = 0; n < 2; ++n) acc[a][b][m][n] = (f32x4){0.f, 0.f, 0.f, 0.f};
    cur = nxt; cA = nA; cB = nB; ++ui;
  }
  PG8_WAIT_V(0);
  if (wr == 0) PG8_BAR;
  PG8_BAR;
#undef PG8_SA
#undef PG8_SB
#undef PG8_STAGE
#undef PG8_LDA
#undef PG8_LDB
#undef PG8_MMA
#undef PG8_WAIT_V
#undef PG8_WAIT_L
#undef PG8_BAR
#undef PG8_SCHED
}
}
using pg8::Unit;
typedef f32x4 AccT[2][2][4][2];

struct EpiBf16 {
  static constexpr bool PERM = true;
  bf16_t* O; int ldc; int ncols;
  DEV void operator()(const AccT& acc, const Unit& u, int wr, int wc, int fr, int fq) const {
    { const int t_ = TIDX(); fr = t_ & 15; fq = (t_ >> 4) & 3; }
    const int row0 = u.pm * 256 + wr * 64 + fr, col0 = u.pn * 256 + wc * 32 + 8 * fq;
#pragma unroll
    for (int ai = 0; ai < 2; ++ai)
#pragma unroll
      for (int m = 0; m < 4; ++m) { bf16_t* rowp = O + (size_t)(row0 + ai * 128 + m * 16) * ldc;
#pragma unroll
        for (int bj = 0; bj < 2; ++bj) { const int col = col0 + bj * 128; if (col < ncols) {
          const f32x4 v0 = acc[ai][bj][m][0], v1 = acc[ai][bj][m][1];
          u32x4 w; w[0] = pack2(v0[0], v0[1]); w[1] = pack2(v0[2], v0[3]); w[2] = pack2(v1[0], v1[1]); w[3] = pack2(v1[2], v1[3]);
          *(u32x4*)(rowp + col) = w; } } }
  }
};
struct EpiF32 {
  static constexpr bool PERM = false;
  float* C; int ldc;
  DEV void operator()(const AccT& acc, const Unit& u, int wr, int wc, int fr, int fq) const {
    { const int t_ = TIDX(); fr = t_ & 15; fq = (t_ >> 4) & 3; }
    const int row0 = u.pm * 256 + wr * 64 + fr, col0 = u.pn * 256 + wc * 32 + 4 * fq;
#pragma unroll
    for (int ai = 0; ai < 2; ++ai)
#pragma unroll
      for (int m = 0; m < 4; ++m) { float* rowp = C + (size_t)(row0 + ai * 128 + m * 16) * ldc + col0;
#pragma unroll
        for (int bj = 0; bj < 2; ++bj)
#pragma unroll
          for (int n = 0; n < 2; ++n) *(f32x4*)(rowp + bj * 128 + n * 16) = acc[ai][bj][m][n]; }
  }
};

#define WS(T, off) ((T*)(p.ws + (off)))
DEV const float* x_in_row(CParams& p, int row) { return row < NCTXR ? p.in[I_CTX] + (size_t)row * DM : p.in[I_X] + (size_t)(row - NCTXR) * DM; }
DEV float* x_cur_row(CParams& p, int row) { return row < NCTXR ? WS(float, OFF_CTXX) + (size_t)row * DM : p.out + (size_t)(row - NCTXR) * DM; }

DEV void tr_tile(const float* __restrict__ src, bf16_t* __restrict__ dst, int K, int N, int nt, int kt, float* tile) {
  const int tid = TIDX();
  { const int r = tid >> 4, c4 = (tid & 15) * 4;
#pragma unroll
    for (int i = 0; i < 2; ++i) { const int k = kt * 64 + r + 32 * i, n = nt * 64 + c4;
      f32x4 v = {0.f, 0.f, 0.f, 0.f}; if (n < N) v = *(const f32x4*)(src + (size_t)k * N + n);
      float* tp = tile + (r + 32 * i) * 65 + c4; tp[0] = v[0]; tp[1] = v[1]; tp[2] = v[2]; tp[3] = v[3]; } }
  __syncthreads();
  { const int n = tid >> 3, k8 = (tid & 7) * 8; float f[8];
#pragma unroll
    for (int j = 0; j < 8; ++j) f[j] = tile[(k8 + j) * 65 + n];
    *(u32x4*)(dst + (size_t)(nt * 64 + n) * K + kt * 64 + k8) = pack8(f); }
  __syncthreads();
}
DEV void mod_unit(CParams& p, int l, int cgp, float* lds) {
  float* sc = lds; float* red = lds + 9 * 1024;
  const int tid = TIDX();
  for (int i = tid; i < 9 * 1024; i += NTHREADS) { const int r = i >> 10, k = i & 1023; const float cv = r < 8 ? p.in[I_C][r * 1024 + k] : p.in[I_CCTX][k]; sc[i] = siluf_(cv); }
  __syncthreads();
  const int kg = tid >> 6, cl = tid & 63, col = cgp * 64 + cl;
  float acc[9];
#pragma unroll
  for (int r = 0; r < 9; ++r) acc[r] = 0.f;
  const float* w = p.in[I_WMOD] + (size_t)l * 1024 * 6144 + col;
  for (int k = kg * 128; k < kg * 128 + 128; ++k) { const float wv = w[(size_t)k * 6144];
#pragma unroll
    for (int r = 0; r < 9; ++r) acc[r] += sc[r * 1024 + k] * wv; }
#pragma unroll
  for (int r = 0; r < 9; ++r) red[(kg * 9 + r) * 64 + cl] = acc[r];
  __syncthreads();
  for (int o = tid; o < 9 * 64; o += NTHREADS) { const int r = o >> 6, c2 = o & 63; float s = 0.f;
    for (int g = 0; g < 8; ++g) s += red[(g * 9 + r) * 64 + c2];
    WS(float, OFF_MOD)[(size_t)(l * 9 + r) * 6144 + cgp * 64 + c2] = s + p.in[I_BMOD][l * 6144 + cgp * 64 + c2]; }
  __syncthreads();
}
struct TrDesc { const float* src; bf16_t* dst; int K, N, nt, kt; };
DEV TrDesc tr_desc(CParams& p, int u) {
  constexpr int T0 = (NINP / 64) * 16, T1 = 16 * 16, T2 = 32 * 16, T3 = 12 * 6, T4 = 12 * 4, TL = T0 + T1 + T2 + T3 + T4;
  int v = u - 192; const int l = v / TL; v -= l * TL;
  if (v < T0) return {p.in[I_WIN] + (size_t)l * 1024 * NIN, WS(bf16_t, OFF_WIN) + (size_t)l * NINP * 1024, 1024, NIN, v / 16, v % 16};
  v -= T0;
  if (v < T1) return {p.in[I_WOUT] + (size_t)l * 1024 * 1024, WS(bf16_t, OFF_WOUT) + (size_t)l * 1024 * 1024, 1024, 1024, v / 16, v % 16};
  v -= T1;
  if (v < T2) return {p.in[I_PWQ] + (size_t)l * 1024 * 2048, WS(bf16_t, OFF_WPQ) + (size_t)l * 2048 * 1024, 1024, 2048, v / 16, v % 16};
  v -= T2;
  if (v < T3) return {p.in[I_QUP] + (size_t)l * 384 * 576, WS(bf16_t, OFF_WQUP) + (size_t)l * 768 * 384, 384, 576, v / 6, v % 6};
  v -= T3;
  return {p.in[I_KVUP] + (size_t)l * 256 * 768, WS(bf16_t, OFF_WKVUP) + (size_t)l * 768 * 256, 256, 768, v / 4, v % 4};
}
DEV void tr_load(const TrDesc& d, f32x4& v0, f32x4& v1) {
  const int tid = TIDX(), r = tid >> 4, c4 = (tid & 15) * 4, n = d.nt * 64 + c4;
  v0 = (f32x4){0.f, 0.f, 0.f, 0.f}; v1 = v0;
  if (n < d.N) { v0 = *(const f32x4*)(d.src + (size_t)(d.kt * 64 + r) * d.N + n); v1 = *(const f32x4*)(d.src + (size_t)(d.kt * 64 + r + 32) * d.N + n); }
}
DEV void tr_finish(const TrDesc& d, const f32x4& v0, const f32x4& v1, float* tile) {
  const int tid = TIDX();
  { const int r = tid >> 4, c4 = (tid & 15) * 4; float* tp = tile + r * 65 + c4; tp[0] = v0[0]; tp[1] = v0[1]; tp[2] = v0[2]; tp[3] = v0[3];
    tp = tile + (r + 32) * 65 + c4; tp[0] = v1[0]; tp[1] = v1[1]; tp[2] = v1[2]; tp[3] = v1[3]; }
  __syncthreads();
  { const int n = tid >> 3, k8 = (tid & 7) * 8; float f[8];
#pragma unroll
    for (int j = 0; j < 8; ++j) f[j] = tile[(k8 + j) * 65 + n];
    *(u32x4*)(d.dst + (size_t)(d.nt * 64 + n) * d.K + d.kt * 64 + k8) = pack8(f); }
  __syncthreads();
}
DEV void ph_init(CParams& p, unsigned char* lds) {
  const int tid = TIDX(), nb = gridDim.x;
  if (blockIdx.x == 0 && tid < 64) WS(unsigned, OFF_CNT)[tid] = 0u;
  constexpr int total = 192 + 2 * ((NINP / 64) * 16 + 16 * 16 + 32 * 16 + 12 * 6 + 12 * 4);
  int u = blockIdx.x;
  if (u < 192) { mod_unit(p, u / 96, u % 96, (float*)lds); u += nb; }
  if (u < total) { TrDesc d = tr_desc(p, u); f32x4 a0, a1; tr_load(d, a0, a1);
    for (;;) { const int un = u + nb; const bool hn = un < total; TrDesc dn = d; f32x4 b0 = a0, b1 = a1;
      if (hn) { dn = tr_desc(p, un); tr_load(dn, b0, b1); }
      tr_finish(d, a0, a1, (float*)lds);
      if (!hn) break;
      d = dn; a0 = b0; a1 = b1; u = un; } }
  const size_t gtid = (size_t)blockIdx.x * NTHREADS + tid, gsz = (size_t)nb * NTHREADS;
  for (size_t i = gtid; i < 2ull * 2048 * 384; i += gsz) {
    const int l = (int)(i / (2048 * 384)); const int rem = (int)(i % (2048 * 384)); const int n = rem / 384, k = rem % 384;
    float v = 0.f;
    if (n < 1920) { const int grp = n / 384, cc = n % 384;
      if (grp < 2) { if ((k >> 6) == grp) v = p.in[I_RWWUP][((size_t)(l * 2 + grp) * 64 + (k & 63)) * 384 + cc]; }
      else if (grp < 4) { if ((k >> 6) == grp) v = p.in[I_RWAUP][((size_t)(l * 2 + grp - 2) * 64 + (k & 63)) * 384 + cc]; }
      else { if (k >= 256) v = p.in[I_RWGUP][((size_t)l * 128 + (k - 256)) * 384 + cc]; } }
    WS(bf16_t, OFF_WLORA)[i] = f2bf(v);
  }
  for (size_t i = gtid; i < 2ull * 16 * 128 * 128; i += gsz) WS(bf16_t, OFF_KEYS)[i] = f2bf(p.in[I_PKEYS][i]);
}

DEV void ph_lnmod(CParams& p, int l) {
  const int lane = TIDX() & 63, per = (NTOK + (int)gridDim.x - 1) / (int)gridDim.x, r0 = (int)blockIdx.x * per, r1 = r0 + per < NTOK ? r0 + per : NTOK;
  f32x4 nv[4];
  if (r0 + (TIDX() >> 6) < r1) { const float* xr = x_in_row(p, r0 + (TIDX() >> 6));
#pragma unroll
    for (int i = 0; i < 4; ++i) nv[i] = *(const f32x4*)(xr + lane * 4 + 256 * i); }
#pragma unroll 1
  for (int row = r0 + (TIDX() >> 6); row < r1; row += 8) {
    f32x4 v[4]; float s = 0.f;
#pragma unroll
    for (int i = 0; i < 4; ++i) v[i] = nv[i];
    if (row + 8 < r1) { const float* xn = x_in_row(p, row + 8);
#pragma unroll
      for (int i = 0; i < 4; ++i) nv[i] = *(const f32x4*)(xn + lane * 4 + 256 * i); }
#pragma unroll
    for (int i = 0; i < 4; ++i) s += (v[i][0] + v[i][1]) + (v[i][2] + v[i][3]);
    const float mean = wave_sum(s) * (1.f / 1024.f); float q = 0.f;
#pragma unroll
    for (int i = 0; i < 4; ++i) { v[i] -= mean; q += (v[i][0] * v[i][0] + v[i][1] * v[i][1]) + (v[i][2] * v[i][2] + v[i][3] * v[i][3]); }
    const float rstd = rsqrtf(wave_sum(q) * (1.f / 1024.f) + LN_EPS);
    const float* md = WS(float, OFF_MOD) + (size_t)(l * 9 + modrow_of(row)) * 6144;
#pragma unroll
    for (int i = 0; i < 4; ++i) { const int col = lane * 4 + 256 * i; const f32x4 sh = *(const f32x4*)(md + col), sc = *(const f32x4*)(md + 1024 + col);
      const f32x4 o = v[i] * rstd * (sc + 1.f) + sh; u32x2 w; w[0] = pack2(o[0], o[1]); w[1] = pack2(o[2], o[3]);
      *(u32x2*)(WS(bf16_t, OFF_H) + (size_t)row * 1024 + col) = w; }
  }
}

struct ChunkInfo { int row0, b, cseq, T, t0; bool isctx; };
DEV ChunkInfo chunk_info(int chunk) { ChunkInfo c; c.row0 = chunk * 64; c.isctx = chunk < 32;
  if (c.isctx) { c.b = chunk >> 2; c.cseq = chunk & 3; c.T = 256; } else { const int lc = chunk - 32; c.b = lc >> 5; c.cseq = lc & 31; c.T = 2048; }
  c.t0 = c.cseq * 64; return c; }
DEV int ml_pc(const ChunkInfo& c, int dir) { return dir == 0 ? (c.isctx ? c.cseq : 4 + c.cseq) : (c.isctx ? 3 - c.cseq : 4 + (31 - c.cseq)); }
DEV u32x4 ld8g(const bf16_t* ptr) { return *(const u32x4*)ptr; }

DEV void prep_mlstm(CParams& p, int l, const ChunkInfo& c, int chunk, int hd, unsigned char* lds) {
  bf16_t* VTl = (bf16_t*)lds;
  bf16_t* KWl = (bf16_t*)(lds + 10880);
  float* wkl = (float*)(lds + 10880 + 17408);
  const bf16_t* pb = WS(bf16_t, OFF_P);
  const int tid = TIDX(), lane = tid & 63, wid = tid >> 6;
  if (tid < 128) {
    const int dir = tid >> 6, s = lane, row = c.row0 + s;
    const float gi = bf2f(pb[(size_t)row * NIN + 1024 + dir * 8 + hd]) + p.in[I_MLIB][l * 8 + dir * 4 + hd];
    const float gf = bf2f(pb[(size_t)row * NIN + 1024 + dir * 8 + 4 + hd]) + p.in[I_MLFB][l * 8 + dir * 4 + hd];
    const float lf = fminf(gf, 0.f) - log1pf(__expf(-fabsf(gf)));
    WS(float, OFF_GLI)[(size_t)(dir * 4 + hd) * NTOK + row] = gi; WS(float, OFF_GLF)[(size_t)(dir * 4 + hd) * NTOK + row] = lf;
    const float incl = scan_sum64(lf, lane);
    const float total = rdlane(incl, 63);
    const float g = (dir == 0 ? total - incl : incl - lf) + gi;
    const float mloc = wave_max(g);
    wkl[dir * 64 + s] = __expf(g - mloc);
    if (s == 0) { const int chain = dir * 32 + c.b * 4 + hd, pc = ml_pc(c, dir); WS(float, OFF_SCM)[chain * 36 + pc] = mloc; WS(float, OFF_SCB)[chain * 36 + pc] = total; }
  }
  __syncthreads();
  { const int s = tid >> 3, d0 = (tid & 7) * 8, row = c.row0 + s, t = c.t0 + s;
    const bool hp = t > 0, hn = t < c.T - 1;
    const float* cw = p.in[I_MLCW] + l * 3 * 512; const float* cb = p.in[I_MLCB] + l * 512;
    const u32x4 z4 = {0u, 0u, 0u, 0u};
    float qk[2][8];
#pragma unroll
    for (int which = 0; which < 2; ++which) { const int col = which * 256 + hd * 64 + d0; const bf16_t* pr = pb + (size_t)row * NIN + col;
      float cur[8], prv[8], nxt[8]; unpack8(ld8g(pr), cur); unpack8(hp ? ld8g(pr - NIN) : z4, prv); unpack8(hn ? ld8g(pr + NIN) : z4, nxt);
#pragma unroll
      for (int i = 0; i < 8; ++i) { const int j = col + i; const float x = prv[i] * cw[j] + cur[i] * cw[512 + j] + nxt[i] * cw[1024 + j] + cb[j]; qk[which][i] = siluf_(x); } }
#pragma unroll
    for (int i = 0; i < 8; ++i) qk[0][i] *= 0.125f;
    *(u32x4*)(WS(bf16_t, OFF_MQ) + (size_t)row * 256 + hd * 64 + d0) = pack8(qk[0]);
    *(u32x4*)(WS(bf16_t, OFF_MK) + (size_t)row * 256 + hd * 64 + d0) = pack8(qk[1]);
    const float w0 = wkl[s], w1 = wkl[64 + s];
#pragma unroll
    for (int i = 0; i < 8; ++i) { KWl[(0 * 64 + d0 + i) * 68 + s] = f2bf(qk[1][i] * w0); KWl[(1 * 64 + d0 + i) * 68 + s] = f2bf(qk[1][i] * w1); }
    const u32x4 vv = ld8g(pb + (size_t)row * NIN + 512 + hd * 64 + d0);
#pragma unroll
    for (int i = 0; i < 4; ++i) { VTl[(d0 + 2 * i) * 68 + s] = (bf16_t)(vv[i] & 0xffffu); VTl[(d0 + 2 * i + 1) * 68 + s] = (bf16_t)(vv[i] >> 16); }
    *(u32x4*)(WS(bf16_t, OFF_MO) + (size_t)row * 256 + hd * 64 + d0) = ld8g(pb + (size_t)row * NIN + 768 + hd * 64 + d0);
    if (tid < 64) VTl[64 * 68 + tid] = (bf16_t)0x3F80u;
    for (int i = tid; i < 15 * 68; i += NTHREADS) VTl[65 * 68 + i] = 0;
  }
  __syncthreads();
  { const int e = tid >> 3, sseg = (tid & 7) * 8; const u32x2 a = *(const u32x2*)(VTl + e * 68 + sseg), b2 = *(const u32x2*)(VTl + e * 68 + sseg + 4);
    u32x4 w; w[0] = a[0]; w[1] = a[1]; w[2] = b2[0]; w[3] = b2[1];
    *(u32x4*)(WS(bf16_t, OFF_MVT) + ((size_t)(chunk * 4 + hd) * 64 + e) * 64 + sseg) = w; }
  { const int fr = lane & 15, fq = lane >> 4;
#pragma unroll 1
    for (int ti = 0; ti < 5; ++ti) { const int id = wid * 5 + ti, dir = id / 20, et = (id % 20) >> 2, dt = id & 3;
      f32x4 acc = {0.f, 0.f, 0.f, 0.f};
#pragma unroll
      for (int ks = 0; ks < 2; ++ks) {
        const bf16_t* ap = VTl + (et * 16 + fr) * 68 + ks * 32 + fq * 8; const bf16_t* bp = KWl + (dir * 64 + dt * 16 + fr) * 68 + ks * 32 + fq * 8;
        u32x4 aw, bw; { const u32x2 x0 = *(const u32x2*)ap, x1 = *(const u32x2*)(ap + 4); aw[0] = x0[0]; aw[1] = x0[1]; aw[2] = x1[0]; aw[3] = x1[1]; }
        { const u32x2 x0 = *(const u32x2*)bp, x1 = *(const u32x2*)(bp + 4); bw[0] = x0[0]; bw[1] = x0[1]; bw[2] = x1[0]; bw[3] = x1[1]; }
        acc = __builtin_amdgcn_mfma_f32_16x16x32_bf16(__builtin_bit_cast(bf16x8, aw), __builtin_bit_cast(bf16x8, bw), acc, 0, 0, 0); }
      const int chain = dir * 32 + c.b * 4 + hd, pc = ml_pc(c, dir);
      bf16_t* st = WS(bf16_t, OFF_ST) + (size_t)(chain * 36 + pc) * 5120;
#pragma unroll
      for (int j = 0; j < 4; ++j) st[(et * 16 + fq * 4 + j) * 64 + dt * 16 + fr] = f2bf(acc[j]); }
  }
  __syncthreads();
}

DEV float tanh_fast(float x) { return 1.f - 2.f * __builtin_amdgcn_rcpf(1.f + __expf(2.f * x)); }
DEV void prep_rwkv_flat(CParams& p, int l) {
  const bf16_t* pb = WS(bf16_t, OFF_P); const float* mu = p.in[I_RWMU] + l * 3072;
  const int lane = TIDX() & 63, wid = TIDX() >> 6;
  const int per = (NTOK + (int)gridDim.x - 1) / (int)gridDim.x, pw = (per + 7) / 8;
  const int rA = (int)blockIdx.x * per + wid * pw; int rB = rA + pw; { const int re = (int)blockIdx.x * per + per; if (rB > re) rB = re; if (rB > NTOK) rB = NTOK; }
  if (rA >= rB) return;
  const u32x4 z4 = {0u, 0u, 0u, 0u};
  u32x4 prv[3], cur[3], nxt[3];
#pragma unroll
  for (int st = 0; st < 3; ++st) { const bf16_t* pr = pb + (size_t)rA * NIN + 1040 + (st * 64 + lane) * 8; cur[st] = ld8g(pr); prv[st] = rA > 0 ? ld8g(pr - NIN) : z4; nxt[st] = rA + 1 < NTOK ? ld8g(pr + NIN) : z4; }
  u32x4 nmq = z4, nmkv = z4; bf16_t nmkr;
  { const bf16_t* mpr = pb + (size_t)rA * NIN; if (lane < 48) nmq = ld8g(mpr + 2576 + lane * 8); if (lane < 32) nmkv = ld8g(mpr + 2960 + lane * 8); nmkr = mpr[3216 + (lane & 31)]; }
#pragma unroll 1
  for (int row = rA; row < rB; ++row) {
    int t, T; if (row < NCTXR) { t = row & 255; T = 256; } else { t = (row - NCTXR) & 2047; T = 2048; }
    u32x4 nx2[3];
#pragma unroll
    for (int st = 0; st < 3; ++st) nx2[st] = row + 2 < NTOK ? ld8g(pb + (size_t)(row + 2) * NIN + 1040 + (st * 64 + lane) * 8) : z4;
    const u32x4 mq = nmq, mkv = nmkv; const bf16_t mkr = nmkr;
    if (row + 1 < rB) { const bf16_t* mpr = pb + (size_t)(row + 1) * NIN; if (lane < 48) nmq = ld8g(mpr + 2576 + lane * 8); if (lane < 32) nmkv = ld8g(mpr + 2960 + lane * 8); nmkr = mpr[3216 + (lane & 31)]; }
    const bool hp = t > 0, hn = t < T - 1;
#pragma unroll
    for (int st = 0; st < 3; ++st) { const int seg = st * 64 + lane, col = seg * 8;
      float c[8], pv[8], nx[8], x[8]; unpack8(cur[st], c); unpack8(hp ? prv[st] : z4, pv); unpack8(hn ? nxt[st] : z4, nx);
#pragma unroll
      for (int i = 0; i < 8; ++i) x[i] = c[i] + mu[col + i] * (pv[i] - c[i]) + mu[1536 + col + i] * (nx[i] - c[i]);
      if (st == 0 && lane < 48) *(u32x4*)(WS(bf16_t, OFF_RB) + (size_t)row * 384 + col) = pack8(x);
      if ((st == 0 && lane >= 48) || (st == 1 && lane < 32)) { const int kc = (seg - 48) * 8; float kk[8], ss = 0.f;
#pragma unroll
        for (int i = 0; i < 8; ++i) { kk[i] = x[i] * p.in[I_RWKK][l * 384 + kc + i]; ss += kk[i] * kk[i]; }
        ss = grp8_sum(ss);
        *(u32x4*)(WS(bf16_t, OFF_KB) + (size_t)row * 384 + kc) = pack8(x); const float inv = rsqrtf(ss + 1e-12f);
#pragma unroll
        for (int i = 0; i < 8; ++i) kk[i] *= inv;
        *(u32x4*)(WS(bf16_t, OFF_KH) + (size_t)row * 384 + kc) = pack8(kk); }
      if ((st == 1 && lane >= 32) || (st == 2 && lane < 16)) *(u32x4*)(WS(bf16_t, OFF_VB) + (size_t)row * 384 + (seg - 96) * 8) = pack8(x);
      if (st == 2 && lane >= 16) { const int zc = (seg - 144) * 8;
        if (zc < 128) { for (int i = 0; i < 8; ++i) x[i] = tanh_fast(x[i]); } else if (zc >= 256) { for (int i = 0; i < 8; ++i) x[i] = sigmoidf_(x[i]); }
        *(u32x4*)(WS(bf16_t, OFF_ZB) + (size_t)row * 384 + zc) = pack8(x); }
      prv[st] = cur[st]; cur[st] = nxt[st]; nxt[st] = nx2[st]; }
    { float v[8]; float ss = 0.f; unpack8(mq, v);
#pragma unroll
      for (int i = 0; i < 8; ++i) ss += v[i] * v[i];
      const float inv = rsqrtf(wave_sum(ss) * (1.f / 384.f) + LN_EPS);
      if (lane < 48) { for (int i = 0; i < 8; ++i) v[i] = v[i] * inv * p.in[I_QNG][l * 384 + lane * 8 + i]; *(u32x4*)(WS(bf16_t, OFF_CQN) + (size_t)row * 384 + lane * 8) = pack8(v); } }
    { float v[8]; float ss = 0.f; unpack8(mkv, v);
#pragma unroll
      for (int i = 0; i < 8; ++i) ss += v[i] * v[i];
      const float inv = rsqrtf(wave_sum(ss) * (1.f / 256.f) + LN_EPS);
      if (lane < 32) { for (int i = 0; i < 8; ++i) v[i] = v[i] * inv * p.in[I_KVNG][l * 256 + lane * 8 + i]; *(u32x4*)(WS(bf16_t, OFF_CKVN) + (size_t)row * 256 + lane * 8) = pack8(v); } }
    { const float x = bf2f(mkr); const float pt = dppf<0x128>(x); float o = x;
      if (row >= NCTXR) { const int f = lane & 7; const int pos = (lane & 16) ? (t & 63) : (t >> 6);
        const float invf = __expf(-(float)f * (9.210340372f / 8.f)); float rev = (float)pos * invf * 0.15915494309f; rev -= floorf(rev);
        const float sn = __builtin_amdgcn_sinf(rev), cs = __builtin_amdgcn_cosf(rev);
        o = (lane & 8) ? x * cs + pt * sn : x * cs - pt * sn; }
      if (lane < 32) WS(bf16_t, OFF_KR)[(size_t)row * 32 + lane] = f2bf(o); }
  }
}
DEV void prep_mla_flat(CParams& p, int l) {
  const bf16_t* pb = WS(bf16_t, OFF_P); const int tid = TIDX(), lane = tid & 63, gw = (int)blockIdx.x * 8 + (tid >> 6), nw = (int)gridDim.x * 8;
#pragma unroll 3
  for (int row = gw; row < NTOK; row += nw) { const bool isctx = row < NCTXR; const int t = isctx ? (row & 255) : ((row - NCTXR) & 2047); const bf16_t* pr = pb + (size_t)row * NIN;
    { float v[8]; float ss = 0.f; if (lane < 48) { unpack8(ld8g(pr + 2576 + lane * 8), v); for (int i = 0; i < 8; ++i) ss += v[i] * v[i]; }
      const float inv = rsqrtf(wave_sum(ss) * (1.f / 384.f) + LN_EPS);
      if (lane < 48) { for (int i = 0; i < 8; ++i) v[i] = v[i] * inv * p.in[I_QNG][l * 384 + lane * 8 + i]; *(u32x4*)(WS(bf16_t, OFF_CQN) + (size_t)row * 384 + lane * 8) = pack8(v); } }
    { float v[8]; float ss = 0.f; if (lane < 32) { unpack8(ld8g(pr + 2960 + lane * 8), v); for (int i = 0; i < 8; ++i) ss += v[i] * v[i]; }
      const float inv = rsqrtf(wave_sum(ss) * (1.f / 256.f) + LN_EPS);
      if (lane < 32) { for (int i = 0; i < 8; ++i) v[i] = v[i] * inv * p.in[I_KVNG][l * 256 + lane * 8 + i]; *(u32x4*)(WS(bf16_t, OFF_CKVN) + (size_t)row * 256 + lane * 8) = pack8(v); } }
    { const float x = bf2f(pr[3216 + (lane & 31)]); const float pt = dppf<0x128>(x); float o = x;
      if (!isctx) { const int f = lane & 7; const int pos = (lane & 16) ? (t & 63) : (t >> 6);
        const float invf = __expf(-(float)f * (9.210340372f / 8.f)); float rev = (float)pos * invf * 0.15915494309f; rev -= floorf(rev);
        const float sn = __builtin_amdgcn_sinf(rev), cs = __builtin_amdgcn_cosf(rev);
        o = (lane & 8) ? x * cs + pt * sn : x * cs - pt * sn; }
      if (lane < 32) WS(bf16_t, OFF_KR)[(size_t)row * 32 + lane] = f2bf(o); }
  }
}

DEV void ph_prep(CParams& p, int l, unsigned char* lds) {
  for (int r_ = 0; r_ < PM_REP; ++r_)
  for (int u = blockIdx.x; u < 288 * 4; u += gridDim.x) { const int chunk = u >> 2; const ChunkInfo c = chunk_info(chunk); prep_mlstm(p, l, c, chunk, u & 3, lds); }
  for (int r_ = 0; r_ < PF_REP; ++r_) prep_rwkv_flat(p, l);
}

DEV void mlstm_state_scan(CParams& p, int chain) {
  const int tid = TIDX(); const bool two = tid < 128;
  float C0[8], C1[8];
#pragma unroll
  for (int i = 0; i < 8; ++i) { C0[i] = 0.f; C1[i] = 0.f; }
  float m = -1e30f;
  bf16_t* blk = WS(bf16_t, OFF_ST) + (size_t)chain * 36 * 5120;
  u32x4 q0a, q0b = {0u, 0u, 0u, 0u}, q1a, q1b = {0u, 0u, 0u, 0u}, q2a, q2b = {0u, 0u, 0u, 0u};
#define SS_LOAD(A, B, pc_) do { const bf16_t* sp_ = blk + (size_t)(pc_) * 5120; A = *(const u32x4*)(sp_ + tid * 8); if (two) B = *(const u32x4*)(sp_ + (512 + tid) * 8); } while (0)
#define SS_STEP(A, B, pc_) do { bf16_t* cb = blk + (size_t)(pc_) * 5120; const u32x4 l0 = A, l1 = B; \
    if ((pc_) + 3 < 36) SS_LOAD(A, B, (pc_) + 3); \
    const float mloc = WS(float, OFF_SCM)[chain * 36 + (pc_)], bend = WS(float, OFF_SCB)[chain * 36 + (pc_)]; \
    *(u32x4*)(cb + tid * 8) = pack8(C0); if (two) *(u32x4*)(cb + (512 + tid) * 8) = pack8(C1); \
    if (tid == 0) WS(float, OFF_SCMB)[chain * 36 + (pc_)] = m; \
    const float mnew = fmaxf(bend + m, mloc), decay = __expf(bend + m - mnew), sl = __expf(mloc - mnew); \
    float f0[8], f1[8]; unpack8(l0, f0); unpack8(l1, f1); \
    _Pragma("unroll") for (int i = 0; i < 8; ++i) { C0[i] = decay * C0[i] + sl * f0[i]; C1[i] = decay * C1[i] + sl * f1[i]; } \
    m = mnew; } while (0)
  SS_LOAD(q0a, q0b, 0); SS_LOAD(q1a, q1b, 1); SS_LOAD(q2a, q2b, 2);
#pragma unroll 1
  for (int pc = 0; pc < 36; pc += 3) { SS_STEP(q0a, q0b, pc); SS_STEP(q1a, q1b, pc + 1); SS_STEP(q2a, q2b, pc + 2); }
#undef SS_LOAD
#undef SS_STEP
}
template <int MASK> DEV void ph_mid_t(CParams& p, int lx, unsigned char* lds) {
  const int l = lx & 1;
  LAS unsigned char* ll = (LAS unsigned char*)lds;
  pg8::StaticOrder S;
  if constexpr (MASK & 1) { S.init(NTOK, 2048, gridDim.x, blockIdx.x); pg8::Gemm g{WS(bf16_t, OFF_ZB), WS(bf16_t, OFF_WLORA) + (size_t)l * 2048 * 384, NTOK, 2048, 384};
    EpiBf16 E{WS(bf16_t, OFF_LORA), 1920, 1920}; pg8::gemm_phase(ll, g, S, E); }
  const bool rot = gridDim.x == 256, act = !rot || blockIdx.x < 192;
  if constexpr (MASK & 2) { if (act) { if (rot) S.init(NTOK, 768, 192, ((int)blockIdx.x + 128) % 192); else S.init(NTOK, 768, gridDim.x, blockIdx.x);
    pg8::Gemm g{WS(bf16_t, OFF_CQN), WS(bf16_t, OFF_WQUP) + (size_t)l * 768 * 384, NTOK, 768, 384};
    EpiBf16 E{WS(bf16_t, OFF_QB), 576, 576}; pg8::gemm_phase(ll, g, S, E); } }
  if constexpr (MASK & 4) { if (act) { if (rot) S.init(NTOK, 768, 192, ((int)blockIdx.x + 104) % 192); else S.init(NTOK, 768, gridDim.x, blockIdx.x);
    pg8::Gemm g{WS(bf16_t, OFF_CKVN), WS(bf16_t, OFF_WKVUP) + (size_t)l * 768 * 256, NTOK, 768, 256};
    EpiBf16 E{WS(bf16_t, OFF_KV), 768, 768}; pg8::gemm_phase(ll, g, S, E); } }
  if constexpr (MASK & 8) { const int c = (int)gridDim.x - 1 - (int)blockIdx.x; if (c < 64) mlstm_state_scan(p, c); }
  if constexpr (MASK & 8) {
  unsigned* cnt = WS(unsigned, OFF_CNT) + 8 + lx; unsigned* slot = (unsigned*)lds;
  for (;;) {
    __syncthreads();
    if (TIDX() == 0) *slot = atomicAdd(cnt, 1u);
    __syncthreads();
    const unsigned ch = *slot + CONV_MID0; if (ch >= 2048u) break;
    const int tb = ch >> 10, e = (int)(ch & 1023) * 16 + (TIDX() >> 5), seg = TIDX() & 31;
    const float* src = p.in[tb ? I_PV : I_PU] + ((size_t)l * 16384 + e) * 1024 + seg * 32; const float scl = tb ? 4.f : 64.f;
    unsigned char* dst = WS(unsigned char, tb ? OFF_TABV : OFF_TABU) + ((size_t)(seg >> 3) * 16384 + e) * 128 + (seg & 7) * 16;
    u32x4 w0;
#pragma unroll
    for (int i = 0; i < 4; ++i) { const f32x4 a = *(const f32x4*)(src + i * 8) * scl, b2 = *(const f32x4*)(src + i * 8 + 4) * scl; unsigned w = 0u;
      w = __builtin_amdgcn_cvt_scalef32_pk_fp4_f32(w, a[0], a[1], 1.0f, 0); w = __builtin_amdgcn_cvt_scalef32_pk_fp4_f32(w, a[2], a[3], 1.0f, 1);
      w = __builtin_amdgcn_cvt_scalef32_pk_fp4_f32(w, b2[0], b2[1], 1.0f, 2); w = __builtin_amdgcn_cvt_scalef32_pk_fp4_f32(w, b2[2], b2[3], 1.0f, 3);
      w0[i] = w; }
    *(u32x4*)dst = w0;
  }
  }
  __syncthreads();
}
DEV void ph_mid(CParams& p, int l, unsigned char* lds) { ph_mid_t<15>(p, l, lds); }

DEV int rw_rowof(int dir, int b, int pos) { if (pos < 256) { const int t = dir ? 255 - pos : pos; return b * 256 + t; } const int q = pos - 256; const int t = dir ? 2047 - q : q; return NCTXR + b * 2048 + t; }
DEV void rwkv_scan_unit(CParams& p, int l, int u, unsigned char* lds) {
  constexpr int TS = 32;
  const int chain = u >> 1, half = u & 1, dir = chain / 48, bh = chain % 48, b = bh / 6, h6 = bh % 6;
  float* sb = (float*)lds;
  float* yb = sb + 2 * 6 * TS * 64;
  const int tid = TIDX(), rl = tid >> 4, kq = tid & 15, col = h6 * 64 + kq * 4;
  float ka[4];
#pragma unroll
  for (int i = 0; i < 4; ++i) ka[i] = p.in[I_RWKA][l * 384 + col + i];
  const bf16_t* RBp = WS(bf16_t, OFF_RB); const bf16_t* KBp = WS(bf16_t, OFF_KB); const bf16_t* KHp = WS(bf16_t, OFF_KH); const bf16_t* VBp = WS(bf16_t, OFF_VB);
  const bf16_t* LOp = WS(bf16_t, OFF_LORA) + dir * 384 + col;
  float w0v[4], a0v[4];
#pragma unroll
  for (int i = 0; i < 4; ++i) { w0v[i] = p.in[I_RWW0][l * 768 + dir * 384 + col + i]; a0v[i] = p.in[I_RWA0][l * 768 + dir * 384 + col + i]; }
  u32x2 g_r, g_k, g_kh, g_v, g_lw, g_a;
#define RW_LOAD(c) do { const size_t off = (size_t)rw_rowof(dir, b, (c) * TS + rl) * 384 + col; g_r = *(const u32x2*)(RBp + off); g_k = *(const u32x2*)(KBp + off); \
    g_kh = *(const u32x2*)(KHp + off); g_v = *(const u32x2*)(VBp + off); const size_t off2 = (size_t)rw_rowof(dir, b, (c) * TS + rl) * 1920; g_lw = *(const u32x2*)(LOp + off2); g_a = *(const u32x2*)(LOp + off2 + 768); } while (0)
#define RW_WRITE(bi) do { float* base = sb + (bi) * 6 * TS * 64 + rl * 64 + kq * 4; \
    const float r_[4] = {lo16(g_r[0]), hi16(g_r[0]), lo16(g_r[1]), hi16(g_r[1])}, k_[4] = {lo16(g_k[0]), hi16(g_k[0]), lo16(g_k[1]), hi16(g_k[1])}; \
    const float kh_[4] = {lo16(g_kh[0]), hi16(g_kh[0]), lo16(g_kh[1]), hi16(g_kh[1])}, v_[4] = {lo16(g_v[0]), hi16(g_v[0]), lo16(g_v[1]), hi16(g_v[1])}; \
    const float lw_[4] = {lo16(g_lw[0]), hi16(g_lw[0]), lo16(g_lw[1]), hi16(g_lw[1])}, a_[4] = {lo16(g_a[0]), hi16(g_a[0]), lo16(g_a[1]), hi16(g_a[1])}; \
    f32x4 o0, o1, o2, o3, o4, o5; \
    _Pragma("unroll") for (int i = 0; i < 4; ++i) { const float aa = sigmoidf_(a0v[i] + a_[i]); o0[i] = __expf(-0.60653065971f * sigmoidf_(w0v[i] + lw_[i])); o1[i] = kh_[i]; o2[i] = kh_[i] * aa; o3[i] = k_[i] * (1.f + (aa - 1.f) * ka[i]); o4[i] = r_[i]; o5[i] = v_[i]; } \
    *(f32x4*)(base + 0 * TS * 64) = o0; *(f32x4*)(base + 1 * TS * 64) = o1; *(f32x4*)(base + 2 * TS * 64) = o2; *(f32x4*)(base + 3 * TS * 64) = o3; \
    *(f32x4*)(base + 4 * TS * 64) = o4; *(f32x4*)(base + 5 * TS * 64) = o5; } while (0)
  f32x2 SA = {0.f, 0.f}, SB = {0.f, 0.f};
  __syncthreads();
  RW_LOAD(0); RW_WRITE(0);
  __syncthreads();
  constexpr int NCH = 2304 / TS;
#pragma unroll 1
  for (int c = 0; c < NCH; ++c) {
    if (c + 1 < NCH) RW_LOAD(c + 1);
    const float* base = sb + (c & 1) * 6 * TS * 64 + kq * 4; const float* vbase = sb + (c & 1) * 6 * TS * 64 + 5 * TS * 64 + half * 32 + rl;
    f32x4 w4 = *(const f32x4*)(base), kh4 = *(const f32x4*)(base + TS * 64), ab4 = *(const f32x4*)(base + 2 * TS * 64), kt4 = *(const f32x4*)(base + 3 * TS * 64), r4 = *(const f32x4*)(base + 4 * TS * 64);
    float vv = vbase[0];
#pragma unroll
    for (int ts = 0; ts < TS; ++ts) {
      f32x4 nw4 = w4, nkh4 = kh4, nab4 = ab4, nkt4 = kt4, nr4 = r4; float nvv = vv;
      if (ts + 1 < TS) { const float* bp = base + (ts + 1) * 64;
        nw4 = *(const f32x4*)(bp); nkh4 = *(const f32x4*)(bp + TS * 64); nab4 = *(const f32x4*)(bp + 2 * TS * 64); nkt4 = *(const f32x4*)(bp + 3 * TS * 64); nr4 = *(const f32x4*)(bp + 4 * TS * 64);
        nvv = vbase[(ts + 1) * 64]; }
      const f32x2 khA = {kh4[0], kh4[1]}, khB = {kh4[2], kh4[3]}, wA = {w4[0], w4[1]}, wB = {w4[2], w4[3]}, abA = {ab4[0], ab4[1]}, abB = {ab4[2], ab4[3]},
                  ktA = {kt4[0], kt4[1]}, ktB = {kt4[2], kt4[3]}, rA = {r4[0], r4[1]}, rB = {r4[2], r4[3]};
      f32x2 pa = SA * khA + SB * khB;
      float sa = row16_sum(pa[0] + pa[1]);
      const f32x2 vv2 = {vv, vv}, sa2 = {sa, sa};
      SA = SA * wA + (vv2 * ktA - sa2 * abA); SB = SB * wB + (vv2 * ktB - sa2 * abB);
      f32x2 py = SA * rA + SB * rB;
      float y = row16_sum(py[0] + py[1]);
      yb[ts * 32 + rl] = y;
      w4 = nw4; kh4 = nkh4; ab4 = nab4; kt4 = nkt4; r4 = nr4; vv = nvv;
    }
    __syncthreads();
    { const int ts = tid >> 4, pr = tid & 15; const int row = rw_rowof(dir, b, c * TS + ts);
      *(unsigned*)(WS(bf16_t, OFF_RWY) + ((size_t)dir * NTOK + row) * 384 + h6 * 64 + half * 32 + pr * 2) = pack2(yb[ts * 32 + pr * 2], yb[ts * 32 + pr * 2 + 1]); }
    if (c + 1 < NCH) RW_WRITE((c + 1) & 1);
    __syncthreads();
  }
#undef RW_LOAD
#undef RW_WRITE
}

DEV bf16x8 ld_frag16(const bf16_t* ptr) { return *(const bf16x8*)ptr; }
DEV bf16x8 ld_frag8x2(const bf16_t* p0, const bf16_t* p1) { const u32x2 x0 = *(const u32x2*)p0, x1 = *(const u32x2*)p1; u32x4 w; w[0] = x0[0]; w[1] = x0[1]; w[2] = x1[0]; w[3] = x1[1]; return __builtin_bit_cast(bf16x8, w); }
typedef short v4s16 __attribute__((ext_vector_type(4)));
template <int OFF> DEV u32x2 tr_read(unsigned addr) { return __builtin_bit_cast(u32x2, __builtin_amdgcn_ds_read_tr16_b64_v4i16((LAS v4s16*)(addr + (unsigned)OFF))); }
DEV bf16x8 frag_lo(u32x2 lo) { u32x4 w; w[0] = lo[0]; w[1] = lo[1]; w[2] = 0u; w[3] = 0u; return __builtin_bit_cast(bf16x8, w); }
DEV bf16x8 frag2(u32x2 lo, u32x2 hi) { u32x4 w; w[0] = lo[0]; w[1] = lo[1]; w[2] = hi[0]; w[3] = hi[1]; return __builtin_bit_cast(bf16x8, w); }
DEV u32x2 acc2bf(f32x4 a) { u32x2 w; w[0] = (unsigned)f2bf(a[0]) | ((unsigned)f2bf(a[1]) << 16); w[1] = (unsigned)f2bf(a[2]) | ((unsigned)f2bf(a[3]) << 16); return w; }
DEV void rwkv_chunk_unit(CParams& p, int l, int u, unsigned char* lds) {
  constexpr int O_A = 0, O_Q = 2176, O_NB = 4352, O_C = 6528, O_V = 8704, O_M1T = 10880, O_U1T = 11392, O_NU2T = 11904, O_TT = 12416, O_GAM = 12928, SCB = 13184, CHB = 4 * SCB;
  constexpr int O_PRIV = 2 * CHB, P_LW = 0, P_M2 = 4096, PRIV = 5120, O_CONST = O_PRIV + 4 * PRIV;
  const int chain = u, dir = chain / 48, bh = chain % 48, b = bh / 6, h6 = bh % 6;
  const int tid = TIDX(), lane = tid & 63, wid = tid >> 6, fr = lane & 15, fq = lane >> 4;
  float* cst = (float*)(lds + O_CONST);
  __syncthreads();
  if (tid < 64) { cst[tid] = p.in[I_RWW0][l * 768 + dir * 384 + h6 * 64 + tid]; cst[64 + tid] = p.in[I_RWA0][l * 768 + dir * 384 + h6 * 64 + tid]; cst[128 + tid] = p.in[I_RWKA][l * 384 + h6 * 64 + tid]; cst[192 + tid] = p.in[I_RWRK][l * 384 + h6 * 64 + tid]; }
  __syncthreads();
  const bool producer = wid >= 4;
  const int pj = wid - 4, pt = lane >> 2, pks = lane & 3;
  u32x4 in_r[2], in_k[2], in_kh[2], in_v[2], in_lw[2], in_a[2];
#define RC_LOAD(c) do { int lo32_ = h6 * 64 + pks * 16; asm volatile("" : "+v"(lo32_));   \
    const int row_ = rw_rowof(dir, b, (c) * 64 + pj * 16 + pt); const size_t o_ = (size_t)row_ * 384 + lo32_; \
    in_r[0] = ld8g(WS(bf16_t, OFF_RB) + o_); in_r[1] = ld8g(WS(bf16_t, OFF_RB) + o_ + 8); in_k[0] = ld8g(WS(bf16_t, OFF_KB) + o_); in_k[1] = ld8g(WS(bf16_t, OFF_KB) + o_ + 8); \
    in_kh[0] = ld8g(WS(bf16_t, OFF_KH) + o_); in_kh[1] = ld8g(WS(bf16_t, OFF_KH) + o_ + 8); in_v[0] = ld8g(WS(bf16_t, OFF_VB) + o_); in_v[1] = ld8g(WS(bf16_t, OFF_VB) + o_ + 8); \
    const bf16_t* lo_ = WS(bf16_t, OFF_LORA) + (size_t)row_ * 1920 + dir * 384 + lo32_; in_lw[0] = ld8g(lo_); in_lw[1] = ld8g(lo_ + 8); in_a[0] = ld8g(lo_ + 768); in_a[1] = ld8g(lo_ + 776); } while (0)
  f32x4 sacc[4];
#pragma unroll
  for (int i = 0; i < 4; ++i) sacc[i] = (f32x4){0.f, 0.f, 0.f, 0.f};
  if (producer) RC_LOAD(0);
#pragma unroll 1
  for (int c = -1; c < 36; ++c) {
    if (producer) {
      if (c + 1 < 36) {
        unsigned char* scb = lds + ((c + 1) & 1) * CHB + pj * SCB; unsigned char* prv = lds + O_PRIV + pj * PRIV;
        float r_[16], k_[16], kh_[16], lw_[16], aa_[16];
        unpack8(in_r[0], r_); unpack8(in_r[1], r_ + 8); unpack8(in_k[0], k_); unpack8(in_k[1], k_ + 8); unpack8(in_kh[0], kh_); unpack8(in_kh[1], kh_ + 8);
        unpack8(in_lw[0], lw_); unpack8(in_lw[1], lw_ + 8); unpack8(in_a[0], aa_); unpack8(in_a[1], aa_ + 8);
        const u32x4 vraw0 = in_v[0], vraw1 = in_v[1];
        float* LW = (float*)(prv + P_LW);
#pragma unroll
        for (int i = 0; i < 16; ++i) { const int col = pks * 16 + i; aa_[i] = sigmoidf_(cst[64 + col] + aa_[i]); lw_[i] = -0.60653065971f * sigmoidf_(cst[col] + lw_[i]); }
#pragma unroll
        for (int i = 0; i < 4; ++i) *(f32x4*)(LW + pt * 64 + pks * 16 + i * 4) = (f32x4){lw_[4 * i], lw_[4 * i + 1], lw_[4 * i + 2], lw_[4 * i + 3]};
        { bf16_t* Vp = (bf16_t*)(scb + O_V) + pt * 68 + pks * 16;
          *(u32x2*)(Vp) = (u32x2){vraw0[0], vraw0[1]}; *(u32x2*)(Vp + 4) = (u32x2){vraw0[2], vraw0[3]}; *(u32x2*)(Vp + 8) = (u32x2){vraw1[0], vraw1[1]}; *(u32x2*)(Vp + 12) = (u32x2){vraw1[2], vraw1[3]}; }
        asm volatile("s_waitcnt lgkmcnt(0)" ::: "memory"); __builtin_amdgcn_wave_barrier();
        { float g = 0.f;
#pragma unroll
          for (int t = 0; t < 16; ++t) { g += LW[t * 64 + lane]; LW[t * 64 + lane] = g; }
          ((float*)(scb + O_GAM))[lane] = __expf(g); }
        asm volatile("s_waitcnt lgkmcnt(0)" ::: "memory"); __builtin_amdgcn_wave_barrier();
        { float av[16], bv[16], cv[16], qv[16];
#pragma unroll
          for (int i = 0; i < 4; ++i) { const f32x4 g4 = *(const f32x4*)(LW + pt * 64 + pks * 16 + i * 4);
#pragma unroll
            for (int jj = 0; jj < 4; ++jj) { const int e = 4 * i + jj; const float G = g4[jj], e1 = __expf(G), e2 = __expf(-G), e3 = __expf(G - lw_[e]);
              const float ab = kh_[e] * aa_[e], kt = k_[e] * (1.f + (aa_[e] - 1.f) * cst[128 + pks * 16 + e]);
              av[e] = kh_[e] * e3; bv[e] = ab * e2; cv[e] = kt * e2; qv[e] = r_[e] * e1; } }
          bf16_t* Ap = (bf16_t*)(scb + O_A) + pt * 68 + pks * 16; bf16_t* Qp = (bf16_t*)(scb + O_Q) + pt * 68 + pks * 16;
          bf16_t* Bp = (bf16_t*)(scb + O_NB) + pt * 68 + pks * 16; bf16_t* Cp = (bf16_t*)(scb + O_C) + pt * 68 + pks * 16;
#pragma unroll
          for (int i = 0; i < 4; ++i) { u32x2 w; w[0] = pack2(av[4 * i], av[4 * i + 1]); w[1] = pack2(av[4 * i + 2], av[4 * i + 3]); *(u32x2*)(Ap + 4 * i) = w;
            w[0] = pack2(qv[4 * i], qv[4 * i + 1]); w[1] = pack2(qv[4 * i + 2], qv[4 * i + 3]); *(u32x2*)(Qp + 4 * i) = w;
            w[0] = pack2(-bv[4 * i], -bv[4 * i + 1]); w[1] = pack2(-bv[4 * i + 2], -bv[4 * i + 3]); *(u32x2*)(Bp + 4 * i) = w;
            w[0] = pack2(cv[4 * i], cv[4 * i + 1]); w[1] = pack2(cv[4 * i + 2], cv[4 * i + 3]); *(u32x2*)(Cp + 4 * i) = w; } }
        asm volatile("s_waitcnt lgkmcnt(0)" ::: "memory"); __builtin_amdgcn_wave_barrier();
        if (c + 2 < 36) RC_LOAD(c + 2);
        {
          f32x4 mBA = {0.f, 0.f, 0.f, 0.f}, mCA = mBA, mBQ = mBA, mCQ = mBA;
#pragma unroll
          for (int ks = 0; ks < 2; ++ks) { const int ko = fr * 68 + ks * 32 + fq * 8;
            const bf16_t* bp = (const bf16_t*)(scb + O_NB) + ko; const bf16_t* cp = (const bf16_t*)(scb + O_C) + ko;   const bf16_t* ap = (const bf16_t*)(scb + O_A) + ko; const bf16_t* qp = (const bf16_t*)(scb + O_Q) + ko;
            const bf16x8 fb = ld_frag8x2(bp, bp + 4), fc = ld_frag8x2(cp, cp + 4), fa = ld_frag8x2(ap, ap + 4), fqv = ld_frag8x2(qp, qp + 4);
            mBA = __builtin_amdgcn_mfma_f32_16x16x32_bf16(fb, fa, mBA, 0, 0, 0); mCA = __builtin_amdgcn_mfma_f32_16x16x32_bf16(fc, fa, mCA, 0, 0, 0);
            mBQ = __builtin_amdgcn_mfma_f32_16x16x32_bf16(fb, fqv, mBQ, 0, 0, 0); mCQ = __builtin_amdgcn_mfma_f32_16x16x32_bf16(fc, fqv, mCQ, 0, 0, 0); }
          float* M2 = (float*)(prv + P_M2); float m1[4], u1[4], u2[4];
#pragma unroll
          for (int j = 0; j < 4; ++j) { const int s_ = 4 * fq + j; M2[s_ * 16 + fr] = s_ < fr ? -mBA[j] : 0.f; m1[j] = s_ < fr ? mCA[j] : 0.f; u1[j] = s_ <= fr ? mCQ[j] : 0.f; u2[j] = s_ <= fr ? mBQ[j] : 0.f; }
          u32x2 w; w[0] = pack2(m1[0], m1[1]); w[1] = pack2(m1[2], m1[3]); *(u32x2*)((bf16_t*)(scb + O_M1T) + fr * 16 + 4 * fq) = w;
          w[0] = pack2(u1[0], u1[1]); w[1] = pack2(u1[2], u1[3]); *(u32x2*)((bf16_t*)(scb + O_U1T) + fr * 16 + 4 * fq) = w;
          w[0] = pack2(u2[0], u2[1]); w[1] = pack2(u2[2], u2[3]); *(u32x2*)((bf16_t*)(scb + O_NU2T) + fr * 16 + 4 * fq) = w; }
        asm volatile("s_waitcnt lgkmcnt(0)" ::: "memory"); __builtin_amdgcn_wave_barrier();
        {
          const float* M2 = (const float*)(prv + P_M2); float Tc[16];
#pragma unroll
          for (int s_ = 15; s_ >= 0; --s_) { float x0 = (fr == s_) ? 1.f : 0.f, x1 = 0.f;
#pragma unroll
            for (int j = s_ + 1; j < 16; ++j) { if (j & 1) x1 -= M2[s_ * 16 + j] * Tc[j]; else x0 -= M2[s_ * 16 + j] * Tc[j]; }
            Tc[s_] = x0 + x1; }
          if (fq == 0) { bf16_t* TT = (bf16_t*)(scb + O_TT) + fr * 16; *(u32x4*)TT = pack8(Tc); *(u32x4*)(TT + 8) = pack8(Tc + 8); } }
      }
    } else if (c >= 0) {
      const int v0 = wid * 16;
      const int bt = lane >> 2, bks = lane & 3, brow = rw_rowof(dir, b, c * 64 + wid * 16 + bt);
      u32x4 b_r0, b_r1, b_k0, b_k1, b_a0, b_a1;
      { int bc = h6 * 64 + bks * 16; asm volatile("" : "+v"(bc)); const size_t bo = (size_t)brow * 384 + bc; const bf16_t* blo = WS(bf16_t, OFF_LORA) + (size_t)brow * 1920 + dir * 384 + bc + 768;
        b_r0 = ld8g(WS(bf16_t, OFF_RB) + bo); b_r1 = ld8g(WS(bf16_t, OFF_RB) + bo + 8); b_k0 = ld8g(WS(bf16_t, OFF_KB) + bo); b_k1 = ld8g(WS(bf16_t, OFF_KB) + bo + 8); b_a0 = ld8g(blo); b_a1 = ld8g(blo + 8); }
      f32x4 cvv[8]; int cm = (u * 4 + wid) * 36 + c; asm volatile("" : "+v"(cm));
      { const int ce = (cm & 8191) * 2 + (lane >> 5); const float* csrc = p.in[(cm >> 13) ? I_PV : I_PU] + ((size_t)l * 16384 + ce) * 1024 + (lane & 31) * 32;
#pragma unroll
        for (int i = 0; i < 8; ++i) cvv[i] = *(const f32x4*)(csrc + i * 4); }
#pragma unroll 1
      for (int j = 0; j < 4; ++j) { const unsigned char* scb = lds + (c & 1) * CHB + j * SCB;
        bf16x8 sb[2];
#pragma unroll
        for (int ks = 0; ks < 2; ++ks) sb[ks] = frag2(acc2bf(sacc[2 * ks]), acc2bf(sacc[2 * ks + 1]));
        const unsigned trl = (unsigned)(uintptr_t)scb + (unsigned)((4 * fq + (fr >> 2)) * 136 + (fr & 3) * 8);
        const bf16x8 vt = frag_lo(tr_read<0>(trl + O_V + v0 * 2));
        const bf16_t* Ar = (const bf16_t*)(scb + O_A) + fr * 68 + 4 * fq; const bf16_t* Qr = (const bf16_t*)(scb + O_Q) + fr * 68 + 4 * fq;
        f32x4 racc = {0.f, 0.f, 0.f, 0.f}, yacc = racc;
#pragma unroll
        for (int ks = 0; ks < 2; ++ks) { racc = __builtin_amdgcn_mfma_f32_16x16x32_bf16(ld_frag8x2(Ar + 32 * ks, Ar + 32 * ks + 16), sb[ks], racc, 0, 0, 0);
          yacc = __builtin_amdgcn_mfma_f32_16x16x32_bf16(ld_frag8x2(Qr + 32 * ks, Qr + 32 * ks + 16), sb[ks], yacc, 0, 0, 0); }
        racc = __builtin_amdgcn_mfma_f32_16x16x32_bf16(frag_lo(*(const u32x2*)((const bf16_t*)(scb + O_M1T) + fr * 16 + 4 * fq)), vt, racc, 0, 0, 0);
        yacc = __builtin_amdgcn_mfma_f32_16x16x32_bf16(frag_lo(*(const u32x2*)((const bf16_t*)(scb + O_U1T) + fr * 16 + 4 * fq)), vt, yacc, 0, 0, 0);
        f32x4 zacc = {0.f, 0.f, 0.f, 0.f};
        zacc = __builtin_amdgcn_mfma_f32_16x16x32_bf16(frag_lo(*(const u32x2*)((const bf16_t*)(scb + O_TT) + fr * 16 + 4 * fq)), frag_lo(acc2bf(racc)), zacc, 0, 0, 0);
        const bf16x8 zf = frag_lo(acc2bf(zacc));
        yacc = __builtin_amdgcn_mfma_f32_16x16x32_bf16(frag_lo(*(const u32x2*)((const bf16_t*)(scb + O_NU2T) + fr * 16 + 4 * fq)), zf, yacc, 0, 0, 0);
        const float* gam = (const float*)(scb + O_GAM);
#pragma unroll
        for (int kt = 0; kt < 4; ++kt) {
          sacc[kt] = __builtin_amdgcn_mfma_f32_16x16x32_bf16(frag_lo(tr_read<0>(trl + O_C + kt * 32)), vt, sacc[kt], 0, 0, 0);
          sacc[kt] = __builtin_amdgcn_mfma_f32_16x16x32_bf16(frag_lo(tr_read<0>(trl + O_NB + kt * 32)), zf, sacc[kt], 0, 0, 0);
          sacc[kt] *= *(const f32x4*)(gam + kt * 16 + 4 * fq); }
#pragma unroll
        for (int jj = 0; jj < 4; ++jj) { const int row = rw_rowof(dir, b, c * 64 + j * 16 + 4 * fq + jj);
          WS(bf16_t, OFF_RWY)[((size_t)dir * NTOK + row) * 384 + h6 * 64 + v0 + fr] = f2bf(yacc[jj]); } }
      { float r_[16], k_[16], a_[16]; unpack8(b_r0, r_); unpack8(b_r1, r_ + 8); unpack8(b_k0, k_); unpack8(b_k1, k_ + 8); unpack8(b_a0, a_); unpack8(b_a1, a_ + 8);
        float s = 0.f;
#pragma unroll
        for (int i = 0; i < 16; ++i) { const int col = bks * 16 + i; const float a = sigmoidf_(cst[64 + col] + a_[i]); s += r_[i] * cst[192 + col] * (k_[i] * (1.f + (a - 1.f) * cst[128 + col])); }
        s += dppf<0xB1>(s); s += dppf<0x4E>(s);
        if (bks == 0) WS(float, OFF_BS)[((size_t)dir * NTOK + brow) * 6 + h6] = s; }
      { const int tb = cm >> 13, ce = (cm & 8191) * 2 + (lane >> 5), cseg = lane & 31; const float scl = tb ? 4.f : 64.f;
        unsigned char* dst = WS(unsigned char, tb ? OFF_TABV : OFF_TABU) + ((size_t)(cseg >> 3) * 16384 + ce) * 128 + (cseg & 7) * 16;
        u32x4 w0;
#pragma unroll
        for (int i = 0; i < 4; ++i) { const f32x4 a = cvv[2 * i] * scl, b2 = cvv[2 * i + 1] * scl; unsigned w = 0u;
          w = __builtin_amdgcn_cvt_scalef32_pk_fp4_f32(w, a[0], a[1], 1.0f, 0); w = __builtin_amdgcn_cvt_scalef32_pk_fp4_f32(w, a[2], a[3], 1.0f, 1);
          w = __builtin_amdgcn_cvt_scalef32_pk_fp4_f32(w, b2[0], b2[1], 1.0f, 2); w = __builtin_amdgcn_cvt_scalef32_pk_fp4_f32(w, b2[2], b2[3], 1.0f, 3);
          w0[i] = w; }
        *(u32x4*)dst = w0; }
    }
    __syncthreads();
  }
#undef RC_LOAD
}

DEV void attn_unit(CParams& p, int u, unsigned char* lds) {
  int b, head, qrow0, ntile; const bool lat = u < 384;
  if (lat) { b = u / 48; const int r = u % 48; head = r / 8; const int qb = r % 8; qrow0 = NCTXR + b * 2048 + qb * 256; ntile = 36; }
  else { const int v = u - 384; b = v / 6; head = v % 6; qrow0 = b * 256; ntile = 4; }
  const int tid = TIDX(), lane = tid & 63, wid = tid >> 6, r32 = lane & 31, hi = lane >> 5;
  constexpr int KROW = 208, VROW = 192, KT_B = 64 * KROW, VT_B = 64 * VROW, BUF_B = KT_B + VT_B;
  const bf16_t* KVp = WS(bf16_t, OFF_KV) + head * 128; const bf16_t* KRp = WS(bf16_t, OFF_KR);
  const int k0key = tid / 12, k0part = tid % 12, k1key = (tid + 512) / 12, k1part = (tid + 512) % 12, vkey = tid >> 3, vpart = tid & 7;
  u32x4 skA0, skA1 = {0u, 0u, 0u, 0u}, svA, skB0, skB1 = {0u, 0u, 0u, 0u}, svB;
#define AT_ROW0(kt) (lat ? ((kt) < 32 ? NCTXR + b * 2048 + (kt) * 64 : b * 256 + ((kt) - 32) * 64) : b * 256 + (kt) * 64)
#define AT_LOAD(kt, sk0, sk1, sv) do { const int r0_ = AT_ROW0(kt); \
    sk0 = k0part < 8 ? ld8g(KVp + (size_t)(r0_ + k0key) * 768 + k0part * 8) : ld8g(KRp + (size_t)(r0_ + k0key) * 32 + (k0part - 8) * 8); \
    if (tid < 256) sk1 = k1part < 8 ? ld8g(KVp + (size_t)(r0_ + k1key) * 768 + k1part * 8) : ld8g(KRp + (size_t)(r0_ + k1key) * 32 + (k1part - 8) * 8); \
    sv = ld8g(KVp + (size_t)(r0_ + vkey) * 768 + 64 + vpart * 8); } while (0)
#define AT_WRITE(bi, sk0, sk1, sv) do { unsigned char* bb = lds + (bi) * BUF_B; *(u32x4*)(bb + k0key * KROW + k0part * 16) = sk0; \
    if (tid < 256) *(u32x4*)(bb + k1key * KROW + k1part * 16) = sk1; *(u32x4*)(bb + KT_B + vkey * VROW + vpart * 16) = sv; } while (0)
  const unsigned trb = (unsigned)(uintptr_t)lds + KT_B + ((4 * (lane >> 5) + ((lane & 15) >> 2)) * VROW + (16 * ((lane >> 4) & 1) + 4 * (lane & 3)) * 2);
  f32x16 o0, o1;
#pragma unroll
  for (int i = 0; i < 16; ++i) { o0[i] = 0.f; o1[i] = 0.f; }
  float m_run = -1e30f, l_run = 0.f;
  AT_LOAD(0, skA0, skA1, svA); AT_LOAD(1, skB0, skB1, svB);
  const int qrow = qrow0 + wid * 32 + r32;
  bf16x8 qf[6];
  { const bf16_t* qp = WS(bf16_t, OFF_QB) + (size_t)qrow * 576 + head * 96 + hi * 8;
    const float SC = 0.10206207262f * 1.44269504089f;
    const int t = lat ? ((qrow - NCTXR) & 2047) : 0;
#pragma unroll
    for (int ks = 0; ks < 6; ++ks) { float f[8]; unpack8(ld8g(qp + ks * 16), f);
      if (ks >= 4) { float pt[8];
#pragma unroll
        for (int j = 0; j < 8; ++j) { auto rr = __builtin_amdgcn_permlane32_swap(__float_as_uint(f[j]), __float_as_uint(f[j]), false, false); pt[j] = __uint_as_float(hi ? rr[0] : rr[1]); }
        if (lat) { const int pos = ks == 4 ? (t >> 6) : (t & 63);
#pragma unroll
          for (int j = 0; j < 8; ++j) { const float invf = __expf(-(float)j * (9.210340372f / 8.f)); float rev = (float)pos * invf * 0.15915494309f; rev -= floorf(rev);
            const float sn = __builtin_amdgcn_sinf(rev), cs = __builtin_amdgcn_cosf(rev);
            f[j] = hi ? f[j] * cs + pt[j] * sn : f[j] * cs - pt[j] * sn; } } }
#pragma unroll
      for (int j = 0; j < 8; ++j) f[j] *= SC;
      qf[ks] = __builtin_bit_cast(bf16x8, pack8(f)); } }
  __syncthreads();
  AT_WRITE(0, skA0, skA1, svA); AT_WRITE(1, skB0, skB1, svB);
  if (2 < ntile) AT_LOAD(2, skA0, skA1, svA);
  if (3 < ntile) AT_LOAD(3, skB0, skB1, svB);
  __syncthreads();
  f32x16 sa0, sa1, sb0, sb1;
#define AT_KF(kb_, ks) *(const bf16x8*)((kb_) + r32 * KROW + ((ks) * 16 + hi * 8) * 2), *(const bf16x8*)((kb_) + (32 + r32) * KROW + ((ks) * 16 + hi * 8) * 2)
  { const unsigned char* kb = lds;
#pragma unroll
    for (int i = 0; i < 16; ++i) { sa0[i] = 0.f; sa1[i] = 0.f; }
#pragma unroll
    for (int ks = 0; ks < 6; ++ks) { const bf16x8 a0 = *(const bf16x8*)(kb + r32 * KROW + (ks * 16 + hi * 8) * 2), a1 = *(const bf16x8*)(kb + (32 + r32) * KROW + (ks * 16 + hi * 8) * 2);
      sa0 = __builtin_amdgcn_mfma_f32_32x32x16_bf16(a0, qf[ks], sa0, 0, 0, 0); sa1 = __builtin_amdgcn_mfma_f32_32x32x16_bf16(a1, qf[ks], sa1, 0, 0, 0); } }
  auto step = [&](f32x16& c0, f32x16& c1, f32x16& n0, f32x16& n1, const int bufv, const int bufk) {
    const unsigned char* kb = lds + bufk * BUF_B;
    const unsigned ta = trb + (unsigned)(bufv * BUF_B);
#define TR(st, rd, eb) tr_read<(st) * 16 * VROW + (rd) * 8 * VROW + (eb) * 64>(ta)
    const u32x2 t00 = TR(0, 0, 0), t01 = TR(0, 1, 0), t10 = TR(1, 0, 0), t11 = TR(1, 1, 0), t20 = TR(2, 0, 0), t21 = TR(2, 1, 0), t30 = TR(3, 0, 0), t31 = TR(3, 1, 0);
    const u32x2 u00 = TR(0, 0, 1), u01 = TR(0, 1, 1), u10 = TR(1, 0, 1), u11 = TR(1, 1, 1), u20 = TR(2, 0, 1), u21 = TR(2, 1, 1), u30 = TR(3, 0, 1), u31 = TR(3, 1, 1);
#undef TR
#define QKA(ks) do { const bf16x8 a0_ = *(const bf16x8*)(kb + r32 * KROW + ((ks) * 16 + hi * 8) * 2); n0 = __builtin_amdgcn_mfma_f32_32x32x16_bf16(a0_, qf[ks], n0, 0, 0, 0); __builtin_amdgcn_sched_barrier(0); } while (0)
#define QKB(ks) do { const bf16x8 a1_ = *(const bf16x8*)(kb + (32 + r32) * KROW + ((ks) * 16 + hi * 8) * 2); n1 = __builtin_amdgcn_mfma_f32_32x32x16_bf16(a1_, qf[ks], n1, 0, 0, 0); __builtin_amdgcn_sched_barrier(0); } while (0)
#define FENCE __builtin_amdgcn_sched_barrier(0)
#pragma unroll
    for (int i = 0; i < 16; ++i) { n0[i] = 0.f; n1[i] = 0.f; }
    QKA(0);
    float mx = fmaxf(fmaxf(c0[0], c0[1]), c0[2]);
#pragma unroll
    for (int i = 3; i < 7; i += 2) mx = fmaxf(fmaxf(mx, c0[i]), c0[i + 1]);
    FENCE; QKB(0);
#pragma unroll
    for (int i = 7; i < 15; i += 2) mx = fmaxf(fmaxf(mx, c0[i]), c0[i + 1]);
    mx = fmaxf(fmaxf(mx, c0[15]), c1[0]);
    FENCE; QKA(1);
#pragma unroll
    for (int i = 1; i < 9; i += 2) mx = fmaxf(fmaxf(mx, c1[i]), c1[i + 1]);
    FENCE; QKB(1);
#pragma unroll
    for (int i = 9; i < 15; i += 2) mx = fmaxf(fmaxf(mx, c1[i]), c1[i + 1]);
    mx = fmaxf(mx, c1[15]);
    mx = xhalf_max(mx);
    if (__builtin_amdgcn_ballot_w64(mx > m_run + 8.f) != 0ull) {
      const float mnew = fmaxf(m_run, mx), alpha = __builtin_amdgcn_exp2f(m_run - mnew); const f32x2 al2 = {alpha, alpha};
      m_run = mnew; l_run *= alpha;
#pragma unroll
      for (int i = 0; i < 8; ++i) { f32x2 a = {o0[2 * i], o0[2 * i + 1]}, b2 = {o1[2 * i], o1[2 * i + 1]}; a *= al2; b2 *= al2; o0[2 * i] = a[0]; o0[2 * i + 1] = a[1]; o1[2 * i] = b2[0]; o1[2 * i + 1] = b2[1]; } }
    const f32x2 mm = {m_run, m_run}; f32x2 ps2 = {0.f, 0.f};
    u32x4 pw[4];
#define SMXH(cc, base, pi, h) do { _Pragma("unroll") for (int i_ = 2 * (h); i_ < 2 * (h) + 2; ++i_) { f32x2 a_ = {cc[base + 2 * i_], cc[base + 2 * i_ + 1]}; a_ -= mm; \
        a_[0] = __builtin_amdgcn_exp2f(a_[0]); a_[1] = __builtin_amdgcn_exp2f(a_[1]); ps2 += a_; pw[pi][i_] = pack2(a_[0], a_[1]); } } while (0)
    FENCE;
    QKA(2); SMXH(c0, 0, 0, 0); FENCE; QKB(2); SMXH(c0, 0, 0, 1); FENCE;
    QKA(3); SMXH(c0, 8, 1, 0); FENCE; QKB(3); SMXH(c0, 8, 1, 1); FENCE;
    QKA(4); SMXH(c1, 0, 2, 0); FENCE; QKB(4); SMXH(c1, 0, 2, 1); FENCE;
    QKA(5); SMXH(c1, 8, 3, 0); FENCE; QKB(5); SMXH(c1, 8, 3, 1);
    l_run += ps2[0] + ps2[1];
    bf16x8 pf[4];
#pragma unroll
    for (int i = 0; i < 4; ++i) pf[i] = __builtin_bit_cast(bf16x8, pw[i]);
#undef SMXH
#undef QKA
#undef QKB
#undef FENCE
    __builtin_amdgcn_sched_barrier(0);
#define VF(lo, hi_) __builtin_bit_cast(bf16x8, (u32x4){lo[0], lo[1], hi_[0], hi_[1]})
    o0 = __builtin_amdgcn_mfma_f32_32x32x16_bf16(VF(t00, t01), pf[0], o0, 0, 0, 0); o1 = __builtin_amdgcn_mfma_f32_32x32x16_bf16(VF(u00, u01), pf[0], o1, 0, 0, 0);
    o0 = __builtin_amdgcn_mfma_f32_32x32x16_bf16(VF(t10, t11), pf[1], o0, 0, 0, 0); o1 = __builtin_amdgcn_mfma_f32_32x32x16_bf16(VF(u10, u11), pf[1], o1, 0, 0, 0);
    o0 = __builtin_amdgcn_mfma_f32_32x32x16_bf16(VF(t20, t21), pf[2], o0, 0, 0, 0); o1 = __builtin_amdgcn_mfma_f32_32x32x16_bf16(VF(u20, u21), pf[2], o1, 0, 0, 0);
    o0 = __builtin_amdgcn_mfma_f32_32x32x16_bf16(VF(t30, t31), pf[3], o0, 0, 0, 0); o1 = __builtin_amdgcn_mfma_f32_32x32x16_bf16(VF(u30, u31), pf[3], o1, 0, 0, 0);
#undef VF
  };
  int bv = 0;
#pragma unroll 1
  for (int kt = 0; kt < ntile; kt += 2) {
    { const int b1 = bv == 2 ? 0 : bv + 1, b2 = b1 == 2 ? 0 : b1 + 1;
      __syncthreads();
      if (kt + 2 < ntile) { AT_WRITE(b2, skA0, skA1, svA); if (kt + 4 < ntile) AT_LOAD(kt + 4, skA0, skA1, svA); }
      step(sa0, sa1, sb0, sb1, bv, b1);
      bv = b1; }
    { const int b1 = bv == 2 ? 0 : bv + 1, b2 = b1 == 2 ? 0 : b1 + 1;
      __syncthreads();
      if (kt + 3 < ntile) { AT_WRITE(b2, skB0, skB1, svB); if (kt + 5 < ntile) AT_LOAD(kt + 5, skB0, skB1, svB); }
      step(sb0, sb1, sa0, sa1, bv, b1);
      bv = b1; }
  }
#undef AT_KF
#undef AT_LOAD
#undef AT_WRITE
#undef AT_ROW0
  const float inv = 1.f / xhalf_sum(l_run);
  bf16_t* op = WS(bf16_t, OFF_H) + (size_t)qrow * 1024 + 640 + head * 64;
#pragma unroll
  for (int k = 0; k < 4; ++k) { const int g = 2 * (k & 1); u32x2 wa, wb;
    if (k < 2) { wa[0] = pack2(o0[4 * g] * inv, o0[4 * g + 1] * inv); wa[1] = pack2(o0[4 * g + 2] * inv, o0[4 * g + 3] * inv); wb[0] = pack2(o0[4 * g + 4] * inv, o0[4 * g + 5] * inv); wb[1] = pack2(o0[4 * g + 6] * inv, o0[4 * g + 7] * inv); }
    else { wa[0] = pack2(o1[4 * g] * inv, o1[4 * g + 1] * inv); wa[1] = pack2(o1[4 * g + 2] * inv, o1[4 * g + 3] * inv); wb[0] = pack2(o1[4 * g + 4] * inv, o1[4 * g + 5] * inv); wb[1] = pack2(o1[4 * g + 6] * inv, o1[4 * g + 7] * inv); }
    const auto s0 = __builtin_amdgcn_permlane32_swap(wa[0], wb[0], false, false), s1 = __builtin_amdgcn_permlane32_swap(wa[1], wb[1], false, false);
    *(u32x4*)(op + (k < 2 ? 0 : 32) + 8 * g + 8 * hi) = (u32x4){(unsigned)s0[0], (unsigned)s1[0], (unsigned)s0[1], (unsigned)s1[1]}; }
}

struct MlRegs { u32x4 q, k, v, c0a, c0b, c1a, c1b; float li, lf, ms; u32x2 og0, og1; };
DEV void ml_load(CParams& p, int chunk, int hd, MlRegs& r) {
  const ChunkInfo c = chunk_info(chunk); const int tid = TIDX(), lane = tid & 63, t = tid >> 3, seg = tid & 7;
  r.q = ld8g(WS(bf16_t, OFF_MQ) + (size_t)(c.row0 + t) * 256 + hd * 64 + seg * 8);
  r.k = ld8g(WS(bf16_t, OFF_MK) + (size_t)(c.row0 + t) * 256 + hd * 64 + seg * 8);
  r.v = ld8g(WS(bf16_t, OFF_MVT) + ((size_t)(chunk * 4 + hd) * 64 + t) * 64 + seg * 8);
  { const int chain = c.b * 4 + hd, pc = ml_pc(c, 0); const bf16_t* st = WS(bf16_t, OFF_ST) + (size_t)(chain * 36 + pc) * 5120; r.c0a = ld8g(st + tid * 8); r.c0b = r.c0a; if (tid < 128) r.c0b = ld8g(st + (512 + tid) * 8); }
  { const int chain = 32 + c.b * 4 + hd, pc = ml_pc(c, 1); const bf16_t* st = WS(bf16_t, OFF_ST) + (size_t)(chain * 36 + pc) * 5120; r.c1a = ld8g(st + tid * 8); r.c1b = r.c1a; if (tid < 128) r.c1b = ld8g(st + (512 + tid) * 8); }
  { const int wid = tid >> 6, fr = lane & 15, fq = lane >> 4, t2 = (wid & 3) * 16 + fr, et0 = (wid >> 2) * 2; const bf16_t* mo = WS(bf16_t, OFF_MO) + (size_t)(c.row0 + t2) * 256 + hd * 64 + fq * 4;
    r.og0 = *(const u32x2*)(mo + et0 * 16); r.og1 = *(const u32x2*)(mo + (et0 + 1) * 16); }
  r.li = 0.f; r.lf = 0.f; r.ms = 0.f;
  if (tid < 128) { const int dir = tid >> 6, tt_ = dir ? 63 - lane : lane, row = c.row0 + tt_; const int chain = dir * 32 + c.b * 4 + hd, pc = ml_pc(c, dir);
    r.li = WS(float, OFF_GLI)[(size_t)(dir * 4 + hd) * NTOK + row]; r.lf = WS(float, OFF_GLF)[(size_t)(dir * 4 + hd) * NTOK + row]; r.ms = WS(float, OFF_SCMB)[chain * 36 + pc]; }
}
DEV void mlstm_out_unit(CParams& p, int l, int chunk, int hd, unsigned char* lds, const MlRegs& r) {
  const ChunkInfo c = chunk_info(chunk);
  bf16_t* Ql = (bf16_t*)lds;
  bf16_t* Kl = (bf16_t*)(lds + 9216);
  bf16_t* VTl = (bf16_t*)(lds + 18432);
  bf16_t* Cl = (bf16_t*)(lds + 18432 + 10880);
  float* sc = (float*)(lds + 18432 + 10880 + 23040);
  float* rowterm = sc; float* uarr = sc + 128; float* winter = sc + 256; float* emt = sc + 384; float* lnred = sc + 512;
  const int tid = TIDX(), lane = tid & 63, wid = tid >> 6, fr = lane & 15, fq = lane >> 4;
  __syncthreads();
  { const int t = tid >> 3, seg = tid & 7;
    *(u32x4*)(Ql + t * 72 + seg * 8) = r.q;
    *(u32x4*)(Kl + t * 72 + seg * 8) = r.k;
    const u32x4 vv = r.v;
    u32x2 a, b2; a[0] = vv[0]; a[1] = vv[1]; b2[0] = vv[2]; b2[1] = vv[3]; *(u32x2*)(VTl + t * 68 + seg * 8) = a; *(u32x2*)(VTl + t * 68 + seg * 8 + 4) = b2;
    if (tid < 64) VTl[64 * 68 + tid] = (bf16_t)0x3F80u;
    for (int i = tid; i < 15 * 68; i += NTHREADS) VTl[65 * 68 + i] = 0;
    *(u32x4*)(Cl + (tid >> 3) * 72 + (tid & 7) * 8) = r.c0a; if (tid < 128) *(u32x4*)(Cl + ((512 + tid) >> 3) * 72 + (tid & 7) * 8) = r.c0b;
    *(u32x4*)(Cl + 80 * 72 + (tid >> 3) * 72 + (tid & 7) * 8) = r.c1a; if (tid < 128) *(u32x4*)(Cl + 80 * 72 + ((512 + tid) >> 3) * 72 + (tid & 7) * 8) = r.c1b; }
  if (tid < 128) { const int dir = tid >> 6, t = dir ? 63 - lane : lane;
    const float li = r.li, lf = r.lf, ms = r.ms;
    const float bc = scan_sum64(lf, lane);
    const float uu = li - bc; const float pm = scan_max64(uu, lane);
    const float mt = fmaxf(bc + ms, bc + pm);
    rowterm[dir * 64 + t] = bc - mt; uarr[dir * 64 + t] = uu; winter[dir * 64 + t] = __expf(bc + ms - mt); emt[dir * 64 + t] = __expf(-mt); }
  __syncthreads();
  const int tt = wid & 3, eh = wid >> 2, t = tt * 16 + fr;
  bf16x8 qfr[2];
#pragma unroll
  for (int ks = 0; ks < 2; ++ks) qfr[ks] = ld_frag16(Ql + t * 72 + ks * 32 + fq * 8);
  f32x4 g[4];
#pragma unroll
  for (int st = 0; st < 4; ++st) { g[st] = (f32x4){0.f, 0.f, 0.f, 0.f};
#pragma unroll
    for (int ks = 0; ks < 2; ++ks) g[st] = __builtin_amdgcn_mfma_f32_16x16x32_bf16(ld_frag16(Kl + (st * 16 + fr) * 72 + ks * 32 + fq * 8), qfr[ks], g[st], 0, 0, 0); }
  const int et0 = eh * 2;
  float hsum[2][4];
#pragma unroll
  for (int a = 0; a < 2; ++a)
#pragma unroll
    for (int j = 0; j < 4; ++j) hsum[a][j] = 0.f;
#pragma unroll
  for (int dir = 0; dir < 2; ++dir) {
    const float rt = rowterm[dir * 64 + t], wi = winter[dir * 64 + t], em = emt[dir * 64 + t];
    bf16x8 pf[2];
#pragma unroll
    for (int kk = 0; kk < 2; ++kk) { float v[8];
#pragma unroll
      for (int hh = 0; hh < 2; ++hh)
#pragma unroll
        for (int j = 0; j < 4; ++j) { const int s = (2 * kk + hh) * 16 + fq * 4 + j; const bool valid = dir ? (s >= t) : (s <= t);
          const float e = __expf(rt + uarr[dir * 64 + s]); v[hh * 4 + j] = valid ? g[2 * kk + hh][j] * e : 0.f; }
      pf[kk] = __builtin_bit_cast(bf16x8, pack8(v)); }
    f32x4 acc[3];
#pragma unroll
    for (int a = 0; a < 3; ++a) { const int et = a < 2 ? et0 + a : 4; const bf16_t* crow = Cl + dir * 80 * 72 + (et * 16 + fr) * 72;
      f32x4 x = {0.f, 0.f, 0.f, 0.f};
#pragma unroll
      for (int ks = 0; ks < 2; ++ks) x = __builtin_amdgcn_mfma_f32_16x16x32_bf16(ld_frag16(crow + ks * 32 + fq * 8), qfr[ks], x, 0, 0, 0);
      x *= wi;
      const bf16_t* vrow = VTl + (et * 16 + fr) * 68;
#pragma unroll
      for (int kk = 0; kk < 2; ++kk) x = __builtin_amdgcn_mfma_f32_16x16x32_bf16(ld_frag8x2(vrow + 32 * kk + fq * 4, vrow + 32 * kk + 16 + fq * 4), pf[kk], x, 0, 0, 0);
      acc[a] = x; }
    const float den = bperm(fr, acc[2][0]);
    const float dinv = 1.f / fmaxf(fabsf(den), em);
#pragma unroll
    for (int a = 0; a < 2; ++a)
#pragma unroll
      for (int j = 0; j < 4; ++j) hsum[a][j] += acc[a][j] * dinv;
  }
  float s1 = 0.f, s2 = 0.f;
#pragma unroll
  for (int a = 0; a < 2; ++a)
#pragma unroll
    for (int j = 0; j < 4; ++j) { s1 += hsum[a][j]; s2 += hsum[a][j] * hsum[a][j]; }
  s1 += bperm(lane ^ 16, s1); s1 += bperm(lane ^ 32, s1); s2 += bperm(lane ^ 16, s2); s2 += bperm(lane ^ 32, s2);
  if (fq == 0) { lnred[(eh * 64 + t) * 2] = s1; lnred[(eh * 64 + t) * 2 + 1] = s2; }
  __syncthreads();
  { const float a1 = lnred[t * 2] + lnred[(64 + t) * 2], a2 = lnred[t * 2 + 1] + lnred[(64 + t) * 2 + 1];
    const float mean = a1 * (1.f / 64.f), var = fmaxf(a2 * (1.f / 64.f) - mean * mean, 0.f), rstd = rsqrtf(var + LN_EPS);
    const int row = c.row0 + t;
#pragma unroll
    for (int a = 0; a < 2; ++a) { const int e0 = (et0 + a) * 16 + fq * 4;
      const u32x2 ow = a == 0 ? r.og0 : r.og1;
      const float og[4] = {lo16(ow[0]), hi16(ow[0]), lo16(ow[1]), hi16(ow[1])};
      const f32x4 ng = *(const f32x4*)(p.in[I_MLNG] + l * 256 + hd * 64 + e0);
      float y[4];
#pragma unroll
      for (int j = 0; j < 4; ++j) y[j] = sigmoidf_(og[j]) * (hsum[a][j] - mean) * rstd * ng[j];
      u32x2 w; w[0] = pack2(y[0], y[1]); w[1] = pack2(y[2], y[3]);
      *(u32x2*)(WS(bf16_t, OFF_H) + (size_t)row * 1024 + hd * 64 + e0) = w; } }
}

DEV void ph_mix(CParams& p, int lx, unsigned char* lds) {
  const int l = lx & 1;
  constexpr int NRW = 96;
  const int n_att = l == 0 ? 432 : 384, n_ml = l == 0 ? 288 * 2 : 256 * 2, total = NRW + n_att + n_ml;
  unsigned* cnt = WS(unsigned, OFF_CNT) + 16 + lx; unsigned* slot = (unsigned*)(lds + LDS_BYTES - 16);
  __syncthreads();
  if (TIDX() == 0) *slot = atomicAdd(cnt, 1u);
  __syncthreads();
  int u = (int)*slot;
  while (u < total) {
    const bool look = u >= NRW; unsigned nxp = 0u;
    if (look && TIDX() == 0) nxp = atomicAdd(cnt, 1u);
    if (u < NRW) { for (int r_ = 0; r_ < RWREP; ++r_) rwkv_chunk_unit(p, l, u, lds); }
    else if (u < NRW + n_att) { for (int r_ = 0; r_ < ATREP; ++r_) attn_unit(p, u - NRW, lds); }
    else { const int v = u - NRW - n_att; const int chunk = (l == 0 ? 0 : 32) + (v >> 1), h0 = (v & 1) * 2;
      for (int r_ = 0; r_ < MLREP; ++r_) { MlRegs ra, rb; ml_load(p, chunk, h0, ra); ml_load(p, chunk, h0 + 1, rb); mlstm_out_unit(p, l, chunk, h0, lds, ra); mlstm_out_unit(p, l, chunk, h0 + 1, lds, rb); } }
    __syncthreads();
    if (TIDX() == 0) *slot = look ? nxp : atomicAdd(cnt, 1u);
    __syncthreads();
    u = (int)*slot;
  }
  __syncthreads();
}

DEV void ph_rwpost(CParams& p, int l) {
  const int tid = TIDX(), lane = tid & 63, gw = blockIdx.x * 8 + (tid >> 6), nw = gridDim.x * 8, sl = lane & 7;
  const int rowbase = l == 0 ? 0 : NCTXR, nitems = (NTOK - rowbase) * 6;
  u32x4 n_y0, n_y1, n_v, n_g; float n_b0, n_b1;
#define RWP_LOAD(it0_) do { const int it_ = (it0_) + (lane >> 3); const int row_ = rowbase + it_ / 6, h6_ = it_ % 6, col_ = h6_ * 64 + sl * 8; const size_t o_ = (size_t)row_ * 384 + col_; \
    n_y0 = ld8g(WS(bf16_t, OFF_RWY) + o_); n_y1 = ld8g(WS(bf16_t, OFF_RWY) + (size_t)NTOK * 384 + o_); n_v = ld8g(WS(bf16_t, OFF_VB) + o_); n_g = ld8g(WS(bf16_t, OFF_LORA) + (size_t)row_ * 1920 + col_ + 1536); \
    n_b0 = WS(float, OFF_BS)[(size_t)row_ * 6 + h6_]; n_b1 = WS(float, OFF_BS)[((size_t)NTOK + row_) * 6 + h6_]; } while (0)
  if (gw * 8 < nitems) RWP_LOAD(gw * 8);
#pragma unroll 1
  for (int it0 = gw * 8; it0 < nitems; it0 += nw * 8) { const int it = it0 + (lane >> 3); const int row = rowbase + it / 6, h6 = it % 6, col = h6 * 64 + sl * 8;
    const u32x4 wy0 = n_y0, wy1 = n_y1, wv = n_v, wg = n_g; const float bs = n_b0 + n_b1;
    if (it0 + nw * 8 < nitems) RWP_LOAD(it0 + nw * 8);
    float y[8], t1[8], t2[8];
    unpack8(wy0, y); unpack8(wy1, t1);
    float s = 0.f;
#pragma unroll
    for (int i = 0; i < 8; ++i) { y[i] += t1[i]; s += y[i]; }
    const float mean = grp8_sum(s) * (1.f / 64.f); float q = 0.f;
#pragma unroll
    for (int i = 0; i < 8; ++i) { y[i] -= mean; q += y[i] * y[i]; }
    const float rstd = rsqrtf(grp8_sum(q) * (1.f / 64.f) + 64e-5f);
    float v[8], g[8], o8[8]; unpack8(wv, v); unpack8(wg, g);
#pragma unroll
    for (int i = 0; i < 8; ++i) o8[i] = (y[i] * rstd * p.in[I_RWGNG][l * 384 + col + i] + p.in[I_RWGNB][l * 384 + col + i] + bs * v[i]) * g[i];
    *(u32x4*)(WS(bf16_t, OFF_H) + (size_t)row * 1024 + 256 + col) = pack8(o8); }
}
#undef RWP_LOAD

DEV void ph_gemm_in(CParams& p, int l, unsigned char* lds) {
  pg8::StaticOrder S; S.init(NTOK, NINP, gridDim.x, blockIdx.x);
  pg8::Gemm g{WS(bf16_t, OFF_H), WS(bf16_t, OFF_WIN) + (size_t)l * NINP * 1024, NTOK, NINP, 1024};
  EpiBf16 E{WS(bf16_t, OFF_P), NIN, NIN}; pg8::gemm_phase((LAS unsigned char*)lds, g, S, E);
}
DEV void gemm_out_rows(CParams& p, int l, int row0, int M, unsigned char* lds) {
  pg8::StaticOrder S; S.init(M, 1024, gridDim.x, blockIdx.x);
  pg8::Gemm g{WS(bf16_t, OFF_H) + (size_t)row0 * 1024, WS(bf16_t, OFF_WOUT) + (size_t)l * 1024 * 1024, M, 1024, 1024};
  EpiBf16 E{WS(bf16_t, OFF_Y) + (size_t)row0 * 1024, 1024, 1024}; pg8::gemm_phase((LAS unsigned char*)lds, g, S, E);
}
DEV void ph_gemm_out(CParams& p, int l, unsigned char* lds) { if (l == 0 && gridDim.x != 256) gemm_out_rows(p, 0, 0, NTOK, lds); else gemm_out_rows(p, l, NCTXR, NLAT, lds); }
DEV void ln1_rows(CParams& p, int l, int r0, int r1, unsigned char* lds);
DEV void ph_gemm_pq(CParams& p, int l, unsigned char* lds) {
  const bool split = l == 0 && gridDim.x == 256; const int rb = (l == 0 && !split) ? 0 : NCTXR, M = NTOK - rb;
  if (split) { ln1_rows(p, 0, (int)blockIdx.x * 8, (int)blockIdx.x * 8 + 8, lds); __syncthreads(); }
  pg8::StaticOrder S; S.init(M, 2048, gridDim.x, blockIdx.x);
  pg8::Gemm g{WS(bf16_t, OFF_H) + (size_t)rb * 1024, WS(bf16_t, OFF_WPQ) + (size_t)l * 2048 * 1024, M, 2048, 1024};
  EpiBf16 E{WS(bf16_t, OFF_QP) + (size_t)rb * 2048, 2048, 2048}; pg8::gemm_phase((LAS unsigned char*)lds, g, S, E);
}

DEV void stage_vec(float* dst, const float* src_) { const int tid = TIDX(); if (tid < 256) *(f32x4*)(dst + tid * 4) = *(const f32x4*)(src_ + tid * 4); }
DEV void ln1_rows(CParams& p, int l, int r0, int r1, unsigned char* lds) {
  const int tid = TIDX(), lane = tid & 63, wid = tid >> 6;
  float* pl = (float*)lds;
  for (int seg0 = r0; seg0 < r1;) { const int mr = modrow_of(seg0); int seg1 = mr == 8 ? NCTXR : NCTXR + (mr + 1) * 2048; if (seg1 > r1) seg1 = r1;
    const float* md = WS(float, OFF_MOD) + (size_t)(l * 9 + mr) * 6144;
    __syncthreads();
    if (tid < 256) { *(f32x4*)(pl + tid * 4) = *(const f32x4*)(md + 2048 + tid * 4); *(f32x4*)(pl + 1024 + tid * 4) = *(const f32x4*)(p.in[I_LNMG] + l * 1024 + tid * 4); *(f32x4*)(pl + 2048 + tid * 4) = *(const f32x4*)(p.in[I_LNMB] + l * 1024 + tid * 4); }
    else { const int t2 = tid - 256; *(f32x4*)(pl + 3072 + t2 * 4) = *(const f32x4*)(md + 4096 + t2 * 4); *(f32x4*)(pl + 4096 + t2 * 4) = *(const f32x4*)(md + 3072 + t2 * 4); }
    __syncthreads();
    u32x2 ny[4], nxh[4]; f32x4 nxf[4];
#define LN1_LOAD(r_) do { const float* xo_ = x_in_row(p, (r_)); const bf16_t* xc_ = WS(bf16_t, OFF_XC) + (size_t)(r_) * 1024; const bf16_t* yr_ = WS(bf16_t, OFF_Y) + (size_t)(r_) * 1024; \
      _Pragma("unroll") for (int i = 0; i < 4; ++i) { const int col = lane * 4 + 256 * i; ny[i] = *(const u32x2*)(yr_ + col); if (l == 0) nxf[i] = *(const f32x4*)(xo_ + col); else nxh[i] = *(const u32x2*)(xc_ + col); } } while (0)
    if (seg0 + wid < seg1) LN1_LOAD(seg0 + wid);
#pragma unroll 1
    for (int row = seg0 + wid; row < seg1; row += 8) {
      u32x2 cy[4], cxh[4]; f32x4 cxf[4];
#pragma unroll
      for (int i = 0; i < 4; ++i) { cy[i] = ny[i]; cxh[i] = nxh[i]; cxf[i] = nxf[i]; }
      if (row + 8 < seg1) LN1_LOAD(row + 8);
      f32x4 v[4]; float s = 0.f;
#pragma unroll
      for (int i = 0; i < 4; ++i) { const int col = lane * 4 + 256 * i; const u32x2 yw = cy[i]; const f32x4 yv = {lo16(yw[0]), hi16(yw[0]), lo16(yw[1]), hi16(yw[1])};
        f32x4 xv; if (l == 0) xv = cxf[i]; else { const u32x2 xw_ = cxh[i]; xv = (f32x4){lo16(xw_[0]), hi16(xw_[0]), lo16(xw_[1]), hi16(xw_[1])}; }
        v[i] = xv * ALPHA + *(const f32x4*)(pl + col) * yv; s += (v[i][0] + v[i][1]) + (v[i][2] + v[i][3]); }
      float mean = wave_sum(s) * (1.f / 1024.f), q = 0.f;
#pragma unroll
      for (int i = 0; i < 4; ++i) { v[i] -= mean; q += (v[i][0] * v[i][0] + v[i][1] * v[i][1]) + (v[i][2] * v[i][2] + v[i][3] * v[i][3]); }
      float rstd = rsqrtf(wave_sum(q) * (1.f / 1024.f) + LN_EPS);
      bf16_t* xw = WS(bf16_t, OFF_XC) + (size_t)row * 1024; s = 0.f;
#pragma unroll
      for (int i = 0; i < 4; ++i) { const int col = lane * 4 + 256 * i; v[i] = v[i] * rstd * *(const f32x4*)(pl + 1024 + col) + *(const f32x4*)(pl + 2048 + col);
        u32x2 wx; wx[0] = pack2(v[i][0], v[i][1]); wx[1] = pack2(v[i][2], v[i][3]); *(u32x2*)(xw + col) = wx;
        v[i] = (f32x4){lo16(wx[0]), hi16(wx[0]), lo16(wx[1]), hi16(wx[1])};
        s += (v[i][0] + v[i][1]) + (v[i][2] + v[i][3]); }
      mean = wave_sum(s) * (1.f / 1024.f); q = 0.f;
#pragma unroll
      for (int i = 0; i < 4; ++i) { v[i] -= mean; q += (v[i][0] * v[i][0] + v[i][1] * v[i][1]) + (v[i][2] * v[i][2] + v[i][3] * v[i][3]); }
      rstd = rsqrtf(wave_sum(q) * (1.f / 1024.f) + LN_EPS);
#pragma unroll
      for (int i = 0; i < 4; ++i) { const int col = lane * 4 + 256 * i; const f32x4 o = v[i] * rstd * (*(const f32x4*)(pl + 3072 + col) + 1.f) + *(const f32x4*)(pl + 4096 + col);
        u32x2 w; w[0] = pack2(o[0], o[1]); w[1] = pack2(o[2], o[3]); *(u32x2*)(WS(bf16_t, OFF_H) + (size_t)row * 1024 + col) = w; }
    }
    seg0 = seg1; }
#undef LN1_LOAD
  __syncthreads();
}

DEV void ph_ln1(CParams& p, int l, unsigned char* lds) {
  const int b = (int)blockIdx.x;
  if (l == 0 && gridDim.x != 256) { const int per = (NTOK + (int)gridDim.x - 1) / (int)gridDim.x, r0 = b * per; int r1 = r0 + per; if (r1 > NTOK) r1 = NTOK; if (r0 < NTOK) ln1_rows(p, 0, r0, r1, lds); }
  else if (l == 0) {
    if (b < 32) { gemm_out_rows(p, 0, 0, NCTXR, lds); __syncthreads(); }
    const int r0 = NCTXR + (b < 32 ? b * 4 : 128 + (b - 32) * 73); int r1 = r0 + (b < 32 ? 4 : 73); if (r1 > NTOK) r1 = NTOK;
    if (r0 < NTOK) ln1_rows(p, 0, r0, r1, lds);
  } else { const int per = (NLAT + (int)gridDim.x - 1) / (int)gridDim.x, r0 = NCTXR + b * per; int r1 = r0 + per; if (r1 > NTOK) r1 = NTOK; if (r0 < NTOK) ln1_rows(p, l, r0, r1, lds); }
}

DEV unsigned f2ord(float f) { const unsigned u = __float_as_uint(f); return (u >> 31) ? ~u : (u | 0x80000000u); }
DEV float ord2f(unsigned o) { return __uint_as_float((o >> 31) ? (o & 0x7fffffffu) : ~o); }
DEV unsigned dppu_max(unsigned x, unsigned y) { return x > y ? x : y; }
template <int CTRL> DEV unsigned dppu(unsigned x) { return (unsigned)__builtin_amdgcn_mov_dpp((int)x, CTRL, 0xf, 0xf, true); }
DEV void topk_q(CParams& p, int l, int tile, int head, bf16x8 (&af)[2][4]) {
  const int tid = TIDX(), lane = tid & 63, wid = tid >> 6, fr = lane & 15, fq = lane >> 4;
  const int row0 = (l == 0 ? 0 : NCTXR) + tile * 128, g = head * 2 + (wid >> 2);
  const bf16_t* qp = WS(bf16_t, OFF_QP) + (size_t)(row0 + (wid & 3) * 32) * 2048 + g * 128 + fq * 8;
#pragma unroll
  for (int tm = 0; tm < 2; ++tm)
#pragma unroll
    for (int ks = 0; ks < 4; ++ks) af[tm][ks] = __builtin_bit_cast(bf16x8, ld8g(qp + (size_t)(tm * 16 + fr) * 2048 + ks * 32));
}
DEV void topk_unit(CParams& p, int l, int tile, int head, unsigned char* lds, const bf16x8 (&kf)[8][4], bf16x8 (&af)[2][4], int next_tile) {
  constexpr int RS = 136;
  unsigned* KEYSl = (unsigned*)lds;
  unsigned* LISTl = (unsigned*)(lds + 256 * RS * 4);
  const int tid = TIDX(), lane = tid & 63, wid = tid >> 6, fr = lane & 15, fq = lane >> 4;
  const int row0 = (l == 0 ? 0 : NCTXR) + tile * 128;
  __syncthreads();
  for (int r1_ = 0; r1_ < T1_REP; ++r1_)
  {
#pragma unroll
    for (int nt = 0; nt < 8; ++nt) { f32x4 a0 = {0.f, 0.f, 0.f, 0.f}, a1 = {0.f, 0.f, 0.f, 0.f};
#pragma unroll
      for (int ks = 0; ks < 4; ++ks) { a0 = __builtin_amdgcn_mfma_f32_16x16x32_bf16(kf[nt][ks], af[0][ks], a0, 0, 0, 0); a1 = __builtin_amdgcn_mfma_f32_16x16x32_bf16(kf[nt][ks], af[1][ks], a1, 0, 0, 0); }
      const int key0 = nt * 16 + fq * 4; const unsigned kb = 127u - (unsigned)key0; const int ko = key0 + (nt >= 4 ? 4 : 0);
      u32x4 w0, w1;
#pragma unroll
      for (int j = 0; j < 4; ++j) { w0[j] = (f2ord(a0[j]) & ~127u) | (kb - (unsigned)j); w1[j] = (f2ord(a1[j]) & ~127u) | (kb - (unsigned)j); }
      *(u32x4*)(KEYSl + (wid * 32 + fr) * RS + ko) = w0; *(u32x4*)(KEYSl + (wid * 32 + 16 + fr) * RS + ko) = w1; } }
  if (next_tile >= 0) topk_q(p, l, next_tile, head, af);
  __syncthreads();
  for (int r2_ = 0; r2_ < T2_REP; ++r2_)
  { const int row = tid >> 1, hf = tid & 1; const unsigned* kr = KEYSl + row * RS + hf * 68; unsigned m[4];
#pragma unroll
    for (int sg = 0; sg < 4; ++sg) { unsigned mm = 0u;
#pragma unroll
      for (int i = 0; i < 4; ++i) { const u32x4 x = *(const u32x4*)(kr + sg * 16 + i * 4); mm = max(max(mm, x[0]), max(x[1], max(x[2], x[3]))); }
      m[sg] = mm; }
#pragma unroll 1
    for (int r = 0; r < 16; ++r) { const unsigned lb = max(max(m[0], m[1]), max(m[2], m[3])); const unsigned best = max(lb, dppu<0xB1>(lb));
      if (hf == 0) LISTl[row * 16 + r] = best;
      if (lb == best) { const int sg = ((int)(127u - (best & 127u)) >> 4) & 3; unsigned nm = 0u;
#pragma unroll
        for (int i = 0; i < 4; ++i) { const u32x4 x = *(const u32x4*)(kr + sg * 16 + i * 4);
#pragma unroll
          for (int j = 0; j < 4; ++j) nm = max(nm, x[j] < best ? x[j] : 0u); }
#pragma unroll
        for (int s2 = 0; s2 < 4; ++s2) m[s2] = (s2 == sg) ? nm : m[s2]; } } }
  __syncthreads();
  for (int r3_ = 0; r3_ < T3_REP; ++r3_)
  { const int token = tid >> 2, role = tid & 3;
    const unsigned* L1 = LISTl + token * 16; const unsigned* L2 = LISTl + (128 + token) * 16;
    unsigned ck[16];
#pragma unroll
    for (int i = 0; i < 16; ++i) { int a, b; bool valid;
      if (role == 0) { a = 0; b = i; valid = true; }
      else if (role == 1) { a = i < 8 ? 1 : 2; b = i < 8 ? i : i - 8; valid = i < 13; }
      else if (role == 2) { a = i < 4 ? 3 : i < 7 ? 4 : i < 9 ? 5 : 6; b = i - (i < 4 ? 0 : i < 7 ? 4 : i < 9 ? 7 : 9); valid = i < 11; }
      else { a = i < 2 ? 7 : 6 + i; b = i < 2 ? i : 0; valid = i < 10; }
      if (!valid) { a = 0; b = 0; }
      const float v = ord2f(L1[a] & ~127u) + ord2f(L2[b] & ~127u);
      ck[i] = valid ? ((f2ord(v) & ~255u) | (unsigned)(255 - (a * 16 + b))) : 0u; }
    unsigned rec[4]; unsigned prev = 0xffffffffu;
#pragma unroll
    for (int r = 0; r < 16; ++r) { unsigned best = 0u;
#pragma unroll
      for (int i = 0; i < 16; ++i) best = max(best, ck[i] < prev ? ck[i] : 0u);
      best = max(best, dppu<0xB1>(best)); best = max(best, dppu<0x4E>(best));
      prev = best;
      if (role == (r & 3)) rec[r >> 2] = best; }
    float bv[4]; int be[4];
#pragma unroll
    for (int j = 0; j < 4; ++j) { const int t = 255 - (int)(rec[j] & 255u); const unsigned x1 = L1[t >> 4], x2 = L2[t & 15];
      bv[j] = ord2f(x1 & ~127u) + ord2f(x2 & ~127u); be[j] = (int)(127u - (x1 & 127u)) * 128 + (int)(127u - (x2 & 127u)); }
    const float v0 = dppf<0x00>(bv[0]);
    float sum = 0.f;
#pragma unroll
    for (int j = 0; j < 4; ++j) { bv[j] = __expf(bv[j] - v0); sum += bv[j]; }
    sum += dppf<0xB1>(sum); sum += dppf<0x4E>(sum);
    const float isum = 1.f / sum;
    const int row = row0 + token;
    int* eo = WS(int, OFF_EID) + (size_t)row * 128 + head * 16; float* go = WS(float, OFF_GATE) + (size_t)row * 128 + head * 16;
#pragma unroll
    for (int j = 0; j < 4; ++j) { eo[j * 4 + role] = be[j]; go[j * 4 + role] = bv[j] * isum; }
  }
  __syncthreads();
}
DEV void topk_keys(CParams& p, int l, int head, bf16x8 (&kf)[8][4]) { const int lane = TIDX() & 63, wid = TIDX() >> 6;
  const bf16_t* kp = WS(bf16_t, OFF_KEYS) + ((size_t)(l * 16 + head * 2 + (wid >> 2)) * 128) * 128 + (lane >> 4) * 8;
#pragma unroll
  for (int nt = 0; nt < 8; ++nt)
#pragma unroll
    for (int ks = 0; ks < 4; ++ks) kf[nt][ks] = __builtin_bit_cast(bf16x8, ld8g(kp + (size_t)(nt * 16 + (lane & 15)) * 128 + ks * 32)); }
DEV void ph_topk_l0(CParams& p, unsigned char* lds) {
  const int b = (int)blockIdx.x, head = b & 7, j = b >> 3;
  bf16x8 kf[8][4], af[2][4];
  if (b < 64) {
    pg8::OneUnit S{true, {j, head}};
    pg8::Gemm g{WS(bf16_t, OFF_H), WS(bf16_t, OFF_WPQ), NCTXR, 2048, 1024};
    EpiBf16 E{WS(bf16_t, OFF_QP), 2048, 2048}; pg8::gemm_phase((LAS unsigned char*)lds, g, S, E);
    asm volatile("s_waitcnt vmcnt(0)" ::: "memory"); __syncthreads();
    __builtin_amdgcn_fence(__ATOMIC_ACQUIRE, "agent"); asm volatile("s_waitcnt vmcnt(0)" ::: "memory");
    topk_keys(p, 0, head, kf); topk_q(p, 0, 2 * j, head, af);
    topk_unit(p, 0, 2 * j, head, lds, kf, af, 2 * j + 1); topk_unit(p, 0, 2 * j + 1, head, lds, kf, af, 16 + j);
    topk_unit(p, 0, 16 + j, head, lds, kf, af, -1);
  } else {
    const int t0 = 16 + 8 + (j - 8) * 5;
    topk_keys(p, 0, head, kf); topk_q(p, 0, t0, head, af);
#pragma unroll 1
    for (int i = 0; i < 5; ++i) topk_unit(p, 0, t0 + i, head, lds, kf, af, i < 4 ? t0 + i + 1 : -1);
  }
}
DEV void ph_topk(CParams& p, int l, unsigned char* lds) {
  if (l == 0 && gridDim.x == 256) { ph_topk_l0(p, lds); return; }
  const int ntile = (l == 0 ? NTOK : NLAT) / 128;
  bf16x8 kf[8][4], af[2][4]; int curh = -1; const int lane = TIDX() & 63, wid = TIDX() >> 6;
  if ((int)blockIdx.x < ntile * 8) topk_q(p, l, (int)blockIdx.x >> 3, (int)blockIdx.x & 7, af);
  for (int u = blockIdx.x; u < ntile * 8; u += gridDim.x) { const int head = u & 7;
    if (head != curh) { curh = head;
      const bf16_t* kp = WS(bf16_t, OFF_KEYS) + ((size_t)(l * 16 + head * 2 + (wid >> 2)) * 128) * 128 + (lane >> 4) * 8;
#pragma unroll
      for (int nt = 0; nt < 8; ++nt)
#pragma unroll
        for (int ks = 0; ks < 4; ++ks) kf[nt][ks] = __builtin_bit_cast(bf16x8, ld8g(kp + (size_t)(nt * 16 + (lane & 15)) * 128 + ks * 32)); }
    const int un = u + (int)gridDim.x; const bool pre = un < ntile * 8 && (un & 7) == head;
    topk_unit(p, l, u >> 3, head, lds, kf, af, pre ? un >> 3 : -1);
    if (!pre && un < ntile * 8) topk_q(p, l, un >> 3, un & 7, af); }
}

DEV float gelu_tanh(float x) { const float z = 0.7978845608f * (x + 0.044715f * x * x * x); const float t = 1.f - 2.f * __builtin_amdgcn_rcpf(1.f + __expf(2.f * z)); return 0.5f * x * (1.f + t); }
DEV void fp8x16_to_f32(u32x4 w, float* f) {
#pragma unroll
  for (int i = 0; i < 4; ++i) { const f32x2 a = __builtin_amdgcn_cvt_pk_f32_fp8((int)w[i], false), b = __builtin_amdgcn_cvt_pk_f32_fp8((int)w[i], true); f[4 * i] = a[0]; f[4 * i + 1] = a[1]; f[4 * i + 2] = b[0]; f[4 * i + 3] = b[1]; } }
DEV void fp4x32_to_f32(u32x4 w, float* f) {
#pragma unroll
  for (int i = 0; i < 4; ++i) {
    const f32x2 a = __builtin_amdgcn_cvt_scalef32_pk_f32_fp4(w[i], 1.0f, 0), b = __builtin_amdgcn_cvt_scalef32_pk_f32_fp4(w[i], 1.0f, 1), c = __builtin_amdgcn_cvt_scalef32_pk_f32_fp4(w[i], 1.0f, 2), d = __builtin_amdgcn_cvt_scalef32_pk_f32_fp4(w[i], 1.0f, 3);
    f[8 * i] = a[0]; f[8 * i + 1] = a[1]; f[8 * i + 2] = b[0]; f[8 * i + 3] = b[1]; f[8 * i + 4] = c[0]; f[8 * i + 5] = c[1]; f[8 * i + 6] = d[0]; f[8 * i + 7] = d[1]; } }
DEV void ph_gather(CParams& p, int l, unsigned char* lds) {
  const int tid = TIDX(), lane = tid & 63, wid = tid >> 6, dl = lane & 7, g = lane >> 3;
  const int rb = l == 0 ? 0 : NCTXR, ntok = NTOK - rb;
  const int per = (ntok + (int)gridDim.x - 1) / (int)gridDim.x, tb0 = (int)blockIdx.x * per;
  int* eidl = (int*)lds; float* gatel = (float*)(lds + 36864); float* dotl = (float*)(lds + 73728);
  const unsigned char* TU = WS(unsigned char, OFF_TABU); const unsigned char* TV = WS(unsigned char, OFF_TABV);
  bf16_t* Yb = WS(bf16_t, OFF_Y);
  float* pvec = (float*)(lds + 110592); int mr0;
  { const int ra = rb + tb0, rz = rb + (tb0 + per < ntok ? tb0 + per : ntok) - 1; mr0 = modrow_of(ra < NTOK ? ra : NTOK - 1); const int mr1 = modrow_of(rz < ra ? (ra < NTOK ? ra : NTOK - 1) : rz);
    __syncthreads();
    for (int i = tid; i < 2 * 5 * 256; i += NTHREADS) { const int set = i / 1280, r5 = (i - set * 1280) >> 8, c4 = (i & 255) * 4; const int mr = set ? mr1 : mr0;
      const float* s_ = r5 == 0 ? WS(float, OFF_MOD) + (size_t)(l * 9 + mr) * 6144 + 5120 : r5 == 1 ? p.in[I_LNFG] + l * 1024 : r5 == 2 ? p.in[I_LNFB] + l * 1024 : WS(float, OFF_MOD) + (size_t)(9 + mr) * 6144 + (r5 - 3) * 1024;
      *(f32x4*)(pvec + set * 5120 + r5 * 1024 + c4) = *(const f32x4*)(s_ + c4); }
    __syncthreads(); }
  for (int base = tb0; base < tb0 + per && base < ntok; base += 72) {
    int n = tb0 + per - base; if (n > 72) n = 72; if (n > ntok - base) n = ntok - base;
    const int row0 = rb + base;
    for (int grep_ = 0; grep_ < GREP; ++grep_) {
    __builtin_amdgcn_wave_barrier();
    for (int tk = wid; tk < n; tk += 8) { const size_t o = (size_t)(row0 + tk) * 128;
      eidl[tk * 128 + lane] = WS(int, OFF_EID)[o + lane]; eidl[tk * 128 + 64 + lane] = WS(int, OFF_EID)[o + 64 + lane];
      gatel[tk * 128 + lane] = WS(float, OFF_GATE)[o + lane]; gatel[tk * 128 + 64 + lane] = WS(float, OFF_GATE)[o + 64 + lane];
      dotl[tk * 128 + lane] = 0.f; dotl[tk * 128 + 64 + lane] = 0.f; }
    asm volatile("s_waitcnt lgkmcnt(0)" ::: "memory"); __builtin_amdgcn_wave_barrier();
#pragma unroll 1
    for (int s = 0; s < 4; ++s) {
#pragma unroll 1
      for (int tk = wid; tk < n; tk += 8) {
        float hx[32]; { const bf16_t* hp = WS(bf16_t, OFF_H) + (size_t)(row0 + tk) * 1024 + s * 256 + dl * 32; unpack8(ld8g(hp), hx); unpack8(ld8g(hp + 8), hx + 8); unpack8(ld8g(hp + 16), hx + 16); unpack8(ld8g(hp + 24), hx + 24); }
        const unsigned char* tus = TU + (size_t)s * 16384 * 128 + dl * 16; const int* el = eidl + tk * 128 + g; float* dp = dotl + tk * 128 + g;
        u32x4 wq[16];
#pragma unroll
        for (int ps = 0; ps < 16; ++ps) wq[ps] = *(const u32x4*)(tus + (size_t)el[ps * 8] * 128);
#pragma unroll
        for (int ps = 0; ps < 16; ++ps) { const u32x4 w = wq[ps]; f32x2 dd = {0.f, 0.f};
#pragma unroll
          for (int i = 0; i < 4; ++i) {
            dd += __builtin_amdgcn_cvt_scalef32_pk_f32_fp4(w[i], 1.0f, 0) * (f32x2){hx[8 * i], hx[8 * i + 1]}; dd += __builtin_amdgcn_cvt_scalef32_pk_f32_fp4(w[i], 1.0f, 1) * (f32x2){hx[8 * i + 2], hx[8 * i + 3]};
            dd += __builtin_amdgcn_cvt_scalef32_pk_f32_fp4(w[i], 1.0f, 2) * (f32x2){hx[8 * i + 4], hx[8 * i + 5]}; dd += __builtin_amdgcn_cvt_scalef32_pk_f32_fp4(w[i], 1.0f, 3) * (f32x2){hx[8 * i + 6], hx[8 * i + 7]}; }
          const float d = grp8_sum(dd[0] + dd[1]);
          if (dl == 0) dp[ps * 8] += d; } } }
    asm volatile("s_waitcnt lgkmcnt(0)" ::: "memory"); __builtin_amdgcn_wave_barrier();
    for (int tk = wid; tk < n; tk += 8) {
#pragma unroll
      for (int hh = 0; hh < 2; ++hh) { const int i = tk * 128 + hh * 64 + lane; dotl[i] = gatel[i] * gelu_tanh(dotl[i] * (1.f / 64.f)); } }
    asm volatile("s_waitcnt lgkmcnt(0)" ::: "memory"); __builtin_amdgcn_wave_barrier();
#pragma unroll 1
    for (int s = 0; s < 4; ++s) {
#pragma unroll 1
      for (int tk = wid; tk < n; tk += 8) {
        const unsigned char* tvs = TV + (size_t)s * 16384 * 128 + dl * 16; const int* el = eidl + tk * 128 + g; const float* cp = dotl + tk * 128 + g;
        f32x2 ac2[16];
#pragma unroll
        for (int j = 0; j < 16; ++j) ac2[j] = (f32x2){0.f, 0.f};
        u32x4 wq[16];
#pragma unroll
        for (int ps = 0; ps < 16; ++ps) wq[ps] = *(const u32x4*)(tvs + (size_t)el[ps * 8] * 128);
#pragma unroll
        for (int ps = 0; ps < 16; ++ps) { const u32x4 w = wq[ps]; const float cc = cp[ps * 8]; const f32x2 c2 = {cc, cc};
#pragma unroll
          for (int i = 0; i < 4; ++i) { ac2[4 * i] += c2 * __builtin_amdgcn_cvt_scalef32_pk_f32_fp4(w[i], 1.0f, 0); ac2[4 * i + 1] += c2 * __builtin_amdgcn_cvt_scalef32_pk_f32_fp4(w[i], 1.0f, 1);
            ac2[4 * i + 2] += c2 * __builtin_amdgcn_cvt_scalef32_pk_f32_fp4(w[i], 1.0f, 2); ac2[4 * i + 3] += c2 * __builtin_amdgcn_cvt_scalef32_pk_f32_fp4(w[i], 1.0f, 3); } }
        float acc[32];
#pragma unroll
        for (int j = 0; j < 16; ++j) { acc[2 * j] = ac2[j][0]; acc[2 * j + 1] = ac2[j][1]; }
        float r16[16], r8[8];
#pragma unroll
        for (int j = 0; j < 16; ++j) { auto rr = __builtin_amdgcn_permlane32_swap(__float_as_uint(acc[j]), __float_as_uint(acc[j + 16]), false, false); r16[j] = __uint_as_float(rr[0]) + __uint_as_float(rr[1]); }
#pragma unroll
        for (int j = 0; j < 8; ++j) { auto rr = __builtin_amdgcn_permlane16_swap(__float_as_uint(r16[j]), __float_as_uint(r16[j + 8]), false, false); r8[j] = __uint_as_float(rr[0]) + __uint_as_float(rr[1]); }
        const bool b3 = (lane & 8) != 0; f32x4 o;
#pragma unroll
        for (int j = 0; j < 4; ++j) { const float x = r8[j] + dppf<0x128>(r8[j]), y = r8[j + 4] + dppf<0x128>(r8[j + 4]); o[j] = (b3 ? y : x) * 0.25f; }
        u32x2 ow; ow[0] = pack2(o[0], o[1]); ow[1] = pack2(o[2], o[3]);
        *(u32x2*)(Yb + (size_t)(row0 + tk) * 1024 + s * 256 + dl * 32 + ((lane >> 5) & 1) * 16 + ((lane >> 4) & 1) * 8 + (b3 ? 4 : 0)) = ow; } }
    }
    asm volatile("s_waitcnt vmcnt(0)" ::: "memory"); __builtin_amdgcn_fence(__ATOMIC_ACQUIRE, "agent"); asm volatile("s_waitcnt vmcnt(0)" ::: "memory");
    u32x2 pyw[4], pxq[4];
    if (wid < n) { const bf16_t* xw0 = WS(bf16_t, OFF_XC) + (size_t)(row0 + wid) * 1024; const bf16_t* yr0 = Yb + (size_t)(row0 + wid) * 1024;
#pragma unroll
      for (int i = 0; i < 4; ++i) { const int col = lane * 4 + 256 * i; pyw[i] = *(const u32x2*)(yr0 + col); pxq[i] = *(const u32x2*)(xw0 + col); } }
#pragma unroll 1
    for (int tk = wid; tk < n; tk += 8) { const int row = row0 + tk;
      bf16_t* xw = WS(bf16_t, OFF_XC) + (size_t)row * 1024;
      const float* pl = pvec + (modrow_of(row) == mr0 ? 0 : 5120);
      u32x2 cyw[4], cxq[4];
#pragma unroll
      for (int i = 0; i < 4; ++i) { cyw[i] = pyw[i]; cxq[i] = pxq[i]; }
      if (tk + 8 < n) { const bf16_t* xwn = WS(bf16_t, OFF_XC) + (size_t)(row + 8) * 1024; const bf16_t* yrn = Yb + (size_t)(row + 8) * 1024;
#pragma unroll
        for (int i = 0; i < 4; ++i) { const int col = lane * 4 + 256 * i; pyw[i] = *(const u32x2*)(yrn + col); pxq[i] = *(const u32x2*)(xwn + col); } }
      f32x4 v[4]; float sm = 0.f;
#pragma unroll
      for (int i = 0; i < 4; ++i) { const int col = lane * 4 + 256 * i; const u32x2 yw = cyw[i], xq = cxq[i];
        const f32x4 xo = {lo16(xq[0]), hi16(xq[0]), lo16(xq[1]), hi16(xq[1])}, ya = {lo16(yw[0]), hi16(yw[0]), lo16(yw[1]), hi16(yw[1])};
        v[i] = xo * ALPHA + *(const f32x4*)(pl + col) * ya; sm += (v[i][0] + v[i][1]) + (v[i][2] + v[i][3]); }
      float mean = wave_sum(sm) * (1.f / 1024.f), q = 0.f;
#pragma unroll
      for (int i = 0; i < 4; ++i) { v[i] -= mean; q += (v[i][0] * v[i][0] + v[i][1] * v[i][1]) + (v[i][2] * v[i][2] + v[i][3] * v[i][3]); }
      float rstd = rsqrtf(wave_sum(q) * (1.f / 1024.f) + LN_EPS);
      sm = 0.f;
#pragma unroll
      for (int i = 0; i < 4; ++i) { const int col = lane * 4 + 256 * i; const f32x4 o = v[i] * rstd * *(const f32x4*)(pl + 1024 + col) + *(const f32x4*)(pl + 2048 + col);
        v[i] = o; sm += (o[0] + o[1]) + (o[2] + o[3]);
        if (l == 0) { u32x2 wx; wx[0] = pack2(o[0], o[1]); wx[1] = pack2(o[2], o[3]); *(u32x2*)(xw + col) = wx; }
        else if (row >= NCTXR) *(f32x4*)(p.out + (size_t)(row - NCTXR) * DM + col) = o; }
      if (l == 0) {
        mean = wave_sum(sm) * (1.f / 1024.f); q = 0.f;
#pragma unroll
        for (int i = 0; i < 4; ++i) { v[i] -= mean; q += (v[i][0] * v[i][0] + v[i][1] * v[i][1]) + (v[i][2] * v[i][2] + v[i][3] * v[i][3]); }
        rstd = rsqrtf(wave_sum(q) * (1.f / 1024.f) + LN_EPS);
#pragma unroll
        for (int i = 0; i < 4; ++i) { const int col = lane * 4 + 256 * i; const f32x4 o = v[i] * rstd * (*(const f32x4*)(pl + 4096 + col) + 1.f) + *(const f32x4*)(pl + 3072 + col);
          u32x2 w; w[0] = pack2(o[0], o[1]); w[1] = pack2(o[2], o[3]); *(u32x2*)(WS(bf16_t, OFF_H) + (size_t)row * 1024 + col) = w; }
      } }
  }
}

#if !MULTI_LAUNCH
__global__ __launch_bounds__(NTHREADS, 2) void mega(Params p_, int lo, int hi, int coop) {
  extern __shared__ __attribute__((aligned(16))) unsigned char shm[];
  volatile LAS unsigned* bst = (volatile LAS unsigned*)(LAS unsigned char*)(shm + LDS_BYTES - 32);
  if (TIDX() == 0) { bst[0] = 0u; bst[1] = 0u; }
  __syncthreads();
  { CParams* kp0 = (CParams*)__builtin_amdgcn_kernarg_segment_ptr(); xcd_barrier_post((unsigned*)(kp0->ws + OFF_BAR)); }
  for (int step = lo; step < hi; ++step) {
    CParams* kp = (CParams*)__builtin_amdgcn_kernarg_segment_ptr(); asm volatile("" : "+s"(kp)); CParams& p = *kp;
    if (step == 0) { ph_init(p, shm); if (REPSET == 25) { __syncthreads(); ph_init(p, shm); } }
    else { const int l = (step - 1) / 11, k = (step - 1) % 11;
      for (int rep = 0; rep < REPS[k]; ++rep) { if (rep > 0 && coop) xcd_barrier(WS(unsigned, OFF_BAR), bst);
      switch (k) {
        case 0: if (l == 0) ph_lnmod(p, 0); break;
        case 1: ph_gemm_in(p, l, shm); break;
        case 2: ph_prep(p, l, shm); break;
        case 3: ph_mid(p, l + 2 * rep, shm); break;
        case 4: ph_mix(p, l + 2 * rep, shm); break;
        case 5: ph_rwpost(p, l); break;
        case 6: ph_gemm_out(p, l, shm); break;
        case 7: ph_ln1(p, l, shm); break;
        case 8: ph_gemm_pq(p, l, shm); break;
        case 9: ph_topk(p, l, shm); break;
        case 10: ph_gather(p, l, shm); break;
      } } }
    if (coop && step + 1 < hi && step != 12) { if (lo < 0) cg::this_grid().sync(); else xcd_barrier(WS(unsigned, OFF_BAR), bst); }
    if (coop && step == 5) for (int xb_ = 0; xb_ < XBAR; ++xb_) xcd_barrier(WS(unsigned, OFF_BAR), bst);
  }
}
#endif

#if MULTI_LAUNCH
template <int K> __global__ __launch_bounds__(NTHREADS, 2) void phase_k(Params p_, int l) {
  extern __shared__ __attribute__((aligned(16))) unsigned char shm[];
  CParams& p = *(CParams*)__builtin_amdgcn_kernarg_segment_ptr();
  if constexpr (K == -1) ph_init(p, shm);
  if constexpr (K == 0) ph_lnmod(p, 0);
  if constexpr (K == 1) ph_gemm_in(p, l, shm);
  if constexpr (K == 2) ph_prep(p, l, shm);
  if constexpr (K == 3) ph_mid(p, l, shm);
  if constexpr (K == 4) ph_mix(p, l, shm);
  if constexpr (K == 5) ph_rwpost(p, l);
  if constexpr (K == 6) ph_gemm_out(p, l, shm);
  if constexpr (K == 7) ph_ln1(p, l, shm);
  if constexpr (K == 8) ph_gemm_pq(p, l, shm);
  if constexpr (K == 9) ph_topk(p, l, shm);
  if constexpr (K == 10) ph_gather(p, l, shm);
  if constexpr (K >= 30) ph_mid_t<K - 30>(p, l, shm);
}
template __global__ void phase_k<-1>(Params, int); template __global__ void phase_k<0>(Params, int); template __global__ void phase_k<1>(Params, int);
template __global__ void phase_k<2>(Params, int); template __global__ void phase_k<4>(Params, int);
template __global__ void phase_k<5>(Params, int); template __global__ void phase_k<6>(Params, int); template __global__ void phase_k<7>(Params, int);
template __global__ void phase_k<8>(Params, int); template __global__ void phase_k<31>(Params, int); template __global__ void phase_k<32>(Params, int); template __global__ void phase_k<34>(Params, int); template __global__ void phase_k<38>(Params, int); template __global__ void phase_k<9>(Params, int); template __global__ void phase_k<10>(Params, int);

#endif

extern "C" void kernel_launch(void* const* d_in, const int* in_sizes, int n_in, void* d_out, int out_size, void* d_ws, size_t ws_size, hipStream_t stream) {
  if (n_in < N_INPUTS || ws_size < WS_NEEDED) return;
  Params p{};
  for (int i = 0; i < N_INPUTS; ++i) p.in[i] = (const float*)d_in[i];
  p.out = (float*)d_out; p.ws = (unsigned char*)d_ws;
  static int grid = 0;
  if (!grid) {
    int dev = 0, cus = 0; (void)hipGetDevice(&dev); (void)hipDeviceGetAttribute(&cus, hipDeviceAttributeMultiprocessorCount, dev);
    grid = cus > 0 ? (cus > 256 ? 256 : cus) : 256;
#if !MULTI_LAUNCH
    (void)hipFuncSetAttribute((const void*)mega, hipFuncAttributeMaxDynamicSharedMemorySize, (int)LDS_BYTES);
    int per = 0; (void)hipOccupancyMaxActiveBlocksPerMultiprocessor(&per, mega, NTHREADS, LDS_BYTES);
    if (per < 1) grid = 0;
#endif
  }
  const int nsteps = 23;
#if MULTI_LAUNCH
#define LAUNCH_K(K, L) do { (void)hipFuncSetAttribute((const void*)phase_k<K>, hipFuncAttributeMaxDynamicSharedMemorySize, (int)LDS_BYTES); \
    hipLaunchKernelGGL(phase_k<K>, dim3(grid), dim3(NTHREADS), LDS_BYTES, stream, p, L); } while (0)
  (void)nsteps;
  LAUNCH_K(-1, 0);
  for (int l = 0; l < 2; ++l) {
    if (l == 0) LAUNCH_K(0, 0);
    LAUNCH_K(1, l); LAUNCH_K(2, l); LAUNCH_K(31, l); LAUNCH_K(32, l); LAUNCH_K(34, l); LAUNCH_K(38, l);
    LAUNCH_K(4, l); LAUNCH_K(5, l); LAUNCH_K(6, l); LAUNCH_K(7, l); LAUNCH_K(8, l); LAUNCH_K(9, l); LAUNCH_K(10, l);
  }
#else
  if (grid <= 0) return;
  (void)hipMemsetAsync((unsigned char*)d_ws + OFF_CNT, 0, SZ_CNT, stream);
  int lo = 0, hi = nsteps, coop = 1; void* args[] = {&p, &lo, &hi, &coop};
  (void)hipLaunchCooperativeKernel((const void*)mega, dim3(grid), dim3(NTHREADS), args, LDS_BYTES, stream);
#endif
}
```
